# Optimizing an MI355X kernel written in HIP

```python
import math
import jax, jax.numpy as jnp
from jax import lax
import numpy as np

D_MODEL = 1024
BATCH = 8
SEQ = 8192
DEPTH = 2

D_MIX = D_MODEL
HEAD = 64
C_HY = D_MIX // 2
C_RW = D_MIX - C_HY
N_HY_GROUPS = C_HY // HEAD
N_RW_HEADS = C_RW // HEAD
HY_ORDER = 2
HY_PROJ = (HY_ORDER + 1) * C_HY
HY_EMB = 33
HY_FILTER_WIDTH = 64
HY_TARGET = 1e-2
HY_FAST_PCT = 0.3
HY_SLOW_PCT = 1.5
RW_DECAY_LORA = 64
RW_AAA_LORA = 64
RW_GATE_LORA = 128
RW_MV_LORA = 32
RW_PROJ = 3 * C_RW + 2 * RW_DECAY_LORA + 2 * RW_AAA_LORA + RW_GATE_LORA
P_IN = HY_PROJ + RW_PROJ
D_FF = 4 * D_MODEL
RMS_EPS = 1e-5
GN_EPS = HEAD * 1e-5

kernel_name = 'hymba_hyena_rwkv7_bidir_encoder'


def f32(a):
    return a.astype(jnp.float32)


def rmsnorm(x, g):
    xf = f32(x)
    y = xf * lax.rsqrt(jnp.mean(xf * xf, axis=-1, keepdims=True) + RMS_EPS)
    return (y * f32(g)).astype(x.dtype)


def shift_prev(u):
    return jnp.pad(u, ((0, 0), (1, 0), (0, 0)))[:, :-1]


def shift_next(u):
    return jnp.pad(u, ((0, 0), (0, 1), (0, 0)))[:, 1:]


def hyena_filters(T, w1, b1, w2, b2, w3, b3, freq, w_out):
    pos = jnp.arange(T, dtype=jnp.float32)
    t = pos / max(T - 1, 1)
    bands = (HY_EMB - 1) // 2
    fr = jnp.linspace(1e-4, bands - 1, bands, dtype=jnp.float32)
    ang = (2.0 * math.pi / T) * pos[:, None] * fr[None, :]
    z = jnp.concatenate([t[:, None], jnp.cos(ang), -jnp.sin(ang)], axis=-1)
    h = jnp.sin(f32(freq[0]) * (z @ f32(w1) + f32(b1)))
    h = jnp.sin(f32(freq[1]) * (h @ f32(w2) + f32(b2)))
    h = jnp.sin(f32(freq[2]) * (h @ f32(w3) + f32(b3)))
    h = (h @ f32(w_out)).reshape(T, HY_ORDER, 2, C_HY)
    max_decay = math.log(HY_TARGET) / HY_FAST_PCT
    min_decay = math.log(HY_TARGET) / HY_SLOW_PCT
    delta = jnp.abs(jnp.linspace(min_decay, max_decay, C_HY, dtype=jnp.float32))
    window = jnp.exp(-t[:, None] * delta[None, :])
    h = h * window[:, None, None, :]
    fwd = h[:, :, 0]
    bwd = h[:, :, 1]
    two = jnp.concatenate([fwd, jnp.zeros_like(fwd[:1]), bwd[1:][::-1]], axis=0)
    two = two * lax.rsqrt(jnp.sum(two * two, axis=0, keepdims=True) + 1e-6)
    return jnp.fft.rfft(two, axis=0)


def long_conv(u, h_f, skip):
    T = u.shape[1]
    y = jnp.fft.irfft(jnp.fft.rfft(u, n=2 * T, axis=1) * h_f[None], n=2 * T, axis=1)[:, :T]
    return y + u * f32(skip)


def hyena_mixer(p, conv_w, conv_b, fw1, fb1, fw2, fb2, fw3, fb3, ffreq, fwout, skip, norm_g):
    B, T, _ = p.shape
    pf = f32(p)
    cw = f32(conv_w)
    u = cw[0] * shift_prev(pf) + cw[1] * pf + cw[2] * shift_next(pf) + f32(conv_b)
    x1, x2, v = jnp.split(u, 3, axis=-1)
    h_f = hyena_filters(T, fw1, fb1, fw2, fb2, fw3, fb3, ffreq, fwout)
    z = x1 * long_conv(v, h_f[:, 0], skip[0])
    z = x2 * long_conv(z, h_f[:, 1], skip[1])
    zg = z.reshape(B, T, N_HY_GROUPS, HEAD)
    zg = zg * lax.rsqrt(jnp.mean(zg * zg, axis=-1, keepdims=True) + RMS_EPS)
    return (zg.reshape(B, T, C_HY) * f32(norm_g)).astype(p.dtype)


def wkv7_scan(r, decay, k, v, kk, a, reverse):
    B, T, H, N = r.shape

    def step(S, inp):
        r_t, w_t, k_t, v_t, kk_t, a_t = inp
        sa = jnp.einsum('bhvk,bhk->bhv', S, -kk_t)
        S = (S * w_t[:, :, None, :] + sa[..., None] * (kk_t * a_t)[:, :, None, :]
             + v_t[..., None] * k_t[:, :, None, :])
        return S, jnp.einsum('bhvk,bhk->bhv', S, r_t)

    S0 = jnp.zeros((B, H, N, N), jnp.float32)
    xs = tuple(jnp.moveaxis(z, 1, 0) for z in (r, decay, k, v, kk, a))
    _, ys = lax.scan(step, S0, xs, reverse=reverse)
    return jnp.moveaxis(ys, 0, 1)


def rwkv7_mixer(p, hn, v_first, shift, w0, w2, a0, a2, g2, k_k, k_a, r_k, lnx_g, lnx_b, vres):
    B, T, _ = p.shape
    out_dtype = p.dtype
    pf = f32(p)
    mu = f32(shift)
    pf = pf + mu[0] * (shift_prev(pf) - pf) + mu[1] * (shift_next(pf) - pf)
    cuts = [C_RW, 2 * C_RW, 3 * C_RW, 3 * C_RW + 2 * RW_DECAY_LORA,
            3 * C_RW + 2 * RW_DECAY_LORA + 2 * RW_AAA_LORA]
    r, k, v, wd, ad, gd = jnp.split(pf, cuts, axis=-1)
    if vres is None:
        v_first = v
    else:
        v0, v1, v2 = vres
        v = v + (v_first - v) * jax.nn.sigmoid(f32(v0) + (f32(hn) @ f32(v1)) @ f32(v2))
    g = jax.nn.sigmoid(gd) @ f32(g2)

    def heads(z):
        return z.reshape(B, T, N_RW_HEADS, HEAD)

    kk = heads(k * f32(k_k))
    kk = kk / jnp.maximum(jnp.linalg.norm(kk, axis=-1, keepdims=True), 1e-12)
    vh = heads(v)
    states = []
    bonuses = []
    for d in range(2):
        wd_d = wd[..., d * RW_DECAY_LORA:(d + 1) * RW_DECAY_LORA]
        ad_d = ad[..., d * RW_AAA_LORA:(d + 1) * RW_AAA_LORA]
        w = -jax.nn.softplus(-(f32(w0[d]) + jnp.tanh(wd_d) @ f32(w2[d]))) - 0.5
        decay = jnp.exp(-jnp.exp(w))
        a = jax.nn.sigmoid(f32(a0[d]) + ad_d @ f32(a2[d]))
        k_d = k * (1.0 + (a - 1.0) * f32(k_a))
        states.append(wkv7_scan(heads(r), heads(decay), heads(k_d), vh, kk, heads(a), d == 1))
        bonuses.append(jnp.sum(heads(r * k_d * f32(r_k)), axis=-1, keepdims=True) * vh)
    s = states[0] + states[1]
    mean = jnp.mean(s, axis=-1, keepdims=True)
    var = jnp.mean(jnp.square(s - mean), axis=-1, keepdims=True)
    s = (s - mean) * lax.rsqrt(var + GN_EPS)
    y = s.reshape(B, T, C_RW) * f32(lnx_g) + f32(lnx_b)
    y = y + (bonuses[0] + bonuses[1]).reshape(B, T, C_RW)
    return (y * g).astype(out_dtype), v_first


def setup_inputs(seed: int = 0) -> dict:
    key = jax.random.key(seed)
    ks = iter(jax.random.split(key, 48))

    def nrm(shape, scale):
        return scale * jax.random.normal(next(ks), shape, jnp.float32)

    def uni(shape, lo, hi):
        return jax.random.uniform(next(ks), shape, jnp.float32, lo, hi)

    L = DEPTH
    ratio = jnp.arange(C_RW, dtype=jnp.float32) / (C_RW - 1)
    decay_base = -6.0 + 5.0 * ratio ** 0.9
    return {
        'x': nrm((BATCH, SEQ, D_MODEL), 1.0),
        'norm1_g': 1.0 + nrm((L, D_MODEL), 0.02),
        'w_in': nrm((L, D_MODEL, P_IN), D_MODEL ** -0.5),
        'hy_conv_w': nrm((L, 3, HY_PROJ), 3 ** -0.5),
        'hy_conv_b': nrm((L, HY_PROJ), 0.02),
        'hy_f_w1': nrm((L, HY_EMB, HY_FILTER_WIDTH), HY_EMB ** -0.5),
        'hy_f_b1': nrm((L, HY_FILTER_WIDTH), 0.1),
        'hy_f_w2': nrm((L, HY_FILTER_WIDTH, HY_FILTER_WIDTH), HY_FILTER_WIDTH ** -0.5),
        'hy_f_b2': nrm((L, HY_FILTER_WIDTH), 0.1),
        'hy_f_w3': nrm((L, HY_FILTER_WIDTH, HY_FILTER_WIDTH), HY_FILTER_WIDTH ** -0.5),
        'hy_f_b3': nrm((L, HY_FILTER_WIDTH), 0.1),
        'hy_f_freq': 1.0 + nrm((L, 3, HY_FILTER_WIDTH), 0.1),
        'hy_f_wout': nrm((L, HY_FILTER_WIDTH, HY_ORDER * 2 * C_HY), HY_FILTER_WIDTH ** -0.5),
        'hy_skip': nrm((L, HY_ORDER, C_HY), 0.5),
        'hy_norm_g': 1.0 + nrm((L, C_HY), 0.02),
        'rw_shift': uni((L, 2, RW_PROJ), 0.0, 0.5),
        'rw_w0': decay_base + nrm((L, 2, C_RW), 0.1),
        'rw_w2': nrm((L, 2, RW_DECAY_LORA, C_RW), 0.1),
        'rw_a0': nrm((L, 2, C_RW), 0.1),
        'rw_a2': nrm((L, 2, RW_AAA_LORA, C_RW), 0.1),
        'rw_g2': nrm((L, RW_GATE_LORA, C_RW), RW_GATE_LORA ** -0.5),
        'rw_k_k': 0.85 + nrm((L, C_RW), 0.02),
        'rw_k_a': 1.0 + nrm((L, C_RW), 0.02),
        'rw_r_k': nrm((L, C_RW), 0.1),
        'rw_lnx_g': 1.0 + nrm((L, C_RW), 0.02),
        'rw_lnx_b': nrm((L, C_RW), 0.02),
        'rw_v0': 1.0 + nrm((L - 1, C_RW), 0.1),
        'rw_v1': nrm((L - 1, D_MODEL, RW_MV_LORA), D_MODEL ** -0.5),
        'rw_v2': nrm((L - 1, RW_MV_LORA, C_RW), 0.1),
        'w_out': nrm((L, D_MIX, D_MODEL), D_MIX ** -0.5),
        'norm2_g': 1.0 + nrm((L, D_MODEL), 0.02),
        'mlp_w1': nrm((L, D_MODEL, D_FF), D_MODEL ** -0.5),
        'mlp_w2': nrm((L, D_FF, D_MODEL), D_FF ** -0.5),
        'final_g': 1.0 + nrm((D_MODEL,), 0.02),
    }


def reference(x, norm1_g, w_in, hy_conv_w, hy_conv_b, hy_f_w1, hy_f_b1, hy_f_w2, hy_f_b2,
              hy_f_w3, hy_f_b3, hy_f_freq, hy_f_wout, hy_skip, hy_norm_g, rw_shift, rw_w0, rw_w2,
              rw_a0, rw_a2, rw_g2, rw_k_k, rw_k_a, rw_r_k, rw_lnx_g, rw_lnx_b, rw_v0, rw_v1, rw_v2,
              w_out, norm2_g, mlp_w1, mlp_w2, final_g):
    v_first = None
    for l in range(DEPTH):
        hn = rmsnorm(x, norm1_g[l])
        p = hn @ w_in[l]
        p_hy, p_rw = p[..., :HY_PROJ], p[..., HY_PROJ:]
        y_hy = hyena_mixer(p_hy, hy_conv_w[l], hy_conv_b[l], hy_f_w1[l], hy_f_b1[l], hy_f_w2[l],
                           hy_f_b2[l], hy_f_w3[l], hy_f_b3[l], hy_f_freq[l], hy_f_wout[l],
                           hy_skip[l], hy_norm_g[l])
        vres = None if l == 0 else (rw_v0[l - 1], rw_v1[l - 1], rw_v2[l - 1])
        y_rw, v_first = rwkv7_mixer(p_rw, hn, v_first, rw_shift[l], rw_w0[l], rw_w2[l], rw_a0[l],
                                    rw_a2[l], rw_g2[l], rw_k_k[l], rw_k_a[l], rw_r_k[l],
                                    rw_lnx_g[l], rw_lnx_b[l], vres)
        x = x + (jnp.concatenate([y_hy, y_rw], axis=-1) @ w_out[l]).astype(x.dtype)
        hn = rmsnorm(x, norm2_g[l])
        x = x + (jnp.square(jax.nn.relu(hn @ mlp_w1[l])) @ mlp_w2[l]).astype(x.dtype)
    return rmsnorm(x, final_g)
```

```cpp
#include <hip/hip_runtime.h>
#include <cstdio>
#include <cstdint>
namespace pg8 {
#define PG8_LAS __attribute__((address_space(3)))
typedef unsigned short bf16_t;
typedef short bf16x8 __attribute__((ext_vector_type(8)));
typedef float f32x4 __attribute__((ext_vector_type(4)));
typedef int i32x4 __attribute__((ext_vector_type(4)));
template <bool I8> struct AccT { typedef f32x4 t; };
template <> struct AccT<true> { typedef i32x4 t; };
typedef unsigned u32x4 __attribute__((ext_vector_type(4)));
constexpr int BM = 256, BK = 64, HALF = 128, HTB = HALF * BK * 2  , STAGE_BYTES = 8 * HTB, NXCD = 8, WGM = 8;

__host__ __device__ __forceinline__ int lds_byte(int r, int c) { const int st = (r >> 4) * 2 + (c >> 5), rr = r & 15, cc = c & 31, ob = rr * 64 + cc * 2; return st * 1024 + (ob ^ (((ob >> 9) & 1) << 5)); }
__host__ __device__ __forceinline__ void stage_rc(int b, int& R, int& C) { const int st = b / 1024, sb = b % 1024, swz = sb ^ (((sb >> 9) & 1) << 5); R = (st >> 1) * 16 + swz / 64; C = (st & 1) * 32 + (swz % 64) / 2; }
__host__ __device__ __forceinline__ int perm32(int rho) { const int n = rho >> 4, i = rho & 15; return 8 * (i >> 2) + 4 * n + (i & 3); }

struct Unit { int pm, pn; };
struct Gemm { const bf16_t* A; const bf16_t* Bt; int M, N, K; };

struct StaticOrder {
    int nM, nN, nwg, G, c;
    __host__ __device__ void init(int M, int N, int G_, int c_) { nM = M / BM; nN = N / BM; nwg = nM * nN; G = G_; c = c_; }
    __host__ __device__ bool next(int i, Unit& u) const {
        const long L = (long)i * G + c; if (L >= nwg) return false;
        int wgid = (int)L; { const int q = nwg / NXCD, r = nwg % NXCD, xcd = wgid % NXCD, off = wgid / NXCD; wgid = (xcd < r ? xcd * (q + 1) : r * (q + 1) + (xcd - r) * q) + off; }
        const int nig = WGM * nN, gid = wgid / nig, fm = gid * WGM, gsz = (nM - fm) < WGM ? (nM - fm) : WGM;
        u.pm = fm + ((wgid % nig) % gsz); u.pn = (wgid % nig) / gsz; return true;
    }
    __device__ __forceinline__ void a_ready(const Unit&) const {}
    __device__ __forceinline__ void done(const Unit&) const {}
};
typedef float f32x2e __attribute__((ext_vector_type(2))); typedef __bf16 bf16x2e __attribute__((ext_vector_type(2)));
__device__ __forceinline__ unsigned cvt_pk_bf16(float lo, float hi) { return __builtin_bit_cast(unsigned, __builtin_convertvector((f32x2e){lo, hi}, bf16x2e)); }
template <int ACT> struct EpiBf16 {
    static constexpr bool PERM = true, AFTER_DRAIN = false, I8 = false;
    bf16_t* O; size_t ldc; size_t bstride = 0; int tshift = 31;
    __device__ __forceinline__ void operator()(const f32x4 (&acc)[2][2][4][2], const Unit& u, int wr, int wc, int fr, int fq) const {
        const int row0 = u.pm * BM + wr * 64 + fr; const int cb = u.pn * BM; const size_t col0 = (size_t)(cb >> tshift) * bstride + (size_t)(cb & ((1 << tshift) - 1)) + wc * 32 + 8 * fq;
#pragma unroll
        for (int ai = 0; ai < 2; ++ai)
#pragma unroll
            for (int m = 0; m < 4; ++m) { bf16_t* rowp = O + (size_t)(row0 + ai * HALF + m * 16) * ldc + col0;
#pragma unroll
                for (int bj = 0; bj < 2; ++bj) { f32x4 v0 = acc[ai][bj][m][0], v1 = acc[ai][bj][m][1];
                    if (ACT == 1) {
#pragma unroll
                        for (int j = 0; j < 4; ++j) { const float a = fmaxf(v0[j], 0.f), b = fmaxf(v1[j], 0.f); v0[j] = a * a; v1[j] = b * b; } }
                    u32x4 w; w.x = cvt_pk_bf16(v0[0], v0[1]); w.y = cvt_pk_bf16(v0[2], v0[3]); w.z = cvt_pk_bf16(v1[0], v1[1]); w.w = cvt_pk_bf16(v1[2], v1[3]);
                    *(u32x4*)(rowp + bj * HALF) = w;
                    } }
    }
};
struct EpiBf16Q {
    static constexpr bool PERM = true, AFTER_DRAIN = false, I8 = true;
    bf16_t* O; size_t ldc; size_t bstride; int tshift; const float* rs; const float* cs;
    __device__ __forceinline__ void operator()(const i32x4 (&acc)[2][2][4][2], const Unit& u, int wr, int wc, int fr, int fq) const {
        const int row0 = u.pm * BM + wr * 64 + fr; const int cb = u.pn * BM, ci0 = cb + wc * 32 + 8 * fq;
        const size_t col0 = (size_t)(cb >> tshift) * bstride + (size_t)(cb & ((1 << tshift) - 1)) + wc * 32 + 8 * fq;
        f32x4 cv[2][2];
#pragma unroll
        for (int bj = 0; bj < 2; ++bj) { cv[bj][0] = *(const f32x4*)(cs + ci0 + bj * HALF); cv[bj][1] = *(const f32x4*)(cs + ci0 + bj * HALF + 4); }
#pragma unroll
        for (int ai = 0; ai < 2; ++ai)
#pragma unroll
            for (int m = 0; m < 4; ++m) { const int row = row0 + ai * HALF + m * 16; bf16_t* rowp = O + (size_t)row * ldc + col0; const float r = rs[row];
#pragma unroll
                for (int bj = 0; bj < 2; ++bj) { const i32x4 a0 = acc[ai][bj][m][0], a1 = acc[ai][bj][m][1];
                    const f32x4 v0 = (f32x4){(float)a0[0], (float)a0[1], (float)a0[2], (float)a0[3]} * r * cv[bj][0], v1 = (f32x4){(float)a1[0], (float)a1[1], (float)a1[2], (float)a1[3]} * r * cv[bj][1];
                    u32x4 w; w.x = cvt_pk_bf16(v0[0], v0[1]); w.y = cvt_pk_bf16(v0[2], v0[3]); w.z = cvt_pk_bf16(v1[0], v1[1]); w.w = cvt_pk_bf16(v1[2], v1[3]);
                    *(u32x4*)(rowp + bj * HALF) = w; } }
    }
};
__device__ __forceinline__ float rss16(const float* p) { const f32x4 a = *(const f32x4*)p, b = *(const f32x4*)(p + 4), c = *(const f32x4*)(p + 8), d = *(const f32x4*)(p + 12);
    return (((a[0] + a[1]) + (a[2] + a[3])) + ((b[0] + b[1]) + (b[2] + b[3]))) + (((c[0] + c[1]) + (c[2] + c[3])) + ((d[0] + d[1]) + (d[2] + d[3]))); }
template <int MODE, bool RB16> struct EpiRes {
    static constexpr bool PERM = true, AFTER_DRAIN = false, I8 = false;
    const float* R; const bf16_t* RB; bf16_t* O; int ldc; float* rss;
    __device__ __forceinline__ void operator()(const f32x4 (&acc)[2][2][4][2], const Unit& u, int wr, int wc, int fr, int fq) const {
        const int row0 = u.pm * BM + wr * 64 + fr, col0 = u.pn * BM + wc * 32 + 8 * fq;
#pragma unroll
        for (int ai = 0; ai < 2; ++ai)
#pragma unroll
            for (int m = 0; m < 4; ++m) { const int row = row0 + ai * HALF + m * 16; const size_t off = (size_t)row * ldc + col0;
                f32x4 rv[2][2]; float ss = 0.f, sc = 1.0f;
                if (MODE == 2) sc = __builtin_amdgcn_rcpf(rss16(rss + (size_t)row * 16) * (1.0f / 1024.0f) + 1e-5f);
#pragma unroll
                for (int bj = 0; bj < 2; ++bj) {
                    if (RB16) { const u32x4 w = *(const u32x4*)(RB + off + bj * HALF);
                        rv[bj][0] = (f32x4){__builtin_bit_cast(float, w.x << 16), __builtin_bit_cast(float, w.x & 0xffff0000u), __builtin_bit_cast(float, w.y << 16), __builtin_bit_cast(float, w.y & 0xffff0000u)};
                        rv[bj][1] = (f32x4){__builtin_bit_cast(float, w.z << 16), __builtin_bit_cast(float, w.z & 0xffff0000u), __builtin_bit_cast(float, w.w << 16), __builtin_bit_cast(float, w.w & 0xffff0000u)}; }
                    else { rv[bj][0] = *(const f32x4*)(R + off + bj * HALF); rv[bj][1] = *(const f32x4*)(R + off + bj * HALF + 4); } }
#pragma unroll
                for (int bj = 0; bj < 2; ++bj) { f32x4 o0 = acc[ai][bj][m][0], o1 = acc[ai][bj][m][1];
                    if (MODE == 2) { o0 = o0 * sc; o1 = o1 * sc; }
                    o0 = o0 + rv[bj][0]; o1 = o1 + rv[bj][1];
                    if (MODE == 1) ss += ((o0[0] * o0[0] + o0[1] * o0[1]) + (o0[2] * o0[2] + o0[3] * o0[3])) + ((o1[0] * o1[0] + o1[1] * o1[1]) + (o1[2] * o1[2] + o1[3] * o1[3]));
                    u32x4 w; w.x = cvt_pk_bf16(o0[0], o0[1]); w.y = cvt_pk_bf16(o0[2], o0[3]); w.z = cvt_pk_bf16(o1[0], o1[1]); w.w = cvt_pk_bf16(o1[2], o1[3]);
                    *(u32x4*)(O + off + bj * HALF) = w; }
                if (MODE == 1) { ss += __shfl_xor(ss, 16); ss += __shfl_xor(ss, 32); if (fq == 0) rss[(size_t)row * 16 + u.pn * 4 + wc] = ss; }
                asm volatile("" ::: "memory"); }
    }
};

template <bool I8> __device__ __forceinline__ typename AccT<I8>::t pg8_mma16(const bf16x8& a, const bf16x8& b, const typename AccT<I8>::t& c) {
    if constexpr (I8) return __builtin_amdgcn_mfma_i32_16x16x64_i8(__builtin_bit_cast(i32x4, a), __builtin_bit_cast(i32x4, b), c, 0, 0, 0);
    else return __builtin_amdgcn_mfma_f32_16x16x32_bf16(a, b, c, 0, 0, 0);
}
template <class Epi, class Sched, bool ALIGN_EPI = false, bool SP2 = false>
__device__ __forceinline__ void gemm_phase(PG8_LAS unsigned char* lds, const Gemm g, const Sched& S, const Epi& E) {
    int tid = threadIdx.x; asm volatile("" : "+v"(tid));
    const int wid = __builtin_amdgcn_readfirstlane(tid >> 6), lane = tid & 63, wr = wid >> 2, wc = wid & 3, fr = lane & 15, fq = lane >> 4;
    const int K = g.K, nt = K / BK;
    unsigned voffA[2], voffB[2];
#pragma unroll
    for (int i = 0; i < 2; ++i) { int R, C; stage_rc(tid * 16 + i * 8192, R, C); const int Rb = Epi::PERM ? ((R & ~31) + perm32(R & 31)) : R;
        voffA[i] = (unsigned)(R * K + C) * 2u; voffB[i] = (unsigned)(Rb * K + C) * 2u; }
    const size_t kstep = (size_t)(BK * 2);
    const size_t hstep = (size_t)HALF * K * 2;
    const size_t tstep = 2 * hstep;
    const unsigned ldsw = (unsigned)wid * 1024u;
    const int aoff = lds_byte(wr * 64 + fr, fq * 8), boff = lds_byte(wc * 32 + fr, fq * 8);
#define PG8_SA(b, h) (((b) * 2 + (h)) * HTB)
#define PG8_SB(b, h) ((4 + (b) * 2 + (h)) * HTB)
#define PG8_STAGE(bufoff, gbase, voff) do { _Pragma("unroll") for (int _i = 0; _i < 2; ++_i) \
        __builtin_amdgcn_global_load_lds((const unsigned*)((const char*)(gbase) + (voff)[_i]), (PG8_LAS unsigned*)(lds + (bufoff) + ldsw + _i * 8192), 16, 0, 0); } while (0)
#define PG8_LDA(dst, b, h) do { _Pragma("unroll") for (int m = 0; m < 4; ++m) _Pragma("unroll") for (int k = 0; k < 2; ++k) dst[m][k] = *(const PG8_LAS bf16x8*)(lds + PG8_SA(b, h) + aoff + m * 2048 + k * 1024); } while (0)
#define PG8_LDB(dst, b, h) do { _Pragma("unroll") for (int n = 0; n < 2; ++n) _Pragma("unroll") for (int k = 0; k < 2; ++k) dst[n][k] = *(const PG8_LAS bf16x8*)(lds + PG8_SB(b, h) + boff + n * 2048 + k * 1024); } while (0)
#define PG8_MMA(ai, bj, At, Bt) do { __builtin_amdgcn_s_setprio(1); _Pragma("unroll") for (int m = 0; m < 4; ++m) _Pragma("unroll") for (int n = 0; n < 2; ++n) _Pragma("unroll") for (int k = 0; k < 2; ++k) \
        acc[ai][bj][m][n] = pg8_mma16<Epi::I8>(Bt[n][k], At[m][k], acc[ai][bj][m][n]); __builtin_amdgcn_s_setprio(0); } while (0)
#define PG8_WAIT_V(n) asm volatile("s_waitcnt vmcnt(" #n ")" ::: "memory")
#define PG8_WAIT_L(n) asm volatile("s_waitcnt lgkmcnt(" #n ")" ::: "memory")
#define PG8_BAR __builtin_amdgcn_s_barrier()
#define PG8_SCHED __builtin_amdgcn_sched_barrier(0)
    Unit cur, nxt; int ui = 0;
    if (!S.next(0, cur)) return;
    typedef typename AccT<Epi::I8>::t acc_t;
    acc_t acc[2][2][4][2];
#pragma unroll
    for (int a = 0; a < 2; ++a)
#pragma unroll
        for (int b = 0; b < 2; ++b)
#pragma unroll
            for (int m = 0; m < 4; ++m)
#pragma unroll
                for (int n = 0; n < 2; ++n) acc[a][b][m][n] = (acc_t){0, 0, 0, 0};
    bf16x8 At[4][2], B0[2][2], B1[2][2];
    const char* cA = (const char*)g.A + (size_t)cur.pm * tstep; const char* cB = (const char*)g.Bt + (size_t)cur.pn * tstep;
    S.a_ready(cur);
    if constexpr (SP2) {
        PG8_STAGE(PG8_SB(0, 0), cB, voffB); PG8_STAGE(PG8_SB(0, 1), cB + hstep, voffB); PG8_STAGE(PG8_SA(0, 0), cA, voffA); PG8_STAGE(PG8_SA(0, 1), cA + hstep, voffA);
        if (wr == 1) PG8_BAR;
        PG8_WAIT_V(2); PG8_BAR;
        PG8_STAGE(PG8_SB(1, 0), cB + kstep, voffB); PG8_STAGE(PG8_SA(1, 0), cA + kstep, voffA); PG8_STAGE(PG8_SB(1, 1), cB + hstep + kstep, voffB);
        PG8_WAIT_V(6); PG8_BAR;
    } else {
        PG8_STAGE(PG8_SB(0, 0), cB, voffB); PG8_STAGE(PG8_SA(0, 0), cA, voffA); PG8_STAGE(PG8_SB(0, 1), cB + hstep, voffB); PG8_STAGE(PG8_SA(0, 1), cA + hstep, voffA);
        if (wr == 1) PG8_BAR;
        PG8_WAIT_V(4); PG8_BAR;
        PG8_STAGE(PG8_SB(1, 0), cB + kstep, voffB); PG8_STAGE(PG8_SA(1, 0), cA + kstep, voffA); PG8_STAGE(PG8_SB(1, 1), cB + hstep + kstep, voffB);
        PG8_WAIT_V(6); PG8_BAR;
    }
    for (;;) {
        const bool has_next = S.next(ui + 1, nxt);
        const char* nA = has_next ? (const char*)g.A + (size_t)nxt.pm * tstep : cA; const char* nB = has_next ? (const char*)g.Bt + (size_t)nxt.pn * tstep : cB;
        for (int t = 0; t < nt; t += 2) {
            const bool last = (t == nt - 2);
            const char* a1 = cA + (size_t)(t + 1) * kstep;
            const char* a2 = last ? nA : cA + (size_t)(t + 2) * kstep; const char* b2 = last ? nB : cB + (size_t)(t + 2) * kstep;
            const char* a3 = a2 + kstep; const char* b3 = b2 + kstep;
            if (last && has_next) S.a_ready(nxt);
            if constexpr (SP2) {
            PG8_LDB(B0, 0, 0); PG8_LDB(B1, 0, 1); PG8_SCHED; PG8_LDA(At, 0, 0); PG8_STAGE(PG8_SA(1, 1), a1 + hstep, voffA);
            PG8_WAIT_V(8); PG8_WAIT_L(0); PG8_BAR; PG8_MMA(0, 0, At, B0); PG8_MMA(0, 1, At, B1); PG8_BAR; PG8_SCHED;
            PG8_LDA(At, 0, 1); PG8_STAGE(PG8_SB(0, 0), b2, voffB); PG8_STAGE(PG8_SB(0, 1), b2 + hstep, voffB); PG8_STAGE(PG8_SA(0, 0), a2, voffA);
            PG8_WAIT_V(8); PG8_WAIT_L(0); PG8_BAR; PG8_MMA(1, 0, At, B0); PG8_MMA(1, 1, At, B1); PG8_BAR; PG8_SCHED;
            PG8_LDB(B0, 1, 0); PG8_LDB(B1, 1, 1); PG8_SCHED; PG8_LDA(At, 1, 0); PG8_STAGE(PG8_SA(0, 1), a2 + hstep, voffA);
            PG8_WAIT_V(8); PG8_WAIT_L(0); PG8_BAR; PG8_MMA(0, 0, At, B0); PG8_MMA(0, 1, At, B1); PG8_BAR; PG8_SCHED;
            PG8_LDA(At, 1, 1); PG8_STAGE(PG8_SB(1, 0), b3, voffB); PG8_STAGE(PG8_SB(1, 1), b3 + hstep, voffB); PG8_STAGE(PG8_SA(1, 0), a3, voffA);
            PG8_WAIT_V(8); PG8_WAIT_L(0); PG8_BAR; PG8_MMA(1, 0, At, B0); PG8_MMA(1, 1, At, B1); PG8_BAR; PG8_SCHED;
            } else {
            PG8_LDB(B0, 0, 0); PG8_SCHED; PG8_LDA(At, 0, 0); PG8_STAGE(PG8_SA(1, 1), a1 + hstep, voffA);
            PG8_WAIT_L(8); PG8_BAR; PG8_WAIT_L(0); PG8_MMA(0, 0, At, B0); PG8_BAR; PG8_SCHED;
            PG8_LDB(B1, 0, 1); PG8_STAGE(PG8_SB(0, 0), b2, voffB);
            PG8_BAR; PG8_WAIT_L(0); PG8_MMA(0, 1, At, B1); PG8_BAR;
            PG8_LDA(At, 0, 1); PG8_STAGE(PG8_SA(0, 0), a2, voffA);
            PG8_BAR; PG8_WAIT_L(0); PG8_MMA(1, 0, At, B0); PG8_BAR; PG8_SCHED;
            PG8_STAGE(PG8_SB(0, 1), b2 + hstep, voffB);
            PG8_WAIT_V(6); PG8_BAR; PG8_MMA(1, 1, At, B1); PG8_BAR;
            PG8_LDB(B0, 1, 0); PG8_SCHED; PG8_LDA(At, 1, 0); PG8_STAGE(PG8_SA(0, 1), a2 + hstep, voffA);
            PG8_WAIT_L(8); PG8_BAR; PG8_WAIT_L(0); PG8_MMA(0, 0, At, B0); PG8_BAR; PG8_SCHED;
            PG8_LDB(B1, 1, 1); PG8_STAGE(PG8_SB(1, 0), b3, voffB);
            PG8_BAR; PG8_WAIT_L(0); PG8_MMA(0, 1, At, B1); PG8_BAR;
            PG8_LDA(At, 1, 1); PG8_STAGE(PG8_SA(1, 0), a3, voffA);
            PG8_BAR; PG8_WAIT_L(0); PG8_MMA(1, 0, At, B0); PG8_BAR; PG8_SCHED;
            PG8_STAGE(PG8_SB(1, 1), b3 + hstep, voffB);
            PG8_WAIT_V(6); PG8_BAR; PG8_MMA(1, 1, At, B1); PG8_BAR;
            }
        }
        if constexpr (ALIGN_EPI) { if (wr == 0) PG8_BAR; }
        if constexpr (!Epi::AFTER_DRAIN) { E(acc, cur, wr, wc, fr, fq); S.done(cur); }
        if (!has_next) break;
#pragma unroll
        for (int a = 0; a < 2; ++a)
#pragma unroll
            for (int b = 0; b < 2; ++b)
#pragma unroll
                for (int m = 0; m < 4; ++m)
#pragma unroll
                    for (int n = 0; n < 2; ++n) acc[a][b][m][n] = (acc_t){0, 0, 0, 0};
        cur = nxt; cA = nA; cB = nB; ++ui;
        if constexpr (ALIGN_EPI) { if (wr == 1) PG8_BAR; }
    }
    PG8_WAIT_V(0);
    if constexpr (!ALIGN_EPI) { if (wr == 0) PG8_BAR; }
    PG8_BAR;
    if constexpr (Epi::AFTER_DRAIN) { E.fused(acc, cur, wr, wc, fr, fq, lds, wid, lane); S.done(cur); }
#undef PG8_SA
#undef PG8_SB
#undef PG8_STAGE
#undef PG8_LDA
#undef PG8_LDB
#undef PG8_MMA
#undef PG8_WAIT_V
#undef PG8_WAIT_L
#undef PG8_BAR
#undef PG8_SCHED
}
}
constexpr int NWAVES = 8, NTHR = 512;
constexpr int NB = 8, T = 8192, M = NB * T, D = 1024, CH = 512, NH = 8, HD = 64, FF = 4096, NL = 2;
constexpr int PIN = 3456, HYP = 1536, RWP = 1920, NRW = 2048;
constexpr float RMS_EPS = 1e-5f, GN_EPS = 64.0f * 1e-5f;
constexpr int MLP_CHUNKS = 4;
static_assert(MLP_CHUNKS >= 2 && M % (MLP_CHUNKS * 256) == 0, "the next layer's first-half RMSNorm is folded into the last MLP chunk: it needs a barrier between the first half's down GEMMs and that chunk");

constexpr size_t MiB = 1u << 20;
constexpr size_t WS_CTL = 0, CTL_ZERO_BYTES = 1 * MiB;
constexpr size_t WS_W = 2 * MiB;
constexpr size_t W_LAYER = 25 * MiB, W_HY = 0, W_RW = 3 * MiB, W_O = 7 * MiB, W_1 = 9 * MiB, W_2 = 17 * MiB;
constexpr size_t WS_RSC = 52 * MiB;
constexpr size_t WS_CSC = 52 * MiB + 512 * 1024;
constexpr size_t WS_FSC = 52 * MiB;
constexpr size_t WS_RSS = 53 * MiB;
constexpr size_t WS_BS = 53 * MiB;
constexpr size_t WS_FRAG = 57 * MiB;
constexpr size_t WS_SFIN = 62 * MiB;
constexpr size_t WS_YPHI = 64 * MiB;
constexpr size_t WS_HF = 64 * MiB;
constexpr size_t WS_HN = 128 * MiB;
constexpr size_t WS_G = 128 * MiB, WS_V2 = 192 * MiB;
constexpr size_t WS_VFIRST = 256 * MiB;
constexpr size_t WS_PHT = 320 * MiB;
constexpr size_t WS_PRW = 512 * MiB;
constexpr size_t WS_YS = 768 * MiB;
constexpr size_t WS_HID = 320 * MiB;
constexpr size_t WS_YMIX = 896 * MiB;
constexpr size_t WS_END = 1024 * MiB;
constexpr int CW_BAR = 4096;
constexpr int CW_CMAX = 32768;
constexpr int CW_QUEUE = 16384;

constexpr int LDS_BYTES = 163840;
constexpr int LDSCTL_OFF = LDS_BYTES - 512;

#define GAS __attribute__((address_space(1)))
#define LAS __attribute__((address_space(3)))
typedef unsigned short bf16;
typedef unsigned v4u __attribute__((ext_vector_type(4)));
typedef unsigned v2u __attribute__((ext_vector_type(2)));
typedef float f32x4 __attribute__((ext_vector_type(4)));
#define PHASE_TID() int bid = blockIdx.x; asm volatile("" : "+s"(bid)); (void)bid; int tid = threadIdx.x; asm volatile("" : "+v"(tid)); const int lane = tid & 63; const int wave = __builtin_amdgcn_readfirstlane(tid >> 6); (void)lane; (void)wave
#define RLX_AGENT __ATOMIC_RELAXED, __HIP_MEMORY_SCOPE_AGENT
#define LDS_WAIT() asm volatile("s_waitcnt lgkmcnt(0)" ::: "memory")
#define VM_WAIT() asm volatile("s_waitcnt vmcnt(0)" ::: "memory")
typedef float f32x2_ __attribute__((ext_vector_type(2)));
typedef __bf16 bf16x2_ __attribute__((ext_vector_type(2)));
__device__ __forceinline__ unsigned pk2(float lo, float hi) { return __builtin_bit_cast(unsigned, __builtin_convertvector((f32x2_){lo, hi}, bf16x2_)); }
__device__ __forceinline__ unsigned f2bf(float f) { return pk2(f, f) & 0xffffu; }
__device__ __forceinline__ float bf2f(unsigned h) { return __uint_as_float(h << 16); }
__device__ __forceinline__ float bflo(unsigned w) { return __uint_as_float(w << 16); }
__device__ __forceinline__ float bfhi(unsigned w) { return __uint_as_float(w & 0xffff0000u); }
__device__ __forceinline__ float sigmoidf_(float x) { return __builtin_amdgcn_rcpf(1.0f + __expf(-x)); }
__device__ __forceinline__ float tanhf_(float x) { return 1.0f - 2.0f * __builtin_amdgcn_rcpf(1.0f + __expf(2.0f * x)); }
template <int CTRL> __device__ __forceinline__ float dpp(float x) { return __builtin_bit_cast(float, __builtin_amdgcn_mov_dpp(__builtin_bit_cast(int, x), CTRL, 0xf, 0xf, true)); }
constexpr int XOR1 = 0xB1, XOR2 = 0x4E, XOR7 = 0x141, XOR8 = 0x128;
__device__ __forceinline__ float sin_hw(float x) { const float r = x * 0.15915494309189535f; return __builtin_amdgcn_sinf(r - floorf(r)); }
__device__ __forceinline__ float sum8(float v) { v += dpp<XOR1>(v); v += dpp<XOR2>(v); v += dpp<XOR7>(v); return v; }
__device__ __forceinline__ float sum16(float v) { v = sum8(v); v += dpp<XOR8>(v); return v; }

#define XB_TMO      128
#define XB_XCNT(j)  (256  + 64 * (j))
#define XB_XSUB(j)  (1280 + 64 * (j))
#define XB_XGEN(j)  (2304 + 64 * (j))
#define XB_TOP      3328
#define XB_TOPGEN   3392
#define XCD_BAR_WORDS 3456
#define XB_SPIN_CAP (1u << 18)

__device__ __forceinline__ unsigned xb_ld(unsigned* p)              { return __hip_atomic_load(p, __ATOMIC_RELAXED, __HIP_MEMORY_SCOPE_AGENT); }
__device__ __forceinline__ unsigned xb_add(unsigned* p, unsigned v) { return __hip_atomic_fetch_add(p, v, __ATOMIC_RELAXED, __HIP_MEMORY_SCOPE_AGENT); }
__device__ __forceinline__ unsigned xb_xcc_id() { return (unsigned)__builtin_amdgcn_s_getreg((3 << 11) | 20) & 0xFu; }
#define XB_SPIN(cond, bar) do { unsigned _sp = 0; while (cond) { __builtin_amdgcn_s_sleep(1); \
    if ((++_sp & 255u) == 0u) { if (xb_ld(&(bar)[XB_TMO])) break; if (_sp > XB_SPIN_CAP) { atomicAdd(&(bar)[XB_TMO], 1u); break; } } } } while (0)

struct XcdBarrier {
    unsigned* bar; unsigned x;
    volatile LAS unsigned* st;
};
__device__ __forceinline__ XcdBarrier xcd_barrier_post(unsigned* bar, volatile LAS unsigned* st) {
    XcdBarrier b; b.bar = bar; b.x = xb_xcc_id(); b.st = st;
    if (threadIdx.x == 0) (void)xb_add(&bar[XB_XCNT(b.x)], 1u);
    return b;
}
__device__ __forceinline__ void xcd_barrier_complete(unsigned* bar, unsigned x, unsigned& nloc, unsigned& nx) {
    const unsigned G = gridDim.x * gridDim.y * gridDim.z;
    unsigned sum, cnt, mine, sp = 0u;
    for (;;) {
        sum = 0u; cnt = 0u; mine = 0u;
#pragma unroll
        for (unsigned j = 0; j < 16; ++j) { const unsigned c = xb_ld(&bar[XB_XCNT(j)]); sum += c; cnt += (c > 0u) ? 1u : 0u; mine = (j == x) ? c : mine; }
        if (sum == G) break;
        __builtin_amdgcn_s_sleep(1);
        if ((++sp & 255u) == 0u) { if (xb_ld(&bar[XB_TMO])) break; if (sp > XB_SPIN_CAP) { atomicAdd(&bar[XB_TMO], 1u); break; } }
    }
    nloc = mine > 0u ? mine : 1u; nx = cnt > 0u ? cnt : 1u;
}
__device__ __forceinline__ void xcd_barrier(const XcdBarrier& b) {
    asm volatile("s_waitcnt vmcnt(0)" ::: "memory");
    __syncthreads();
    if (threadIdx.x == 0) {
        unsigned* bar = b.bar;
        unsigned bx = b.x; asm volatile("" : "+s"(bx));
        __builtin_amdgcn_s_waitcnt(0);
        unsigned nloc = b.st[0], nx = b.st[1];
        if (nloc == 0u) { xcd_barrier_complete(bar, bx, nloc, nx); b.st[0] = nloc; b.st[1] = nx; }
        const unsigned old = xb_add(&bar[XB_XSUB(bx)], 1u);
        const unsigned gen = old / nloc;
        if (old + 1u == (gen + 1u) * nloc) {
            __builtin_amdgcn_fence(__ATOMIC_RELEASE, "agent");
            asm volatile("s_waitcnt vmcnt(0)" ::: "memory");
            const unsigned og = xb_add(&bar[XB_TOP], 1u);
            const unsigned tg = og / nx;
            if (og + 1u == (tg + 1u) * nx) xb_add(&bar[XB_TOPGEN], 1u);
            else XB_SPIN(xb_ld(&bar[XB_TOPGEN]) == tg, bar);
            __builtin_amdgcn_fence(__ATOMIC_ACQUIRE, "agent");
            xb_add(&bar[XB_XGEN(bx)], 1u);
            asm volatile("s_waitcnt vmcnt(0)" ::: "memory");
        } else {
            XB_SPIN(xb_ld(&bar[XB_XGEN(bx)]) == gen, bar);
            __builtin_amdgcn_fence(__ATOMIC_ACQUIRE, "agent");
            asm volatile("s_waitcnt vmcnt(0)" ::: "memory");
        }
    }
    __syncthreads();
}

struct Frame {
    LAS unsigned char* lds;
    volatile LAS unsigned* MISC;
    unsigned* ctl;
    int G;
    const float* const* in;
    float* out; unsigned char* ws;
};
enum { I_X = 0, I_N1G, I_WIN, I_HCW, I_HCB, I_FW1, I_FB1, I_FW2, I_FB2, I_FW3, I_FB3, I_FFREQ, I_FWOUT, I_HSKIP, I_HNG, I_SHIFT, I_W0, I_W2, I_A0, I_A2, I_G2, I_KK, I_KA, I_RK, I_LNG, I_LNB, I_V0, I_V1, I_V2, I_WOUT, I_N2G, I_MW1, I_MW2, I_FING };

__device__ __forceinline__ float wave_max(float v) {
#pragma unroll
    for (int o = 1; o < 64; o <<= 1) v = fmaxf(v, __shfl_xor(v, o));
    return v;
}
__device__ __forceinline__ unsigned q4(float a, float b, float c, float d) {
    const int ia = (int)__builtin_rintf(a), ib = (int)__builtin_rintf(b), ic = (int)__builtin_rintf(c), id = (int)__builtin_rintf(d);
    return (unsigned)(ia & 255) | ((unsigned)(ib & 255) << 8) | ((unsigned)(ic & 255) << 16) | ((unsigned)id << 24);
}
__device__ __forceinline__ float wave_sum(float v) {
#pragma unroll
    for (int o = 1; o < 64; o <<= 1) v += __shfl_xor(v, o);
    return v;
}
typedef float f32x2 __attribute__((ext_vector_type(2)));
constexpr int FN = 2 * T;
constexpr int XPAD = FN + FN / 16 + 16 * (FN / 512);
__device__ __forceinline__ f32x2 cmul(f32x2 a, f32x2 b) { return (f32x2){a.x * b.x - a.y * b.y, a.x * b.y + a.y * b.x}; }
__device__ __forceinline__ f32x2 cmulc(f32x2 a, f32x2 b) { return (f32x2){a.x * b.x + a.y * b.y, a.y * b.x - a.x * b.y}; }
__device__ constexpr float C32[16] = {1.0f, 0.98078528040323043f, 0.92387953251128674f, 0.83146961230254524f, 0.70710678118654752f, 0.55557023301960218f, 0.38268343236508977f, 0.19509032201612825f,
                                      0.0f, -0.19509032201612825f, -0.38268343236508977f, -0.55557023301960218f, -0.70710678118654752f, -0.83146961230254524f, -0.92387953251128674f, -0.98078528040323043f};
__device__ constexpr float S32[16] = {0.0f, 0.19509032201612825f, 0.38268343236508977f, 0.55557023301960218f, 0.70710678118654752f, 0.83146961230254524f, 0.92387953251128674f, 0.98078528040323043f,
                                      1.0f, 0.98078528040323043f, 0.92387953251128674f, 0.83146961230254524f, 0.70710678118654752f, 0.55557023301960218f, 0.38268343236508977f, 0.19509032201612825f};
constexpr int bitrev_c(int v, int bits) { int r = 0; for (int i = 0; i < bits; ++i) r |= ((v >> i) & 1) << (bits - 1 - i); return r; }
template <int R, bool INV> __device__ __forceinline__ void dft_regs(f32x2 (&x)[R]) {
    constexpr int LOG = (R == 32) ? 5 : 4;
#pragma unroll
    for (int s = R / 2; s >= 1; s >>= 1) {
#pragma unroll
        for (int blk = 0; blk < R; blk += 2 * s) {
#pragma unroll
            for (int j = 0; j < s; ++j) {
                const f32x2 a = x[blk + j], b = x[blk + j + s];
                x[blk + j] = a + b;
                f32x2 d = a - b;
                const int m = j * (16 / s);
                if (m == 0) x[blk + j + s] = d;
                else if (m == 8) x[blk + j + s] = INV ? (f32x2){-d.y, d.x} : (f32x2){d.y, -d.x};
                else { const float c = C32[m], sn = INV ? S32[m] : -S32[m]; x[blk + j + s] = (f32x2){d.x * c - d.y * sn, d.x * sn + d.y * c}; }
            }
        }
    }
    f32x2 y[R];
#pragma unroll
    for (int k = 0; k < R; ++k) y[k] = x[bitrev_c(k, LOG)];
#pragma unroll
    for (int k = 0; k < R; ++k) x[k] = y[k];
}
template <int R, bool INV> __device__ __forceinline__ void twiddle_regs(f32x2 (&x)[R], float frac) {
    asm volatile("" : "+v"(frac));
    const float sn = __builtin_amdgcn_sinf(0.5f * frac), cs = __builtin_amdgcn_cosf(0.5f * frac);
    const f32x2 w = (f32x2){cs, INV ? sn : -sn};
    f32x2 wk = w;
#pragma unroll
    for (int k = 1; k < R; ++k) { x[k] = cmul(x[k], wk); if (k + 1 < R) wk = cmul(wk, w); }
}
#define XP(i) ((i) + ((i) >> 4) + 16 * ((i) >> 9))
constexpr int XBP = 560;
template <bool ZUP> __device__ __forceinline__ void fft_f1(LAS f32x2* X, int t) {
    f32x2 x[32]; const int base = t + (t >> 4);
#pragma unroll
    for (int j = 0; j < 32; ++j) x[j] = (ZUP && j >= 16) ? (f32x2){0.f, 0.f} : X[base + j * XBP];
    dft_regs<32, false>(x);
    twiddle_regs<32, false>(x, (float)t * (1.0f / 8192.0f));
#pragma unroll
    for (int k = 0; k < 32; ++k) X[base + k * XBP] = x[k];
}
__device__ __forceinline__ void fft_f2(LAS f32x2* X, int t) {
    f32x2 x[32]; const int base = (t >> 4) * XBP + (t & 15);
#pragma unroll
    for (int j = 0; j < 32; ++j) x[j] = X[base + j * 17];
    dft_regs<32, false>(x);
    twiddle_regs<32, false>(x, (float)(t & 15) * (1.0f / 256.0f));
#pragma unroll
    for (int k = 0; k < 32; ++k) X[base + k * 17] = x[k];
}
__device__ __forceinline__ void fft_mid(LAS f32x2* X, const f32x2* H, int t) {
#pragma unroll 1
    for (int r = 0; r < 2; ++r) { const int b = t + 512 * r; f32x2 x[16];
        const f32x4* hp = (const f32x4*)(H + 16 * b); f32x4 h[8];
#pragma unroll
        for (int k = 0; k < 8; ++k) h[k] = hp[k];
#pragma unroll
        for (int j = 0; j < 16; ++j) x[j] = X[17 * b + 16 * (b >> 5) + j];
        dft_regs<16, false>(x);
#pragma unroll
        for (int k = 0; k < 8; ++k) { x[2 * k] = cmul(x[2 * k], (f32x2){h[k][0], h[k][1]}); x[2 * k + 1] = cmul(x[2 * k + 1], (f32x2){h[k][2], h[k][3]}); }
        dft_regs<16, true>(x);
#pragma unroll
        for (int j = 0; j < 16; ++j) X[17 * b + 16 * (b >> 5) + j] = x[j]; }
}
__device__ __forceinline__ void fft_i2(LAS f32x2* X, int t) {
    f32x2 x[32]; const int base = (t >> 4) * XBP + (t & 15);
#pragma unroll
    for (int k = 0; k < 32; ++k) x[k] = X[base + k * 17];
    twiddle_regs<32, true>(x, (float)(t & 15) * (1.0f / 256.0f));
    dft_regs<32, true>(x);
#pragma unroll
    for (int j = 0; j < 32; ++j) X[base + j * 17] = x[j];
}
__device__ __forceinline__ void fft_i1(LAS f32x2* X, int t) {
    f32x2 x[32]; const int base = t + (t >> 4);
#pragma unroll
    for (int k = 0; k < 32; ++k) x[k] = X[base + k * XBP];
    twiddle_regs<32, true>(x, (float)t * (1.0f / 8192.0f));
    dft_regs<32, true>(x);
#pragma unroll
    for (int j = 0; j < 16; ++j) X[base + j * XBP] = x[j];
}
__device__ __forceinline__ void fft_conv(LAS f32x2* X, const f32x2* H, int tid) {
    __syncthreads(); fft_f1<true>(X, tid);
    __syncthreads(); fft_f2(X, tid);
    __syncthreads(); fft_mid(X, H, tid);
    __syncthreads(); fft_i2(X, tid);
    __syncthreads(); fft_i1(X, tid);
    __syncthreads();
}
__device__ __forceinline__ void hy_spectrum_item(Frame& F, int item) {
    PHASE_TID();
    LAS f32x2* X = (LAS f32x2*)F.lds; LAS float* RED = (LAS float*)(F.lds + XPAD * 8);
    const int o = item >> 9, c = item & 511;
    const float* HF = (const float*)(F.ws + WS_HF);
    const float* f = HF + ((size_t)(o * 2 + 0) * CH + c) * T; const float* bw = HF + ((size_t)(o * 2 + 1) * CH + c) * T;
    f32x2* HS = (f32x2*)(F.ws + WS_YMIX) + (size_t)item * FN;
    __syncthreads();
    f32x2 x[32]; float ss = 0.f; const int base = tid + (tid >> 4);
#pragma unroll
    for (int j = 0; j < 32; ++j) { const int idx = j * 512 + tid; float v;
        if (j < 16) v = f[idx]; else v = (idx == T) ? 0.f : bw[FN - idx];
        ss += v * v; x[j] = (f32x2){v, 0.f}; }
    ss = wave_sum(ss);
    if (lane == 0) RED[wave] = ss;
    dft_regs<32, false>(x);
    twiddle_regs<32, false>(x, (float)tid * (1.0f / 8192.0f));
#pragma unroll
    for (int k = 0; k < 32; ++k) X[base + k * XBP] = x[k];
    __syncthreads();
    float tot = 0.f;
#pragma unroll
    for (int w = 0; w < 8; ++w) tot += RED[w];
    const float sc = (1.0f / sqrtf(tot + 1e-6f)) * (1.0f / (float)FN);
    fft_f2(X, tid);
    __syncthreads();
#pragma unroll 1
    for (int r = 0; r < 2; ++r) { const int b = tid + 512 * r; f32x2 y[16];
#pragma unroll
        for (int j = 0; j < 16; ++j) y[j] = X[17 * b + 16 * (b >> 5) + j];
        dft_regs<16, false>(y);
        f32x4* dst = (f32x4*)(HS + 16 * b);
#pragma unroll
        for (int k = 0; k < 8; ++k) dst[k] = (f32x4){y[2 * k].x * sc, y[2 * k].y * sc, y[2 * k + 1].x * sc, y[2 * k + 1].y * sc}; }
}
__device__ __forceinline__ void p_spectra(Frame& F) { PHASE_TID(); (void)tid; for (int it = bid; it < 2 * CH; it += F.G) hy_spectrum_item(F, it); __syncthreads(); }

struct RowRaw { v4u a, b; unsigned lo, hi; };
__device__ __forceinline__ void hy_row_load(RowRaw& R, const bf16* row, int t0) {
    R.a = *(const v4u*)(row + t0); R.b = *(const v4u*)(row + t0 + 8);
    R.lo = t0 > 0 ? (unsigned)row[t0 - 1] : 0u; R.hi = t0 + 16 < T ? (unsigned)row[t0 + 16] : 0u;
}
__device__ __forceinline__ void hy_u16r(const RowRaw& R, float w0, float w1, float w2, float bias, float (&u)[16]) {
    float p[18];
    p[0] = __builtin_bit_cast(float, R.lo << 16); p[17] = __builtin_bit_cast(float, R.hi << 16);
    const unsigned w[8] = {R.a.x, R.a.y, R.a.z, R.a.w, R.b.x, R.b.y, R.b.z, R.b.w};
#pragma unroll
    for (int i = 0; i < 8; ++i) { p[1 + 2 * i] = bflo(w[i]); p[2 + 2 * i] = bfhi(w[i]); }
#pragma unroll
    for (int i = 0; i < 16; ++i) u[i] = w0 * p[i] + w1 * p[i + 1] + w2 * p[i + 2] + bias;
}
__device__ __forceinline__ void hy_pack_store(bf16* dst, const float (&y)[16]) {
    v4u o0, o1;
    o0.x = pk2(y[0], y[1]); o0.y = pk2(y[2], y[3]); o0.z = pk2(y[4], y[5]); o0.w = pk2(y[6], y[7]);
    o1.x = pk2(y[8], y[9]); o1.y = pk2(y[10], y[11]); o1.z = pk2(y[12], y[13]); o1.w = pk2(y[14], y[15]);
    *(v4u*)dst = o0; *(v4u*)(dst + 8) = o1;
}
__device__ __forceinline__ void hy_fft_item(Frame& F, int l, int item) {
    PHASE_TID(); const int c = item >> 2, bp = item & 3, t0 = 16 * tid, xb = 17 * tid + 16 * (tid >> 5);
    LAS f32x2* X = (LAS f32x2*)F.lds;
    bf16* PHT = (bf16*)(F.ws + WS_PHT);
    bf16* rx1a = PHT + ((size_t)(2 * bp) * HYP + c) * T; bf16* rx1b = rx1a + (size_t)HYP * T;
    bf16* rx2a = PHT + ((size_t)(2 * bp) * HYP + CH + c) * T; bf16* rx2b = rx2a + (size_t)HYP * T;
    const bf16* rva = PHT + ((size_t)(2 * bp) * HYP + 2 * CH + c) * T; const bf16* rvb = rva + (size_t)HYP * T;
    const float* cw = F.in[I_HCW] + (size_t)l * 3 * HYP; const float* cb = F.in[I_HCB] + (size_t)l * HYP;
    const float* skip = F.in[I_HSKIP] + (size_t)l * 2 * CH;
    const f32x2* H0 = (const f32x2*)(F.ws + WS_YMIX) + (size_t)c * FN; const f32x2* H1 = H0 + (size_t)CH * FN;
    __syncthreads();
    RowRaw va, vb, xa, xb2;
    hy_row_load(va, rva, t0); hy_row_load(vb, rvb, t0);
    const float vw0 = cw[2 * CH + c], vw1 = cw[HYP + 2 * CH + c], vw2 = cw[2 * HYP + 2 * CH + c], vbs = cb[2 * CH + c];
    const float x1w0 = cw[c], x1w1 = cw[HYP + c], x1w2 = cw[2 * HYP + c], x1bs = cb[c], x2w0 = cw[CH + c], x2w1 = cw[HYP + CH + c], x2w2 = cw[2 * HYP + CH + c], x2bs = cb[CH + c], s0 = skip[c], s1 = skip[CH + c];
    { float ua[16], ub[16];
      hy_u16r(va, vw0, vw1, vw2, vbs, ua); hy_u16r(vb, vw0, vw1, vw2, vbs, ub);
#pragma unroll
      for (int i = 0; i < 16; ++i) X[xb + i] = (f32x2){ua[i], ub[i]}; }
    hy_row_load(xa, rx1a, t0); hy_row_load(xb2, rx1b, t0);
    fft_conv(X, H0, tid);
    v4u z2a[2], z2b[2];
    { float ua[16], ub[16], za[16], zb[16];
      {
        hy_u16r(va, vw0, vw1, vw2, vbs, ua); hy_u16r(vb, vw0, vw1, vw2, vbs, ub);
#pragma unroll
        for (int i = 0; i < 16; ++i) { const f32x2 y = X[xb + i]; za[i] = y.x + s0 * ua[i]; zb[i] = y.y + s0 * ub[i]; } }
      hy_u16r(xa, x1w0, x1w1, x1w2, x1bs, ua); hy_u16r(xb2, x1w0, x1w1, x1w2, x1bs, ub);
#pragma unroll
      for (int i = 0; i < 16; ++i) { za[i] *= ua[i]; zb[i] *= ub[i]; }
#pragma unroll
      for (int q = 0; q < 2; ++q) { z2a[q].x = pk2(za[8 * q], za[8 * q + 1]); z2a[q].y = pk2(za[8 * q + 2], za[8 * q + 3]); z2a[q].z = pk2(za[8 * q + 4], za[8 * q + 5]); z2a[q].w = pk2(za[8 * q + 6], za[8 * q + 7]);
                                    z2b[q].x = pk2(zb[8 * q], zb[8 * q + 1]); z2b[q].y = pk2(zb[8 * q + 2], zb[8 * q + 3]); z2b[q].z = pk2(zb[8 * q + 4], zb[8 * q + 5]); z2b[q].w = pk2(zb[8 * q + 6], zb[8 * q + 7]); }
#pragma unroll
      for (int i = 0; i < 16; ++i) X[xb + i] = (f32x2){za[i], zb[i]}; }
    hy_row_load(xa, rx2a, t0); hy_row_load(xb2, rx2b, t0);
    fft_conv(X, H1, tid);
    { float ua[16], ub[16];
      hy_u16r(xa, x2w0, x2w1, x2w2, x2bs, ua); hy_u16r(xb2, x2w0, x2w1, x2w2, x2bs, ub);
      float za[16], zb[16];
      const unsigned wa[8] = {z2a[0].x, z2a[0].y, z2a[0].z, z2a[0].w, z2a[1].x, z2a[1].y, z2a[1].z, z2a[1].w}, wb[8] = {z2b[0].x, z2b[0].y, z2b[0].z, z2b[0].w, z2b[1].x, z2b[1].y, z2b[1].z, z2b[1].w};
#pragma unroll
      for (int i = 0; i < 8; ++i) { za[2 * i] = bflo(wa[i]); za[2 * i + 1] = bfhi(wa[i]); zb[2 * i] = bflo(wb[i]); zb[2 * i + 1] = bfhi(wb[i]); }
#pragma unroll
      for (int i = 0; i < 16; ++i) { const f32x2 y = X[xb + i]; za[i] = ua[i] * (y.x + s1 * za[i]); zb[i] = ub[i] * (y.y + s1 * zb[i]); }
      hy_pack_store(rx2a + t0, za); hy_pack_store(rx2b + t0, zb); }
}
typedef short bf16x8 __attribute__((ext_vector_type(8)));
constexpr int CL_ = 64;
constexpr int LDB = 80;
constexpr int LDSG = 144, LDVL = 48;
constexpr int LDF = 65;
constexpr int MB = 64 * LDB * 2;
constexpr int MF = 64 * LDF * 4;
constexpr int O_AH = 0, O_AHT = MB, O_RH = 2 * MB, O_BH = 3 * MB, O_BHT = 4 * MB, O_KH = 5 * MB, O_KHT = 6 * MB, O_VT = 7 * MB;
constexpr int O_TW = 0, O_AD = MB, O_SG = 2 * MB  , O_VL = 2 * MB + 64 * LDSG * 2  ;
constexpr int O_APB = O_KH;
constexpr int O_F = 8 * MB;
constexpr int O_AF = O_F, O_LW = O_F + MF, O_ZV = O_F + 2 * MF;
constexpr int O_XA = O_F, O_XAT = O_F + MB, O_AAK = O_F + 2 * MB, O_ARB = O_F + 3 * MB, O_ARK = O_F + 4 * MB;
constexpr int O_S0B = O_F + ((3 * MF > 5 * MB) ? 3 * MF : 5 * MB);
constexpr int O_UT = O_S0B + MB;
constexpr int O_TB = O_UT, O_M1T = O_BH, O_T0T = O_AH, O_WT = O_KH;
constexpr int O_PL = O_UT + MB;
constexpr int O_PART = O_PL + 256;
constexpr int O_MU = O_PART + 2048;
constexpr int O_CK = O_MU + 1792;
constexpr int O_MC = O_CK + 768;
static_assert(O_ARK + MB <= O_S0B && O_ZV + MF <= O_S0B && O_VL + 64 * LDVL * 2 <= O_F && O_MC + 1792 <= LDSCTL_OFF, "cscan LDS map");

__device__ __forceinline__ unsigned pk2s(float v) { return pk2(v, v); }
#define MFMA16(a, b, c) __builtin_amdgcn_mfma_f32_16x16x32_bf16((a), (b), (c), 0, 0, 0)
__device__ __forceinline__ bf16x8 ldfrag(const LAS unsigned char* base, int ld, int row0, int k0, int fr, int fq) {
    return *(const LAS bf16x8*)(base + ((row0 + fr) * ld + k0 + 8 * fq) * 2);
}
__device__ __forceinline__ void st_tile_bf16(LAS unsigned char* base, int ld, int m0, int n0, int fr, int fq, const f32x4& v) {
#pragma unroll
    for (int jj = 0; jj < 4; ++jj) *(LAS bf16*)(base + ((m0 + 4 * fq + jj) * ld + n0 + fr) * 2) = (bf16)pk2s(v[jj]);
}
__device__ __forceinline__ void st_tile_bf16_T(LAS unsigned char* base, int ld, int m0, int n0, int fr, int fq, const f32x4& v) {
    v2u o; o.x = pk2(v[0], v[1]); o.y = pk2(v[2], v[3]);
    *(LAS v2u*)(base + ((n0 + fr) * ld + m0 + 4 * fq) * 2) = o;
}
#define CFENCE() asm volatile("" ::: "memory")
#define ZFRAG ((bf16x8){0, 0, 0, 0, 0, 0, 0, 0})
__device__ __forceinline__ void ldA(bf16x8 (&a)[2], const LAS unsigned char* A, int mt, int fr, int fq) {
#pragma unroll
    for (int ks = 0; ks < 2; ++ks) a[ks] = ldfrag(A, LDB, 16 * mt, 32 * ks, fr, fq);
}
__device__ __forceinline__ void ldB(bf16x8 (&b)[2][2], const LAS unsigned char* B, int nt0, int fr, int fq) {
#pragma unroll
    for (int ks = 0; ks < 2; ++ks)
#pragma unroll
        for (int j = 0; j < 2; ++j) b[ks][j] = ldfrag(B, LDB, 16 * (nt0 + j), 32 * ks, fr, fq);
}
#define PIN(x) asm volatile("" : "+v"(x))
__device__ __forceinline__ void mmac(bf16x8 (&a)[2], bf16x8 (&b)[2][2], f32x4 (&acc)[2]) {
#pragma unroll
    for (int ks = 0; ks < 2; ++ks) { PIN(a[ks]);
#pragma unroll
        for (int j = 0; j < 2; ++j) { PIN(b[ks][j]); acc[j] = MFMA16(a[ks], b[ks][j], acc[j]); } }
}
__device__ __forceinline__ void mmacT(bf16x8 (&a)[2], bf16x8 (&b)[2][2], f32x4 (&acc)[2]) {
#pragma unroll
    for (int ks = 0; ks < 2; ++ks) { PIN(a[ks]);
#pragma unroll
        for (int j = 0; j < 2; ++j) { PIN(b[ks][j]); acc[j] = MFMA16(b[ks][j], a[ks], acc[j]); } }
}
__device__ __forceinline__ v4u pack8(const float (&v)[8]) { v4u o; o.x = pk2(v[0], v[1]); o.y = pk2(v[2], v[3]); o.z = pk2(v[4], v[5]); o.w = pk2(v[6], v[7]); return o; }
__device__ __forceinline__ bf16x8 wfrag(const float* W, int k0, int col, int fq) {
    float v[8];
#pragma unroll
    for (int e = 0; e < 8; ++e) v[e] = W[(size_t)(k0 + 8 * fq + e) * CH + col];
    return __builtin_bit_cast(bf16x8, pack8(v));
}

struct RawTok { v4u g[7][3]; };
__device__ __forceinline__ void load_raw(RawTok& R, const bf16* PRW, const bf16* VFIRST, int b, int tok, int hc, int ec, int d, int l, bool has_vl) {
    const size_t m = (size_t)b * T + tok; const v4u z = (v4u){0u, 0u, 0u, 0u};
    const int cols[7] = {hc + ec, CH + hc + ec, 2 * CH + hc + ec, 1536 + d * 64 + ec, 1664 + d * 64 + ec, 1792 + ec, 1856 + ec};
#pragma unroll
    for (int g = 0; g < 7; ++g) { if (g >= 5 && d != 0) { R.g[g][0] = z; R.g[g][1] = z; R.g[g][2] = z; continue; }
        const bf16* p = PRW + m * NRW + cols[g];
        R.g[g][1] = *(const v4u*)p; R.g[g][0] = *(const v4u*)(p - NRW); R.g[g][2] = *(const v4u*)(p + NRW); }
    if (__builtin_amdgcn_readfirstlane((int)__builtin_amdgcn_ballot_w64(tok == 0 || tok == T - 1) != 0 || (int)(__builtin_amdgcn_ballot_w64(tok == 0 || tok == T - 1) >> 32) != 0)) {
#pragma unroll
        for (int g = 0; g < 7; ++g) { R.g[g][0] = (tok == 0) ? z : R.g[g][0]; R.g[g][2] = (tok == T - 1) ? z : R.g[g][2]; } }
}
typedef __bf16 bf16x2v __attribute__((ext_vector_type(2)));
__device__ __forceinline__ void mix8r(const v4u (&r)[3], const LAS unsigned* mub, const LAS float* mcb, float (&out)[8]) {
    const v4u ma = *(const LAS v4u*)mub, mb = *(const LAS v4u*)(mub + 4); const f32x4 ca = *(const LAS f32x4*)mcb, cb = *(const LAS f32x4*)(mcb + 4);
    const unsigned mw[8] = {ma.x, ma.y, ma.z, ma.w, mb.x, mb.y, mb.z, mb.w}; const float mc[8] = {ca[0], ca[1], ca[2], ca[3], cb[0], cb[1], cb[2], cb[3]};
    const unsigned pw[4] = {r[0].x, r[0].y, r[0].z, r[0].w}, cw[4] = {r[1].x, r[1].y, r[1].z, r[1].w}, nw[4] = {r[2].x, r[2].y, r[2].z, r[2].w};
#pragma unroll
    for (int i = 0; i < 4; ++i) {
        const unsigned pn0 = __builtin_amdgcn_perm(nw[i], pw[i], 0x05040100u), pn1 = __builtin_amdgcn_perm(nw[i], pw[i], 0x07060302u);
        out[2 * i] = __builtin_amdgcn_fdot2_f32_bf16(__builtin_bit_cast(bf16x2v, pn0), __builtin_bit_cast(bf16x2v, mw[2 * i]), bflo(cw[i]) * mc[2 * i], false);
        out[2 * i + 1] = __builtin_amdgcn_fdot2_f32_bf16(__builtin_bit_cast(bf16x2v, pn1), __builtin_bit_cast(bf16x2v, mw[2 * i + 1]), bfhi(cw[i]) * mc[2 * i + 1], false); }
}
template <bool DO_T, bool DO_X, bool LAST> __device__ __forceinline__ void blk_stage(const LAS unsigned char* X, const LAS unsigned char* XT, const LAS unsigned char* TT, LAS unsigned char* To, LAS unsigned char* T0T,
                                                                                    LAS unsigned char* Xo, LAS unsigned char* XoT, int wave, int fr, int fq) {
    const int bk = wave >> 2, k0 = 32 * bk, m0 = k0 + 16 * ((wave >> 1) & 1), n0 = k0 + 16 * (wave & 1);
    bf16x8 a = ldfrag(X, LDB, m0, k0, fr, fq), tb = a, xb = a; v2u tw = (v2u){0u, 0u};
    if (DO_T) { tb = ldfrag(TT, LDB, n0, k0, fr, fq); tw = *(const LAS v2u*)(TT + ((n0 + fr) * LDB + m0 + 4 * fq) * 2); }
    if (DO_X) xb = ldfrag(XT, LDB, n0, k0, fr, fq);
    CFENCE();
    PIN(a);
    if (DO_T) { f32x4 ta = (f32x4){bflo(tw.x), bfhi(tw.x), bflo(tw.y), bfhi(tw.y)}; PIN(tb); ta = MFMA16(a, tb, ta);
        if (LAST) { st_tile_bf16(To, LDB, m0, n0, fr, fq, ta); if (bk == 0) st_tile_bf16_T(T0T, LDB, m0, n0, fr, fq, ta); }
        else st_tile_bf16_T(To, LDB, m0, n0, fr, fq, ta); }
    if (DO_X) { f32x4 xa = (f32x4){0.f, 0.f, 0.f, 0.f}; PIN(xb); xa = MFMA16(a, xb, xa);
        st_tile_bf16(Xo, LDB, m0, n0, fr, fq, xa); st_tile_bf16_T(XoT, LDB, m0, n0, fr, fq, xa); }
}

template <int HH> __device__ __forceinline__ void m2_half(LAS unsigned char* L, int q, int fr, int fq) {
    const LAS unsigned char* Am = L + ((q < 2) ? O_AH : O_RH); const LAS unsigned char* Bm = L + ((q & 1) ? O_KH : O_BH);
    LAS unsigned char* Om = L + (q == 0 ? O_XA : (q == 1 ? O_AAK : (q == 2 ? O_ARB : O_ARK)));
    constexpr int MT0 = HH ? 1 : 0, MT1 = HH ? 2 : 3, NB = MT1 + 1;
    unsigned zz_ = 0u; asm volatile("" : "+v"(zz_)); const v2u z2 = (v2u){zz_, zz_};
    bf16x8 a[2][2], b[NB][2];
#pragma unroll
    for (int ks = 0; ks < 2; ++ks) { a[0][ks] = ldfrag(Am, LDB, 16 * MT0, 32 * ks, fr, fq); a[1][ks] = ldfrag(Am, LDB, 16 * MT1, 32 * ks, fr, fq); }
#pragma unroll
    for (int nt = 0; nt < NB; ++nt)
#pragma unroll
        for (int ks = 0; ks < 2; ++ks) b[nt][ks] = ldfrag(Bm, LDB, 16 * nt, 32 * ks, fr, fq);
    CFENCE();
#pragma unroll
    for (int mi = 0; mi < 2; ++mi) { const int mtile = mi ? MT1 : MT0;
        PIN(a[mi][0]); PIN(a[mi][1]);
#pragma unroll
        for (int nt = 0; nt < 4; ++nt) {
            if (nt > mtile) {
                *(LAS v2u*)(Om + ((16 * mtile + fr) * LDB + 16 * nt + 4 * fq) * 2) = z2;
                if (q == 0) { *(LAS v2u*)(L + O_XAT + ((16 * nt + fr) * LDB + 16 * mtile + 4 * fq) * 2) = z2; *(LAS v2u*)(L + O_UT + ((16 * nt + fr) * LDB + 16 * mtile + 4 * fq) * 2) = z2; }
                continue; }
            if (mi == 0) { PIN(b[nt][0]); PIN(b[nt][1]); }
            f32x4 at = (f32x4){0.f, 0.f, 0.f, 0.f};
            at = MFMA16(b[nt][0], a[mi][0], at); at = MFMA16(b[nt][1], a[mi][1], at);
            if (nt == mtile) {
#pragma unroll
                for (int jj = 0; jj < 4; ++jj) { const bool keep = (q < 2) ? (4 * fq + jj < fr) : (4 * fq + jj <= fr); if (!keep) at[jj] = 0.f; } }
            { v2u o; o.x = pk2(at[0], at[1]); o.y = pk2(at[2], at[3]); *(LAS v2u*)(Om + ((16 * mtile + fr) * LDB + 16 * nt + 4 * fq) * 2) = o; }
            if ((mtile >> 1) == (nt >> 1)) {
                if (q == 0) { f32x4 an = (f32x4){0.f, 0.f, 0.f, 0.f};
                    an = MFMA16(a[mi][0], b[nt][0], an); an = MFMA16(a[mi][1], b[nt][1], an);
                    f32x4 t1 = an;
                    if (nt == mtile) {
#pragma unroll
                        for (int jj = 0; jj < 4; ++jj) { if (!(fr < 4 * fq + jj)) an[jj] = 0.f; t1[jj] = (fr == 4 * fq + jj) ? 1.0f : an[jj]; } }
                    st_tile_bf16_T(L + O_XAT, LDB, 16 * mtile, 16 * nt, fr, fq, an);
                    st_tile_bf16_T(L + O_UT, LDB, 16 * mtile, 16 * nt, fr, fq, t1); } }
        } }
}

__device__ __forceinline__ void cscan_chain(Frame& F, int l, int unit) {
    PHASE_TID(); const int chain = unit >> 1, seg = unit & 1; const int b = chain >> 4, h = (chain >> 1) & 7, d = chain & 1, hc = h * HD;
    const int fr_o = lane & 15, fq_o = lane >> 4;
    LAS unsigned char* L = F.lds;
    const bf16* PRW = (const bf16*)(F.ws + WS_PRW);
    const float* mu = F.in[I_SHIFT] + (size_t)l * 2 * RWP;
    const bf16* VFIRST = (const bf16*)(F.ws + WS_VFIRST);
    bf16* VOUT = (l == 0) ? (bf16*)(F.ws + WS_VFIRST) : (bf16*)(F.ws + WS_V2);
    bf16* GOUT = (bf16*)(F.ws + WS_G);
    bf16* YS = (bf16*)(F.ws + WS_YS) + (size_t)d * M * CH;
    float* BS = (float*)(F.ws + WS_BS) + (size_t)d * M * NH;
    bf16* YPHI = (bf16*)(F.ws + WS_YPHI) + (size_t)chain * (T / 2) * 64;
    const int lnt = wave & 3, lmt0 = 2 * (wave >> 2);
    if (wave < 4) { const int lcol = hc + 16 * lnt + fr_o; bf16x8* FRAGS = (bf16x8*)(F.ws + WS_FRAG) + ((size_t)chain * 4 + lnt) * 9 * 64 + lane; const float* w2 = F.in[I_W2] + (size_t)(l * 2 + d) * 64 * CH; const float* a2 = F.in[I_A2] + (size_t)(l * 2 + d) * 64 * CH; const float* g2 = F.in[I_G2] + (size_t)l * 128 * CH;
#pragma unroll
      for (int ks = 0; ks < 2; ++ks) { FRAGS[ks * 64] = wfrag(w2, 32 * ks, lcol, fq_o); FRAGS[(2 + ks) * 64] = wfrag(a2, 32 * ks, lcol, fq_o); }
      if (l == 1) FRAGS[4 * 64] = wfrag(F.in[I_V2], 0, lcol, fq_o);
#pragma unroll
      for (int ks = 0; ks < 4; ++ks) if (d == 0) FRAGS[(5 + ks) * 64] = wfrag(g2, 32 * ks, lcol, fq_o); }
    const int lcol_o = hc + 16 * lnt + fr_o;
    const float lc_w0 = F.in[I_W0][(l * 2 + d) * CH + lcol_o], lc_a0 = F.in[I_A0][(l * 2 + d) * CH + lcol_o], lc_v0 = (l == 1) ? F.in[I_V0][lcol_o] : 0.f;
    const int mt = wave >> 1, nt0 = 2 * (wave & 1);
    f32x4 S[2] = {(f32x4){0.f, 0.f, 0.f, 0.f}, (f32x4){0.f, 0.f, 0.f, 0.f}};
    f32x4 Ph[2];
#pragma unroll
    for (int j = 0; j < 2; ++j)
#pragma unroll
        for (int jj = 0; jj < 4; ++jj) Ph[j][jj] = (16 * mt + 4 * fq_o + jj == 16 * (nt0 + j) + fr_o) ? 1.0f : 0.f;
    __syncthreads();
    for (int e = tid; e < MB / 4; e += NTHR) ((LAS unsigned*)(L + O_S0B))[e] = 0u;
    if (tid < 448) { const int g = tid >> 6, j = tid & 63; const int col = (g < 3) ? g * CH + hc + j : (g == 3 ? 1536 + d * 64 + j : (g == 4 ? 1664 + d * 64 + j : 1792 + (tid - 320)));
        const unsigned pm = pk2(mu[col], mu[RWP + col]); ((LAS unsigned*)(L + O_MU))[tid] = pm; ((LAS float*)(L + O_MC))[tid] = 1.0f - bflo(pm) - bfhi(pm); }
    if (tid < 192) { const int g = tid >> 6, j = tid & 63; ((LAS float*)(L + O_CK))[tid] = F.in[g == 0 ? I_KK : (g == 1 ? I_KA : I_RK)][l * CH + hc + j]; }
    RawTok raw;
    { const int et0 = tid >> 3, ec0 = (tid & 7) * 8; const int cf = (d == 0) ? seg * 64 * CL_ : (127 - seg * 64) * CL_; load_raw(raw, PRW, VFIRST, b, (d == 0) ? cf + et0 : cf + 63 - et0, hc, ec0, d, l, (tid & 7) < 4); }
#pragma unroll 1
    for (int ci = 0; ci < T / CL_ / 2; ++ci) {
        int tid = (wave << 6) | (int)__builtin_amdgcn_mbcnt_hi(~0u, __builtin_amdgcn_mbcnt_lo(~0u, 0u)); asm volatile("" : "+v"(tid));
        const int lane = tid & 63, fr = lane & 15, fq = lane >> 4, et = tid >> 3, ec = (tid & 7) * 8;
        const int lcol = hc + 16 * lnt + fr;
        const unsigned char* FRB = F.ws + WS_FRAG + (((size_t)chain * 4 + lnt) * 9 * 64) * 16; unsigned fo = (unsigned)lane * 16u;
#define FRAGS_(k) (*(const bf16x8*)(FRB + fo + (k) * 1024))
        int c0 = (d == 0 ? seg * 64 + ci : 127 - seg * 64 - ci) * CL_; asm volatile("" : "+s"(c0));
        const int tok = (d == 0) ? c0 + et : c0 + 63 - et;
        const size_t m = (size_t)b * T + tok;
        __syncthreads();
        float rr[8], kr[8], vr[8];
        const LAS unsigned* MUB = (const LAS unsigned*)(L + O_MU) + ec; const LAS float* MCB = (const LAS float*)(L + O_MC) + ec;
        v4u vl4 = (v4u){0u, 0u, 0u, 0u}, vf4 = vl4;
        if (l == 1 && (tid & 7) < 4) vl4 = *(const v4u*)(PRW + m * NRW + RWP + ec);
        bf16x8 wf[5];
        {
          if (d == 0) { float g0[8], g1[8];
              mix8r(raw.g[5], MUB + 320, MCB + 320, g0); CFENCE(); mix8r(raw.g[6], MUB + 384, MCB + 384, g1); CFENCE();
#pragma unroll
              for (int e = 0; e < 8; ++e) { g0[e] = sigmoidf_(g0[e]); g1[e] = sigmoidf_(g1[e]); }
              *(LAS v4u*)(L + O_SG + (et * LDSG + ec) * 2) = pack8(g0); *(LAS v4u*)(L + O_SG + (et * LDSG + 64 + ec) * 2) = pack8(g1); }
          float xw[8], xa[8];
          mix8r(raw.g[3], MUB + 192, MCB + 192, xw); CFENCE(); mix8r(raw.g[4], MUB + 256, MCB + 256, xa);
          asm volatile("" : "+v"(fo) : "v"(xw[7]), "v"(xa[7]));
          wf[0] = FRAGS_(0); wf[1] = FRAGS_(1); wf[2] = FRAGS_(2); wf[3] = FRAGS_(3); wf[4] = ZFRAG; if (l == 1) wf[4] = FRAGS_(4);
          CFENCE();
#pragma unroll
          for (int e = 0; e < 8; ++e) xw[e] = tanhf_(xw[e]);
          *(LAS v4u*)(L + O_TW + (et * LDB + ec) * 2) = pack8(xw);
          *(LAS v4u*)(L + O_AD + (et * LDB + ec) * 2) = pack8(xa);
          mix8r(raw.g[0], MUB, MCB, rr); CFENCE(); mix8r(raw.g[1], MUB + 64, MCB + 64, kr); CFENCE(); mix8r(raw.g[2], MUB + 128, MCB + 128, vr);
          if (l == 1 && (tid & 7) < 4) *(LAS v4u*)(L + O_VL + (et * LDVL + ec) * 2) = vl4;
          if (l == 1) vf4 = *(const v4u*)(VFIRST + m * CH + hc + ec); }
        __syncthreads();
        { bf16x8 gf[4];
          gf[0] = ZFRAG; gf[1] = ZFRAG; gf[2] = ZFRAG; gf[3] = ZFRAG;
          if (d == 0) { gf[0] = FRAGS_(5); gf[1] = FRAGS_(6); gf[2] = FRAGS_(7); gf[3] = FRAGS_(8); }
#pragma unroll
          for (int mi = 0; mi < 2; ++mi) { const int m0 = 16 * (lmt0 + mi);
              bf16x8 tw[2], ad[2], vl;
#pragma unroll
              for (int ks = 0; ks < 2; ++ks) { tw[ks] = ldfrag(L + O_TW, LDB, m0, 32 * ks, fr, fq); ad[ks] = ldfrag(L + O_AD, LDB, m0, 32 * ks, fr, fq); }
              vl = ZFRAG; if (l == 1) vl = ldfrag(L + O_VL, LDVL, m0, 0, fr, fq);
              CFENCE();
              f32x4 zw = (f32x4){0.f, 0.f, 0.f, 0.f}, za = zw, zv = zw;
#pragma unroll
              for (int ks = 0; ks < 2; ++ks) { PIN(tw[ks]); zw = MFMA16(tw[ks], wf[ks], zw); PIN(ad[ks]); za = MFMA16(ad[ks], wf[2 + ks], za); }
              if (l == 1) { PIN(vl); zv = MFMA16(vl, wf[4], zv); }
#pragma unroll
              for (int jj = 0; jj < 4; ++jj) { const int s = m0 + 4 * fq + jj, o = (s * LDF + 16 * lnt + fr) * 4;
                  *(LAS float*)(L + O_AF + o) = sigmoidf_(za[jj] + lc_a0);
                  *(LAS float*)(L + O_LW + o) = -0.6065306597126334f * sigmoidf_(zw[jj] + lc_w0); }
              if (l == 1) {
#pragma unroll
                  for (int jj = 0; jj < 4; ++jj) { const int s = m0 + 4 * fq + jj, o = (s * LDF + 16 * lnt + fr) * 4; *(LAS float*)(L + O_ZV + o) = sigmoidf_(zv[jj] + lc_v0); } } }
          if (d == 0) {
#pragma unroll
              for (int mi = 0; mi < 2; ++mi) { const int m0 = 16 * (lmt0 + mi);
                  bf16x8 sg[4];
#pragma unroll
                  for (int ks = 0; ks < 4; ++ks) sg[ks] = ldfrag(L + O_SG, LDSG, m0, 32 * ks, fr, fq);
                  CFENCE();
                  f32x4 zg = (f32x4){0.f, 0.f, 0.f, 0.f};
#pragma unroll
                  for (int ks = 0; ks < 4; ++ks) { PIN(sg[ks]); zg = MFMA16(gf[ks], sg[ks], zg); }
                  { v2u o; o.x = pk2(zg[0], zg[1]); o.y = pk2(zg[2], zg[3]); *(v2u*)(GOUT + ((size_t)b * T + c0 + m0 + fr) * CH + hc + 16 * lnt + 4 * fq) = o; } } } }
        __syncthreads();
        { const int j = tid & 63, sg = tid >> 6; float c[8]; float run = 0.f;
#pragma unroll
          for (int i = 0; i < 8; ++i) { run += *(LAS float*)(L + O_LW + ((8 * sg + i) * LDF + j) * 4); c[i] = run; }
          *(LAS float*)(L + O_PART + (sg * 64 + j) * 4) = run;
          __syncthreads();
          float pre = 0.f;
#pragma unroll
          for (int q = 0; q < 8; ++q) { const float pv = *(LAS float*)(L + O_PART + (q * 64 + j) * 4); pre += (q < sg) ? pv : 0.f; }
#pragma unroll
          for (int i = 0; i < 8; ++i) *(LAS float*)(L + O_LW + ((8 * sg + i) * LDF + j) * 4) = c[i] + pre; }
        __syncthreads();
        { float kkr[8], av[8], cl[8], clm[8], zv[8], kd[8], ss = 0.f, bon = 0.f;
          const unsigned vfw[4] = {vf4.x, vf4.y, vf4.z, vf4.w};
          const LAS float* CKT = (const LAS float*)(L + O_CK) + ec;
          const f32x4 kka = *(const LAS f32x4*)CKT, kkb = *(const LAS f32x4*)(CKT + 4), kaa = *(const LAS f32x4*)(CKT + 64), kab = *(const LAS f32x4*)(CKT + 68), rka = *(const LAS f32x4*)(CKT + 128), rkb = *(const LAS f32x4*)(CKT + 132);
          const int o0 = (et * LDF + ec) * 4, om = (et > 0) ? o0 - LDF * 4 : o0;
#pragma unroll
          for (int e = 0; e < 8; ++e) { av[e] = *(LAS float*)(L + O_AF + o0 + 4 * e); cl[e] = *(LAS float*)(L + O_LW + o0 + 4 * e); clm[e] = *(LAS float*)(L + O_LW + om + 4 * e); zv[e] = 0.f; }
          if (l == 1) {
#pragma unroll
              for (int e = 0; e < 8; ++e) zv[e] = *(LAS float*)(L + O_ZV + o0 + 4 * e); }
          CFENCE();
          const float ckk[8] = {kka[0], kka[1], kka[2], kka[3], kkb[0], kkb[1], kkb[2], kkb[3]}, cka[8] = {kaa[0], kaa[1], kaa[2], kaa[3], kab[0], kab[1], kab[2], kab[3]},
                      crk[8] = {rka[0], rka[1], rka[2], rka[3], rkb[0], rkb[1], rkb[2], rkb[3]};
#pragma unroll
          for (int e = 0; e < 8; ++e) {
              const float vf = (e & 1) ? bfhi(vfw[e >> 1]) : bflo(vfw[e >> 1]); vr[e] = vr[e] + (vf - vr[e]) * zv[e];
              kkr[e] = kr[e] * ckk[e]; ss += kkr[e] * kkr[e];
              kd[e] = kr[e] * (1.0f + (av[e] - 1.0f) * cka[e]); bon += rr[e] * kd[e] * crk[e]; }
          ss = sum8(ss); bon = sum8(bon);
          const float inv = __builtin_amdgcn_rsqf(fmaxf(ss, 1e-24f));
          if ((tid & 7) == 0) BS[m * NH + h] = bon;
          if (d == 0) *(v4u*)(VOUT + m * CH + hc + ec) = pack8(vr);
          float ah[8], bh[8], kh[8], rh[8], Pv[8];
#pragma unroll
          for (int e = 0; e < 8; ++e) {
              const float P = __expf(cl[e]), Pi = __builtin_amdgcn_rcpf(P), Pm = (et > 0) ? __expf(clm[e]) : 1.0f, kk = kkr[e] * inv;
              ah[e] = -kk * Pm; bh[e] = kk * av[e] * Pi; kh[e] = kd[e] * Pi; rh[e] = rr[e] * P; Pv[e] = P; }
          if (et == 63) { *(LAS f32x4*)(L + O_PL + ec * 4) = (f32x4){Pv[0], Pv[1], Pv[2], Pv[3]}; *(LAS f32x4*)(L + O_PL + ec * 4 + 16) = (f32x4){Pv[4], Pv[5], Pv[6], Pv[7]}; }
          *(LAS v4u*)(L + O_AH + (et * LDB + ec) * 2) = pack8(ah); *(LAS v4u*)(L + O_BH + (et * LDB + ec) * 2) = pack8(bh);
          *(LAS v4u*)(L + O_KH + (et * LDB + ec) * 2) = pack8(kh); *(LAS v4u*)(L + O_RH + (et * LDB + ec) * 2) = pack8(rh);
          { unsigned pab[8], pkv[8]; const int c = tid & 7;
#pragma unroll
            for (int e = 0; e < 8; ++e) { pab[e] = pk2(ah[e], bh[e]); pkv[e] = pk2(kh[e], vr[e]); }
#pragma unroll
            for (int sh = 1; sh < 8; sh <<= 1) { const bool on = (c & sh) != 0; unsigned ta[8], tk[8];
#pragma unroll
                for (int e = 0; e < 8; ++e) { ta[e] = on ? pab[(e + sh) & 7] : pab[e]; tk[e] = on ? pkv[(e + sh) & 7] : pkv[e]; }
#pragma unroll
                for (int e = 0; e < 8; ++e) { pab[e] = ta[e]; pkv[e] = tk[e]; } }
#pragma unroll
            for (int e = 0; e < 8; ++e) { const int o = ((ec + ((e + c) & 7)) * LDB + et) * 2;
                *(LAS bf16*)(L + O_AHT + o) = (bf16)(pab[e] & 0xffffu); *(LAS bf16*)(L + O_BHT + o) = (bf16)(pab[e] >> 16);
                *(LAS bf16*)(L + O_KHT + o) = (bf16)(pkv[e] & 0xffffu); *(LAS bf16*)(L + O_VT + o) = (bf16)(pkv[e] >> 16); } } }
        __syncthreads();
        { if (wave & 1) m2_half<1>(L, wave >> 1, fr, fq); else m2_half<0>(L, wave >> 1, fr, fq); }
        __syncthreads();
        if (ci + 1 < T / CL_ / 2) { const int c0n = (d == 0) ? c0 + CL_ : c0 - CL_; load_raw(raw, PRW, VFIRST, b, (d == 0) ? c0n + et : c0n + 63 - et, hc, ec, d, l, (tid & 7) < 4); }
        { blk_stage<false, true, false>(L + O_XA, L + O_XAT, nullptr, nullptr, nullptr, L + O_AH, L + O_KH, wave, fr, fq); }
        __syncthreads();
        { blk_stage<true, true, false>(L + O_AH, L + O_KH, L + O_UT, L + O_BH, nullptr, L + O_XA, L + O_XAT, wave, fr, fq); }
        __syncthreads();
        { blk_stage<true, true, false>(L + O_XA, L + O_XAT, L + O_BH, L + O_UT, nullptr, L + O_AH, L + O_KH, wave, fr, fq); }
        __syncthreads();
        { blk_stage<true, true, false>(L + O_AH, L + O_KH, L + O_UT, L + O_BH, nullptr, L + O_XA, L + O_XAT, wave, fr, fq); }
        __syncthreads();
        { blk_stage<true, false, true>(L + O_XA, L + O_XAT, L + O_BH, L + O_TB, L + O_T0T, nullptr, nullptr, wave, fr, fq); }
        __syncthreads();
        { if (wave < 4) { const int bmt = (wave >> 1) & 1, bnt = wave & 1;
            bf16x8 a0 = ldfrag(L + O_XA, LDB, 32, 0, fr, fq), a1 = ldfrag(L + O_XA, LDB, 48, 0, fr, fq), t1b = ldfrag(L + O_T0T, LDB, 16 * bnt, 0, fr, fq), t22 = ldfrag(L + O_TB, LDB, 32 + 16 * bmt, 32, fr, fq);
            const f32x4 z4 = (f32x4){0.f, 0.f, 0.f, 0.f};
            const f32x4 w0 = MFMA16(a0, t1b, z4), w1 = MFMA16(a1, t1b, z4);
            st_tile_bf16_T(L + O_WT, LDB, 0, 16 * bnt, fr, fq, w0); st_tile_bf16_T(L + O_WT, LDB, 16, 16 * bnt, fr, fq, w1);
            LDS_WAIT();
            const bf16x8 wb = ldfrag(L + O_WT, LDB, 16 * bnt, 0, fr, fq);
            const f32x4 t21 = MFMA16(t22, wb, z4);
            st_tile_bf16(L + O_TB, LDB, 32 + 16 * bmt, 16 * bnt, fr, fq, t21);
        } else { const int bmt = (wave >> 1) & 1, bnt = wave & 1;
            unsigned zz_ = 0u; asm volatile("" : "+v"(zz_)); *(LAS v2u*)(L + O_TB + ((16 * bmt + fr) * LDB + 32 + 16 * bnt + 4 * fq) * 2) = (v2u){zz_, zz_}; } }
        f32x4 y0[2] = {(f32x4){0.f, 0.f, 0.f, 0.f}, (f32x4){0.f, 0.f, 0.f, 0.f}}, g0[2] = {y0[0], y0[0]};
        { f32x4 m1[2] = {(f32x4){0.f, 0.f, 0.f, 0.f}, (f32x4){0.f, 0.f, 0.f, 0.f}};
          bf16x8 aak[2], ark[2], vta[2], vtb[2][2], khb[2][2];
          ldA(aak, L + O_AAK, mt, fr, fq); ldB(vtb, L + O_VT, nt0, fr, fq); ldA(ark, L + O_ARK, mt, fr, fq); ldA(vta, L + O_VT, mt, fr, fq); ldB(khb, L + O_KHT, nt0, fr, fq);
          CFENCE();
          mmac(aak, vtb, m1); mmacT(ark, vtb, y0); mmac(vta, khb, g0);
#pragma unroll
          for (int j = 0; j < 2; ++j) st_tile_bf16_T(L + O_M1T, LDB, 16 * mt, 16 * (nt0 + j), fr, fq, m1[j]); }
        __syncthreads();
        f32x4 u0[2] = {(f32x4){0.f, 0.f, 0.f, 0.f}, (f32x4){0.f, 0.f, 0.f, 0.f}};
        { f32x4 ap[2] = {u0[0], u0[0]};
          bf16x8 tba[2], ahb[2][2], m1b[2][2];
          ldA(tba, L + O_TB, mt, fr, fq); ldB(ahb, L + O_AHT, nt0, fr, fq); ldB(m1b, L + O_M1T, nt0, fr, fq);
          CFENCE();
          mmac(tba, ahb, ap); mmac(tba, m1b, u0);
#pragma unroll
          for (int j = 0; j < 2; ++j) st_tile_bf16(L + O_APB, LDB, 16 * mt, 16 * (nt0 + j), fr, fq, ap[j]);
          if (seg) {
#pragma unroll
              for (int j = 0; j < 2; ++j) st_tile_bf16(L + O_VT, LDB, 16 * mt, 16 * (nt0 + j), fr, fq, Ph[j]); } }
        __syncthreads();
        { bf16x8 apa[2], s0b[2][2], phb[2][2];
          ldA(apa, L + O_APB, mt, fr, fq); ldB(s0b, L + O_S0B, nt0, fr, fq); phb[0][0] = ZFRAG; phb[0][1] = ZFRAG; phb[1][0] = ZFRAG; phb[1][1] = ZFRAG; if (seg) ldB(phb, L + O_VT, nt0, fr, fq);
          CFENCE();
          mmac(apa, s0b, u0);
#pragma unroll
          for (int j = 0; j < 2; ++j) st_tile_bf16_T(L + O_UT, LDB, 16 * mt, 16 * (nt0 + j), fr, fq, u0[j]);
          if (seg) { f32x4 up[2] = {(f32x4){0.f, 0.f, 0.f, 0.f}, (f32x4){0.f, 0.f, 0.f, 0.f}};
              mmac(apa, phb, up);
#pragma unroll
              for (int j = 0; j < 2; ++j) st_tile_bf16_T(L + O_KHT, LDB, 16 * mt, 16 * (nt0 + j), fr, fq, up[j]); } }
        __syncthreads();
        { bf16x8 rha[2], arba[2], uta[2], s0b[2][2], utb[2][2], bhb[2][2]; float plv[2];
          ldA(rha, L + O_RH, mt, fr, fq); ldB(s0b, L + O_S0B, nt0, fr, fq); ldA(arba, L + O_ARB, mt, fr, fq); ldB(utb, L + O_UT, nt0, fr, fq);
#pragma unroll
          for (int j = 0; j < 2; ++j) plv[j] = *(LAS float*)(L + O_PL + (16 * (nt0 + j) + fr) * 4);
          CFENCE();
          mmacT(rha, s0b, y0);
          ldA(uta, L + O_UT, mt, fr, fq); ldB(bhb, L + O_BHT, nt0, fr, fq);
          CFENCE();
          mmacT(arba, utb, y0);
          { const int s = 16 * mt + fr; const int tk = (d == 0) ? c0 + s : c0 + 63 - s;
#pragma unroll
            for (int j = 0; j < 2; ++j) { v2u o; o.x = pk2(y0[j][0], y0[j][1]); o.y = pk2(y0[j][2], y0[j][3]); *(v2u*)(YS + ((size_t)b * T + tk) * CH + hc + 16 * (nt0 + j) + 4 * fq) = o; } }
          f32x4 sn[2] = {g0[0], g0[1]};
          mmac(uta, bhb, sn);
#pragma unroll
          for (int j = 0; j < 2; ++j) S[j] = (S[j] + sn[j]) * plv[j];
          if (seg) { f32x4 yp[2] = {(f32x4){0.f, 0.f, 0.f, 0.f}, (f32x4){0.f, 0.f, 0.f, 0.f}}, pn[2] = {yp[0], yp[0]};
              bf16x8 rh2[2], arb2[2], kha[2], phb[2][2], khb[2][2], bh2[2][2];
              ldA(rh2, L + O_RH, mt, fr, fq); ldB(phb, L + O_VT, nt0, fr, fq); ldA(arb2, L + O_ARB, mt, fr, fq); ldB(khb, L + O_KHT, nt0, fr, fq); ldA(kha, L + O_KHT, mt, fr, fq); ldB(bh2, L + O_BHT, nt0, fr, fq);
              CFENCE();
              mmacT(rh2, phb, yp);
              mmacT(arb2, khb, yp);
              { const int s = 16 * mt + fr; const int tk = (d == 0) ? c0 + s : c0 + 63 - s;
#pragma unroll
                for (int j = 0; j < 2; ++j) { v2u o; o.x = pk2(yp[j][0], yp[j][1]); o.y = pk2(yp[j][2], yp[j][3]); *(v2u*)(YPHI + (size_t)(tk & (T / 2 - 1)) * 64 + 16 * (nt0 + j) + 4 * fq) = o; } }
              mmac(kha, bh2, pn);
#pragma unroll
              for (int j = 0; j < 2; ++j) Ph[j] = (Ph[j] + pn[j]) * plv[j]; } }
        __syncthreads();
#pragma unroll
        for (int j = 0; j < 2; ++j) st_tile_bf16(L + O_S0B, LDB, 16 * mt, 16 * (nt0 + j), fr, fq, S[j]);
    }
    if (seg == 0) { float* SF = (float*)(F.ws + WS_SFIN) + (size_t)chain * 4096;
        int t2 = (int)__builtin_amdgcn_mbcnt_hi(~0u, __builtin_amdgcn_mbcnt_lo(~0u, 0u)); asm volatile("" : "+v"(t2)); const int fr2 = t2 & 15, fq2 = (t2 >> 4) & 3;
#pragma unroll
        for (int j = 0; j < 2; ++j)
#pragma unroll
            for (int jj = 0; jj < 4; ++jj) SF[(16 * mt + 4 * fq2 + jj) * 64 + 16 * (nt0 + j) + fr2] = S[j][jj]; }
    __syncthreads();
}


__device__ __forceinline__ void tr_item(const float* W, int ld, int col0, int nblk, int K, bf16* WT, int row_off, LAS float* scr, int item, int lane, const float* gain = nullptr) {
    const int kb = item / nblk, nb = item % nblk, k0 = 64 * kb, n0 = 32 * nb;
    float wv[32];
#pragma unroll
    for (int i = 0; i < 32; ++i) wv[i] = W[(size_t)(k0 + 2 * i + (lane >> 5)) * ld + col0 + n0 + (lane & 31)];
    if (gain) {
#pragma unroll
        for (int i = 0; i < 32; ++i) wv[i] *= gain[k0 + 2 * i + (lane >> 5)]; }
#pragma unroll
    for (int i = 0; i < 32; ++i) scr[(2 * i + (lane >> 5)) * 33 + (lane & 31)] = wv[i];
    LDS_WAIT(); asm volatile("" ::: "memory");
    const int c = lane & 7;
#pragma unroll
    for (int j = 0; j < 4; ++j) { const int n = (lane >> 3) + 8 * j; const LAS float* s = scr + (8 * c) * 33 + n;
        v4u o; o.x = pk2(s[0 * 33], s[1 * 33]); o.y = pk2(s[2 * 33], s[3 * 33]); o.z = pk2(s[4 * 33], s[5 * 33]); o.w = pk2(s[6 * 33], s[7 * 33]);
        *(v4u*)(WT + (size_t)(row_off + n0 + n) * K + k0 + 8 * c) = o; }
    LDS_WAIT(); asm volatile("" ::: "memory");
}
__device__ __forceinline__ void wq_max_item(const float* W, int ld, int col0, int nblk, unsigned* cmax, int item, int lane) {
    const int kb = item / nblk, nb = item % nblk, k0 = 64 * kb, n0 = 32 * nb; float am = 0.f;
#pragma unroll
    for (int i = 0; i < 32; ++i) am = fmaxf(am, fabsf(W[(size_t)(k0 + 2 * i + (lane >> 5)) * ld + col0 + n0 + (lane & 31)]));
    am = fmaxf(am, __shfl_xor(am, 32));
    if (lane < 32) atomicMax(cmax + n0 + lane, __float_as_uint(am));
}
__device__ __forceinline__ void wq_item(const float* W, int ld, int col0, int nblk, const unsigned* cmax, float* csc, unsigned char* WQ, int row_off, LAS float* scr, int item, int lane) {
    const int kb = item / nblk, nb = item % nblk, k0 = 64 * kb, n0 = 32 * nb;
    float wv[32];
#pragma unroll
    for (int i = 0; i < 32; ++i) wv[i] = W[(size_t)(k0 + 2 * i + (lane >> 5)) * ld + col0 + n0 + (lane & 31)];
#pragma unroll
    for (int i = 0; i < 32; ++i) scr[(2 * i + (lane >> 5)) * 33 + (lane & 31)] = wv[i];
    LDS_WAIT(); asm volatile("" ::: "memory");
    const int c = lane & 7;
#pragma unroll
    for (int j = 0; j < 4; ++j) { const int n = (lane >> 3) + 8 * j; const LAS float* sp = scr + (8 * c) * 33 + n;
        const float cm = __uint_as_float(cmax[n0 + n]), inv = cm > 0.f ? 127.0f / cm : 0.f;
        v2u o; o.x = q4(sp[0 * 33] * inv, sp[1 * 33] * inv, sp[2 * 33] * inv, sp[3 * 33] * inv); o.y = q4(sp[4 * 33] * inv, sp[5 * 33] * inv, sp[6 * 33] * inv, sp[7 * 33] * inv);
        *(v2u*)(WQ + (size_t)(row_off + n0 + n) * D + k0 + 8 * c) = o;
        if (kb == 0 && c == 0) csc[n0 + n] = cm * (1.0f / 127.0f); }
    LDS_WAIT(); asm volatile("" ::: "memory");
}
__device__ __forceinline__ void p_convert(Frame& F) {
    PHASE_TID();
    LAS float* scr = (LAS float*)(F.lds + wave * 16384);
    const int gw = bid * NWAVES + wave, NGW = F.G * NWAVES;
    constexpr int C_HY = 16 * 48, C_RW = 16 * 60, C_V1 = 16, C_O = 16 * 32, C_1 = 16 * 128, C_2 = 64 * 32, C_L = C_HY + C_RW + C_V1 + C_O + C_1 + C_2;
    for (int it = gw; it < NL * C_L; it += NGW) {
        const int l = it / C_L; int r = it % C_L;
        unsigned char* wb = F.ws + WS_W + (size_t)l * W_LAYER;
        const float* win = F.in[I_WIN] + (size_t)l * D * PIN;
        unsigned* cmax = F.ctl + CW_CMAX + l * (HYP + NRW);
        if (r < C_HY) { wq_max_item(win, PIN, 0, 48, cmax, r, lane); continue; } r -= C_HY;
        if (r < C_RW) { wq_max_item(win, PIN, HYP, 60, cmax + HYP, r, lane); continue; } r -= C_RW;
        if (r < C_V1) { if (l == 1) wq_max_item(F.in[I_V1], 32, 0, 1, cmax + HYP + RWP, r, lane); continue; } r -= C_V1;
        if (r < C_O) { tr_item(F.in[I_WOUT] + (size_t)l * D * D, D, 0, 32, D, (bf16*)(wb + W_O), 0, scr, r, lane); continue; } r -= C_O;
        if (r < C_1) { tr_item(F.in[I_MW1] + (size_t)l * D * FF, FF, 0, 128, D, (bf16*)(wb + W_1), 0, scr, r, lane, F.in[I_N2G] + (size_t)l * D); continue; } r -= C_1;
        tr_item(F.in[I_MW2] + (size_t)l * FF * D, D, 0, 32, FF, (bf16*)(wb + W_2), 0, scr, r, lane);
    }
}
__device__ __forceinline__ void p_wquant(Frame& F) {
    PHASE_TID();
    LAS float* scr = (LAS float*)(F.lds + wave * 16384);
    const int gw = bid * NWAVES + wave, NGW = F.G * NWAVES;
    constexpr int C_HY = 16 * 48, C_RW = 16 * 60, C_V1 = 16, C_L = C_HY + C_RW + C_V1;
    for (int it = gw; it < NL * C_L; it += NGW) {
        const int l = it / C_L; int r = it % C_L;
        unsigned char* wb = F.ws + WS_W + (size_t)l * W_LAYER;
        const float* win = F.in[I_WIN] + (size_t)l * D * PIN;
        const unsigned* cmax = F.ctl + CW_CMAX + l * (HYP + NRW); float* csc = (float*)(F.ws + WS_CSC) + l * (HYP + NRW);
        if (r < C_HY) { wq_item(win, PIN, 0, 48, cmax, csc, wb + W_HY, 0, scr, r, lane); continue; } r -= C_HY;
        if (r < C_RW) { wq_item(win, PIN, HYP, 60, cmax + HYP, csc + HYP, wb + W_RW, 0, scr, r, lane); continue; } r -= C_RW;
        if (l == 1) wq_item(F.in[I_V1], 32, 0, 1, cmax + HYP + RWP, csc + HYP + RWP, wb + W_RW, RWP, scr, r, lane);
    }
    for (int l = 0; l < NL; ++l) {
        const int r0 = (l == 0) ? RWP : RWP + 32; const int n16 = (NRW - r0) * D / 16;
        v4u* p = (v4u*)(F.ws + WS_W + (size_t)l * W_LAYER + W_RW + (size_t)r0 * D);
        for (int i = bid * NTHR + tid; i < n16; i += F.G * NTHR) p[i] = (v4u){0u, 0u, 0u, 0u};
        float* csc = (float*)(F.ws + WS_CSC) + l * (HYP + NRW) + HYP;
        if (bid == 0 && tid < NRW - r0) csc[r0 + tid] = 0.f;
    }
}

__device__ __forceinline__ void p_filter_item(Frame& F, int l, int item) {
    LAS float* Z = (LAS float*)F.lds;
    LAS float* H1 = Z + 32 * 36;
    LAS float* H2 = H1 + 32 * 64;
    LAS float* H3 = H2 + 32 * 64;
    PHASE_TID(); const int pos0 = item * 32;
    const float* w1 = F.in[I_FW1] + l * 33 * 64; const float* b1 = F.in[I_FB1] + l * 64;
    const float* w2 = F.in[I_FW2] + l * 64 * 64; const float* b2 = F.in[I_FB2] + l * 64;
    const float* w3 = F.in[I_FW3] + l * 64 * 64; const float* b3 = F.in[I_FB3] + l * 64;
    const float* fq = F.in[I_FFREQ] + l * 3 * 64;
    __syncthreads();
    for (int e = tid; e < 32 * 33; e += NTHR) {
        const int p = e / 33, f = e % 33, pos = pos0 + p; float v;
        if (f == 0) v = (float)pos / (float)(T - 1);
        else { const int band = (f - 1) & 15; const float fr = 1e-4f + (float)band * ((15.0f - 1e-4f) / 15.0f);
            float x = (float)pos * fr * (1.0f / (float)T); x -= floorf(x);
            v = (f <= 16) ? __builtin_amdgcn_cosf(x) : -__builtin_amdgcn_sinf(x); }
        Z[p * 36 + f] = v;
    }
    __syncthreads();
    const int j = tid & 63, pb = tid >> 6;
    { float wc[33];
#pragma unroll
      for (int f = 0; f < 33; ++f) wc[f] = w1[f * 64 + j];
      const float bj = b1[j], fj = fq[j];
#pragma unroll
      for (int i = 0; i < 4; ++i) { const int p = pb + 8 * i; float s = bj;
#pragma unroll
          for (int f = 0; f < 33; ++f) s += Z[p * 36 + f] * wc[f];
          H1[p * 64 + j] = sin_hw(fj * s); } }
    __syncthreads();
#pragma unroll 1
    for (int ly = 0; ly < 2; ++ly) { const float* w = ly ? w3 : w2; const float* bb = ly ? b3 : b2; const LAS float* Hi = ly ? H2 : H1; LAS float* Ho = ly ? H3 : H2;
        float wc[64];
#pragma unroll
        for (int f = 0; f < 64; ++f) wc[f] = w[f * 64 + j];
        const float bj = bb[j], fj = fq[64 + 64 * ly + j];
#pragma unroll
        for (int i = 0; i < 4; ++i) { const int p = pb + 8 * i; float s = bj;
#pragma unroll
            for (int q = 0; q < 16; ++q) { const f32x4 h = *(const LAS f32x4*)(Hi + p * 64 + 4 * q); s += (h[0] * wc[4 * q] + h[1] * wc[4 * q + 1]) + (h[2] * wc[4 * q + 2] + h[3] * wc[4 * q + 3]); }
            Ho[p * 64 + j] = sin_hw(fj * s); }
        __syncthreads(); }
    const int fr = lane & 15, fqd = lane >> 4;
    bf16x8 af[2][2];
#pragma unroll
    for (int mt = 0; mt < 2; ++mt)
#pragma unroll
        for (int ks = 0; ks < 2; ++ks) { const LAS float* hp = H3 + (16 * mt + fr) * 64 + 32 * ks + 8 * fqd; const f32x4 h0 = *(const LAS f32x4*)hp, h1 = *(const LAS f32x4*)(hp + 4);
            const float hv[8] = {h0[0], h0[1], h0[2], h0[3], h1[0], h1[1], h1[2], h1[3]}; af[mt][ks] = __builtin_bit_cast(bf16x8, pack8(hv)); }
    const float* wo = F.in[I_FWOUT] + (size_t)l * 64 * 2048;
    float* HF = (float*)(F.ws + WS_HF);
#pragma unroll 1
    for (int tb = 0; tb < 16; tb += 4) {
        bf16x8 bfr[4][2];
#pragma unroll
        for (int u = 0; u < 4; ++u)
#pragma unroll
            for (int ks = 0; ks < 2; ++ks) { float v[8]; const float* wp = wo + (size_t)(32 * ks + 8 * fqd) * 2048 + 256 * wave + 16 * (tb + u) + fr;
#pragma unroll
                for (int e = 0; e < 8; ++e) v[e] = wp[(size_t)e * 2048];
                bfr[u][ks] = __builtin_bit_cast(bf16x8, pack8(v)); }
#pragma unroll
        for (int u = 0; u < 4; ++u) { const int col = 256 * wave + 16 * (tb + u) + fr, c = col & 511;
            const float delta = 3.0701134573f + (float)c * ((15.350567286f - 3.0701134573f) / 511.0f);
#pragma unroll
            for (int mt = 0; mt < 2; ++mt) { f32x4 acc = (f32x4){0.f, 0.f, 0.f, 0.f};
                acc = MFMA16(af[mt][0], bfr[u][0], acc); acc = MFMA16(af[mt][1], bfr[u][1], acc);
                f32x4 o;
#pragma unroll
                for (int jj = 0; jj < 4; ++jj) { const float t = (float)(pos0 + 16 * mt + 4 * fqd + jj) / (float)(T - 1); o[jj] = acc[jj] * __expf(-t * delta); }
                *(f32x4*)(HF + (size_t)col * T + pos0 + 16 * mt + 4 * fqd) = o; } } }
}
__device__ __forceinline__ void p_filter(Frame& F, int l) { PHASE_TID(); (void)tid; for (int it = bid; it < T / 32; it += F.G) p_filter_item(F, l, it); __syncthreads(); }

template <bool F32IN> __device__ __forceinline__ void p_rmsnorm_q(Frame& F, const void* xin, const float* g, unsigned char* HQ, float* RSC, int m0, int m1) {
    PHASE_TID();
    const int gw = bid * NWAVES + wave, NGW = F.G * NWAVES;
    constexpr int R = F32IN ? 2 : 4;
    f32x4 gv[4];
#pragma unroll
    for (int j = 0; j < 4; ++j) gv[j] = F32IN ? *(const f32x4*)(g + 4 * lane + 256 * j) : *(const f32x4*)(g + 16 * lane + 4 * j);
    for (int mb = m0 + gw; mb < m1; mb += R * NGW) {
        f32x4 xf[F32IN ? R : 1][4]; v4u xw[F32IN ? 1 : R][2];
#pragma unroll
        for (int r = 0; r < R; ++r) { const int m = mb + r * NGW;
            if (F32IN) { const f32x4* xr = (const f32x4*)((const float*)xin + (size_t)m * D) + lane;
#pragma unroll
                for (int j = 0; j < 4; ++j) xf[r][j] = xr[64 * j]; }
            else { const v4u* xr = (const v4u*)((const bf16*)xin + (size_t)m * D + 16 * lane); xw[r][0] = xr[0]; xw[r][1] = xr[1]; } }
        asm volatile("" ::: "memory");
#pragma unroll
        for (int r = 0; r < R; ++r) { const int m = mb + r * NGW;
            f32x4 v[4]; float s = 0.f;
            if (F32IN) {
#pragma unroll
                for (int j = 0; j < 4; ++j) v[j] = xf[r][j]; }
            else { const unsigned ww[8] = {xw[r][0].x, xw[r][0].y, xw[r][0].z, xw[r][0].w, xw[r][1].x, xw[r][1].y, xw[r][1].z, xw[r][1].w};
#pragma unroll
                for (int j = 0; j < 4; ++j) v[j] = (f32x4){bflo(ww[2 * j]), bfhi(ww[2 * j]), bflo(ww[2 * j + 1]), bfhi(ww[2 * j + 1])}; }
#pragma unroll
            for (int j = 0; j < 4; ++j) s += (v[j].x * v[j].x + v[j].y * v[j].y) + (v[j].z * v[j].z + v[j].w * v[j].w);
            const float rstd = 1.0f / sqrtf(wave_sum(s) * (1.0f / D) + RMS_EPS);
            float am = 0.f;
#pragma unroll
            for (int j = 0; j < 4; ++j) { v[j] = v[j] * rstd * gv[j]; am = fmaxf(fmaxf(am, fmaxf(fabsf(v[j].x), fabsf(v[j].y))), fmaxf(fabsf(v[j].z), fabsf(v[j].w))); }
            am = wave_max(am);
            const float inv = am > 0.f ? 127.0f / am : 0.f;
            unsigned qd[4];
#pragma unroll
            for (int j = 0; j < 4; ++j) qd[j] = q4(v[j].x * inv, v[j].y * inv, v[j].z * inv, v[j].w * inv);
            if (F32IN) {
#pragma unroll
                for (int j = 0; j < 4; ++j) *(unsigned*)(HQ + (size_t)m * D + 256 * j + 4 * lane) = qd[j]; }
            else *(v4u*)(HQ + (size_t)m * D + 16 * lane) = (v4u){qd[0], qd[1], qd[2], qd[3]};
            if (lane == 0) RSC[m] = am * (1.0f / 127.0f); }
    }
}
__device__ __forceinline__ void p_rmsnorm_b16(Frame& F, const bf16* x, const float* g, bf16* out, int m0, int m1) {
    PHASE_TID();
    const int gw = bid * NWAVES + wave, NGW = F.G * NWAVES;
    f32x4 gv[4];
#pragma unroll
    for (int j = 0; j < 4; ++j) gv[j] = *(const f32x4*)(g + 16 * lane + 4 * j);
    for (int m = m0 + gw; m < m1; m += NGW) {
        const v4u* xr = (const v4u*)(x + (size_t)m * D + 16 * lane); const v4u w0 = xr[0], w1 = xr[1];
        const unsigned ww[8] = {w0.x, w0.y, w0.z, w0.w, w1.x, w1.y, w1.z, w1.w}; f32x4 v[4]; float s = 0.f;
#pragma unroll
        for (int j = 0; j < 4; ++j) { v[j] = (f32x4){bflo(ww[2 * j]), bfhi(ww[2 * j]), bflo(ww[2 * j + 1]), bfhi(ww[2 * j + 1])}; s += (v[j].x * v[j].x + v[j].y * v[j].y) + (v[j].z * v[j].z + v[j].w * v[j].w); }
        const float rstd = 1.0f / sqrtf(wave_sum(s) * (1.0f / D) + RMS_EPS);
        v4u o[2];
#pragma unroll
        for (int j = 0; j < 2; ++j) { const f32x4 ya = v[2 * j] * rstd * gv[2 * j], yb = v[2 * j + 1] * rstd * gv[2 * j + 1]; o[j].x = pk2(ya.x, ya.y); o[j].y = pk2(ya.z, ya.w); o[j].z = pk2(yb.x, yb.y); o[j].w = pk2(yb.z, yb.w); }
        v4u* op = (v4u*)(out + (size_t)m * D + 16 * lane); op[0] = o[0]; op[1] = o[1];
    }
}
__device__ __forceinline__ void p_finalnorm(Frame& F, const bf16* x, const float* g, float* out) {
    PHASE_TID();
    const int gw = bid * NWAVES + wave, NGW = F.G * NWAVES;
    constexpr int R = 4;
    f32x4 gv[4];
#pragma unroll
    for (int j = 0; j < 4; ++j) gv[j] = *(const f32x4*)(g + 4 * lane + 256 * j);
    for (int mb = gw; mb < M; mb += R * NGW) {
        v2u xw[R][4];
#pragma unroll
        for (int r = 0; r < R; ++r) { const v2u* xr = (const v2u*)(x + (size_t)(mb + r * NGW) * D) + lane;
#pragma unroll
            for (int j = 0; j < 4; ++j) xw[r][j] = xr[64 * j]; }
        asm volatile("" ::: "memory");
#pragma unroll
        for (int r = 0; r < R; ++r) { f32x4 v[4]; float s = 0.f;
#pragma unroll
            for (int j = 0; j < 4; ++j) { v[j] = (f32x4){bflo(xw[r][j].x), bfhi(xw[r][j].x), bflo(xw[r][j].y), bfhi(xw[r][j].y)}; s += (v[j].x * v[j].x + v[j].y * v[j].y) + (v[j].z * v[j].z + v[j].w * v[j].w); }
            const float rstd = 1.0f / sqrtf(wave_sum(s) * (1.0f / D) + RMS_EPS);
            f32x4* o = (f32x4*)(out + (size_t)(mb + r * NGW) * D) + lane;
#pragma unroll
            for (int j = 0; j < 4; ++j) o[64 * j] = v[j] * rstd * gv[j]; }
    }
}
template <bool F32OUT> __device__ __forceinline__ void p_rmsnorm(Frame& F, const float* x, const float* g, void* outp, int m0, int m1) {
    PHASE_TID();
    const int gw = bid * NWAVES + wave, NGW = F.G * NWAVES;
    f32x4 gv[4];
#pragma unroll
    for (int j = 0; j < 4; ++j) gv[j] = *(const f32x4*)(g + 4 * lane + 256 * j);
    for (int m = m0 + gw; m < m1; m += NGW) {
        const f32x4* xr = (const f32x4*)(x + (size_t)m * D) + lane; f32x4 v[4]; float s = 0.f;
#pragma unroll
        for (int j = 0; j < 4; ++j) { v[j] = xr[64 * j]; s += (v[j].x * v[j].x + v[j].y * v[j].y) + (v[j].z * v[j].z + v[j].w * v[j].w); }
        const float rstd = 1.0f / sqrtf(wave_sum(s) * (1.0f / D) + RMS_EPS);
        if (F32OUT) { f32x4* o = (f32x4*)((float*)outp + (size_t)m * D) + lane;
#pragma unroll
            for (int j = 0; j < 4; ++j) o[64 * j] = v[j] * rstd * gv[j]; }
        else { v2u* o = (v2u*)((bf16*)outp + (size_t)m * D) + lane;
#pragma unroll
            for (int j = 0; j < 4; ++j) { const f32x4 y = v[j] * rstd * gv[j]; v2u w; w.x = pk2(y.x, y.y); w.y = pk2(y.z, y.w); o[64 * j] = w; } }
    }
}

constexpr int KPAD = 2 * T + 2 * T / 16;

constexpr int LC = 32;

__device__ __forceinline__ void p_mix(Frame& F, int l) {
    PHASE_TID();
#ifndef NO_SCAN
#ifdef SEQ_SCAN
    if (bid < 128) scan_chain(F, l, bid);
#else
    cscan_chain(F, l, bid);
#endif
#endif
    unsigned* head = F.ctl + CW_QUEUE + 64 * l;
    for (;;) {
        __syncthreads();
        if (tid == 0) F.MISC[16] = __hip_atomic_fetch_add(head, 1u, RLX_AGENT);
        __syncthreads();
        const unsigned it = F.MISC[16];
        if (it >= (unsigned)(4 * CH)) break;
        hy_fft_item(F, l, (int)it);
    }
    __syncthreads();
}

__device__ __forceinline__ void p_post(Frame& F, int l) {
    PHASE_TID();
    const int gw = bid * NWAVES + wave, NGW = F.G * NWAVES;
    bf16* YM = (bf16*)(F.ws + WS_YMIX);
    { LAS float* scr = (LAS float*)(F.lds + wave * 16640);
      const bf16* PHT = (const bf16*)(F.ws + WS_PHT); const float* ng = F.in[I_HNG] + (size_t)l * CH;
      for (int it = gw; it < NB * 8 * (T / 64); it += NGW) { const int tb = it & 127, g = (it >> 7) & 7, b = it >> 10, t0 = tb * 64;
          const bf16* src = PHT + ((size_t)b * HYP + CH + g * 64 + lane) * T + t0;
#pragma unroll
          for (int q = 0; q < 8; ++q) { const v4u w = *(const v4u*)(src + 8 * q); LAS float* d = scr + lane * 65 + 8 * q;
              d[0] = bflo(w.x); d[1] = bfhi(w.x); d[2] = bflo(w.y); d[3] = bfhi(w.y); d[4] = bflo(w.z); d[5] = bfhi(w.z); d[6] = bflo(w.w); d[7] = bfhi(w.w); }
          LDS_WAIT(); asm volatile("" ::: "memory");
          float z[64], ss = 0.f;
#pragma unroll
          for (int cc = 0; cc < 64; ++cc) { z[cc] = scr[cc * 65 + lane]; ss += z[cc] * z[cc]; }
          const float rs = 1.0f / sqrtf(ss * (1.0f / 64.0f) + RMS_EPS);
          bf16* dst = YM + ((size_t)b * T + t0 + lane) * D + g * 64;
#pragma unroll
          for (int q = 0; q < 8; ++q) { v4u o; const float* gq = ng + g * 64 + 8 * q;
              o.x = pk2(z[8 * q] * rs * gq[0], z[8 * q + 1] * rs * gq[1]); o.y = pk2(z[8 * q + 2] * rs * gq[2], z[8 * q + 3] * rs * gq[3]);
              o.z = pk2(z[8 * q + 4] * rs * gq[4], z[8 * q + 5] * rs * gq[5]); o.w = pk2(z[8 * q + 6] * rs * gq[6], z[8 * q + 7] * rs * gq[7]);
              *(v4u*)(dst + 8 * q) = o; }
          LDS_WAIT(); asm volatile("" ::: "memory"); } }
}

struct PostRows { v4u a, c, v, g; float bs; };
__device__ __forceinline__ void post_rows_load(PostRows& R, const bf16* YS0, const bf16* YS1, const bf16* VV, const bf16* GG, const float* BS0, const float* BS1, size_t m, int h, int ec) {
    const size_t o = m * CH + h * HD + ec;
    R.a = *(const v4u*)(YS0 + o); R.c = *(const v4u*)(YS1 + o); R.v = *(const v4u*)(VV + o); R.g = *(const v4u*)(GG + o); R.bs = BS0[m * NH + h] + BS1[m * NH + h];
}
__device__ __forceinline__ void p_postfix(Frame& F, int l) {
    PHASE_TID(); const int fr = lane & 15, fq = lane >> 4, mtw = wave >> 1, ntw = 2 * (wave & 1), et = tid >> 3, ec = (tid & 7) * 8;
    const int bh = bid >> 2, b = bh >> 3, h = bh & 7, tq = bid & 3, dfix = (tq >= 2) ? 0 : 1, chain = (b * NH + h) * 2 + dfix;
    const float* SF = (const float*)(F.ws + WS_SFIN) + (size_t)chain * 4096;
    bf16x8 sfb[2][2];
#pragma unroll
    for (int ks = 0; ks < 2; ++ks)
#pragma unroll
        for (int j = 0; j < 2; ++j) { const float* sp = SF + (16 * (ntw + j) + fr) * 64 + 32 * ks + 8 * fq; const f32x4 s0 = *(const f32x4*)sp, s1 = *(const f32x4*)(sp + 4);
            const float sv[8] = {s0[0], s0[1], s0[2], s0[3], s1[0], s1[1], s1[2], s1[3]}; sfb[ks][j] = __builtin_bit_cast(bf16x8, pack8(sv)); }
    const bf16* YP = (const bf16*)(F.ws + WS_YPHI) + ((size_t)chain * (T / 2) + 16 * mtw + fr) * 64 + 8 * fq;
    const bf16* YS0 = (const bf16*)(F.ws + WS_YS); const bf16* YS1 = YS0 + (size_t)M * CH;
    const bf16* VV = (l == 0) ? (const bf16*)(F.ws + WS_VFIRST) : (const bf16*)(F.ws + WS_V2);
    const bf16* GG = (const bf16*)(F.ws + WS_G); const float* BS0 = (const float*)(F.ws + WS_BS); const float* BS1 = BS0 + (size_t)M * NH;
    bf16* YM = (bf16*)(F.ws + WS_YMIX);
    float lg[8], lb[8];
#pragma unroll
    for (int j = 0; j < 8; ++j) { lg[j] = F.in[I_LNG][l * CH + h * HD + ec + j]; lb[j] = F.in[I_LNB][l * CH + h * HD + ec + j]; }
    LAS float* FX = (LAS float*)F.lds;
    const size_t mb = (size_t)b * T + 64 * (32 * tq) + et;
    __syncthreads();
    PostRows cur; bf16x8 acur[2];
    post_rows_load(cur, YS0, YS1, VV, GG, BS0, BS1, mb, h, ec);
#pragma unroll
    for (int ks = 0; ks < 2; ++ks) acur[ks] = *(const bf16x8*)(YP + (size_t)((32 * tq) & 63) * 64 * 64 + 32 * ks);
#pragma unroll 1
    for (int t = 0; t < 32; ++t) {
        PostRows nxt; bf16x8 anxt[2]; const int tn = (t + 1 < 32) ? t + 1 : t;
        post_rows_load(nxt, YS0, YS1, VV, GG, BS0, BS1, mb + 64 * tn, h, ec);
#pragma unroll
        for (int ks = 0; ks < 2; ++ks) anxt[ks] = *(const bf16x8*)(YP + (size_t)((32 * tq + tn) & 63) * 64 * 64 + 32 * ks);
        { f32x4 acc[2] = {(f32x4){0.f, 0.f, 0.f, 0.f}, (f32x4){0.f, 0.f, 0.f, 0.f}};
#pragma unroll
          for (int ks = 0; ks < 2; ++ks)
#pragma unroll
              for (int j = 0; j < 2; ++j) acc[j] = MFMA16(sfb[ks][j], acur[ks], acc[j]);
          LAS float* fx = FX + (t & 1) * 64 * 68 + (16 * mtw + fr) * 68 + 16 * ntw + 4 * fq;
          *(LAS f32x4*)fx = acc[0]; *(LAS f32x4*)(fx + 16) = acc[1]; }
        __syncthreads();
        { const LAS float* fx = FX + (t & 1) * 64 * 68 + et * 68 + ec; const f32x4 f0 = *(const LAS f32x4*)fx, f1 = *(const LAS f32x4*)(fx + 4);
          const float fv[8] = {f0[0], f0[1], f0[2], f0[3], f1[0], f1[1], f1[2], f1[3]};
          const unsigned aw[4] = {cur.a.x, cur.a.y, cur.a.z, cur.a.w}, cw[4] = {cur.c.x, cur.c.y, cur.c.z, cur.c.w}, vx[4] = {cur.v.x, cur.v.y, cur.v.z, cur.v.w}, gx[4] = {cur.g.x, cur.g.y, cur.g.z, cur.g.w};
          float sv[8], sum = 0.f;
#pragma unroll
          for (int j = 0; j < 4; ++j) { sv[2 * j] = bflo(aw[j]) + bflo(cw[j]) + fv[2 * j]; sv[2 * j + 1] = bfhi(aw[j]) + bfhi(cw[j]) + fv[2 * j + 1]; sum += sv[2 * j] + sv[2 * j + 1]; }
          const float mean = sum8(sum) * (1.0f / 64.0f); float q = 0.f;
#pragma unroll
          for (int j = 0; j < 8; ++j) { sv[j] -= mean; q += sv[j] * sv[j]; }
          const float rs = 1.0f / sqrtf(sum8(q) * (1.0f / 64.0f) + GN_EPS);
          float y[8];
#pragma unroll
          for (int j = 0; j < 4; ++j) { y[2 * j] = (sv[2 * j] * rs * lg[2 * j] + lb[2 * j] + cur.bs * bflo(vx[j])) * bflo(gx[j]);
                                        y[2 * j + 1] = (sv[2 * j + 1] * rs * lg[2 * j + 1] + lb[2 * j + 1] + cur.bs * bfhi(vx[j])) * bfhi(gx[j]); }
          v4u ov; ov.x = pk2(y[0], y[1]); ov.y = pk2(y[2], y[3]); ov.z = pk2(y[4], y[5]); ov.w = pk2(y[6], y[7]);
          *(v4u*)(YM + (mb + 64 * t) * D + CH + h * HD + ec) = ov; }
        cur = nxt; acur[0] = anxt[0]; acur[1] = anxt[1];
    }
    __syncthreads();
}
__device__ __forceinline__ int obid() { int b = blockIdx.x; asm volatile("" : "+s"(b)); return b; }
struct Args { const float* in[34]; float* out; unsigned char* ws; int ph_lo, ph_hi; };
__global__ void __launch_bounds__(NTHR, 2) enc_fwd(Args args) {
    extern __shared__ __attribute__((aligned(16))) unsigned char lds[];
    Frame F;
    F.lds = (LAS unsigned char*)lds;
    F.MISC = (volatile LAS unsigned*)(F.lds + LDSCTL_OFF);
    F.G = gridDim.x;
    F.ws = args.ws; F.out = args.out; F.ctl = (unsigned*)(args.ws + WS_CTL);
    F.in = args.in;
    for (int u = threadIdx.x; u < (LDS_BYTES - LDSCTL_OFF) / 4; u += NTHR) F.MISC[u] = 0u;
    __syncthreads();
    const XcdBarrier bar = xcd_barrier_post(F.ctl + CW_BAR, F.MISC + 8);
#define SEAM() xcd_barrier(bar)

    bf16* HN = (bf16*)(F.ws + WS_HN);
    float* RSS = (float*)(F.ws + WS_RSS);
    unsigned char* HQ = F.ws + WS_HN; float* RSC = (float*)(F.ws + WS_RSC);
    p_convert(F); __syncthreads(); p_filter(F, 0); p_rmsnorm_q<true>(F, F.in[I_X], F.in[I_N1G], HQ, RSC, 0, M / 2);
    SEAM();
    p_wquant(F);
    SEAM();
#pragma unroll 1
    for (int l = 0; l < NL; ++l) {
        unsigned char* wb = F.ws + WS_W + (size_t)l * W_LAYER;
        bf16* X2B = (bf16*)F.out;
        {
#pragma unroll 1
            for (int hf = 0; hf < 2; ++hf) { constexpr int MH = M / 2; const size_t r0 = (size_t)hf * MH;
                if (hf == 0) p_spectra(F);
                const float* CSC = (const float*)(F.ws + WS_CSC) + l * (HYP + NRW);
                { pg8::Gemm g{(const bf16*)(wb + W_HY), (const bf16*)(HQ + r0 * D), HYP, MH, D / 2}; pg8::StaticOrder S; S.init(HYP, MH, F.G, obid());
                  pg8::EpiBf16Q E{(bf16*)(F.ws + WS_PHT) + (size_t)(4 * hf) * HYP * T, (size_t)T, (size_t)HYP * T, 13, CSC, RSC + r0};
                  pg8::gemm_phase<pg8::EpiBf16Q, pg8::StaticOrder, true, true>(F.lds, g, S, E); }
                { pg8::Gemm g{(const bf16*)(HQ + r0 * D), (const bf16*)(wb + W_RW), MH, NRW, D / 2}; pg8::StaticOrder S; S.init(MH, NRW, F.G, obid());
                  pg8::EpiBf16Q E{(bf16*)(F.ws + WS_PRW) + r0 * NRW, (size_t)NRW, 0, 31, RSC + r0, CSC + HYP};
                  pg8::gemm_phase<pg8::EpiBf16Q, pg8::StaticOrder, true, true>(F.lds, g, S, E); }
                if (hf == 0) { if (l == 0) p_rmsnorm_q<true>(F, F.in[I_X], F.in[I_N1G], HQ, RSC, MH, M); else p_rmsnorm_q<false>(F, X2B, F.in[I_N1G] + (size_t)l * D, HQ, RSC, MH, M);
                    SEAM(); } }
        }
        SEAM();
        p_mix(F, l);
        SEAM();
        { p_post(F, l); p_postfix(F, l); }
        SEAM();
        {
            if (l + 1 < NL) p_filter(F, l + 1);
            pg8::Gemm g{(const bf16*)(F.ws + WS_YMIX), (const bf16*)(wb + W_O), M, D, D}; pg8::StaticOrder S; S.init(M, D, F.G, obid());
            if (l == 0) { pg8::EpiRes<1, false> E{F.in[I_X], nullptr, HN, D, RSS}; pg8::gemm_phase<pg8::EpiRes<1, false>, pg8::StaticOrder, true, true>(F.lds, g, S, E); }
            else { pg8::EpiRes<1, true> E{nullptr, X2B, HN, D, RSS}; pg8::gemm_phase<pg8::EpiRes<1, true>, pg8::StaticOrder, true, true>(F.lds, g, S, E); }
        }
        SEAM();
#pragma unroll 1
        for (int ck = 0; ck < MLP_CHUNKS; ++ck) { constexpr int MC = M / MLP_CHUNKS; const size_t r0 = (size_t)ck * MC;
            bf16* HIDc = (bf16*)(F.ws + WS_HID + (size_t)(ck & 1) * MC * FF * 2);
            {
                pg8::Gemm g{HN + r0 * D, (const bf16*)(wb + W_1), MC, FF, D}; pg8::StaticOrder S; S.init(MC, FF, F.G, obid());
                pg8::EpiBf16<1> E{HIDc, (size_t)FF};
                pg8::gemm_phase<pg8::EpiBf16<1>, pg8::StaticOrder, true, true>(F.lds, g, S, E);
            }
            SEAM();
            {
                pg8::Gemm g{HIDc, (const bf16*)(wb + W_2), MC, D, FF}; pg8::StaticOrder S; S.init(MC, D, F.G, obid());
                pg8::EpiRes<2, true> E{nullptr, HN + r0 * D, ((l + 1 < NL) ? X2B : HN) + r0 * D, D, RSS + r0 * 16};
                pg8::gemm_phase<pg8::EpiRes<2, true>, pg8::StaticOrder, true, true>(F.lds, g, S, E);
            }
            if (ck == MLP_CHUNKS - 1 && l + 1 < NL) p_rmsnorm_q<false>(F, X2B, F.in[I_N1G] + (size_t)(l + 1) * D, HQ, RSC, 0, M / 2);
        }
        SEAM();
        if (l + 1 == NL) p_finalnorm(F, HN, F.in[I_FING], F.out);
    }
#undef SEAM
}

extern "C" void kernel_launch(void* const* d_in, const int* in_sizes, int n_in, void* d_out, int out_size, void* d_ws, size_t ws_size, hipStream_t stream) {
    static int grid = 0;
    if (grid == 0) {
        if (n_in != 34 || in_sizes[0] != M * D || out_size != M * D || ws_size < WS_END) {
            fprintf(stderr, "kernel_launch: unexpected problem: n_in %d in0 %d out %d ws %zu (need %zu); nothing launched\n", n_in, n_in > 0 ? in_sizes[0] : -1, out_size, ws_size, (size_t)WS_END); grid = -1; return; }
        int dev = 0, cus = 0, per_cu = 0;
        if (hipGetDevice(&dev) != hipSuccess || hipDeviceGetAttribute(&cus, hipDeviceAttributeMultiprocessorCount, dev) != hipSuccess) { grid = -1; return; }
        if (hipFuncSetAttribute((const void*)enc_fwd, hipFuncAttributeMaxDynamicSharedMemorySize, LDS_BYTES) != hipSuccess) { fprintf(stderr, "kernel_launch: hipFuncSetAttribute failed\n"); grid = -1; return; }
        if (hipOccupancyMaxActiveBlocksPerMultiprocessor(&per_cu, (const void*)enc_fwd, NTHR, LDS_BYTES) != hipSuccess || per_cu < 1)
            fprintf(stderr, "kernel_launch: note: occupancy query reports %d workgroups per CU\n", per_cu);
        (void)hipGetLastError();
        grid = cus;
        if (grid != 256) { fprintf(stderr, "kernel_launch: built for a 256-CU device (got %d); nothing launched\n", cus); grid = -1; return; }
    }
    if (grid < 0) return;
    if (hipMemsetAsync((char*)d_ws + WS_CTL, 0, CTL_ZERO_BYTES, stream) != hipSuccess) return;
    Args a{};
    for (int i = 0; i < 34; ++i) a.in[i] = (const float*)d_in[i];
    a.out = (float*)d_out; a.ws = (unsigned char*)d_ws;
    a.ph_lo = 0; a.ph_hi = 0;
    hipLaunchKernelGGL(enc_fwd, dim3(grid), dim3(NTHR), LDS_BYTES, stream, a);
}
```

```cpp
#include <hip/hip_runtime.h>
#include <cstdio>
#include <cstdint>
namespace pg8 {
#define PG8_LAS __attribute__((address_space(3)))
typedef unsigned short bf16_t;
typedef short bf16x8 __attribute__((ext_vector_type(8)));
typedef float f32x4 __attribute__((ext_vector_type(4)));
typedef int i32x4 __attribute__((ext_vector_type(4)));
template <bool I8> struct AccT { typedef f32x4 t; };
template <> struct AccT<true> { typedef i32x4 t; };
typedef unsigned u32x4 __attribute__((ext_vector_type(4)));
constexpr int BM = 256, BK = 64, HALF = 128, HTB = HALF * BK * 2  , STAGE_BYTES = 8 * HTB, NXCD = 8, WGM = 8;

__host__ __device__ __forceinline__ int lds_byte(int r, int c) { const int st = (r >> 4) * 2 + (c >> 5), rr = r & 15, cc = c & 31, ob = rr * 64 + cc * 2; return st * 1024 + (ob ^ (((ob >> 9) & 1) << 5)); }
__host__ __device__ __forceinline__ void stage_rc(int b, int& R, int& C) { const int st = b / 1024, sb = b % 1024, swz = sb ^ (((sb >> 9) & 1) << 5); R = (st >> 1) * 16 + swz / 64; C = (st & 1) * 32 + (swz % 64) / 2; }
__host__ __device__ __forceinline__ int perm32(int rho) { const int n = rho >> 4, i = rho & 15; return 8 * (i >> 2) + 4 * n + (i & 3); }

struct Unit { int pm, pn; };
struct Gemm { const bf16_t* A; const bf16_t* Bt; int M, N, K; };

struct StaticOrder {
    int nM, nN, nwg, G, c;
    __host__ __device__ void init(int M, int N, int G_, int c_) { nM = M / BM; nN = N / BM; nwg = nM * nN; G = G_; c = c_; }
    __host__ __device__ bool next(int i, Unit& u) const {
        const long L = (long)i * G + c; if (L >= nwg) return false;
        int wgid = (int)L; { const int q = nwg / NXCD, r = nwg % NXCD, xcd = wgid % NXCD, off = wgid / NXCD; wgid = (xcd < r ? xcd * (q + 1) : r * (q + 1) + (xcd - r) * q) + off; }
        const int nig = WGM * nN, gid = wgid / nig, fm = gid * WGM, gsz = (nM - fm) < WGM ? (nM - fm) : WGM;
        u.pm = fm + ((wgid % nig) % gsz); u.pn = (wgid % nig) / gsz; return true;
    }
    __device__ __forceinline__ void a_ready(const Unit&) const {}
    __device__ __forceinline__ void done(const Unit&) const {}
};
typedef float f32x2e __attribute__((ext_vector_type(2))); typedef __bf16 bf16x2e __attribute__((ext_vector_type(2)));
__device__ __forceinline__ unsigned cvt_pk_bf16(float lo, float hi) { return __builtin_bit_cast(unsigned, __builtin_convertvector((f32x2e){lo, hi}, bf16x2e)); }
template <int ACT> struct EpiBf16 {
    static constexpr bool PERM = true, AFTER_DRAIN = false, I8 = false;
    bf16_t* O; size_t ldc; size_t bstride = 0; int tshift = 31;
    __device__ __forceinline__ void operator()(const f32x4 (&acc)[2][2][4][2], const Unit& u, int wr, int wc, int fr, int fq) const {
        const int row0 = u.pm * BM + wr * 64 + fr; const int cb = u.pn * BM; const size_t col0 = (size_t)(cb >> tshift) * bstride + (size_t)(cb & ((1 << tshift) - 1)) + wc * 32 + 8 * fq;
#pragma unroll
        for (int ai = 0; ai < 2; ++ai)
#pragma unroll
            for (int m = 0; m < 4; ++m) { bf16_t* rowp = O + (size_t)(row0 + ai * HALF + m * 16) * ldc + col0;
#pragma unroll
                for (int bj = 0; bj < 2; ++bj) { f32x4 v0 = acc[ai][bj][m][0], v1 = acc[ai][bj][m][1];
                    if (ACT == 1) {
#pragma unroll
                        for (int j = 0; j < 4; ++j) { const float a = fmaxf(v0[j], 0.f), b = fmaxf(v1[j], 0.f); v0[j] = a * a; v1[j] = b * b; } }
                    u32x4 w; w.x = cvt_pk_bf16(v0[0], v0[1]); w.y = cvt_pk_bf16(v0[2], v0[3]); w.z = cvt_pk_bf16(v1[0], v1[1]); w.w = cvt_pk_bf16(v1[2], v1[3]);
                    *(u32x4*)(rowp + bj * HALF) = w;
                    } }
    }
};
struct EpiBf16Q {
    static constexpr bool PERM = true, AFTER_DRAIN = false, I8 = true;
    bf16_t* O; size_t ldc; size_t bstride; int tshift; const float* rs; const float* cs;
    __device__ __forceinline__ void operator()(const i32x4 (&acc)[2][2][4][2], const Unit& u, int wr, int wc, int fr, int fq) const {
        const int row0 = u.pm * BM + wr * 64 + fr; const int cb = u.pn * BM, ci0 = cb + wc * 32 + 8 * fq;
        const size_t col0 = (size_t)(cb >> tshift) * bstride + (size_t)(cb & ((1 << tshift) - 1)) + wc * 32 + 8 * fq;
        f32x4 cv[2][2];
#pragma unroll
        for (int bj = 0; bj < 2; ++bj) { cv[bj][0] = *(const f32x4*)(cs + ci0 + bj * HALF); cv[bj][1] = *(const f32x4*)(cs + ci0 + bj * HALF + 4); }
#pragma unroll
        for (int ai = 0; ai < 2; ++ai)
#pragma unroll
            for (int m = 0; m < 4; ++m) { const int row = row0 + ai * HALF + m * 16; bf16_t* rowp = O + (size_t)row * ldc + col0; const float r = rs[row];
#pragma unroll
                for (int bj = 0; bj < 2; ++bj) { const i32x4 a0 = acc[ai][bj][m][0], a1 = acc[ai][bj][m][1];
                    const f32x4 v0 = (f32x4){(float)a0[0], (float)a0[1], (float)a0[2], (float)a0[3]} * r * cv[bj][0], v1 = (f32x4){(float)a1[0], (float)a1[1], (float)a1[2], (float)a1[3]} * r * cv[bj][1];
                    u32x4 w; w.x = cvt_pk_bf16(v0[0], v0[1]); w.y = cvt_pk_bf16(v0[2], v0[3]); w.z = cvt_pk_bf16(v1[0], v1[1]); w.w = cvt_pk_bf16(v1[2], v1[3]);
                    *(u32x4*)(rowp + bj * HALF) = w; } }
    }
};
__device__ __forceinline__ float rss16(const float* p) { const f32x4 a = *(const f32x4*)p, b = *(const f32x4*)(p + 4), c = *(const f32x4*)(p + 8), d = *(const f32x4*)(p + 12);
    return (((a[0] + a[1]) + (a[2] + a[3])) + ((b[0] + b[1]) + (b[2] + b[3]))) + (((c[0] + c[1]) + (c[2] + c[3])) + ((d[0] + d[1]) + (d[2] + d[3]))); }
template <int MODE, bool RB16> struct EpiRes {
    static constexpr bool PERM = true, AFTER_DRAIN = false, I8 = false;
    const float* R; const bf16_t* RB; bf16_t* O; int ldc; float* rss;
    __device__ __forceinline__ void operator()(const f32x4 (&acc)[2][2][4][2], const Unit& u, int wr, int wc, int fr, int fq) const {
        const int row0 = u.pm * BM + wr * 64 + fr, col0 = u.pn * BM + wc * 32 + 8 * fq;
#pragma unroll
        for (int ai = 0; ai < 2; ++ai)
#pragma unroll
            for (int m = 0; m < 4; ++m) { const int row = row0 + ai * HALF + m * 16; const size_t off = (size_t)row * ldc + col0;
                f32x4 rv[2][2]; float ss = 0.f, sc = 1.0f;
                if (MODE == 2) sc = __builtin_amdgcn_rcpf(rss16(rss + (size_t)row * 16) * (1.0f / 1024.0f) + 1e-5f);
#pragma unroll
                for (int bj = 0; bj < 2; ++bj) {
                    if (RB16) { const u32x4 w = *(const u32x4*)(RB + off + bj * HALF);
                        rv[bj][0] = (f32x4){__builtin_bit_cast(float, w.x << 16), __builtin_bit_cast(float, w.x & 0xffff0000u), __builtin_bit_cast(float, w.y << 16), __builtin_bit_cast(float, w.y & 0xffff0000u)};
                        rv[bj][1] = (f32x4){__builtin_bit_cast(float, w.z << 16), __builtin_bit_cast(float, w.z & 0xffff0000u), __builtin_bit_cast(float, w.w << 16), __builtin_bit_cast(float, w.w & 0xffff0000u)}; }
                    else { rv[bj][0] = *(const f32x4*)(R + off + bj * HALF); rv[bj][1] = *(const f32x4*)(R + off + bj * HALF + 4); } }
#pragma unroll
                for (int bj = 0; bj < 2; ++bj) { f32x4 o0 = acc[ai][bj][m][0], o1 = acc[ai][bj][m][1];
                    if (MODE == 2) { o0 = o0 * sc; o1 = o1 * sc; }
                    o0 = o0 + rv[bj][0]; o1 = o1 + rv[bj][1];
                    if (MODE == 1) ss += ((o0[0] * o0[0] + o0[1] * o0[1]) + (o0[2] * o0[2] + o0[3] * o0[3])) + ((o1[0] * o1[0] + o1[1] * o1[1]) + (o1[2] * o1[2] + o1[3] * o1[3]));
                    u32x4 w; w.x = cvt_pk_bf16(o0[0], o0[1]); w.y = cvt_pk_bf16(o0[2], o0[3]); w.z = cvt_pk_bf16(o1[0], o1[1]); w.w = cvt_pk_bf16(o1[2], o1[3]);
                    *(u32x4*)(O + off + bj * HALF) = w; }
                if (MODE == 1) { ss += __shfl_xor(ss, 16); ss += __shfl_xor(ss, 32); if (fq == 0) rss[(size_t)row * 16 + u.pn * 4 + wc] = ss; }
                asm volatile("" ::: "memory"); }
    }
};

template <bool I8> __device__ __forceinline__ typename AccT<I8>::t pg8_mma16(const bf16x8& a, const bf16x8& b, const typename AccT<I8>::t& c) {
    if constexpr (I8) return __builtin_amdgcn_mfma_i32_16x16x64_i8(__builtin_bit_cast(i32x4, a), __builtin_bit_cast(i32x4, b), c, 0, 0, 0);
    else return __builtin_amdgcn_mfma_f32_16x16x32_bf16(a, b, c, 0, 0, 0);
}
template <class Epi, class Sched, bool ALIGN_EPI = false, bool SP2 = false>
__device__ __forceinline__ void gemm_phase(PG8_LAS unsigned char* lds, const Gemm g, const Sched& S, const Epi& E) {
    int tid = threadIdx.x; asm volatile("" : "+v"(tid));
    const int wid = __builtin_amdgcn_readfirstlane(tid >> 6), lane = tid & 63, wr = wid >> 2, wc = wid & 3, fr = lane & 15, fq = lane >> 4;
    const int K = g.K, nt = K / BK;
    unsigned voffA[2], voffB[2];
#pragma unroll
    for (int i = 0; i < 2; ++i) { int R, C; stage_rc(tid * 16 + i * 8192, R, C); const int Rb = Epi::PERM ? ((R & ~31) + perm32(R & 31)) : R;
        voffA[i] = (unsigned)(R * K + C) * 2u; voffB[i] = (unsigned)(Rb * K + C) * 2u; }
    const size_t kstep = (size_t)(BK * 2);
    const size_t hstep = (size_t)HALF * K * 2;
    const size_t tstep = 2 * hstep;
    const unsigned ldsw = (unsigned)wid * 1024u;
    const int aoff = lds_byte(wr * 64 + fr, fq * 8), boff = lds_byte(wc * 32 + fr, fq * 8);
#define PG8_SA(b, h) (((b) * 2 + (h)) * HTB)
#define PG8_SB(b, h) ((4 + (b) * 2 + (h)) * HTB)
#define PG8_STAGE(bufoff, gbase, voff) do { _Pragma("unroll") for (int _i = 0; _i < 2; ++_i) \
        __builtin_amdgcn_global_load_lds((const unsigned*)((const char*)(gbase) + (voff)[_i]), (PG8_LAS unsigned*)(lds + (bufoff) + ldsw + _i * 8192), 16, 0, 0); } while (0)
#define PG8_LDA(dst, b, h) do { _Pragma("unroll") for (int m = 0; m < 4; ++m) _Pragma("unroll") for (int k = 0; k < 2; ++k) dst[m][k] = *(const PG8_LAS bf16x8*)(lds + PG8_SA(b, h) + aoff + m * 2048 + k * 1024); } while (0)
#define PG8_LDB(dst, b, h) do { _Pragma("unroll") for (int n = 0; n < 2; ++n) _Pragma("unroll") for (int k = 0; k < 2; ++k) dst[n][k] = *(const PG8_LAS bf16x8*)(lds + PG8_SB(b, h) + boff + n * 2048 + k * 1024); } while (0)
#define PG8_MMA(ai, bj, At, Bt) do { __builtin_amdgcn_s_setprio(1); _Pragma("unroll") for (int m = 0; m < 4; ++m) _Pragma("unroll") for (int n = 0; n < 2; ++n) _Pragma("unroll") for (int k = 0; k < 2; ++k) \
        acc[ai][bj][m][n] = pg8_mma16<Epi::I8>(Bt[n][k], At[m][k], acc[ai][bj][m][n]); __builtin_amdgcn_s_setprio(0); } while (0)
#define PG8_WAIT_V(n) asm volatile("s_waitcnt vmcnt(" #n ")" ::: "memory")
#define PG8_WAIT_L(n) asm volatile("s_waitcnt lgkmcnt(" #n ")" ::: "memory")
#define PG8_BAR __builtin_amdgcn_s_barrier()
#define PG8_SCHED __builtin_amdgcn_sched_barrier(0)
    Unit cur, nxt; int ui = 0;
    if (!S.next(0, cur)) return;
    typedef typename AccT<Epi::I8>::t acc_t;
    acc_t acc[2][2][4][2];
#pragma unroll
    for (int a = 0; a < 2; ++a)
#pragma unroll
        for (int b = 0; b < 2; ++b)
#pragma unroll
            for (int m = 0; m < 4; ++m)
#pragma unroll
                for (int n = 0; n < 2; ++n) acc[a][b][m][n] = (acc_t){0, 0, 0, 0};
    bf16x8 At[4][2], B0[2][2], B1[2][2];
    const char* cA = (const char*)g.A + (size_t)cur.pm * tstep; const char* cB = (const char*)g.Bt + (size_t)cur.pn * tstep;
    S.a_ready(cur);
    if constexpr (SP2) {
        PG8_STAGE(PG8_SB(0, 0), cB, voffB); PG8_STAGE(PG8_SB(0, 1), cB + hstep, voffB); PG8_STAGE(PG8_SA(0, 0), cA, voffA); PG8_STAGE(PG8_SA(0, 1), cA + hstep, voffA);
        if (wr == 1) PG8_BAR;
        PG8_WAIT_V(2); PG8_BAR;
        PG8_STAGE(PG8_SB(1, 0), cB + kstep, voffB); PG8_STAGE(PG8_SA(1, 0), cA + kstep, voffA); PG8_STAGE(PG8_SB(1, 1), cB + hstep + kstep, voffB);
        PG8_WAIT_V(6); PG8_BAR;
    } else {
        PG8_STAGE(PG8_SB(0, 0), cB, voffB); PG8_STAGE(PG8_SA(0, 0), cA, voffA); PG8_STAGE(PG8_SB(0, 1), cB + hstep, voffB); PG8_STAGE(PG8_SA(0, 1), cA + hstep, voffA);
        if (wr == 1) PG8_BAR;
        PG8_WAIT_V(4); PG8_BAR;
        PG8_STAGE(PG8_SB(1, 0), cB + kstep, voffB); PG8_STAGE(PG8_SA(1, 0), cA + kstep, voffA); PG8_STAGE(PG8_SB(1, 1), cB + hstep + kstep, voffB);
        PG8_WAIT_V(6); PG8_BAR;
    }
    for (;;) {
        const bool has_next = S.next(ui + 1, nxt);
        const char* nA = has_next ? (const char*)g.A + (size_t)nxt.pm * tstep : cA; const char* nB = has_next ? (const char*)g.Bt + (size_t)nxt.pn * tstep : cB;
        for (int t = 0; t < nt; t += 2) {
            const bool last = (t == nt - 2);
            const char* a1 = cA + (size_t)(t + 1) * kstep;
            const char* a2 = last ? nA : cA + (size_t)(t + 2) * kstep; const char* b2 = last ? nB : cB + (size_t)(t + 2) * kstep;
            const char* a3 = a2 + kstep; const char* b3 = b2 + kstep;
            if (last && has_next) S.a_ready(nxt);
            if constexpr (SP2) {
            PG8_LDB(B0, 0, 0); PG8_LDB(B1, 0, 1); PG8_SCHED; PG8_LDA(At, 0, 0); PG8_STAGE(PG8_SA(1, 1), a1 + hstep, voffA);
            PG8_WAIT_V(8); PG8_WAIT_L(0); PG8_BAR; PG8_MMA(0, 0, At, B0); PG8_MMA(0, 1, At, B1); PG8_BAR; PG8_SCHED;
            PG8_LDA(At, 0, 1); PG8_STAGE(PG8_SB(0, 0), b2, voffB); PG8_STAGE(PG8_SB(0, 1), b2 + hstep, voffB); PG8_STAGE(PG8_SA(0, 0), a2, voffA);
            PG8_WAIT_V(8); PG8_WAIT_L(0); PG8_BAR; PG8_MMA(1, 0, At, B0); PG8_MMA(1, 1, At, B1); PG8_BAR; PG8_SCHED;
            PG8_LDB(B0, 1, 0); PG8_LDB(B1, 1, 1); PG8_SCHED; PG8_LDA(At, 1, 0); PG8_STAGE(PG8_SA(0, 1), a2 + hstep, voffA);
            PG8_WAIT_V(8); PG8_WAIT_L(0); PG8_BAR; PG8_MMA(0, 0, At, B0); PG8_MMA(0, 1, At, B1); PG8_BAR; PG8_SCHED;
            PG8_LDA(At, 1, 1); PG8_STAGE(PG8_SB(1, 0), b3, voffB); PG8_STAGE(PG8_SB(1, 1), b3 + hstep, voffB); PG8_STAGE(PG8_SA(1, 0), a3, voffA);
            PG8_WAIT_V(8); PG8_WAIT_L(0); PG8_BAR; PG8_MMA(1, 0, At, B0); PG8_MMA(1, 1, At, B1); PG8_BAR; PG8_SCHED;
            } else {
            PG8_LDB(B0, 0, 0); PG8_SCHED; PG8_LDA(At, 0, 0); PG8_STAGE(PG8_SA(1, 1), a1 + hstep, voffA);
            PG8_WAIT_L(8); PG8_BAR; PG8_WAIT_L(0); PG8_MMA(0, 0, At, B0); PG8_BAR; PG8_SCHED;
            PG8_LDB(B1, 0, 1); PG8_STAGE(PG8_SB(0, 0), b2, voffB);
            PG8_BAR; PG8_WAIT_L(0); PG8_MMA(0, 1, At, B1); PG8_BAR;
            PG8_LDA(At, 0, 1); PG8_STAGE(PG8_SA(0, 0), a2, voffA);
            PG8_BAR; PG8_WAIT_L(0); PG8_MMA(1, 0, At, B0); PG8_BAR; PG8_SCHED;
            PG8_STAGE(PG8_SB(0, 1), b2 + hstep, voffB);
            PG8_WAIT_V(6); PG8_BAR; PG8_MMA(1, 1, At, B1); PG8_BAR;
            PG8_LDB(B0, 1, 0); PG8_SCHED; PG8_LDA(At, 1, 0); PG8_STAGE(PG8_SA(0, 1), a2 + hstep, voffA);
            PG8_WAIT_L(8); PG8_BAR; PG8_WAIT_L(0); PG8_MMA(0, 0, At, B0); PG8_BAR; PG8_SCHED;
            PG8_LDB(B1, 1, 1); PG8_STAGE(PG8_SB(1, 0), b3, voffB);
            PG8_BAR; PG8_WAIT_L(0); PG8_MMA(0, 1, At, B1); PG8_BAR;
            PG8_LDA(At, 1, 1); PG8_STAGE(PG8_SA(1, 0), a3, voffA);
            PG8_BAR; PG8_WAIT_L(0); PG8_MMA(1, 0, At, B0); PG8_BAR; PG8_SCHED;
            PG8_STAGE(PG8_SB(1, 1), b3 + hstep, voffB);
            PG8_WAIT_V(6); PG8_BAR; PG8_MMA(1, 1, At, B1); PG8_BAR;
            }
        }
        if constexpr (ALIGN_EPI) { if (wr == 0) PG8_BAR; }
        if constexpr (!Epi::AFTER_DRAIN) { E(acc, cur, wr, wc, fr, fq); S.done(cur); }
        if (!has_next) break;
#pragma unroll
        for (int a = 0; a < 2; ++a)
#pragma unroll
            for (int b = 0; b < 2; ++b)
#pragma unroll
                for (int m = 0; m < 4; ++m)
#pragma unroll
                    for (int n = 0; n < 2; ++n) acc[a][b][m][n] = (acc_t){0, 0, 0, 0};
        cur = nxt; cA = nA; cB = nB; ++ui;
        if constexpr (ALIGN_EPI) { if (wr == 1) PG8_BAR; }
    }
    PG8_WAIT_V(0);
    if constexpr (!ALIGN_EPI) { if (wr == 0) PG8_BAR; }
    PG8_BAR;
    if constexpr (Epi::AFTER_DRAIN) { E.fused(acc, cur, wr, wc, fr, fq, lds, wid, lane); S.done(cur); }
#undef PG8_SA
#undef PG8_SB
#undef PG8_STAGE
#undef PG8_LDA
#undef PG8_LDB
#undef PG8_MMA
#undef PG8_WAIT_V
#undef PG8_WAIT_L
#undef PG8_BAR
#undef PG8_SCHED
}
}
constexpr int NWAVES = 8, NTHR = 512;
constexpr int NB = 8, T = 8192, M = NB * T, D = 1024, CH = 512, NH = 8, HD = 64, FF = 4096, NL = 2;
constexpr int PIN = 3456, HYP = 1536, RWP = 1920, NRW = 2048;
constexpr float RMS_EPS = 1e-5f, GN_EPS = 64.0f * 1e-5f;
constexpr int MLP_CHUNKS = 4;
static_assert(MLP_CHUNKS >= 2 && M % (MLP_CHUNKS * 256) == 0, "the next layer's first-half RMSNorm is folded into the last MLP chunk: it needs a barrier between the first half's down GEMMs and that chunk");

constexpr size_t MiB = 1u << 20;
constexpr size_t WS_CTL = 0, CTL_ZERO_BYTES = 1 * MiB;
constexpr size_t WS_W = 2 * MiB;
constexpr size_t W_LAYER = 25 * MiB, W_HY = 0, W_RW = 3 * MiB, W_O = 7 * MiB, W_1 = 9 * MiB, W_2 = 17 * MiB;
constexpr size_t WS_RSC = 52 * MiB;
constexpr size_t WS_CSC = 52 * MiB + 512 * 1024;
constexpr size_t WS_FSC = 52 * MiB;
constexpr size_t WS_RSS = 53 * MiB;
constexpr size_t WS_BS = 53 * MiB;
constexpr size_t WS_FRAG = 57 * MiB;
constexpr size_t WS_SFIN = 62 * MiB;
constexpr size_t WS_YPHI = 64 * MiB;
constexpr size_t WS_HF = 64 * MiB;
constexpr size_t WS_HN = 128 * MiB;
constexpr size_t WS_G = 128 * MiB, WS_V2 = 192 * MiB;
constexpr size_t WS_VFIRST = 256 * MiB;
constexpr size_t WS_PHT = 320 * MiB;
constexpr size_t WS_PRW = 512 * MiB;
constexpr size_t WS_YS = 768 * MiB;
constexpr size_t WS_HID = 320 * MiB;
constexpr size_t WS_YMIX = 896 * MiB;
constexpr size_t WS_END = 1024 * MiB;
constexpr int CW_BAR = 4096;
constexpr int CW_CMAX = 32768;
constexpr int CW_QUEUE = 16384;

constexpr int LDS_BYTES = 163840;
constexpr int LDSCTL_OFF = LDS_BYTES - 512;

#define GAS __attribute__((address_space(1)))
#define LAS __attribute__((address_space(3)))
typedef unsigned short bf16;
typedef unsigned v4u __attribute__((ext_vector_type(4)));
typedef unsigned v2u __attribute__((ext_vector_type(2)));
typedef float f32x4 __attribute__((ext_vector_type(4)));
#define PHASE_TID() int bid = blockIdx.x; asm volatile("" : "+s"(bid)); (void)bid; int tid = threadIdx.x; asm volatile("" : "+v"(tid)); const int lane = tid & 63; const int wave = __builtin_amdgcn_readfirstlane(tid >> 6); (void)lane; (void)wave
#define RLX_AGENT __ATOMIC_RELAXED, __HIP_MEMORY_SCOPE_AGENT
#define LDS_WAIT() asm volatile("s_waitcnt lgkmcnt(0)" ::: "memory")
#define VM_WAIT() asm volatile("s_waitcnt vmcnt(0)" ::: "memory")
typedef float f32x2_ __attribute__((ext_vector_type(2)));
typedef __bf16 bf16x2_ __attribute__((ext_vector_type(2)));
__device__ __forceinline__ unsigned pk2(float lo, float hi) { return __builtin_bit_cast(unsigned, __builtin_convertvector((f32x2_){lo, hi}, bf16x2_)); }
__device__ __forceinline__ unsigned f2bf(float f) { return pk2(f, f) & 0xffffu; }
__device__ __forceinline__ float bf2f(unsigned h) { return __uint_as_float(h << 16); }
__device__ __forceinline__ float bflo(unsigned w) { return __uint_as_float(w << 16); }
__device__ __forceinline__ float bfhi(unsigned w) { return __uint_as_float(w & 0xffff0000u); }
__device__ __forceinline__ float sigmoidf_(float x) { return __builtin_amdgcn_rcpf(1.0f + __expf(-x)); }
__device__ __forceinline__ float tanhf_(float x) { return 1.0f - 2.0f * __builtin_amdgcn_rcpf(1.0f + __expf(2.0f * x)); }
template <int CTRL> __device__ __forceinline__ float dpp(float x) { return __builtin_bit_cast(float, __builtin_amdgcn_mov_dpp(__builtin_bit_cast(int, x), CTRL, 0xf, 0xf, true)); }
constexpr int XOR1 = 0xB1, XOR2 = 0x4E, XOR7 = 0x141, XOR8 = 0x128;
__device__ __forceinline__ float sin_hw(float x) { const float r = x * 0.15915494309189535f; return __builtin_amdgcn_sinf(r - floorf(r)); }
__device__ __forceinline__ float sum8(float v) { v += dpp<XOR1>(v); v += dpp<XOR2>(v); v += dpp<XOR7>(v); return v; }
__device__ __forceinline__ float sum16(float v) { v = sum8(v); v += dpp<XOR8>(v); return v; }

#define XB_TMO      128
#define XB_XCNT(j)  (256  + 64 * (j))
#define XB_XSUB(j)  (1280 + 64 * (j))
#define XB_XGEN(j)  (2304 + 64 * (j))
#define XB_TOP      3328
#define XB_TOPGEN   3392
#define XCD_BAR_WORDS 3456
#define XB_SPIN_CAP (1u << 18)

__device__ __forceinline__ unsigned xb_ld(unsigned* p)              { return __hip_atomic_load(p, __ATOMIC_RELAXED, __HIP_MEMORY_SCOPE_AGENT); }
__device__ __forceinline__ unsigned xb_add(unsigned* p, unsigned v) { return __hip_atomic_fetch_add(p, v, __ATOMIC_RELAXED, __HIP_MEMORY_SCOPE_AGENT); }
__device__ __forceinline__ unsigned xb_xcc_id() { return (unsigned)__builtin_amdgcn_s_getreg((3 << 11) | 20) & 0xFu; }
#define XB_SPIN(cond, bar) do { unsigned _sp = 0; while (cond) { __builtin_amdgcn_s_sleep(1); \
    if ((++_sp & 255u) == 0u) { if (xb_ld(&(bar)[XB_TMO])) break; if (_sp > XB_SPIN_CAP) { atomicAdd(&(bar)[XB_TMO], 1u); break; } } } } while (0)

struct XcdBarrier {
    unsigned* bar; unsigned x;
    volatile LAS unsigned* st;
};
__device__ __forceinline__ XcdBarrier xcd_barrier_post(unsigned* bar, volatile LAS unsigned* st) {
    XcdBarrier b; b.bar = bar; b.x = xb_xcc_id(); b.st = st;
    if (threadIdx.x == 0) (void)xb_add(&bar[XB_XCNT(b.x)], 1u);
    return b;
}
__device__ __forceinline__ void xcd_barrier_complete(unsigned* bar, unsigned x, unsigned& nloc, unsigned& nx) {
    const unsigned G = gridDim.x * gridDim.y * gridDim.z;
    unsigned sum, cnt, mine, sp = 0u;
    for (;;) {
        sum = 0u; cnt = 0u; mine = 0u;
#pragma unroll
        for (unsigned j = 0; j < 16; ++j) { const unsigned c = xb_ld(&bar[XB_XCNT(j)]); sum += c; cnt += (c > 0u) ? 1u : 0u; mine = (j == x) ? c : mine; }
        if (sum == G) break;
        __builtin_amdgcn_s_sleep(1);
        if ((++sp & 255u) == 0u) { if (xb_ld(&bar[XB_TMO])) break; if (sp > XB_SPIN_CAP) { atomicAdd(&bar[XB_TMO], 1u); break; } }
    }
    nloc = mine > 0u ? mine : 1u; nx = cnt > 0u ? cnt : 1u;
}
__device__ __forceinline__ void xcd_barrier(const XcdBarrier& b) {
    asm volatile("s_waitcnt vmcnt(0)" ::: "memory");
    __syncthreads();
    if (threadIdx.x == 0) {
        unsigned* bar = b.bar;
        unsigned bx = b.x; asm volatile("" : "+s"(bx));
        __builtin_amdgcn_s_waitcnt(0);
        unsigned nloc = b.st[0], nx = b.st[1];
        if (nloc == 0u) { xcd_barrier_complete(bar, bx, nloc, nx); b.st[0] = nloc; b.st[1] = nx; }
        const unsigned old = xb_add(&bar[XB_XSUB(bx)], 1u);
        const unsigned gen = old / nloc;
        if (old + 1u == (gen + 1u) * nloc) {
            __builtin_amdgcn_fence(__ATOMIC_RELEASE, "agent");
            asm volatile("s_waitcnt vmcnt(0)" ::: "memory");
            const unsigned og = xb_add(&bar[XB_TOP], 1u);
            const unsigned tg = og / nx;
            if (og + 1u == (tg + 1u) * nx) xb_add(&bar[XB_TOPGEN], 1u);
            else XB_SPIN(xb_ld(&bar[XB_TOPGEN]) == tg, bar);
            __builtin_amdgcn_fence(__ATOMIC_ACQUIRE, "agent");
            xb_add(&bar[XB_XGEN(bx)], 1u);
            asm volatile("s_waitcnt vmcnt(0)" ::: "memory");
        } else {
            XB_SPIN(xb_ld(&bar[XB_XGEN(bx)]) == gen, bar);
            __builtin_amdgcn_fence(__ATOMIC_ACQUIRE, "agent");
            asm volatile("s_waitcnt vmcnt(0)" ::: "memory");
        }
    }
    __syncthreads();
}

struct Frame {
    LAS unsigned char* lds;
    volatile LAS unsigned* MISC;
    unsigned* ctl;
    int G;
    const float* const* in;
    float* out; unsigned char* ws;
};
enum { I_X = 0, I_N1G, I_WIN, I_HCW, I_HCB, I_FW1, I_FB1, I_FW2, I_FB2, I_FW3, I_FB3, I_FFREQ, I_FWOUT, I_HSKIP, I_HNG, I_SHIFT, I_W0, I_W2, I_A0, I_A2, I_G2, I_KK, I_KA, I_RK, I_LNG, I_LNB, I_V0, I_V1, I_V2, I_WOUT, I_N2G, I_MW1, I_MW2, I_FING };

__device__ __forceinline__ float wave_max(float v) {
#pragma unroll
    for (int o = 1; o < 64; o <<= 1) v = fmaxf(v, __shfl_xor(v, o));
    return v;
}
__device__ __forceinline__ unsigned q4(float a, float b, float c, float d) {
    const int ia = (int)__builtin_rintf(a), ib = (int)__builtin_rintf(b), ic = (int)__builtin_rintf(c), id = (int)__builtin_rintf(d);
    return (unsigned)(ia & 255) | ((unsigned)(ib & 255) << 8) | ((unsigned)(ic & 255) << 16) | ((unsigned)id << 24);
}
__device__ __forceinline__ float wave_sum(float v) {
#pragma unroll
    for (int o = 1; o < 64; o <<= 1) v += __shfl_xor(v, o);
    return v;
}
typedef float f32x2 __attribute__((ext_vector_type(2)));
constexpr int FN = 2 * T;
constexpr int XPAD = FN + FN / 16 + 16 * (FN / 512);
__device__ __forceinline__ f32x2 cmul(f32x2 a, f32x2 b) { return (f32x2){a.x * b.x - a.y * b.y, a.x * b.y + a.y * b.x}; }
__device__ __forceinline__ f32x2 cmulc(f32x2 a, f32x2 b) { return (f32x2){a.x * b.x + a.y * b.y, a.y * b.x - a.x * b.y}; }
__device__ constexpr float C32[16] = {1.0f, 0.98078528040323043f, 0.92387953251128674f, 0.83146961230254524f, 0.70710678118654752f, 0.55557023301960218f, 0.38268343236508977f, 0.19509032201612825f,
                                      0.0f, -0.19509032201612825f, -0.38268343236508977f, -0.55557023301960218f, -0.70710678118654752f, -0.83146961230254524f, -0.92387953251128674f, -0.98078528040323043f};
__device__ constexpr float S32[16] = {0.0f, 0.19509032201612825f, 0.38268343236508977f, 0.55557023301960218f, 0.70710678118654752f, 0.83146961230254524f, 0.92387953251128674f, 0.98078528040323043f,
                                      1.0f, 0.98078528040323043f, 0.92387953251128674f, 0.83146961230254524f, 0.70710678118654752f, 0.55557023301960218f, 0.38268343236508977f, 0.19509032201612825f};
constexpr int bitrev_c(int v, int bits) { int r = 0; for (int i = 0; i < bits; ++i) r |= ((v >> i) & 1) << (bits - 1 - i); return r; }
template <int R, bool INV> __device__ __forceinline__ void dft_regs(f32x2 (&x)[R]) {
    constexpr int LOG = (R == 32) ? 5 : 4;
#pragma unroll
    for (int s = R / 2; s >= 1; s >>= 1) {
#pragma unroll
        for (int blk = 0; blk < R; blk += 2 * s) {
#pragma unroll
            for (int j = 0; j < s; ++j) {
                const f32x2 a = x[blk + j], b = x[blk + j + s];
                x[blk + j] = a + b;
                f32x2 d = a - b;
                const int m = j * (16 / s);
                if (m == 0) x[blk + j + s] = d;
                else if (m == 8) x[blk + j + s] = INV ? (f32x2){-d.y, d.x} : (f32x2){d.y, -d.x};
                else { const float c = C32[m], sn = INV ? S32[m] : -S32[m];
                    const f32x2 k1 = (f32x2){c, sn}, k2 = (f32x2){-sn, c};
                    x[blk + j + s] = __builtin_shufflevector(d, d, 0, 0) * k1 + __builtin_shufflevector(d, d, 1, 1) * k2; }
            }
        }
    }
    f32x2 y[R];
#pragma unroll
    for (int k = 0; k < R; ++k) y[k] = x[bitrev_c(k, LOG)];
#pragma unroll
    for (int k = 0; k < R; ++k) x[k] = y[k];
}
template <int R, bool INV> __device__ __forceinline__ void twiddle_regs(f32x2 (&x)[R], float frac) {
    asm volatile("" : "+v"(frac));
    const float sn0 = __builtin_amdgcn_sinf(0.5f * frac), cs = __builtin_amdgcn_cosf(0.5f * frac);
    const float sn = INV ? sn0 : -sn0;
    const f32x2 w = (f32x2){cs, sn}, iw = (f32x2){-sn, cs};
    f32x2 wk = w, vk = iw;
#pragma unroll
    for (int k = 1; k < R; ++k) {
        f32x2 t1 = __builtin_shufflevector(wk, wk, 0, 0) * w, t2 = __builtin_shufflevector(vk, vk, 0, 0) * w, t3 = __builtin_shufflevector(x[k], x[k], 0, 0) * wk;
        asm volatile("" : "+v"(t1), "+v"(t2), "+v"(t3));
        x[k] = __builtin_elementwise_fma(__builtin_shufflevector(x[k], x[k], 1, 1), vk, t3);
        if (k + 1 < R) { const f32x2 nw = __builtin_elementwise_fma(__builtin_shufflevector(wk, wk, 1, 1), iw, t1);
            vk = __builtin_elementwise_fma(__builtin_shufflevector(vk, vk, 1, 1), iw, t2); wk = nw; }
    }
}
#define XP(i) ((i) + ((i) >> 4) + 16 * ((i) >> 9))
constexpr int XBP = 560;
template <bool ZUP> __device__ __forceinline__ void fft_f1(LAS f32x2* X, int t) {
    f32x2 x[32]; const int base = t + (t >> 4);
#pragma unroll
    for (int j = 0; j < 32; ++j) x[j] = (ZUP && j >= 16) ? (f32x2){0.f, 0.f} : X[base + j * XBP];
    dft_regs<32, false>(x);
    twiddle_regs<32, false>(x, (float)t * (1.0f / 8192.0f));
#pragma unroll
    for (int k = 0; k < 32; ++k) X[base + k * XBP] = x[k];
}
__device__ __forceinline__ void fft_f2(LAS f32x2* X, int t) {
    f32x2 x[32]; const int base = (t >> 4) * XBP + (t & 15);
#pragma unroll
    for (int j = 0; j < 32; ++j) x[j] = X[base + j * 17];
    dft_regs<32, false>(x);
    twiddle_regs<32, false>(x, (float)(t & 15) * (1.0f / 256.0f));
#pragma unroll
    for (int k = 0; k < 32; ++k) X[base + k * 17] = x[k];
}
__device__ __forceinline__ void fft_mid(LAS f32x2* X, const f32x2* H, int t) {
#pragma unroll 1
    for (int r = 0; r < 2; ++r) { const int b = t + 512 * r; f32x2 x[16];
        const f32x4* hp = (const f32x4*)(H + 16 * b); f32x4 h[8];
#pragma unroll
        for (int k = 0; k < 8; ++k) h[k] = hp[k];
#pragma unroll
        for (int j = 0; j < 16; ++j) x[j] = X[17 * b + 16 * (b >> 5) + j];
        dft_regs<16, false>(x);
#pragma unroll
        for (int k = 0; k < 8; ++k) { x[2 * k] = cmul(x[2 * k], (f32x2){h[k][0], h[k][1]}); x[2 * k + 1] = cmul(x[2 * k + 1], (f32x2){h[k][2], h[k][3]}); }
        dft_regs<16, true>(x);
#pragma unroll
        for (int j = 0; j < 16; ++j) X[17 * b + 16 * (b >> 5) + j] = x[j]; }
}
__device__ __forceinline__ void fft_i2(LAS f32x2* X, int t) {
    f32x2 x[32]; const int base = (t >> 4) * XBP + (t & 15);
#pragma unroll
    for (int k = 0; k < 32; ++k) x[k] = X[base + k * 17];
    twiddle_regs<32, true>(x, (float)(t & 15) * (1.0f / 256.0f));
    dft_regs<32, true>(x);
#pragma unroll
    for (int j = 0; j < 32; ++j) X[base + j * 17] = x[j];
}
__device__ __forceinline__ void fft_i1(LAS f32x2* X, int t) {
    f32x2 x[32]; const int base = t + (t >> 4);
#pragma unroll
    for (int k = 0; k < 32; ++k) x[k] = X[base + k * XBP];
    twiddle_regs<32, true>(x, (float)t * (1.0f / 8192.0f));
    dft_regs<32, true>(x);
#pragma unroll
    for (int j = 0; j < 16; ++j) X[base + j * XBP] = x[j];
}
__device__ __forceinline__ void fft_conv(LAS f32x2* X, const f32x2* H, int tid) {
    __syncthreads(); fft_f1<true>(X, tid);
    __syncthreads(); fft_f2(X, tid);
    __syncthreads(); fft_mid(X, H, tid);
    __syncthreads(); fft_i2(X, tid);
    __syncthreads(); fft_i1(X, tid);
    __syncthreads();
}
__device__ __forceinline__ void hy_spectrum_item(Frame& F, int item) {
    PHASE_TID();
    LAS f32x2* X = (LAS f32x2*)F.lds; LAS float* RED = (LAS float*)(F.lds + XPAD * 8);
    const int o = item >> 9, c = item & 511;
    const float* HF = (const float*)(F.ws + WS_HF);
    const float* f = HF + ((size_t)(o * 2 + 0) * CH + c) * T; const float* bw = HF + ((size_t)(o * 2 + 1) * CH + c) * T;
    f32x2* HS = (f32x2*)(F.ws + WS_YMIX) + (size_t)item * FN;
    __syncthreads();
    f32x2 x[32]; float ss = 0.f; const int base = tid + (tid >> 4);
#pragma unroll
    for (int j = 0; j < 32; ++j) { const int idx = j * 512 + tid; float v;
        if (j < 16) v = f[idx]; else v = (idx == T) ? 0.f : bw[FN - idx];
        ss += v * v; x[j] = (f32x2){v, 0.f}; }
    ss = wave_sum(ss);
    if (lane == 0) RED[wave] = ss;
    dft_regs<32, false>(x);
    twiddle_regs<32, false>(x, (float)tid * (1.0f / 8192.0f));
#pragma unroll
    for (int k = 0; k < 32; ++k) X[base + k * XBP] = x[k];
    __syncthreads();
    float tot = 0.f;
#pragma unroll
    for (int w = 0; w < 8; ++w) tot += RED[w];
    const float sc = (1.0f / sqrtf(tot + 1e-6f)) * (1.0f / (float)FN);
    fft_f2(X, tid);
    __syncthreads();
#pragma unroll 1
    for (int r = 0; r < 2; ++r) { const int b = tid + 512 * r; f32x2 y[16];
#pragma unroll
        for (int j = 0; j < 16; ++j) y[j] = X[17 * b + 16 * (b >> 5) + j];
        dft_regs<16, false>(y);
        f32x4* dst = (f32x4*)(HS + 16 * b);
#pragma unroll
        for (int k = 0; k < 8; ++k) dst[k] = (f32x4){y[2 * k].x * sc, y[2 * k].y * sc, y[2 * k + 1].x * sc, y[2 * k + 1].y * sc}; }
}
__device__ __forceinline__ void p_spectra(Frame& F) { PHASE_TID(); (void)tid; for (int it = bid; it < 2 * CH; it += F.G) hy_spectrum_item(F, it); __syncthreads(); }

struct RowRaw { v4u a, b; unsigned lo, hi; };
__device__ __forceinline__ void hy_row_load(RowRaw& R, const bf16* row, int t0) {
    R.a = *(const v4u*)(row + t0); R.b = *(const v4u*)(row + t0 + 8);
    R.lo = t0 > 0 ? (unsigned)row[t0 - 1] : 0u; R.hi = t0 + 16 < T ? (unsigned)row[t0 + 16] : 0u;
}
__device__ __forceinline__ void hy_u16r(const RowRaw& R, float w0, float w1, float w2, float bias, float (&u)[16]) {
    float p[18];
    p[0] = __builtin_bit_cast(float, R.lo << 16); p[17] = __builtin_bit_cast(float, R.hi << 16);
    const unsigned w[8] = {R.a.x, R.a.y, R.a.z, R.a.w, R.b.x, R.b.y, R.b.z, R.b.w};
#pragma unroll
    for (int i = 0; i < 8; ++i) { p[1 + 2 * i] = bflo(w[i]); p[2 + 2 * i] = bfhi(w[i]); }
#pragma unroll
    for (int i = 0; i < 16; ++i) u[i] = w0 * p[i] + w1 * p[i + 1] + w2 * p[i + 2] + bias;
}
__device__ __forceinline__ void hy_pack_store(bf16* dst, const float (&y)[16]) {
    v4u o0, o1;
    o0.x = pk2(y[0], y[1]); o0.y = pk2(y[2], y[3]); o0.z = pk2(y[4], y[5]); o0.w = pk2(y[6], y[7]);
    o1.x = pk2(y[8], y[9]); o1.y = pk2(y[10], y[11]); o1.z = pk2(y[12], y[13]); o1.w = pk2(y[14], y[15]);
    *(v4u*)dst = o0; *(v4u*)(dst + 8) = o1;
}
__device__ __forceinline__ void hy_fft_item(Frame& F, int l, int item) {
    PHASE_TID(); const int c = item >> 2, bp = item & 3, t0 = 16 * tid, xb = 17 * tid + 16 * (tid >> 5);
    LAS f32x2* X = (LAS f32x2*)F.lds;
    bf16* PHT = (bf16*)(F.ws + WS_PHT);
    bf16* rx1a = PHT + ((size_t)(2 * bp) * HYP + c) * T; bf16* rx1b = rx1a + (size_t)HYP * T;
    bf16* rx2a = PHT + ((size_t)(2 * bp) * HYP + CH + c) * T; bf16* rx2b = rx2a + (size_t)HYP * T;
    const bf16* rva = PHT + ((size_t)(2 * bp) * HYP + 2 * CH + c) * T; const bf16* rvb = rva + (size_t)HYP * T;
    const float* cw = F.in[I_HCW] + (size_t)l * 3 * HYP; const float* cb = F.in[I_HCB] + (size_t)l * HYP;
    const float* skip = F.in[I_HSKIP] + (size_t)l * 2 * CH;
    const f32x2* H0 = (const f32x2*)(F.ws + WS_YMIX) + (size_t)c * FN; const f32x2* H1 = H0 + (size_t)CH * FN;
    __syncthreads();
    RowRaw va, vb, xa, xb2;
    hy_row_load(va, rva, t0); hy_row_load(vb, rvb, t0);
    const float vw0 = cw[2 * CH + c], vw1 = cw[HYP + 2 * CH + c], vw2 = cw[2 * HYP + 2 * CH + c], vbs = cb[2 * CH + c];
    const float x1w0 = cw[c], x1w1 = cw[HYP + c], x1w2 = cw[2 * HYP + c], x1bs = cb[c], x2w0 = cw[CH + c], x2w1 = cw[HYP + CH + c], x2w2 = cw[2 * HYP + CH + c], x2bs = cb[CH + c], s0 = skip[c], s1 = skip[CH + c];
    { float ua[16], ub[16];
      hy_u16r(va, vw0, vw1, vw2, vbs, ua); hy_u16r(vb, vw0, vw1, vw2, vbs, ub);
#pragma unroll
      for (int i = 0; i < 16; ++i) X[xb + i] = (f32x2){ua[i], ub[i]}; }
    hy_row_load(xa, rx1a, t0); hy_row_load(xb2, rx1b, t0);
    fft_conv(X, H0, tid);
    v4u z2a[2], z2b[2];
    { float ua[16], ub[16], za[16], zb[16];
      {
        hy_u16r(va, vw0, vw1, vw2, vbs, ua); hy_u16r(vb, vw0, vw1, vw2, vbs, ub);
#pragma unroll
        for (int i = 0; i < 16; ++i) { const f32x2 y = X[xb + i]; za[i] = y.x + s0 * ua[i]; zb[i] = y.y + s0 * ub[i]; } }
      hy_u16r(xa, x1w0, x1w1, x1w2, x1bs, ua); hy_u16r(xb2, x1w0, x1w1, x1w2, x1bs, ub);
#pragma unroll
      for (int i = 0; i < 16; ++i) { za[i] *= ua[i]; zb[i] *= ub[i]; }
#pragma unroll
      for (int q = 0; q < 2; ++q) { z2a[q].x = pk2(za[8 * q], za[8 * q + 1]); z2a[q].y = pk2(za[8 * q + 2], za[8 * q + 3]); z2a[q].z = pk2(za[8 * q + 4], za[8 * q + 5]); z2a[q].w = pk2(za[8 * q + 6], za[8 * q + 7]);
                                    z2b[q].x = pk2(zb[8 * q], zb[8 * q + 1]); z2b[q].y = pk2(zb[8 * q + 2], zb[8 * q + 3]); z2b[q].z = pk2(zb[8 * q + 4], zb[8 * q + 5]); z2b[q].w = pk2(zb[8 * q + 6], zb[8 * q + 7]); }
#pragma unroll
      for (int i = 0; i < 16; ++i) X[xb + i] = (f32x2){za[i], zb[i]}; }
    hy_row_load(xa, rx2a, t0); hy_row_load(xb2, rx2b, t0);
    fft_conv(X, H1, tid);
    { float ua[16], ub[16];
      hy_u16r(xa, x2w0, x2w1, x2w2, x2bs, ua); hy_u16r(xb2, x2w0, x2w1, x2w2, x2bs, ub);
      float za[16], zb[16];
      const unsigned wa[8] = {z2a[0].x, z2a[0].y, z2a[0].z, z2a[0].w, z2a[1].x, z2a[1].y, z2a[1].z, z2a[1].w}, wb[8] = {z2b[0].x, z2b[0].y, z2b[0].z, z2b[0].w, z2b[1].x, z2b[1].y, z2b[1].z, z2b[1].w};
#pragma unroll
      for (int i = 0; i < 8; ++i) { za[2 * i] = bflo(wa[i]); za[2 * i + 1] = bfhi(wa[i]); zb[2 * i] = bflo(wb[i]); zb[2 * i + 1] = bfhi(wb[i]); }
#pragma unroll
      for (int i = 0; i < 16; ++i) { const f32x2 y = X[xb + i]; za[i] = ua[i] * (y.x + s1 * za[i]); zb[i] = ub[i] * (y.y + s1 * zb[i]); }
      hy_pack_store(rx2a + t0, za); hy_pack_store(rx2b + t0, zb); }
}
typedef short bf16x8 __attribute__((ext_vector_type(8)));
constexpr int CL_ = 64;
constexpr int LDB = 80;
constexpr int LDSG = 144, LDVL = 48;
constexpr int LDF = 65;
constexpr int MB = 64 * LDB * 2;
constexpr int MF = 64 * LDF * 4;
constexpr int O_AH = 0, O_AHT = MB, O_RH = 2 * MB, O_BH = 3 * MB, O_BHT = 4 * MB, O_KH = 5 * MB, O_KHT = 6 * MB, O_VT = 7 * MB;
constexpr int O_TW = 0, O_AD = MB, O_SG = 2 * MB  , O_VL = 2 * MB + 64 * LDSG * 2  ;
constexpr int O_APB = O_KH;
constexpr int O_F = 8 * MB;
constexpr int O_AF = O_F, O_LW = O_F + MF, O_ZV = O_F + 2 * MF;
constexpr int O_XA = O_F, O_XAT = O_F + MB, O_AAK = O_F + 2 * MB, O_ARB = O_F + 3 * MB, O_ARK = O_F + 4 * MB;
constexpr int O_S0B = O_F + ((3 * MF > 5 * MB) ? 3 * MF : 5 * MB);
constexpr int O_UT = O_S0B + MB;
constexpr int O_TB = O_UT, O_M1T = O_BH, O_T0T = O_AH, O_WT = O_KH;
constexpr int O_PL = O_UT + MB;
constexpr int O_PART = O_PL + 256;
constexpr int O_MU = O_PART + 2048;
constexpr int O_CK = O_MU + 1792;
constexpr int O_MC = O_CK + 768;
static_assert(O_ARK + MB <= O_S0B && O_ZV + MF <= O_S0B && O_VL + 64 * LDVL * 2 <= O_F && O_MC + 1792 <= LDSCTL_OFF, "cscan LDS map");

__device__ __forceinline__ unsigned pk2s(float v) { return pk2(v, v); }
#define MFMA16(a, b, c) __builtin_amdgcn_mfma_f32_16x16x32_bf16((a), (b), (c), 0, 0, 0)
__device__ __forceinline__ bf16x8 ldfrag(const LAS unsigned char* base, int ld, int row0, int k0, int fr, int fq) {
    return *(const LAS bf16x8*)(base + ((row0 + fr) * ld + k0 + 8 * fq) * 2);
}
__device__ __forceinline__ void st_tile_bf16(LAS unsigned char* base, int ld, int m0, int n0, int fr, int fq, const f32x4& v) {
#pragma unroll
    for (int jj = 0; jj < 4; ++jj) *(LAS bf16*)(base + ((m0 + 4 * fq + jj) * ld + n0 + fr) * 2) = (bf16)pk2s(v[jj]);
}
__device__ __forceinline__ void st_tile_bf16_T(LAS unsigned char* base, int ld, int m0, int n0, int fr, int fq, const f32x4& v) {
    v2u o; o.x = pk2(v[0], v[1]); o.y = pk2(v[2], v[3]);
    *(LAS v2u*)(base + ((n0 + fr) * ld + m0 + 4 * fq) * 2) = o;
}
#define CFENCE() asm volatile("" ::: "memory")
#define ZFRAG ((bf16x8){0, 0, 0, 0, 0, 0, 0, 0})
__device__ __forceinline__ void ldA(bf16x8 (&a)[2], const LAS unsigned char* A, int mt, int fr, int fq) {
#pragma unroll
    for (int ks = 0; ks < 2; ++ks) a[ks] = ldfrag(A, LDB, 16 * mt, 32 * ks, fr, fq);
}
__device__ __forceinline__ void ldB(bf16x8 (&b)[2][2], const LAS unsigned char* B, int nt0, int fr, int fq) {
#pragma unroll
    for (int ks = 0; ks < 2; ++ks)
#pragma unroll
        for (int j = 0; j < 2; ++j) b[ks][j] = ldfrag(B, LDB, 16 * (nt0 + j), 32 * ks, fr, fq);
}
#define PIN(x) asm volatile("" : "+v"(x))
__device__ __forceinline__ void mmac(bf16x8 (&a)[2], bf16x8 (&b)[2][2], f32x4 (&acc)[2]) {
#pragma unroll
    for (int ks = 0; ks < 2; ++ks) { PIN(a[ks]);
#pragma unroll
        for (int j = 0; j < 2; ++j) { PIN(b[ks][j]); acc[j] = MFMA16(a[ks], b[ks][j], acc[j]); } }
}
__device__ __forceinline__ void mmacT(bf16x8 (&a)[2], bf16x8 (&b)[2][2], f32x4 (&acc)[2]) {
#pragma unroll
    for (int ks = 0; ks < 2; ++ks) { PIN(a[ks]);
#pragma unroll
        for (int j = 0; j < 2; ++j) { PIN(b[ks][j]); acc[j] = MFMA16(b[ks][j], a[ks], acc[j]); } }
}
__device__ __forceinline__ v4u pack8(const float (&v)[8]) { v4u o; o.x = pk2(v[0], v[1]); o.y = pk2(v[2], v[3]); o.z = pk2(v[4], v[5]); o.w = pk2(v[6], v[7]); return o; }
__device__ __forceinline__ bf16x8 wfrag(const float* W, int k0, int col, int fq) {
    float v[8];
#pragma unroll
    for (int e = 0; e < 8; ++e) v[e] = W[(size_t)(k0 + 8 * fq + e) * CH + col];
    return __builtin_bit_cast(bf16x8, pack8(v));
}

struct RawTok { v4u g[7][3]; };
__device__ __forceinline__ void load_raw(RawTok& R, const bf16* PRW, const bf16* VFIRST, int b, int tok, int hc, int ec, int d, int l, bool has_vl) {
    const size_t m = (size_t)b * T + tok; const v4u z = (v4u){0u, 0u, 0u, 0u};
    const int cols[7] = {hc + ec, CH + hc + ec, 2 * CH + hc + ec, 1536 + d * 64 + ec, 1664 + d * 64 + ec, 1792 + ec, 1856 + ec};
#pragma unroll
    for (int g = 0; g < 7; ++g) { if (g >= 5 && d != 0) { R.g[g][0] = z; R.g[g][1] = z; R.g[g][2] = z; continue; }
        const bf16* p = PRW + m * NRW + cols[g];
        R.g[g][1] = *(const v4u*)p; R.g[g][0] = *(const v4u*)(p - NRW); R.g[g][2] = *(const v4u*)(p + NRW); }
    if (__builtin_amdgcn_readfirstlane((int)__builtin_amdgcn_ballot_w64(tok == 0 || tok == T - 1) != 0 || (int)(__builtin_amdgcn_ballot_w64(tok == 0 || tok == T - 1) >> 32) != 0)) {
#pragma unroll
        for (int g = 0; g < 7; ++g) { R.g[g][0] = (tok == 0) ? z : R.g[g][0]; R.g[g][2] = (tok == T - 1) ? z : R.g[g][2]; } }
}
typedef __bf16 bf16x2v __attribute__((ext_vector_type(2)));
__device__ __forceinline__ void mix8r(const v4u (&r)[3], const LAS unsigned* mub, const LAS float* mcb, float (&out)[8]) {
    const v4u ma = *(const LAS v4u*)mub, mb = *(const LAS v4u*)(mub + 4); const f32x4 ca = *(const LAS f32x4*)mcb, cb = *(const LAS f32x4*)(mcb + 4);
    const unsigned mw[8] = {ma.x, ma.y, ma.z, ma.w, mb.x, mb.y, mb.z, mb.w}; const float mc[8] = {ca[0], ca[1], ca[2], ca[3], cb[0], cb[1], cb[2], cb[3]};
    const unsigned pw[4] = {r[0].x, r[0].y, r[0].z, r[0].w}, cw[4] = {r[1].x, r[1].y, r[1].z, r[1].w}, nw[4] = {r[2].x, r[2].y, r[2].z, r[2].w};
#pragma unroll
    for (int i = 0; i < 4; ++i) {
        const unsigned pn0 = __builtin_amdgcn_perm(nw[i], pw[i], 0x05040100u), pn1 = __builtin_amdgcn_perm(nw[i], pw[i], 0x07060302u);
        out[2 * i] = __builtin_amdgcn_fdot2_f32_bf16(__builtin_bit_cast(bf16x2v, pn0), __builtin_bit_cast(bf16x2v, mw[2 * i]), bflo(cw[i]) * mc[2 * i], false);
        out[2 * i + 1] = __builtin_amdgcn_fdot2_f32_bf16(__builtin_bit_cast(bf16x2v, pn1), __builtin_bit_cast(bf16x2v, mw[2 * i + 1]), bfhi(cw[i]) * mc[2 * i + 1], false); }
}
template <bool DO_T, bool DO_X, bool LAST> __device__ __forceinline__ void blk_stage(const LAS unsigned char* X, const LAS unsigned char* XT, const LAS unsigned char* TT, LAS unsigned char* To, LAS unsigned char* T0T,
                                                                                    LAS unsigned char* Xo, LAS unsigned char* XoT, int wave, int fr, int fq) {
    const int bk = wave >> 2, k0 = 32 * bk, m0 = k0 + 16 * ((wave >> 1) & 1), n0 = k0 + 16 * (wave & 1);
    bf16x8 a = ldfrag(X, LDB, m0, k0, fr, fq), tb = a, xb = a; v2u tw = (v2u){0u, 0u};
    if (DO_T) { tb = ldfrag(TT, LDB, n0, k0, fr, fq); tw = *(const LAS v2u*)(TT + ((n0 + fr) * LDB + m0 + 4 * fq) * 2); }
    if (DO_X) xb = ldfrag(XT, LDB, n0, k0, fr, fq);
    CFENCE();
    PIN(a);
    if (DO_T) { f32x4 ta = (f32x4){bflo(tw.x), bfhi(tw.x), bflo(tw.y), bfhi(tw.y)}; PIN(tb); ta = MFMA16(a, tb, ta);
        if (LAST) { st_tile_bf16(To, LDB, m0, n0, fr, fq, ta); if (bk == 0) st_tile_bf16_T(T0T, LDB, m0, n0, fr, fq, ta); }
        else st_tile_bf16_T(To, LDB, m0, n0, fr, fq, ta); }
    if (DO_X) { f32x4 xa = (f32x4){0.f, 0.f, 0.f, 0.f}; PIN(xb); xa = MFMA16(a, xb, xa);
        st_tile_bf16(Xo, LDB, m0, n0, fr, fq, xa); st_tile_bf16_T(XoT, LDB, m0, n0, fr, fq, xa); }
}

template <int HH> __device__ __forceinline__ void m2_half(LAS unsigned char* L, int q, int fr, int fq) {
    const LAS unsigned char* Am = L + ((q < 2) ? O_AH : O_RH); const LAS unsigned char* Bm = L + ((q & 1) ? O_KH : O_BH);
    LAS unsigned char* Om = L + (q == 0 ? O_XA : (q == 1 ? O_AAK : (q == 2 ? O_ARB : O_ARK)));
    constexpr int MT0 = HH ? 1 : 0, MT1 = HH ? 2 : 3, NB = MT1 + 1;
    unsigned zz_ = 0u; asm volatile("" : "+v"(zz_)); const v2u z2 = (v2u){zz_, zz_};
    bf16x8 a[2][2], b[NB][2];
#pragma unroll
    for (int ks = 0; ks < 2; ++ks) { a[0][ks] = ldfrag(Am, LDB, 16 * MT0, 32 * ks, fr, fq); a[1][ks] = ldfrag(Am, LDB, 16 * MT1, 32 * ks, fr, fq); }
#pragma unroll
    for (int nt = 0; nt < NB; ++nt)
#pragma unroll
        for (int ks = 0; ks < 2; ++ks) b[nt][ks] = ldfrag(Bm, LDB, 16 * nt, 32 * ks, fr, fq);
    CFENCE();
#pragma unroll
    for (int mi = 0; mi < 2; ++mi) { const int mtile = mi ? MT1 : MT0;
        PIN(a[mi][0]); PIN(a[mi][1]);
#pragma unroll
        for (int nt = 0; nt < 4; ++nt) {
            if (nt > mtile) {
                *(LAS v2u*)(Om + ((16 * mtile + fr) * LDB + 16 * nt + 4 * fq) * 2) = z2;
                if (q == 0) { *(LAS v2u*)(L + O_XAT + ((16 * nt + fr) * LDB + 16 * mtile + 4 * fq) * 2) = z2; *(LAS v2u*)(L + O_UT + ((16 * nt + fr) * LDB + 16 * mtile + 4 * fq) * 2) = z2; }
                continue; }
            if (mi == 0) { PIN(b[nt][0]); PIN(b[nt][1]); }
            f32x4 at = (f32x4){0.f, 0.f, 0.f, 0.f};
            at = MFMA16(b[nt][0], a[mi][0], at); at = MFMA16(b[nt][1], a[mi][1], at);
            if (nt == mtile) {
#pragma unroll
                for (int jj = 0; jj < 4; ++jj) { const bool keep = (q < 2) ? (4 * fq + jj < fr) : (4 * fq + jj <= fr); if (!keep) at[jj] = 0.f; } }
            { v2u o; o.x = pk2(at[0], at[1]); o.y = pk2(at[2], at[3]); *(LAS v2u*)(Om + ((16 * mtile + fr) * LDB + 16 * nt + 4 * fq) * 2) = o; }
            if ((mtile >> 1) == (nt >> 1)) {
                if (q == 0) { f32x4 an = (f32x4){0.f, 0.f, 0.f, 0.f};
                    an = MFMA16(a[mi][0], b[nt][0], an); an = MFMA16(a[mi][1], b[nt][1], an);
                    f32x4 t1 = an;
                    if (nt == mtile) {
#pragma unroll
                        for (int jj = 0; jj < 4; ++jj) { if (!(fr < 4 * fq + jj)) an[jj] = 0.f; t1[jj] = (fr == 4 * fq + jj) ? 1.0f : an[jj]; } }
                    st_tile_bf16_T(L + O_XAT, LDB, 16 * mtile, 16 * nt, fr, fq, an);
                    st_tile_bf16_T(L + O_UT, LDB, 16 * mtile, 16 * nt, fr, fq, t1); } }
        } }
}

__device__ __forceinline__ void cscan_chain(Frame& F, int l, int unit) {
    PHASE_TID(); const int chain = unit >> 1, seg = unit & 1; const int b = chain >> 4, h = (chain >> 1) & 7, d = chain & 1, hc = h * HD;
    const int fr_o = lane & 15, fq_o = lane >> 4;
    LAS unsigned char* L = F.lds;
    const bf16* PRW = (const bf16*)(F.ws + WS_PRW);
    const float* mu = F.in[I_SHIFT] + (size_t)l * 2 * RWP;
    const bf16* VFIRST = (const bf16*)(F.ws + WS_VFIRST);
    bf16* VOUT = (l == 0) ? (bf16*)(F.ws + WS_VFIRST) : (bf16*)(F.ws + WS_V2);
    bf16* GOUT = (bf16*)(F.ws + WS_G);
    bf16* YS = (bf16*)(F.ws + WS_YS) + (size_t)d * M * CH;
    float* BS = (float*)(F.ws + WS_BS) + (size_t)d * M * NH;
    bf16* YPHI = (bf16*)(F.ws + WS_YPHI) + (size_t)chain * (T / 2) * 64;
    const int lnt = wave & 3, lmt0 = 2 * (wave >> 2);
    if (wave < 4) { const int lcol = hc + 16 * lnt + fr_o; bf16x8* FRAGS = (bf16x8*)(F.ws + WS_FRAG) + ((size_t)chain * 4 + lnt) * 9 * 64 + lane; const float* w2 = F.in[I_W2] + (size_t)(l * 2 + d) * 64 * CH; const float* a2 = F.in[I_A2] + (size_t)(l * 2 + d) * 64 * CH; const float* g2 = F.in[I_G2] + (size_t)l * 128 * CH;
#pragma unroll
      for (int ks = 0; ks < 2; ++ks) { FRAGS[ks * 64] = wfrag(w2, 32 * ks, lcol, fq_o); FRAGS[(2 + ks) * 64] = wfrag(a2, 32 * ks, lcol, fq_o); }
      if (l == 1) FRAGS[4 * 64] = wfrag(F.in[I_V2], 0, lcol, fq_o);
#pragma unroll
      for (int ks = 0; ks < 4; ++ks) if (d == 0) FRAGS[(5 + ks) * 64] = wfrag(g2, 32 * ks, lcol, fq_o); }
    const int lcol_o = hc + 16 * lnt + fr_o;
    const float lc_w0 = F.in[I_W0][(l * 2 + d) * CH + lcol_o], lc_a0 = F.in[I_A0][(l * 2 + d) * CH + lcol_o], lc_v0 = (l == 1) ? F.in[I_V0][lcol_o] : 0.f;
    const int mt = wave >> 1, nt0 = 2 * (wave & 1);
    f32x4 S[2] = {(f32x4){0.f, 0.f, 0.f, 0.f}, (f32x4){0.f, 0.f, 0.f, 0.f}};
    f32x4 Ph[2];
#pragma unroll
    for (int j = 0; j < 2; ++j)
#pragma unroll
        for (int jj = 0; jj < 4; ++jj) Ph[j][jj] = (16 * mt + 4 * fq_o + jj == 16 * (nt0 + j) + fr_o) ? 1.0f : 0.f;
    __syncthreads();
    for (int e = tid; e < MB / 4; e += NTHR) ((LAS unsigned*)(L + O_S0B))[e] = 0u;
    if (tid < 448) { const int g = tid >> 6, j = tid & 63; const int col = (g < 3) ? g * CH + hc + j : (g == 3 ? 1536 + d * 64 + j : (g == 4 ? 1664 + d * 64 + j : 1792 + (tid - 320)));
        const unsigned pm = pk2(mu[col], mu[RWP + col]); ((LAS unsigned*)(L + O_MU))[tid] = pm; ((LAS float*)(L + O_MC))[tid] = 1.0f - bflo(pm) - bfhi(pm); }
    if (tid < 192) { const int g = tid >> 6, j = tid & 63; ((LAS float*)(L + O_CK))[tid] = F.in[g == 0 ? I_KK : (g == 1 ? I_KA : I_RK)][l * CH + hc + j]; }
    RawTok raw;
    { const int et0 = tid >> 3, ec0 = (tid & 7) * 8; const int cf = (d == 0) ? seg * 64 * CL_ : (127 - seg * 64) * CL_; load_raw(raw, PRW, VFIRST, b, (d == 0) ? cf + et0 : cf + 63 - et0, hc, ec0, d, l, (tid & 7) < 4); }
#pragma unroll 1
    for (int ci = 0; ci < T / CL_ / 2; ++ci) {
        int tid = (wave << 6) | (int)__builtin_amdgcn_mbcnt_hi(~0u, __builtin_amdgcn_mbcnt_lo(~0u, 0u)); asm volatile("" : "+v"(tid));
        const int lane = tid & 63, fr = lane & 15, fq = lane >> 4, et = tid >> 3, ec = (tid & 7) * 8;
        const int lcol = hc + 16 * lnt + fr;
        const unsigned char* FRB = F.ws + WS_FRAG + (((size_t)chain * 4 + lnt) * 9 * 64) * 16; unsigned fo = (unsigned)lane * 16u;
#define FRAGS_(k) (*(const bf16x8*)(FRB + fo + (k) * 1024))
        int c0 = (d == 0 ? seg * 64 + ci : 127 - seg * 64 - ci) * CL_; asm volatile("" : "+s"(c0));
        const int tok = (d == 0) ? c0 + et : c0 + 63 - et;
        const size_t m = (size_t)b * T + tok;
        __syncthreads();
        float rr[8], kr[8], vr[8];
        const LAS unsigned* MUB = (const LAS unsigned*)(L + O_MU) + ec; const LAS float* MCB = (const LAS float*)(L + O_MC) + ec;
        v4u vl4 = (v4u){0u, 0u, 0u, 0u}, vf4 = vl4;
        if (l == 1 && (tid & 7) < 4) vl4 = *(const v4u*)(PRW + m * NRW + RWP + ec);
        bf16x8 wf[5];
        {
          if (d == 0) { float g0[8], g1[8];
              mix8r(raw.g[5], MUB + 320, MCB + 320, g0); CFENCE(); mix8r(raw.g[6], MUB + 384, MCB + 384, g1); CFENCE();
#pragma unroll
              for (int e = 0; e < 8; ++e) { g0[e] = sigmoidf_(g0[e]); g1[e] = sigmoidf_(g1[e]); }
              *(LAS v4u*)(L + O_SG + (et * LDSG + ec) * 2) = pack8(g0); *(LAS v4u*)(L + O_SG + (et * LDSG + 64 + ec) * 2) = pack8(g1); }
          float xw[8], xa[8];
          mix8r(raw.g[3], MUB + 192, MCB + 192, xw); CFENCE(); mix8r(raw.g[4], MUB + 256, MCB + 256, xa);
          asm volatile("" : "+v"(fo) : "v"(xw[7]), "v"(xa[7]));
          wf[0] = FRAGS_(0); wf[1] = FRAGS_(1); wf[2] = FRAGS_(2); wf[3] = FRAGS_(3); wf[4] = ZFRAG; if (l == 1) wf[4] = FRAGS_(4);
          CFENCE();
#pragma unroll
          for (int e = 0; e < 8; ++e) xw[e] = tanhf_(xw[e]);
          *(LAS v4u*)(L + O_TW + (et * LDB + ec) * 2) = pack8(xw);
          *(LAS v4u*)(L + O_AD + (et * LDB + ec) * 2) = pack8(xa);
          mix8r(raw.g[0], MUB, MCB, rr); CFENCE(); mix8r(raw.g[1], MUB + 64, MCB + 64, kr); CFENCE(); mix8r(raw.g[2], MUB + 128, MCB + 128, vr);
          if (l == 1 && (tid & 7) < 4) *(LAS v4u*)(L + O_VL + (et * LDVL + ec) * 2) = vl4;
          if (l == 1) vf4 = *(const v4u*)(VFIRST + m * CH + hc + ec); }
        __syncthreads();
        { bf16x8 gf[4];
          gf[0] = ZFRAG; gf[1] = ZFRAG; gf[2] = ZFRAG; gf[3] = ZFRAG;
          if (d == 0) { gf[0] = FRAGS_(5); gf[1] = FRAGS_(6); gf[2] = FRAGS_(7); gf[3] = FRAGS_(8); }
#pragma unroll
          for (int mi = 0; mi < 2; ++mi) { const int m0 = 16 * (lmt0 + mi);
              bf16x8 tw[2], ad[2], vl;
#pragma unroll
              for (int ks = 0; ks < 2; ++ks) { tw[ks] = ldfrag(L + O_TW, LDB, m0, 32 * ks, fr, fq); ad[ks] = ldfrag(L + O_AD, LDB, m0, 32 * ks, fr, fq); }
              vl = ZFRAG; if (l == 1) vl = ldfrag(L + O_VL, LDVL, m0, 0, fr, fq);
              CFENCE();
              f32x4 zw = (f32x4){0.f, 0.f, 0.f, 0.f}, za = zw, zv = zw;
#pragma unroll
              for (int ks = 0; ks < 2; ++ks) { PIN(tw[ks]); zw = MFMA16(tw[ks], wf[ks], zw); PIN(ad[ks]); za = MFMA16(ad[ks], wf[2 + ks], za); }
              if (l == 1) { PIN(vl); zv = MFMA16(vl, wf[4], zv); }
#pragma unroll
              for (int jj = 0; jj < 4; ++jj) { const int s = m0 + 4 * fq + jj, o = (s * LDF + 16 * lnt + fr) * 4;
                  *(LAS float*)(L + O_AF + o) = sigmoidf_(za[jj] + lc_a0);
                  *(LAS float*)(L + O_LW + o) = -0.6065306597126334f * sigmoidf_(zw[jj] + lc_w0); }
              if (l == 1) {
#pragma unroll
                  for (int jj = 0; jj < 4; ++jj) { const int s = m0 + 4 * fq + jj, o = (s * LDF + 16 * lnt + fr) * 4; *(LAS float*)(L + O_ZV + o) = sigmoidf_(zv[jj] + lc_v0); } } }
          if (d == 0) {
#pragma unroll
              for (int mi = 0; mi < 2; ++mi) { const int m0 = 16 * (lmt0 + mi);
                  bf16x8 sg[4];
#pragma unroll
                  for (int ks = 0; ks < 4; ++ks) sg[ks] = ldfrag(L + O_SG, LDSG, m0, 32 * ks, fr, fq);
                  CFENCE();
                  f32x4 zg = (f32x4){0.f, 0.f, 0.f, 0.f};
#pragma unroll
                  for (int ks = 0; ks < 4; ++ks) { PIN(sg[ks]); zg = MFMA16(gf[ks], sg[ks], zg); }
                  { v2u o; o.x = pk2(zg[0], zg[1]); o.y = pk2(zg[2], zg[3]); *(v2u*)(GOUT + ((size_t)b * T + c0 + m0 + fr) * CH + hc + 16 * lnt + 4 * fq) = o; } } } }
        __syncthreads();
        { const int j = tid & 63, sg = tid >> 6; float c[8]; float run = 0.f;
#pragma unroll
          for (int i = 0; i < 8; ++i) { run += *(LAS float*)(L + O_LW + ((8 * sg + i) * LDF + j) * 4); c[i] = run; }
          *(LAS float*)(L + O_PART + (sg * 64 + j) * 4) = run;
          __syncthreads();
          float pre = 0.f;
#pragma unroll
          for (int q = 0; q < 8; ++q) { const float pv = *(LAS float*)(L + O_PART + (q * 64 + j) * 4); pre += (q < sg) ? pv : 0.f; }
#pragma unroll
          for (int i = 0; i < 8; ++i) *(LAS float*)(L + O_LW + ((8 * sg + i) * LDF + j) * 4) = c[i] + pre; }
        __syncthreads();
        { float kkr[8], av[8], cl[8], clm[8], zv[8], kd[8], ss = 0.f, bon = 0.f;
          const unsigned vfw[4] = {vf4.x, vf4.y, vf4.z, vf4.w};
          const LAS float* CKT = (const LAS float*)(L + O_CK) + ec;
          const f32x4 kka = *(const LAS f32x4*)CKT, kkb = *(const LAS f32x4*)(CKT + 4), kaa = *(const LAS f32x4*)(CKT + 64), kab = *(const LAS f32x4*)(CKT + 68), rka = *(const LAS f32x4*)(CKT + 128), rkb = *(const LAS f32x4*)(CKT + 132);
          const int o0 = (et * LDF + ec) * 4, om = (et > 0) ? o0 - LDF * 4 : o0;
#pragma unroll
          for (int e = 0; e < 8; ++e) { av[e] = *(LAS float*)(L + O_AF + o0 + 4 * e); cl[e] = *(LAS float*)(L + O_LW + o0 + 4 * e); clm[e] = *(LAS float*)(L + O_LW + om + 4 * e); zv[e] = 0.f; }
          if (l == 1) {
#pragma unroll
              for (int e = 0; e < 8; ++e) zv[e] = *(LAS float*)(L + O_ZV + o0 + 4 * e); }
          CFENCE();
          const float ckk[8] = {kka[0], kka[1], kka[2], kka[3], kkb[0], kkb[1], kkb[2], kkb[3]}, cka[8] = {kaa[0], kaa[1], kaa[2], kaa[3], kab[0], kab[1], kab[2], kab[3]},
                      crk[8] = {rka[0], rka[1], rka[2], rka[3], rkb[0], rkb[1], rkb[2], rkb[3]};
#pragma unroll
          for (int e = 0; e < 8; ++e) {
              const float vf = (e & 1) ? bfhi(vfw[e >> 1]) : bflo(vfw[e >> 1]); vr[e] = vr[e] + (vf - vr[e]) * zv[e];
              kkr[e] = kr[e] * ckk[e]; ss += kkr[e] * kkr[e];
              kd[e] = kr[e] * (1.0f + (av[e] - 1.0f) * cka[e]); bon += rr[e] * kd[e] * crk[e]; }
          ss = sum8(ss); bon = sum8(bon);
          const float inv = __builtin_amdgcn_rsqf(fmaxf(ss, 1e-24f));
          if ((tid & 7) == 0) BS[m * NH + h] = bon;
          if (d == 0) *(v4u*)(VOUT + m * CH + hc + ec) = pack8(vr);
          float ah[8], bh[8], kh[8], rh[8], Pv[8];
#pragma unroll
          for (int e = 0; e < 8; ++e) {
              const float P = __expf(cl[e]), Pi = __builtin_amdgcn_rcpf(P), Pm = (et > 0) ? __expf(clm[e]) : 1.0f, kk = kkr[e] * inv;
              ah[e] = -kk * Pm; bh[e] = kk * av[e] * Pi; kh[e] = kd[e] * Pi; rh[e] = rr[e] * P; Pv[e] = P; }
          if (et == 63) { *(LAS f32x4*)(L + O_PL + ec * 4) = (f32x4){Pv[0], Pv[1], Pv[2], Pv[3]}; *(LAS f32x4*)(L + O_PL + ec * 4 + 16) = (f32x4){Pv[4], Pv[5], Pv[6], Pv[7]}; }
          *(LAS v4u*)(L + O_AH + (et * LDB + ec) * 2) = pack8(ah); *(LAS v4u*)(L + O_BH + (et * LDB + ec) * 2) = pack8(bh);
          *(LAS v4u*)(L + O_KH + (et * LDB + ec) * 2) = pack8(kh); *(LAS v4u*)(L + O_RH + (et * LDB + ec) * 2) = pack8(rh);
          { unsigned pab[8], pkv[8]; const int c = tid & 7;
#pragma unroll
            for (int e = 0; e < 8; ++e) { pab[e] = pk2(ah[e], bh[e]); pkv[e] = pk2(kh[e], vr[e]); }
#pragma unroll
            for (int sh = 1; sh < 8; sh <<= 1) { const bool on = (c & sh) != 0; unsigned ta[8], tk[8];
#pragma unroll
                for (int e = 0; e < 8; ++e) { ta[e] = on ? pab[(e + sh) & 7] : pab[e]; tk[e] = on ? pkv[(e + sh) & 7] : pkv[e]; }
#pragma unroll
                for (int e = 0; e < 8; ++e) { pab[e] = ta[e]; pkv[e] = tk[e]; } }
#pragma unroll
            for (int e = 0; e < 8; ++e) { const int o = ((ec + ((e + c) & 7)) * LDB + et) * 2;
                *(LAS bf16*)(L + O_AHT + o) = (bf16)(pab[e] & 0xffffu); *(LAS bf16*)(L + O_BHT + o) = (bf16)(pab[e] >> 16);
                *(LAS bf16*)(L + O_KHT + o) = (bf16)(pkv[e] & 0xffffu); *(LAS bf16*)(L + O_VT + o) = (bf16)(pkv[e] >> 16); } } }
        __syncthreads();
        { if (wave & 1) m2_half<1>(L, wave >> 1, fr, fq); else m2_half<0>(L, wave >> 1, fr, fq); }
        __syncthreads();
        if (ci + 1 < T / CL_ / 2) { const int c0n = (d == 0) ? c0 + CL_ : c0 - CL_; load_raw(raw, PRW, VFIRST, b, (d == 0) ? c0n + et : c0n + 63 - et, hc, ec, d, l, (tid & 7) < 4); }
        { blk_stage<false, true, false>(L + O_XA, L + O_XAT, nullptr, nullptr, nullptr, L + O_AH, L + O_KH, wave, fr, fq); }
        __syncthreads();
        { blk_stage<true, true, false>(L + O_AH, L + O_KH, L + O_UT, L + O_BH, nullptr, L + O_XA, L + O_XAT, wave, fr, fq); }
        __syncthreads();
        { blk_stage<true, true, false>(L + O_XA, L + O_XAT, L + O_BH, L + O_UT, nullptr, L + O_AH, L + O_KH, wave, fr, fq); }
        __syncthreads();
        { blk_stage<true, true, false>(L + O_AH, L + O_KH, L + O_UT, L + O_BH, nullptr, L + O_XA, L + O_XAT, wave, fr, fq); }
        __syncthreads();
        { blk_stage<true, false, true>(L + O_XA, L + O_XAT, L + O_BH, L + O_TB, L + O_T0T, nullptr, nullptr, wave, fr, fq); }
        __syncthreads();
        { if (wave < 4) { const int bmt = (wave >> 1) & 1, bnt = wave & 1;
            bf16x8 a0 = ldfrag(L + O_XA, LDB, 32, 0, fr, fq), a1 = ldfrag(L + O_XA, LDB, 48, 0, fr, fq), t1b = ldfrag(L + O_T0T, LDB, 16 * bnt, 0, fr, fq), t22 = ldfrag(L + O_TB, LDB, 32 + 16 * bmt, 32, fr, fq);
            const f32x4 z4 = (f32x4){0.f, 0.f, 0.f, 0.f};
            const f32x4 w0 = MFMA16(a0, t1b, z4), w1 = MFMA16(a1, t1b, z4);
            st_tile_bf16_T(L + O_WT, LDB, 0, 16 * bnt, fr, fq, w0); st_tile_bf16_T(L + O_WT, LDB, 16, 16 * bnt, fr, fq, w1);
            LDS_WAIT();
            const bf16x8 wb = ldfrag(L + O_WT, LDB, 16 * bnt, 0, fr, fq);
            const f32x4 t21 = MFMA16(t22, wb, z4);
            st_tile_bf16(L + O_TB, LDB, 32 + 16 * bmt, 16 * bnt, fr, fq, t21);
        } else { const int bmt = (wave >> 1) & 1, bnt = wave & 1;
            unsigned zz_ = 0u; asm volatile("" : "+v"(zz_)); *(LAS v2u*)(L + O_TB + ((16 * bmt + fr) * LDB + 32 + 16 * bnt + 4 * fq) * 2) = (v2u){zz_, zz_}; } }
        f32x4 y0[2] = {(f32x4){0.f, 0.f, 0.f, 0.f}, (f32x4){0.f, 0.f, 0.f, 0.f}}, g0[2] = {y0[0], y0[0]};
        { f32x4 m1[2] = {(f32x4){0.f, 0.f, 0.f, 0.f}, (f32x4){0.f, 0.f, 0.f, 0.f}};
          bf16x8 aak[2], ark[2], vta[2], vtb[2][2], khb[2][2];
          ldA(aak, L + O_AAK, mt, fr, fq); ldB(vtb, L + O_VT, nt0, fr, fq); ldA(ark, L + O_ARK, mt, fr, fq); ldA(vta, L + O_VT, mt, fr, fq); ldB(khb, L + O_KHT, nt0, fr, fq);
          CFENCE();
          mmac(aak, vtb, m1); mmacT(ark, vtb, y0); mmac(vta, khb, g0);
#pragma unroll
          for (int j = 0; j < 2; ++j) st_tile_bf16_T(L + O_M1T, LDB, 16 * mt, 16 * (nt0 + j), fr, fq, m1[j]); }
        __syncthreads();
        f32x4 u0[2] = {(f32x4){0.f, 0.f, 0.f, 0.f}, (f32x4){0.f, 0.f, 0.f, 0.f}};
        { f32x4 ap[2] = {u0[0], u0[0]};
          bf16x8 tba[2], ahb[2][2], m1b[2][2];
          ldA(tba, L + O_TB, mt, fr, fq); ldB(ahb, L + O_AHT, nt0, fr, fq); ldB(m1b, L + O_M1T, nt0, fr, fq);
          CFENCE();
          mmac(tba, ahb, ap); mmac(tba, m1b, u0);
#pragma unroll
          for (int j = 0; j < 2; ++j) st_tile_bf16(L + O_APB, LDB, 16 * mt, 16 * (nt0 + j), fr, fq, ap[j]);
          if (seg) {
#pragma unroll
              for (int j = 0; j < 2; ++j) st_tile_bf16(L + O_VT, LDB, 16 * mt, 16 * (nt0 + j), fr, fq, Ph[j]); } }
        __syncthreads();
        { bf16x8 apa[2], s0b[2][2], phb[2][2];
          ldA(apa, L + O_APB, mt, fr, fq); ldB(s0b, L + O_S0B, nt0, fr, fq); phb[0][0] = ZFRAG; phb[0][1] = ZFRAG; phb[1][0] = ZFRAG; phb[1][1] = ZFRAG; if (seg) ldB(phb, L + O_VT, nt0, fr, fq);
          CFENCE();
          mmac(apa, s0b, u0);
#pragma unroll
          for (int j = 0; j < 2; ++j) st_tile_bf16_T(L + O_UT, LDB, 16 * mt, 16 * (nt0 + j), fr, fq, u0[j]);
          if (seg) { f32x4 up[2] = {(f32x4){0.f, 0.f, 0.f, 0.f}, (f32x4){0.f, 0.f, 0.f, 0.f}};
              mmac(apa, phb, up);
#pragma unroll
              for (int j = 0; j < 2; ++j) st_tile_bf16_T(L + O_KHT, LDB, 16 * mt, 16 * (nt0 + j), fr, fq, up[j]); } }
        __syncthreads();
        { bf16x8 rha[2], arba[2], uta[2], s0b[2][2], utb[2][2], bhb[2][2]; float plv[2];
          ldA(rha, L + O_RH, mt, fr, fq); ldB(s0b, L + O_S0B, nt0, fr, fq); ldA(arba, L + O_ARB, mt, fr, fq); ldB(utb, L + O_UT, nt0, fr, fq);
#pragma unroll
          for (int j = 0; j < 2; ++j) plv[j] = *(LAS float*)(L + O_PL + (16 * (nt0 + j) + fr) * 4);
          CFENCE();
          mmacT(rha, s0b, y0);
          ldA(uta, L + O_UT, mt, fr, fq); ldB(bhb, L + O_BHT, nt0, fr, fq);
          CFENCE();
          mmacT(arba, utb, y0);
          { const int s = 16 * mt + fr; const int tk = (d == 0) ? c0 + s : c0 + 63 - s;
#pragma unroll
            for (int j = 0; j < 2; ++j) { v2u o; o.x = pk2(y0[j][0], y0[j][1]); o.y = pk2(y0[j][2], y0[j][3]); *(v2u*)(YS + ((size_t)b * T + tk) * CH + hc + 16 * (nt0 + j) + 4 * fq) = o; } }
          f32x4 sn[2] = {g0[0], g0[1]};
          mmac(uta, bhb, sn);
#pragma unroll
          for (int j = 0; j < 2; ++j) S[j] = (S[j] + sn[j]) * plv[j];
          if (seg) { f32x4 yp[2] = {(f32x4){0.f, 0.f, 0.f, 0.f}, (f32x4){0.f, 0.f, 0.f, 0.f}}, pn[2] = {yp[0], yp[0]};
              bf16x8 rh2[2], arb2[2], kha[2], phb[2][2], khb[2][2], bh2[2][2];
              ldA(rh2, L + O_RH, mt, fr, fq); ldB(phb, L + O_VT, nt0, fr, fq); ldA(arb2, L + O_ARB, mt, fr, fq); ldB(khb, L + O_KHT, nt0, fr, fq); ldA(kha, L + O_KHT, mt, fr, fq); ldB(bh2, L + O_BHT, nt0, fr, fq);
              CFENCE();
              mmacT(rh2, phb, yp);
              mmacT(arb2, khb, yp);
              { const int s = 16 * mt + fr; const int tk = (d == 0) ? c0 + s : c0 + 63 - s;
#pragma unroll
                for (int j = 0; j < 2; ++j) { v2u o; o.x = pk2(yp[j][0], yp[j][1]); o.y = pk2(yp[j][2], yp[j][3]); *(v2u*)(YPHI + (size_t)(tk & (T / 2 - 1)) * 64 + 16 * (nt0 + j) + 4 * fq) = o; } }
              mmac(kha, bh2, pn);
#pragma unroll
              for (int j = 0; j < 2; ++j) Ph[j] = (Ph[j] + pn[j]) * plv[j]; } }
        __syncthreads();
#pragma unroll
        for (int j = 0; j < 2; ++j) st_tile_bf16(L + O_S0B, LDB, 16 * mt, 16 * (nt0 + j), fr, fq, S[j]);
    }
    if (seg == 0) { float* SF = (float*)(F.ws + WS_SFIN) + (size_t)chain * 4096;
        int t2 = (int)__builtin_amdgcn_mbcnt_hi(~0u, __builtin_amdgcn_mbcnt_lo(~0u, 0u)); asm volatile("" : "+v"(t2)); const int fr2 = t2 & 15, fq2 = (t2 >> 4) & 3;
#pragma unroll
        for (int j = 0; j < 2; ++j)
#pragma unroll
            for (int jj = 0; jj < 4; ++jj) SF[(16 * mt + 4 * fq2 + jj) * 64 + 16 * (nt0 + j) + fr2] = S[j][jj]; }
    __syncthreads();
}


__device__ __forceinline__ void tr_item(const float* W, int ld, int col0, int nblk, int K, bf16* WT, int row_off, LAS float* scr, int item, int lane, const float* gain = nullptr) {
    const int kb = item / nblk, nb = item % nblk, k0 = 64 * kb, n0 = 32 * nb;
    float wv[32];
#pragma unroll
    for (int i = 0; i < 32; ++i) wv[i] = W[(size_t)(k0 + 2 * i + (lane >> 5)) * ld + col0 + n0 + (lane & 31)];
    if (gain) {
#pragma unroll
        for (int i = 0; i < 32; ++i) wv[i] *= gain[k0 + 2 * i + (lane >> 5)]; }
#pragma unroll
    for (int i = 0; i < 32; ++i) scr[(2 * i + (lane >> 5)) * 33 + (lane & 31)] = wv[i];
    LDS_WAIT(); asm volatile("" ::: "memory");
    const int c = lane & 7;
#pragma unroll
    for (int j = 0; j < 4; ++j) { const int n = (lane >> 3) + 8 * j; const LAS float* s = scr + (8 * c) * 33 + n;
        v4u o; o.x = pk2(s[0 * 33], s[1 * 33]); o.y = pk2(s[2 * 33], s[3 * 33]); o.z = pk2(s[4 * 33], s[5 * 33]); o.w = pk2(s[6 * 33], s[7 * 33]);
        *(v4u*)(WT + (size_t)(row_off + n0 + n) * K + k0 + 8 * c) = o; }
    LDS_WAIT(); asm volatile("" ::: "memory");
}
__device__ __forceinline__ void wq_max_item(const float* W, int ld, int col0, int nblk, unsigned* cmax, int item, int lane) {
    const int kb = item / nblk, nb = item % nblk, k0 = 64 * kb, n0 = 32 * nb; float am = 0.f;
#pragma unroll
    for (int i = 0; i < 32; ++i) am = fmaxf(am, fabsf(W[(size_t)(k0 + 2 * i + (lane >> 5)) * ld + col0 + n0 + (lane & 31)]));
    am = fmaxf(am, __shfl_xor(am, 32));
    if (lane < 32) atomicMax(cmax + n0 + lane, __float_as_uint(am));
}
__device__ __forceinline__ void wq_item(const float* W, int ld, int col0, int nblk, const unsigned* cmax, float* csc, unsigned char* WQ, int row_off, LAS float* scr, int item, int lane) {
    const int kb = item / nblk, nb = item % nblk, k0 = 64 * kb, n0 = 32 * nb;
    float wv[32];
#pragma unroll
    for (int i = 0; i < 32; ++i) wv[i] = W[(size_t)(k0 + 2 * i + (lane >> 5)) * ld + col0 + n0 + (lane & 31)];
#pragma unroll
    for (int i = 0; i < 32; ++i) scr[(2 * i + (lane >> 5)) * 33 + (lane & 31)] = wv[i];
    LDS_WAIT(); asm volatile("" ::: "memory");
    const int c = lane & 7;
#pragma unroll
    for (int j = 0; j < 4; ++j) { const int n = (lane >> 3) + 8 * j; const LAS float* sp = scr + (8 * c) * 33 + n;
        const float cm = __uint_as_float(cmax[n0 + n]), inv = cm > 0.f ? 127.0f / cm : 0.f;
        v2u o; o.x = q4(sp[0 * 33] * inv, sp[1 * 33] * inv, sp[2 * 33] * inv, sp[3 * 33] * inv); o.y = q4(sp[4 * 33] * inv, sp[5 * 33] * inv, sp[6 * 33] * inv, sp[7 * 33] * inv);
        *(v2u*)(WQ + (size_t)(row_off + n0 + n) * D + k0 + 8 * c) = o;
        if (kb == 0 && c == 0) csc[n0 + n] = cm * (1.0f / 127.0f); }
    LDS_WAIT(); asm volatile("" ::: "memory");
}
__device__ __forceinline__ void p_convert(Frame& F) {
    PHASE_TID();
    LAS float* scr = (LAS float*)(F.lds + wave * 16384);
    const int gw = bid * NWAVES + wave, NGW = F.G * NWAVES;
    constexpr int C_HY = 16 * 48, C_RW = 16 * 60, C_V1 = 16, C_O = 16 * 32, C_1 = 16 * 128, C_2 = 64 * 32, C_L = C_HY + C_RW + C_V1 + C_O + C_1 + C_2;
    for (int it = gw; it < NL * C_L; it += NGW) {
        const int l = it / C_L; int r = it % C_L;
        unsigned char* wb = F.ws + WS_W + (size_t)l * W_LAYER;
        const float* win = F.in[I_WIN] + (size_t)l * D * PIN;
        unsigned* cmax = F.ctl + CW_CMAX + l * (HYP + NRW);
        if (r < C_HY) { wq_max_item(win, PIN, 0, 48, cmax, r, lane); continue; } r -= C_HY;
        if (r < C_RW) { wq_max_item(win, PIN, HYP, 60, cmax + HYP, r, lane); continue; } r -= C_RW;
        if (r < C_V1) { if (l == 1) wq_max_item(F.in[I_V1], 32, 0, 1, cmax + HYP + RWP, r, lane); continue; } r -= C_V1;
        if (r < C_O) { tr_item(F.in[I_WOUT] + (size_t)l * D * D, D, 0, 32, D, (bf16*)(wb + W_O), 0, scr, r, lane); continue; } r -= C_O;
        if (r < C_1) { tr_item(F.in[I_MW1] + (size_t)l * D * FF, FF, 0, 128, D, (bf16*)(wb + W_1), 0, scr, r, lane, F.in[I_N2G] + (size_t)l * D); continue; } r -= C_1;
        tr_item(F.in[I_MW2] + (size_t)l * FF * D, D, 0, 32, FF, (bf16*)(wb + W_2), 0, scr, r, lane);
    }
}
__device__ __forceinline__ void p_wquant(Frame& F) {
    PHASE_TID();
    LAS float* scr = (LAS float*)(F.lds + wave * 16384);
    const int gw = bid * NWAVES + wave, NGW = F.G * NWAVES;
    constexpr int C_HY = 16 * 48, C_RW = 16 * 60, C_V1 = 16, C_L = C_HY + C_RW + C_V1;
    for (int it = gw; it < NL * C_L; it += NGW) {
        const int l = it / C_L; int r = it % C_L;
        unsigned char* wb = F.ws + WS_W + (size_t)l * W_LAYER;
        const float* win = F.in[I_WIN] + (size_t)l * D * PIN;
        const unsigned* cmax = F.ctl + CW_CMAX + l * (HYP + NRW); float* csc = (float*)(F.ws + WS_CSC) + l * (HYP + NRW);
        if (r < C_HY) { wq_item(win, PIN, 0, 48, cmax, csc, wb + W_HY, 0, scr, r, lane); continue; } r -= C_HY;
        if (r < C_RW) { wq_item(win, PIN, HYP, 60, cmax + HYP, csc + HYP, wb + W_RW, 0, scr, r, lane); continue; } r -= C_RW;
        if (l == 1) wq_item(F.in[I_V1], 32, 0, 1, cmax + HYP + RWP, csc + HYP + RWP, wb + W_RW, RWP, scr, r, lane);
    }
    for (int l = 0; l < NL; ++l) {
        const int r0 = (l == 0) ? RWP : RWP + 32; const int n16 = (NRW - r0) * D / 16;
        v4u* p = (v4u*)(F.ws + WS_W + (size_t)l * W_LAYER + W_RW + (size_t)r0 * D);
        for (int i = bid * NTHR + tid; i < n16; i += F.G * NTHR) p[i] = (v4u){0u, 0u, 0u, 0u};
        float* csc = (float*)(F.ws + WS_CSC) + l * (HYP + NRW) + HYP;
        if (bid == 0 && tid < NRW - r0) csc[r0 + tid] = 0.f;
    }
}

__device__ __forceinline__ void p_filter_item(Frame& F, int l, int item) {
    LAS float* Z = (LAS float*)F.lds;
    LAS float* H1 = Z + 32 * 36;
    LAS float* H2 = H1 + 32 * 64;
    LAS float* H3 = H2 + 32 * 64;
    PHASE_TID(); const int pos0 = item * 32;
    const float* w1 = F.in[I_FW1] + l * 33 * 64; const float* b1 = F.in[I_FB1] + l * 64;
    const float* w2 = F.in[I_FW2] + l * 64 * 64; const float* b2 = F.in[I_FB2] + l * 64;
    const float* w3 = F.in[I_FW3] + l * 64 * 64; const float* b3 = F.in[I_FB3] + l * 64;
    const float* fq = F.in[I_FFREQ] + l * 3 * 64;
    __syncthreads();
    for (int e = tid; e < 32 * 33; e += NTHR) {
        const int p = e / 33, f = e % 33, pos = pos0 + p; float v;
        if (f == 0) v = (float)pos / (float)(T - 1);
        else { const int band = (f - 1) & 15; const float fr = 1e-4f + (float)band * ((15.0f - 1e-4f) / 15.0f);
            float x = (float)pos * fr * (1.0f / (float)T); x -= floorf(x);
            v = (f <= 16) ? __builtin_amdgcn_cosf(x) : -__builtin_amdgcn_sinf(x); }
        Z[p * 36 + f] = v;
    }
    __syncthreads();
    const int j = tid & 63, pb = tid >> 6;
    { float wc[33];
#pragma unroll
      for (int f = 0; f < 33; ++f) wc[f] = w1[f * 64 + j];
      const float bj = b1[j], fj = fq[j];
#pragma unroll
      for (int i = 0; i < 4; ++i) { const int p = pb + 8 * i; float s = bj;
#pragma unroll
          for (int f = 0; f < 33; ++f) s += Z[p * 36 + f] * wc[f];
          H1[p * 64 + j] = sin_hw(fj * s); } }
    __syncthreads();
#pragma unroll 1
    for (int ly = 0; ly < 2; ++ly) { const float* w = ly ? w3 : w2; const float* bb = ly ? b3 : b2; const LAS float* Hi = ly ? H2 : H1; LAS float* Ho = ly ? H3 : H2;
        float wc[64];
#pragma unroll
        for (int f = 0; f < 64; ++f) wc[f] = w[f * 64 + j];
        const float bj = bb[j], fj = fq[64 + 64 * ly + j];
#pragma unroll
        for (int i = 0; i < 4; ++i) { const int p = pb + 8 * i; float s = bj;
#pragma unroll
            for (int q = 0; q < 16; ++q) { const f32x4 h = *(const LAS f32x4*)(Hi + p * 64 + 4 * q); s += (h[0] * wc[4 * q] + h[1] * wc[4 * q + 1]) + (h[2] * wc[4 * q + 2] + h[3] * wc[4 * q + 3]); }
            Ho[p * 64 + j] = sin_hw(fj * s); }
        __syncthreads(); }
    const int fr = lane & 15, fqd = lane >> 4;
    bf16x8 af[2][2];
#pragma unroll
    for (int mt = 0; mt < 2; ++mt)
#pragma unroll
        for (int ks = 0; ks < 2; ++ks) { const LAS float* hp = H3 + (16 * mt + fr) * 64 + 32 * ks + 8 * fqd; const f32x4 h0 = *(const LAS f32x4*)hp, h1 = *(const LAS f32x4*)(hp + 4);
            const float hv[8] = {h0[0], h0[1], h0[2], h0[3], h1[0], h1[1], h1[2], h1[3]}; af[mt][ks] = __builtin_bit_cast(bf16x8, pack8(hv)); }
    const float* wo = F.in[I_FWOUT] + (size_t)l * 64 * 2048;
    float* HF = (float*)(F.ws + WS_HF);
#pragma unroll 1
    for (int tb = 0; tb < 16; tb += 4) {
        bf16x8 bfr[4][2];
#pragma unroll
        for (int u = 0; u < 4; ++u)
#pragma unroll
            for (int ks = 0; ks < 2; ++ks) { float v[8]; const float* wp = wo + (size_t)(32 * ks + 8 * fqd) * 2048 + 256 * wave + 16 * (tb + u) + fr;
#pragma unroll
                for (int e = 0; e < 8; ++e) v[e] = wp[(size_t)e * 2048];
                bfr[u][ks] = __builtin_bit_cast(bf16x8, pack8(v)); }
#pragma unroll
        for (int u = 0; u < 4; ++u) { const int col = 256 * wave + 16 * (tb + u) + fr, c = col & 511;
            const float delta = 3.0701134573f + (float)c * ((15.350567286f - 3.0701134573f) / 511.0f);
#pragma unroll
            for (int mt = 0; mt < 2; ++mt) { f32x4 acc = (f32x4){0.f, 0.f, 0.f, 0.f};
                acc = MFMA16(af[mt][0], bfr[u][0], acc); acc = MFMA16(af[mt][1], bfr[u][1], acc);
                f32x4 o;
#pragma unroll
                for (int jj = 0; jj < 4; ++jj) { const float t = (float)(pos0 + 16 * mt + 4 * fqd + jj) / (float)(T - 1); o[jj] = acc[jj] * __expf(-t * delta); }
                *(f32x4*)(HF + (size_t)col * T + pos0 + 16 * mt + 4 * fqd) = o; } } }
}
__device__ __forceinline__ void p_filter(Frame& F, int l) { PHASE_TID(); (void)tid; for (int it = bid; it < T / 32; it += F.G) p_filter_item(F, l, it); __syncthreads(); }

template <bool F32IN> __device__ __forceinline__ void p_rmsnorm_q(Frame& F, const void* xin, const float* g, unsigned char* HQ, float* RSC, int m0, int m1) {
    PHASE_TID();
    const int gw = bid * NWAVES + wave, NGW = F.G * NWAVES;
    constexpr int R = F32IN ? 2 : 4;
    f32x4 gv[4];
#pragma unroll
    for (int j = 0; j < 4; ++j) gv[j] = F32IN ? *(const f32x4*)(g + 4 * lane + 256 * j) : *(const f32x4*)(g + 16 * lane + 4 * j);
    for (int mb = m0 + gw; mb < m1; mb += R * NGW) {
        f32x4 xf[F32IN ? R : 1][4]; v4u xw[F32IN ? 1 : R][2];
#pragma unroll
        for (int r = 0; r < R; ++r) { const int m = mb + r * NGW;
            if (F32IN) { const f32x4* xr = (const f32x4*)((const float*)xin + (size_t)m * D) + lane;
#pragma unroll
                for (int j = 0; j < 4; ++j) xf[r][j] = xr[64 * j]; }
            else { const v4u* xr = (const v4u*)((const bf16*)xin + (size_t)m * D + 16 * lane); xw[r][0] = xr[0]; xw[r][1] = xr[1]; } }
        asm volatile("" ::: "memory");
#pragma unroll
        for (int r = 0; r < R; ++r) { const int m = mb + r * NGW;
            f32x4 v[4]; float s = 0.f;
            if (F32IN) {
#pragma unroll
                for (int j = 0; j < 4; ++j) v[j] = xf[r][j]; }
            else { const unsigned ww[8] = {xw[r][0].x, xw[r][0].y, xw[r][0].z, xw[r][0].w, xw[r][1].x, xw[r][1].y, xw[r][1].z, xw[r][1].w};
#pragma unroll
                for (int j = 0; j < 4; ++j) v[j] = (f32x4){bflo(ww[2 * j]), bfhi(ww[2 * j]), bflo(ww[2 * j + 1]), bfhi(ww[2 * j + 1])}; }
#pragma unroll
            for (int j = 0; j < 4; ++j) s += (v[j].x * v[j].x + v[j].y * v[j].y) + (v[j].z * v[j].z + v[j].w * v[j].w);
            const float rstd = 1.0f / sqrtf(wave_sum(s) * (1.0f / D) + RMS_EPS);
            float am = 0.f;
#pragma unroll
            for (int j = 0; j < 4; ++j) { v[j] = v[j] * rstd * gv[j]; am = fmaxf(fmaxf(am, fmaxf(fabsf(v[j].x), fabsf(v[j].y))), fmaxf(fabsf(v[j].z), fabsf(v[j].w))); }
            am = wave_max(am);
            const float inv = am > 0.f ? 127.0f / am : 0.f;
            unsigned qd[4];
#pragma unroll
            for (int j = 0; j < 4; ++j) qd[j] = q4(v[j].x * inv, v[j].y * inv, v[j].z * inv, v[j].w * inv);
            if (F32IN) {
#pragma unroll
                for (int j = 0; j < 4; ++j) *(unsigned*)(HQ + (size_t)m * D + 256 * j + 4 * lane) = qd[j]; }
            else *(v4u*)(HQ + (size_t)m * D + 16 * lane) = (v4u){qd[0], qd[1], qd[2], qd[3]};
            if (lane == 0) RSC[m] = am * (1.0f / 127.0f); }
    }
}
__device__ __forceinline__ void p_rmsnorm_b16(Frame& F, const bf16* x, const float* g, bf16* out, int m0, int m1) {
    PHASE_TID();
    const int gw = bid * NWAVES + wave, NGW = F.G * NWAVES;
    f32x4 gv[4];
#pragma unroll
    for (int j = 0; j < 4; ++j) gv[j] = *(const f32x4*)(g + 16 * lane + 4 * j);
    for (int m = m0 + gw; m < m1; m += NGW) {
        const v4u* xr = (const v4u*)(x + (size_t)m * D + 16 * lane); const v4u w0 = xr[0], w1 = xr[1];
        const unsigned ww[8] = {w0.x, w0.y, w0.z, w0.w, w1.x, w1.y, w1.z, w1.w}; f32x4 v[4]; float s = 0.f;
#pragma unroll
        for (int j = 0; j < 4; ++j) { v[j] = (f32x4){bflo(ww[2 * j]), bfhi(ww[2 * j]), bflo(ww[2 * j + 1]), bfhi(ww[2 * j + 1])}; s += (v[j].x * v[j].x + v[j].y * v[j].y) + (v[j].z * v[j].z + v[j].w * v[j].w); }
        const float rstd = 1.0f / sqrtf(wave_sum(s) * (1.0f / D) + RMS_EPS);
        v4u o[2];
#pragma unroll
        for (int j = 0; j < 2; ++j) { const f32x4 ya = v[2 * j] * rstd * gv[2 * j], yb = v[2 * j + 1] * rstd * gv[2 * j + 1]; o[j].x = pk2(ya.x, ya.y); o[j].y = pk2(ya.z, ya.w); o[j].z = pk2(yb.x, yb.y); o[j].w = pk2(yb.z, yb.w); }
        v4u* op = (v4u*)(out + (size_t)m * D + 16 * lane); op[0] = o[0]; op[1] = o[1];
    }
}
__device__ __forceinline__ void p_finalnorm(Frame& F, const bf16* x, const float* g, float* out) {
    PHASE_TID();
    const int gw = bid * NWAVES + wave, NGW = F.G * NWAVES;
    constexpr int R = 4;
    f32x4 gv[4];
#pragma unroll
    for (int j = 0; j < 4; ++j) gv[j] = *(const f32x4*)(g + 4 * lane + 256 * j);
    for (int mb = gw; mb < M; mb += R * NGW) {
        v2u xw[R][4];
#pragma unroll
        for (int r = 0; r < R; ++r) { const v2u* xr = (const v2u*)(x + (size_t)(mb + r * NGW) * D) + lane;
#pragma unroll
            for (int j = 0; j < 4; ++j) xw[r][j] = xr[64 * j]; }
        asm volatile("" ::: "memory");
#pragma unroll
        for (int r = 0; r < R; ++r) { f32x4 v[4]; float s = 0.f;
#pragma unroll
            for (int j = 0; j < 4; ++j) { v[j] = (f32x4){bflo(xw[r][j].x), bfhi(xw[r][j].x), bflo(xw[r][j].y), bfhi(xw[r][j].y)}; s += (v[j].x * v[j].x + v[j].y * v[j].y) + (v[j].z * v[j].z + v[j].w * v[j].w); }
            const float rstd = 1.0f / sqrtf(wave_sum(s) * (1.0f / D) + RMS_EPS);
            f32x4* o = (f32x4*)(out + (size_t)(mb + r * NGW) * D) + lane;
#pragma unroll
            for (int j = 0; j < 4; ++j) o[64 * j] = v[j] * rstd * gv[j]; }
    }
}
template <bool F32OUT> __device__ __forceinline__ void p_rmsnorm(Frame& F, const float* x, const float* g, void* outp, int m0, int m1) {
    PHASE_TID();
    const int gw = bid * NWAVES + wave, NGW = F.G * NWAVES;
    f32x4 gv[4];
#pragma unroll
    for (int j = 0; j < 4; ++j) gv[j] = *(const f32x4*)(g + 4 * lane + 256 * j);
    for (int m = m0 + gw; m < m1; m += NGW) {
        const f32x4* xr = (const f32x4*)(x + (size_t)m * D) + lane; f32x4 v[4]; float s = 0.f;
#pragma unroll
        for (int j = 0; j < 4; ++j) { v[j] = xr[64 * j]; s += (v[j].x * v[j].x + v[j].y * v[j].y) + (v[j].z * v[j].z + v[j].w * v[j].w); }
        const float rstd = 1.0f / sqrtf(wave_sum(s) * (1.0f / D) + RMS_EPS);
        if (F32OUT) { f32x4* o = (f32x4*)((float*)outp + (size_t)m * D) + lane;
#pragma unroll
            for (int j = 0; j < 4; ++j) o[64 * j] = v[j] * rstd * gv[j]; }
        else { v2u* o = (v2u*)((bf16*)outp + (size_t)m * D) + lane;
#pragma unroll
            for (int j = 0; j < 4; ++j) { const f32x4 y = v[j] * rstd * gv[j]; v2u w; w.x = pk2(y.x, y.y); w.y = pk2(y.z, y.w); o[64 * j] = w; } }
    }
}

constexpr int KPAD = 2 * T + 2 * T / 16;

constexpr int LC = 32;

__device__ __forceinline__ void p_mix(Frame& F, int l) {
    PHASE_TID();
#ifndef NO_SCAN
#ifdef SEQ_SCAN
    if (bid < 128) scan_chain(F, l, bid);
#else
    cscan_chain(F, l, bid);
#endif
#endif
    unsigned* head = F.ctl + CW_QUEUE + 64 * l;
    for (;;) {
        __syncthreads();
        if (tid == 0) F.MISC[16] = __hip_atomic_fetch_add(head, 1u, RLX_AGENT);
        __syncthreads();
        const unsigned it = F.MISC[16];
        if (it >= (unsigned)(4 * CH)) break;
        hy_fft_item(F, l, (int)it);
    }
    __syncthreads();
}

__device__ __forceinline__ void p_post(Frame& F, int l) {
    PHASE_TID();
    const int gw = bid * NWAVES + wave, NGW = F.G * NWAVES;
    bf16* YM = (bf16*)(F.ws + WS_YMIX);
    { LAS float* scr = (LAS float*)(F.lds + wave * 16640);
      const bf16* PHT = (const bf16*)(F.ws + WS_PHT); const float* ng = F.in[I_HNG] + (size_t)l * CH;
      for (int it = gw; it < NB * 8 * (T / 64); it += NGW) { const int tb = it & 127, g = (it >> 7) & 7, b = it >> 10, t0 = tb * 64;
          const bf16* src = PHT + ((size_t)b * HYP + CH + g * 64 + lane) * T + t0;
#pragma unroll
          for (int q = 0; q < 8; ++q) { const v4u w = *(const v4u*)(src + 8 * q); LAS float* d = scr + lane * 65 + 8 * q;
              d[0] = bflo(w.x); d[1] = bfhi(w.x); d[2] = bflo(w.y); d[3] = bfhi(w.y); d[4] = bflo(w.z); d[5] = bfhi(w.z); d[6] = bflo(w.w); d[7] = bfhi(w.w); }
          LDS_WAIT(); asm volatile("" ::: "memory");
          float z[64], ss = 0.f;
#pragma unroll
          for (int cc = 0; cc < 64; ++cc) { z[cc] = scr[cc * 65 + lane]; ss += z[cc] * z[cc]; }
          const float rs = 1.0f / sqrtf(ss * (1.0f / 64.0f) + RMS_EPS);
          bf16* dst = YM + ((size_t)b * T + t0 + lane) * D + g * 64;
#pragma unroll
          for (int q = 0; q < 8; ++q) { v4u o; const float* gq = ng + g * 64 + 8 * q;
              o.x = pk2(z[8 * q] * rs * gq[0], z[8 * q + 1] * rs * gq[1]); o.y = pk2(z[8 * q + 2] * rs * gq[2], z[8 * q + 3] * rs * gq[3]);
              o.z = pk2(z[8 * q + 4] * rs * gq[4], z[8 * q + 5] * rs * gq[5]); o.w = pk2(z[8 * q + 6] * rs * gq[6], z[8 * q + 7] * rs * gq[7]);
              *(v4u*)(dst + 8 * q) = o; }
          LDS_WAIT(); asm volatile("" ::: "memory"); } }
}

struct PostRows { v4u a, c, v, g; float bs; };
__device__ __forceinline__ void post_rows_load(PostRows& R, const bf16* YS0, const bf16* YS1, const bf16* VV, const bf16* GG, const float* BS0, const float* BS1, size_t m, int h, int ec) {
    const size_t o = m * CH + h * HD + ec;
    R.a = *(const v4u*)(YS0 + o); R.c = *(const v4u*)(YS1 + o); R.v = *(const v4u*)(VV + o); R.g = *(const v4u*)(GG + o); R.bs = BS0[m * NH + h] + BS1[m * NH + h];
}
__device__ __forceinline__ void p_postfix(Frame& F, int l) {
    PHASE_TID(); const int fr = lane & 15, fq = lane >> 4, mtw = wave >> 1, ntw = 2 * (wave & 1), et = tid >> 3, ec = (tid & 7) * 8;
    const int bh = bid >> 2, b = bh >> 3, h = bh & 7, tq = bid & 3, dfix = (tq >= 2) ? 0 : 1, chain = (b * NH + h) * 2 + dfix;
    const float* SF = (const float*)(F.ws + WS_SFIN) + (size_t)chain * 4096;
    bf16x8 sfb[2][2];
#pragma unroll
    for (int ks = 0; ks < 2; ++ks)
#pragma unroll
        for (int j = 0; j < 2; ++j) { const float* sp = SF + (16 * (ntw + j) + fr) * 64 + 32 * ks + 8 * fq; const f32x4 s0 = *(const f32x4*)sp, s1 = *(const f32x4*)(sp + 4);
            const float sv[8] = {s0[0], s0[1], s0[2], s0[3], s1[0], s1[1], s1[2], s1[3]}; sfb[ks][j] = __builtin_bit_cast(bf16x8, pack8(sv)); }
    const bf16* YP = (const bf16*)(F.ws + WS_YPHI) + ((size_t)chain * (T / 2) + 16 * mtw + fr) * 64 + 8 * fq;
    const bf16* YS0 = (const bf16*)(F.ws + WS_YS); const bf16* YS1 = YS0 + (size_t)M * CH;
    const bf16* VV = (l == 0) ? (const bf16*)(F.ws + WS_VFIRST) : (const bf16*)(F.ws + WS_V2);
    const bf16* GG = (const bf16*)(F.ws + WS_G); const float* BS0 = (const float*)(F.ws + WS_BS); const float* BS1 = BS0 + (size_t)M * NH;
    bf16* YM = (bf16*)(F.ws + WS_YMIX);
    float lg[8], lb[8];
#pragma unroll
    for (int j = 0; j < 8; ++j) { lg[j] = F.in[I_LNG][l * CH + h * HD + ec + j]; lb[j] = F.in[I_LNB][l * CH + h * HD + ec + j]; }
    LAS float* FX = (LAS float*)F.lds;
    const size_t mb = (size_t)b * T + 64 * (32 * tq) + et;
    __syncthreads();
    PostRows cur; bf16x8 acur[2];
    post_rows_load(cur, YS0, YS1, VV, GG, BS0, BS1, mb, h, ec);
#pragma unroll
    for (int ks = 0; ks < 2; ++ks) acur[ks] = *(const bf16x8*)(YP + (size_t)((32 * tq) & 63) * 64 * 64 + 32 * ks);
#pragma unroll 1
    for (int t = 0; t < 32; ++t) {
        PostRows nxt; bf16x8 anxt[2]; const int tn = (t + 1 < 32) ? t + 1 : t;
        post_rows_load(nxt, YS0, YS1, VV, GG, BS0, BS1, mb + 64 * tn, h, ec);
#pragma unroll
        for (int ks = 0; ks < 2; ++ks) anxt[ks] = *(const bf16x8*)(YP + (size_t)((32 * tq + tn) & 63) * 64 * 64 + 32 * ks);
        { f32x4 acc[2] = {(f32x4){0.f, 0.f, 0.f, 0.f}, (f32x4){0.f, 0.f, 0.f, 0.f}};
#pragma unroll
          for (int ks = 0; ks < 2; ++ks)
#pragma unroll
              for (int j = 0; j < 2; ++j) acc[j] = MFMA16(sfb[ks][j], acur[ks], acc[j]);
          LAS float* fx = FX + (t & 1) * 64 * 68 + (16 * mtw + fr) * 68 + 16 * ntw + 4 * fq;
          *(LAS f32x4*)fx = acc[0]; *(LAS f32x4*)(fx + 16) = acc[1]; }
        __syncthreads();
        { const LAS float* fx = FX + (t & 1) * 64 * 68 + et * 68 + ec; const f32x4 f0 = *(const LAS f32x4*)fx, f1 = *(const LAS f32x4*)(fx + 4);
          const float fv[8] = {f0[0], f0[1], f0[2], f0[3], f1[0], f1[1], f1[2], f1[3]};
          const unsigned aw[4] = {cur.a.x, cur.a.y, cur.a.z, cur.a.w}, cw[4] = {cur.c.x, cur.c.y, cur.c.z, cur.c.w}, vx[4] = {cur.v.x, cur.v.y, cur.v.z, cur.v.w}, gx[4] = {cur.g.x, cur.g.y, cur.g.z, cur.g.w};
          float sv[8], sum = 0.f;
#pragma unroll
          for (int j = 0; j < 4; ++j) { sv[2 * j] = bflo(aw[j]) + bflo(cw[j]) + fv[2 * j]; sv[2 * j + 1] = bfhi(aw[j]) + bfhi(cw[j]) + fv[2 * j + 1]; sum += sv[2 * j] + sv[2 * j + 1]; }
          const float mean = sum8(sum) * (1.0f / 64.0f); float q = 0.f;
#pragma unroll
          for (int j = 0; j < 8; ++j) { sv[j] -= mean; q += sv[j] * sv[j]; }
          const float rs = 1.0f / sqrtf(sum8(q) * (1.0f / 64.0f) + GN_EPS);
          float y[8];
#pragma unroll
          for (int j = 0; j < 4; ++j) { y[2 * j] = (sv[2 * j] * rs * lg[2 * j] + lb[2 * j] + cur.bs * bflo(vx[j])) * bflo(gx[j]);
                                        y[2 * j + 1] = (sv[2 * j + 1] * rs * lg[2 * j + 1] + lb[2 * j + 1] + cur.bs * bfhi(vx[j])) * bfhi(gx[j]); }
          v4u ov; ov.x = pk2(y[0], y[1]); ov.y = pk2(y[2], y[3]); ov.z = pk2(y[4], y[5]); ov.w = pk2(y[6], y[7]);
          *(v4u*)(YM + (mb + 64 * t) * D + CH + h * HD + ec) = ov; }
        cur = nxt; acur[0] = anxt[0]; acur[1] = anxt[1];
    }
    __syncthreads();
}
__device__ __forceinline__ int obid() { int b = blockIdx.x; asm volatile("" : "+s"(b)); return b; }
struct Args { const float* in[34]; float* out; unsigned char* ws; int ph_lo, ph_hi; };
__global__ void __launch_bounds__(NTHR, 2) enc_fwd(Args args) {
    extern __shared__ __attribute__((aligned(16))) unsigned char lds[];
    Frame F;
    F.lds = (LAS unsigned char*)lds;
    F.MISC = (volatile LAS unsigned*)(F.lds + LDSCTL_OFF);
    F.G = gridDim.x;
    F.ws = args.ws; F.out = args.out; F.ctl = (unsigned*)(args.ws + WS_CTL);
    F.in = args.in;
    for (int u = threadIdx.x; u < (LDS_BYTES - LDSCTL_OFF) / 4; u += NTHR) F.MISC[u] = 0u;
    __syncthreads();
    const XcdBarrier bar = xcd_barrier_post(F.ctl + CW_BAR, F.MISC + 8);
#define SEAM() xcd_barrier(bar)

    bf16* HN = (bf16*)(F.ws + WS_HN);
    float* RSS = (float*)(F.ws + WS_RSS);
    unsigned char* HQ = F.ws + WS_HN; float* RSC = (float*)(F.ws + WS_RSC);
    p_convert(F); __syncthreads(); p_filter(F, 0); p_rmsnorm_q<true>(F, F.in[I_X], F.in[I_N1G], HQ, RSC, 0, M / 2);
    SEAM();
    p_wquant(F);
    SEAM();
#pragma unroll 1
    for (int l = 0; l < NL; ++l) {
        unsigned char* wb = F.ws + WS_W + (size_t)l * W_LAYER;
        bf16* X2B = (bf16*)F.out;
        {
#pragma unroll 1
            for (int hf = 0; hf < 2; ++hf) { constexpr int MH = M / 2; const size_t r0 = (size_t)hf * MH;
                if (hf == 0) p_spectra(F);
                const float* CSC = (const float*)(F.ws + WS_CSC) + l * (HYP + NRW);
                { pg8::Gemm g{(const bf16*)(wb + W_HY), (const bf16*)(HQ + r0 * D), HYP, MH, D / 2}; pg8::StaticOrder S; S.init(HYP, MH, F.G, obid());
                  pg8::EpiBf16Q E{(bf16*)(F.ws + WS_PHT) + (size_t)(4 * hf) * HYP * T, (size_t)T, (size_t)HYP * T, 13, CSC, RSC + r0};
                  pg8::gemm_phase<pg8::EpiBf16Q, pg8::StaticOrder, true, true>(F.lds, g, S, E); }
                { pg8::Gemm g{(const bf16*)(HQ + r0 * D), (const bf16*)(wb + W_RW), MH, NRW, D / 2}; pg8::StaticOrder S; S.init(MH, NRW, F.G, obid());
                  pg8::EpiBf16Q E{(bf16*)(F.ws + WS_PRW) + r0 * NRW, (size_t)NRW, 0, 31, RSC + r0, CSC + HYP};
                  pg8::gemm_phase<pg8::EpiBf16Q, pg8::StaticOrder, true, true>(F.lds, g, S, E); }
                if (hf == 0) { if (l == 0) p_rmsnorm_q<true>(F, F.in[I_X], F.in[I_N1G], HQ, RSC, MH, M); else p_rmsnorm_q<false>(F, X2B, F.in[I_N1G] + (size_t)l * D, HQ, RSC, MH, M);
                    SEAM(); } }
        }
        SEAM();
        p_mix(F, l);
        SEAM();
        { p_post(F, l); p_postfix(F, l); }
        SEAM();
        {
            if (l + 1 < NL) p_filter(F, l + 1);
            pg8::Gemm g{(const bf16*)(F.ws + WS_YMIX), (const bf16*)(wb + W_O), M, D, D}; pg8::StaticOrder S; S.init(M, D, F.G, obid());
            if (l == 0) { pg8::EpiRes<1, false> E{F.in[I_X], nullptr, HN, D, RSS}; pg8::gemm_phase<pg8::EpiRes<1, false>, pg8::StaticOrder, true, true>(F.lds, g, S, E); }
            else { pg8::EpiRes<1, true> E{nullptr, X2B, HN, D, RSS}; pg8::gemm_phase<pg8::EpiRes<1, true>, pg8::StaticOrder, true, true>(F.lds, g, S, E); }
        }
        SEAM();
#pragma unroll 1
        for (int ck = 0; ck < MLP_CHUNKS; ++ck) { constexpr int MC = M / MLP_CHUNKS; const size_t r0 = (size_t)ck * MC;
            bf16* HIDc = (bf16*)(F.ws + WS_HID + (size_t)(ck & 1) * MC * FF * 2);
            {
                pg8::Gemm g{HN + r0 * D, (const bf16*)(wb + W_1), MC, FF, D}; pg8::StaticOrder S; S.init(MC, FF, F.G, obid());
                pg8::EpiBf16<1> E{HIDc, (size_t)FF};
                pg8::gemm_phase<pg8::EpiBf16<1>, pg8::StaticOrder, true, true>(F.lds, g, S, E);
            }
            SEAM();
            {
                pg8::Gemm g{HIDc, (const bf16*)(wb + W_2), MC, D, FF}; pg8::StaticOrder S; S.init(MC, D, F.G, obid());
                pg8::EpiRes<2, true> E{nullptr, HN + r0 * D, ((l + 1 < NL) ? X2B : HN) + r0 * D, D, RSS + r0 * 16};
                pg8::gemm_phase<pg8::EpiRes<2, true>, pg8::StaticOrder, true, true>(F.lds, g, S, E);
            }
            if (ck == MLP_CHUNKS - 1 && l + 1 < NL) p_rmsnorm_q<false>(F, X2B, F.in[I_N1G] + (size_t)(l + 1) * D, HQ, RSC, 0, M / 2);
        }
        SEAM();
        if (l + 1 == NL) p_finalnorm(F, HN, F.in[I_FING], F.out);
    }
#undef SEAM
}

extern "C" void kernel_launch(void* const* d_in, const int* in_sizes, int n_in, void* d_out, int out_size, void* d_ws, size_t ws_size, hipStream_t stream) {
    static int grid = 0;
    if (grid == 0) {
        if (n_in != 34 || in_sizes[0] != M * D || out_size != M * D || ws_size < WS_END) {
            fprintf(stderr, "kernel_launch: unexpected problem: n_in %d in0 %d out %d ws %zu (need %zu); nothing launched\n", n_in, n_in > 0 ? in_sizes[0] : -1, out_size, ws_size, (size_t)WS_END); grid = -1; return; }
        int dev = 0, cus = 0, per_cu = 0;
        if (hipGetDevice(&dev) != hipSuccess || hipDeviceGetAttribute(&cus, hipDeviceAttributeMultiprocessorCount, dev) != hipSuccess) { grid = -1; return; }
        if (hipFuncSetAttribute((const void*)enc_fwd, hipFuncAttributeMaxDynamicSharedMemorySize, LDS_BYTES) != hipSuccess) { fprintf(stderr, "kernel_launch: hipFuncSetAttribute failed\n"); grid = -1; return; }
        if (hipOccupancyMaxActiveBlocksPerMultiprocessor(&per_cu, (const void*)enc_fwd, NTHR, LDS_BYTES) != hipSuccess || per_cu < 1)
            fprintf(stderr, "kernel_launch: note: occupancy query reports %d workgroups per CU\n", per_cu);
        (void)hipGetLastError();
        grid = cus;
        if (grid != 256) { fprintf(stderr, "kernel_launch: built for a 256-CU device (got %d); nothing launched\n", cus); grid = -1; return; }
    }
    if (grid < 0) return;
    if (hipMemsetAsync((char*)d_ws + WS_CTL, 0, CTL_ZERO_BYTES, stream) != hipSuccess) return;
    Args a{};
    for (int i = 0; i < 34; ++i) a.in[i] = (const float*)d_in[i];
    a.out = (float*)d_out; a.ws = (unsigned char*)d_ws;
    a.ph_lo = 0; a.ph_hi = 0;
    hipLaunchKernelGGL(enc_fwd, dim3(grid), dim3(NTHR), LDS_BYTES, stream, a);
}
```

```cpp
#include <hip/hip_runtime.h>
#include <cstdio>
#include <cstdint>
namespace pg8 {
#define PG8_LAS __attribute__((address_space(3)))
typedef unsigned short bf16_t;
typedef short bf16x8 __attribute__((ext_vector_type(8)));
typedef float f32x4 __attribute__((ext_vector_type(4)));
typedef int i32x4 __attribute__((ext_vector_type(4)));
template <bool I8> struct AccT { typedef f32x4 t; };
template <> struct AccT<true> { typedef i32x4 t; };
typedef unsigned u32x4 __attribute__((ext_vector_type(4)));
constexpr int BM = 256, BK = 64, HALF = 128, HTB = HALF * BK * 2  , STAGE_BYTES = 8 * HTB, NXCD = 8, WGM = 8;

__host__ __device__ __forceinline__ int lds_byte(int r, int c) { const int st = (r >> 4) * 2 + (c >> 5), rr = r & 15, cc = c & 31, ob = rr * 64 + cc * 2; return st * 1024 + (ob ^ (((ob >> 9) & 1) << 5)); }
__host__ __device__ __forceinline__ void stage_rc(int b, int& R, int& C) { const int st = b / 1024, sb = b % 1024, swz = sb ^ (((sb >> 9) & 1) << 5); R = (st >> 1) * 16 + swz / 64; C = (st & 1) * 32 + (swz % 64) / 2; }
__host__ __device__ __forceinline__ int perm32(int rho) { const int n = rho >> 4, i = rho & 15; return 8 * (i >> 2) + 4 * n + (i & 3); }

struct Unit { int pm, pn; };
struct Gemm { const bf16_t* A; const bf16_t* Bt; int M, N, K; };

struct StaticOrder {
    int nM, nN, nwg, G, c;
    __host__ __device__ void init(int M, int N, int G_, int c_) { nM = M / BM; nN = N / BM; nwg = nM * nN; G = G_; c = c_; }
    __host__ __device__ bool next(int i, Unit& u) const {
        const long L = (long)i * G + c; if (L >= nwg) return false;
        int wgid = (int)L; { const int q = nwg / NXCD, r = nwg % NXCD, xcd = wgid % NXCD, off = wgid / NXCD; wgid = (xcd < r ? xcd * (q + 1) : r * (q + 1) + (xcd - r) * q) + off; }
        const int nig = WGM * nN, gid = wgid / nig, fm = gid * WGM, gsz = (nM - fm) < WGM ? (nM - fm) : WGM;
        u.pm = fm + ((wgid % nig) % gsz); u.pn = (wgid % nig) / gsz; return true;
    }
    __device__ __forceinline__ void a_ready(const Unit&) const {}
    __device__ __forceinline__ void done(const Unit&) const {}
};
typedef float f32x2e __attribute__((ext_vector_type(2))); typedef __bf16 bf16x2e __attribute__((ext_vector_type(2)));
__device__ __forceinline__ unsigned cvt_pk_bf16(float lo, float hi) { return __builtin_bit_cast(unsigned, __builtin_convertvector((f32x2e){lo, hi}, bf16x2e)); }
template <int ACT> struct EpiBf16 {
    static constexpr bool PERM = true, AFTER_DRAIN = false, I8 = false;
    bf16_t* O; size_t ldc; size_t bstride = 0; int tshift = 31;
    __device__ __forceinline__ void operator()(const f32x4 (&acc)[2][2][4][2], const Unit& u, int wr, int wc, int fr, int fq) const {
        const int row0 = u.pm * BM + wr * 64 + fr; const int cb = u.pn * BM; const size_t col0 = (size_t)(cb >> tshift) * bstride + (size_t)(cb & ((1 << tshift) - 1)) + wc * 32 + 8 * fq;
#pragma unroll
        for (int ai = 0; ai < 2; ++ai)
#pragma unroll
            for (int m = 0; m < 4; ++m) { bf16_t* rowp = O + (size_t)(row0 + ai * HALF + m * 16) * ldc + col0;
#pragma unroll
                for (int bj = 0; bj < 2; ++bj) { f32x4 v0 = acc[ai][bj][m][0], v1 = acc[ai][bj][m][1];
                    if (ACT == 1) {
#pragma unroll
                        for (int j = 0; j < 4; ++j) { const float a = fmaxf(v0[j], 0.f), b = fmaxf(v1[j], 0.f); v0[j] = a * a; v1[j] = b * b; } }
                    u32x4 w; w.x = cvt_pk_bf16(v0[0], v0[1]); w.y = cvt_pk_bf16(v0[2], v0[3]); w.z = cvt_pk_bf16(v1[0], v1[1]); w.w = cvt_pk_bf16(v1[2], v1[3]);
                    *(u32x4*)(rowp + bj * HALF) = w;
                    } }
    }
};
struct EpiBf16Q {
    static constexpr bool PERM = true, AFTER_DRAIN = false, I8 = true;
    bf16_t* O; size_t ldc; size_t bstride; int tshift; const float* rs; const float* cs;
    __device__ __forceinline__ void operator()(const i32x4 (&acc)[2][2][4][2], const Unit& u, int wr, int wc, int fr, int fq) const {
        const int row0 = u.pm * BM + wr * 64 + fr; const int cb = u.pn * BM, ci0 = cb + wc * 32 + 8 * fq;
        const size_t col0 = (size_t)(cb >> tshift) * bstride + (size_t)(cb & ((1 << tshift) - 1)) + wc * 32 + 8 * fq;
        f32x4 cv[2][2];
#pragma unroll
        for (int bj = 0; bj < 2; ++bj) { cv[bj][0] = *(const f32x4*)(cs + ci0 + bj * HALF); cv[bj][1] = *(const f32x4*)(cs + ci0 + bj * HALF + 4); }
#pragma unroll
        for (int ai = 0; ai < 2; ++ai)
#pragma unroll
            for (int m = 0; m < 4; ++m) { const int row = row0 + ai * HALF + m * 16; bf16_t* rowp = O + (size_t)row * ldc + col0; const float r = rs[row];
#pragma unroll
                for (int bj = 0; bj < 2; ++bj) { const i32x4 a0 = acc[ai][bj][m][0], a1 = acc[ai][bj][m][1];
                    const f32x4 v0 = (f32x4){(float)a0[0], (float)a0[1], (float)a0[2], (float)a0[3]} * r * cv[bj][0], v1 = (f32x4){(float)a1[0], (float)a1[1], (float)a1[2], (float)a1[3]} * r * cv[bj][1];
                    u32x4 w; w.x = cvt_pk_bf16(v0[0], v0[1]); w.y = cvt_pk_bf16(v0[2], v0[3]); w.z = cvt_pk_bf16(v1[0], v1[1]); w.w = cvt_pk_bf16(v1[2], v1[3]);
                    *(u32x4*)(rowp + bj * HALF) = w; } }
    }
};
__device__ __forceinline__ float rss16(const float* p) { const f32x4 a = *(const f32x4*)p, b = *(const f32x4*)(p + 4), c = *(const f32x4*)(p + 8), d = *(const f32x4*)(p + 12);
    return (((a[0] + a[1]) + (a[2] + a[3])) + ((b[0] + b[1]) + (b[2] + b[3]))) + (((c[0] + c[1]) + (c[2] + c[3])) + ((d[0] + d[1]) + (d[2] + d[3]))); }
template <int MODE, bool RB16> struct EpiRes {
    static constexpr bool PERM = true, AFTER_DRAIN = false, I8 = false;
    const float* R; const bf16_t* RB; bf16_t* O; int ldc; float* rss;
    __device__ __forceinline__ void operator()(const f32x4 (&acc)[2][2][4][2], const Unit& u, int wr, int wc, int fr, int fq) const {
        const int row0 = u.pm * BM + wr * 64 + fr, col0 = u.pn * BM + wc * 32 + 8 * fq;
#pragma unroll
        for (int ai = 0; ai < 2; ++ai)
#pragma unroll
            for (int m = 0; m < 4; ++m) { const int row = row0 + ai * HALF + m * 16; const size_t off = (size_t)row * ldc + col0;
                f32x4 rv[2][2]; float ss = 0.f, sc = 1.0f;
                if (MODE == 2) sc = __builtin_amdgcn_rcpf(rss16(rss + (size_t)row * 16) * (1.0f / 1024.0f) + 1e-5f);
#pragma unroll
                for (int bj = 0; bj < 2; ++bj) {
                    if (RB16) { const u32x4 w = *(const u32x4*)(RB + off + bj * HALF);
                        rv[bj][0] = (f32x4){__builtin_bit_cast(float, w.x << 16), __builtin_bit_cast(float, w.x & 0xffff0000u), __builtin_bit_cast(float, w.y << 16), __builtin_bit_cast(float, w.y & 0xffff0000u)};
                        rv[bj][1] = (f32x4){__builtin_bit_cast(float, w.z << 16), __builtin_bit_cast(float, w.z & 0xffff0000u), __builtin_bit_cast(float, w.w << 16), __builtin_bit_cast(float, w.w & 0xffff0000u)}; }
                    else { rv[bj][0] = *(const f32x4*)(R + off + bj * HALF); rv[bj][1] = *(const f32x4*)(R + off + bj * HALF + 4); } }
#pragma unroll
                for (int bj = 0; bj < 2; ++bj) { f32x4 o0 = acc[ai][bj][m][0], o1 = acc[ai][bj][m][1];
                    if (MODE == 2) { o0 = o0 * sc; o1 = o1 * sc; }
                    o0 = o0 + rv[bj][0]; o1 = o1 + rv[bj][1];
                    if (MODE == 1) ss += ((o0[0] * o0[0] + o0[1] * o0[1]) + (o0[2] * o0[2] + o0[3] * o0[3])) + ((o1[0] * o1[0] + o1[1] * o1[1]) + (o1[2] * o1[2] + o1[3] * o1[3]));
                    u32x4 w; w.x = cvt_pk_bf16(o0[0], o0[1]); w.y = cvt_pk_bf16(o0[2], o0[3]); w.z = cvt_pk_bf16(o1[0], o1[1]); w.w = cvt_pk_bf16(o1[2], o1[3]);
                    *(u32x4*)(O + off + bj * HALF) = w; }
                if (MODE == 1) { ss += __shfl_xor(ss, 16); ss += __shfl_xor(ss, 32); if (fq == 0) rss[(size_t)row * 16 + u.pn * 4 + wc] = ss; }
                asm volatile("" ::: "memory"); }
    }
};

template <bool I8> __device__ __forceinline__ typename AccT<I8>::t pg8_mma16(const bf16x8& a, const bf16x8& b, const typename AccT<I8>::t& c) {
    if constexpr (I8) return __builtin_amdgcn_mfma_i32_16x16x64_i8(__builtin_bit_cast(i32x4, a), __builtin_bit_cast(i32x4, b), c, 0, 0, 0);
    else return __builtin_amdgcn_mfma_f32_16x16x32_bf16(a, b, c, 0, 0, 0);
}
template <class Epi, class Sched, bool ALIGN_EPI = false, bool SP2 = false>
__device__ __forceinline__ void gemm_phase(PG8_LAS unsigned char* lds, const Gemm g, const Sched& S, const Epi& E) {
    int tid = threadIdx.x; asm volatile("" : "+v"(tid));
    const int wid = __builtin_amdgcn_readfirstlane(tid >> 6), lane = tid & 63, wr = wid >> 2, wc = wid & 3, fr = lane & 15, fq = lane >> 4;
    const int K = g.K, nt = K / BK;
    unsigned voffA[2], voffB[2];
#pragma unroll
    for (int i = 0; i < 2; ++i) { int R, C; stage_rc(tid * 16 + i * 8192, R, C); const int Rb = Epi::PERM ? ((R & ~31) + perm32(R & 31)) : R;
        voffA[i] = (unsigned)(R * K + C) * 2u; voffB[i] = (unsigned)(Rb * K + C) * 2u; }
    const size_t kstep = (size_t)(BK * 2);
    const size_t hstep = (size_t)HALF * K * 2;
    const size_t tstep = 2 * hstep;
    const unsigned ldsw = (unsigned)wid * 1024u;
    const int aoff = lds_byte(wr * 64 + fr, fq * 8), boff = lds_byte(wc * 32 + fr, fq * 8);
#define PG8_SA(b, h) (((b) * 2 + (h)) * HTB)
#define PG8_SB(b, h) ((4 + (b) * 2 + (h)) * HTB)
#define PG8_STAGE(bufoff, gbase, voff) do { _Pragma("unroll") for (int _i = 0; _i < 2; ++_i) \
        __builtin_amdgcn_global_load_lds((const unsigned*)((const char*)(gbase) + (voff)[_i]), (PG8_LAS unsigned*)(lds + (bufoff) + ldsw + _i * 8192), 16, 0, 0); } while (0)
#define PG8_LDA(dst, b, h) do { _Pragma("unroll") for (int m = 0; m < 4; ++m) _Pragma("unroll") for (int k = 0; k < 2; ++k) dst[m][k] = *(const PG8_LAS bf16x8*)(lds + PG8_SA(b, h) + aoff + m * 2048 + k * 1024); } while (0)
#define PG8_LDB(dst, b, h) do { _Pragma("unroll") for (int n = 0; n < 2; ++n) _Pragma("unroll") for (int k = 0; k < 2; ++k) dst[n][k] = *(const PG8_LAS bf16x8*)(lds + PG8_SB(b, h) + boff + n * 2048 + k * 1024); } while (0)
#define PG8_MMA(ai, bj, At, Bt) do { __builtin_amdgcn_s_setprio(1); _Pragma("unroll") for (int m = 0; m < 4; ++m) _Pragma("unroll") for (int n = 0; n < 2; ++n) _Pragma("unroll") for (int k = 0; k < 2; ++k) \
        acc[ai][bj][m][n] = pg8_mma16<Epi::I8>(Bt[n][k], At[m][k], acc[ai][bj][m][n]); __builtin_amdgcn_s_setprio(0); } while (0)
#define PG8_WAIT_V(n) asm volatile("s_waitcnt vmcnt(" #n ")" ::: "memory")
#define PG8_WAIT_L(n) asm volatile("s_waitcnt lgkmcnt(" #n ")" ::: "memory")
#define PG8_BAR __builtin_amdgcn_s_barrier()
#define PG8_SCHED __builtin_amdgcn_sched_barrier(0)
    Unit cur, nxt; int ui = 0;
    if (!S.next(0, cur)) return;
    typedef typename AccT<Epi::I8>::t acc_t;
    acc_t acc[2][2][4][2];
#pragma unroll
    for (int a = 0; a < 2; ++a)
#pragma unroll
        for (int b = 0; b < 2; ++b)
#pragma unroll
            for (int m = 0; m < 4; ++m)
#pragma unroll
                for (int n = 0; n < 2; ++n) acc[a][b][m][n] = (acc_t){0, 0, 0, 0};
    bf16x8 At[4][2], B0[2][2], B1[2][2];
    const char* cA = (const char*)g.A + (size_t)cur.pm * tstep; const char* cB = (const char*)g.Bt + (size_t)cur.pn * tstep;
    S.a_ready(cur);
    if constexpr (SP2) {
        PG8_STAGE(PG8_SB(0, 0), cB, voffB); PG8_STAGE(PG8_SB(0, 1), cB + hstep, voffB); PG8_STAGE(PG8_SA(0, 0), cA, voffA); PG8_STAGE(PG8_SA(0, 1), cA + hstep, voffA);
        if (wr == 1) PG8_BAR;
        PG8_WAIT_V(2); PG8_BAR;
        PG8_STAGE(PG8_SB(1, 0), cB + kstep, voffB); PG8_STAGE(PG8_SA(1, 0), cA + kstep, voffA); PG8_STAGE(PG8_SB(1, 1), cB + hstep + kstep, voffB);
        PG8_WAIT_V(6); PG8_BAR;
    } else {
        PG8_STAGE(PG8_SB(0, 0), cB, voffB); PG8_STAGE(PG8_SA(0, 0), cA, voffA); PG8_STAGE(PG8_SB(0, 1), cB + hstep, voffB); PG8_STAGE(PG8_SA(0, 1), cA + hstep, voffA);
        if (wr == 1) PG8_BAR;
        PG8_WAIT_V(4); PG8_BAR;
        PG8_STAGE(PG8_SB(1, 0), cB + kstep, voffB); PG8_STAGE(PG8_SA(1, 0), cA + kstep, voffA); PG8_STAGE(PG8_SB(1, 1), cB + hstep + kstep, voffB);
        PG8_WAIT_V(6); PG8_BAR;
    }
    for (;;) {
        const bool has_next = S.next(ui + 1, nxt);
        const char* nA = has_next ? (const char*)g.A + (size_t)nxt.pm * tstep : cA; const char* nB = has_next ? (const char*)g.Bt + (size_t)nxt.pn * tstep : cB;
        for (int t = 0; t < nt; t += 2) {
            const bool last = (t == nt - 2);
            const char* a1 = cA + (size_t)(t + 1) * kstep;
            const char* a2 = last ? nA : cA + (size_t)(t + 2) * kstep; const char* b2 = last ? nB : cB + (size_t)(t + 2) * kstep;
            const char* a3 = a2 + kstep; const char* b3 = b2 + kstep;
            if (last && has_next) S.a_ready(nxt);
            if constexpr (SP2) {
            PG8_LDB(B0, 0, 0); PG8_LDB(B1, 0, 1); PG8_SCHED; PG8_LDA(At, 0, 0); PG8_STAGE(PG8_SA(1, 1), a1 + hstep, voffA);
            PG8_WAIT_V(8); PG8_WAIT_L(0); PG8_BAR; PG8_MMA(0, 0, At, B0); PG8_MMA(0, 1, At, B1); PG8_BAR; PG8_SCHED;
            PG8_LDA(At, 0, 1); PG8_STAGE(PG8_SB(0, 0), b2, voffB); PG8_STAGE(PG8_SB(0, 1), b2 + hstep, voffB); PG8_STAGE(PG8_SA(0, 0), a2, voffA);
            PG8_WAIT_V(8); PG8_WAIT_L(0); PG8_BAR; PG8_MMA(1, 0, At, B0); PG8_MMA(1, 1, At, B1); PG8_BAR; PG8_SCHED;
            PG8_LDB(B0, 1, 0); PG8_LDB(B1, 1, 1); PG8_SCHED; PG8_LDA(At, 1, 0); PG8_STAGE(PG8_SA(0, 1), a2 + hstep, voffA);
            PG8_WAIT_V(8); PG8_WAIT_L(0); PG8_BAR; PG8_MMA(0, 0, At, B0); PG8_MMA(0, 1, At, B1); PG8_BAR; PG8_SCHED;
            PG8_LDA(At, 1, 1); PG8_STAGE(PG8_SB(1, 0), b3, voffB); PG8_STAGE(PG8_SB(1, 1), b3 + hstep, voffB); PG8_STAGE(PG8_SA(1, 0), a3, voffA);
            PG8_WAIT_V(8); PG8_WAIT_L(0); PG8_BAR; PG8_MMA(1, 0, At, B0); PG8_MMA(1, 1, At, B1); PG8_BAR; PG8_SCHED;
            } else {
            PG8_LDB(B0, 0, 0); PG8_SCHED; PG8_LDA(At, 0, 0); PG8_STAGE(PG8_SA(1, 1), a1 + hstep, voffA);
            PG8_WAIT_L(8); PG8_BAR; PG8_WAIT_L(0); PG8_MMA(0, 0, At, B0); PG8_BAR; PG8_SCHED;
            PG8_LDB(B1, 0, 1); PG8_STAGE(PG8_SB(0, 0), b2, voffB);
            PG8_BAR; PG8_WAIT_L(0); PG8_MMA(0, 1, At, B1); PG8_BAR;
            PG8_LDA(At, 0, 1); PG8_STAGE(PG8_SA(0, 0), a2, voffA);
            PG8_BAR; PG8_WAIT_L(0); PG8_MMA(1, 0, At, B0); PG8_BAR; PG8_SCHED;
            PG8_STAGE(PG8_SB(0, 1), b2 + hstep, voffB);
            PG8_WAIT_V(6); PG8_BAR; PG8_MMA(1, 1, At, B1); PG8_BAR;
            PG8_LDB(B0, 1, 0); PG8_SCHED; PG8_LDA(At, 1, 0); PG8_STAGE(PG8_SA(0, 1), a2 + hstep, voffA);
            PG8_WAIT_L(8); PG8_BAR; PG8_WAIT_L(0); PG8_MMA(0, 0, At, B0); PG8_BAR; PG8_SCHED;
            PG8_LDB(B1, 1, 1); PG8_STAGE(PG8_SB(1, 0), b3, voffB);
            PG8_BAR; PG8_WAIT_L(0); PG8_MMA(0, 1, At, B1); PG8_BAR;
            PG8_LDA(At, 1, 1); PG8_STAGE(PG8_SA(1, 0), a3, voffA);
            PG8_BAR; PG8_WAIT_L(0); PG8_MMA(1, 0, At, B0); PG8_BAR; PG8_SCHED;
            PG8_STAGE(PG8_SB(1, 1), b3 + hstep, voffB);
            PG8_WAIT_V(6); PG8_BAR; PG8_MMA(1, 1, At, B1); PG8_BAR;
            }
        }
        if constexpr (ALIGN_EPI) { if (wr == 0) PG8_BAR; }
        if constexpr (!Epi::AFTER_DRAIN) { E(acc, cur, wr, wc, fr, fq); S.done(cur); }
        if (!has_next) break;
#pragma unroll
        for (int a = 0; a < 2; ++a)
#pragma unroll
            for (int b = 0; b < 2; ++b)
#pragma unroll
                for (int m = 0; m < 4; ++m)
#pragma unroll
                    for (int n = 0; n < 2; ++n) acc[a][b][m][n] = (acc_t){0, 0, 0, 0};
        cur = nxt; cA = nA; cB = nB; ++ui;
        if constexpr (ALIGN_EPI) { if (wr == 1) PG8_BAR; }
    }
    PG8_WAIT_V(0);
    if constexpr (!ALIGN_EPI) { if (wr == 0) PG8_BAR; }
    PG8_BAR;
    if constexpr (Epi::AFTER_DRAIN) { E.fused(acc, cur, wr, wc, fr, fq, lds, wid, lane); S.done(cur); }
#undef PG8_SA
#undef PG8_SB
#undef PG8_STAGE
#undef PG8_LDA
#undef PG8_LDB
#undef PG8_MMA
#undef PG8_WAIT_V
#undef PG8_WAIT_L
#undef PG8_BAR
#undef PG8_SCHED
}
}
constexpr int NWAVES = 8, NTHR = 512;
constexpr int NB = 8, T = 8192, M = NB * T, D = 1024, CH = 512, NH = 8, HD = 64, FF = 4096, NL = 2;
constexpr int PIN = 3456, HYP = 1536, RWP = 1920, NRW = 2048;
constexpr float RMS_EPS = 1e-5f, GN_EPS = 64.0f * 1e-5f;
constexpr int MLP_CHUNKS = 4;
static_assert(MLP_CHUNKS >= 2 && M % (MLP_CHUNKS * 256) == 0, "the next layer's first-half RMSNorm is folded into the last MLP chunk: it needs a barrier between the first half's down GEMMs and that chunk");

constexpr size_t MiB = 1u << 20;
constexpr size_t WS_CTL = 0, CTL_ZERO_BYTES = 1 * MiB;
constexpr size_t WS_W = 2 * MiB;
constexpr size_t W_LAYER = 25 * MiB, W_HY = 0, W_RW = 3 * MiB, W_O = 7 * MiB, W_1 = 9 * MiB, W_2 = 17 * MiB;
constexpr size_t WS_RSC = 52 * MiB;
constexpr size_t WS_CSC = 52 * MiB + 512 * 1024;
constexpr size_t WS_FSC = 52 * MiB;
constexpr size_t WS_RSS = 53 * MiB;
constexpr size_t WS_BS = 53 * MiB;
constexpr size_t WS_FRAG = 57 * MiB;
constexpr size_t WS_SFIN = 62 * MiB;
constexpr size_t WS_YPHI = 64 * MiB;
constexpr size_t WS_HF = 64 * MiB;
constexpr size_t WS_HN = 128 * MiB;
constexpr size_t WS_G = 128 * MiB, WS_V2 = 192 * MiB;
constexpr size_t WS_VFIRST = 256 * MiB;
constexpr size_t WS_PHT = 320 * MiB;
constexpr size_t WS_PRW = 512 * MiB;
constexpr size_t WS_YS = 768 * MiB;
constexpr size_t WS_HID = 320 * MiB;
constexpr size_t WS_YMIX = 896 * MiB;
constexpr size_t WS_END = 1024 * MiB;
constexpr int CW_BAR = 4096;
constexpr int CW_CMAX = 32768;
constexpr int CW_QUEUE = 16384;

constexpr int LDS_BYTES = 163840;
constexpr int LDSCTL_OFF = LDS_BYTES - 512;

#define GAS __attribute__((address_space(1)))
#define LAS __attribute__((address_space(3)))
typedef unsigned short bf16;
typedef unsigned v4u __attribute__((ext_vector_type(4)));
typedef unsigned v2u __attribute__((ext_vector_type(2)));
typedef float f32x4 __attribute__((ext_vector_type(4)));
#define PHASE_TID() int bid = blockIdx.x; asm volatile("" : "+s"(bid)); (void)bid; int tid = threadIdx.x; asm volatile("" : "+v"(tid)); const int lane = tid & 63; const int wave = __builtin_amdgcn_readfirstlane(tid >> 6); (void)lane; (void)wave
#define RLX_AGENT __ATOMIC_RELAXED, __HIP_MEMORY_SCOPE_AGENT
#define LDS_WAIT() asm volatile("s_waitcnt lgkmcnt(0)" ::: "memory")
#define VM_WAIT() asm volatile("s_waitcnt vmcnt(0)" ::: "memory")
typedef float f32x2_ __attribute__((ext_vector_type(2)));
typedef __bf16 bf16x2_ __attribute__((ext_vector_type(2)));
__device__ __forceinline__ unsigned pk2(float lo, float hi) { return __builtin_bit_cast(unsigned, __builtin_convertvector((f32x2_){lo, hi}, bf16x2_)); }
__device__ __forceinline__ unsigned f2bf(float f) { return pk2(f, f) & 0xffffu; }
__device__ __forceinline__ float bf2f(unsigned h) { return __uint_as_float(h << 16); }
__device__ __forceinline__ float bflo(unsigned w) { return __uint_as_float(w << 16); }
__device__ __forceinline__ float bfhi(unsigned w) { return __uint_as_float(w & 0xffff0000u); }
__device__ __forceinline__ float sigmoidf_(float x) { return __builtin_amdgcn_rcpf(1.0f + __expf(-x)); }
__device__ __forceinline__ float tanhf_(float x) { return 1.0f - 2.0f * __builtin_amdgcn_rcpf(1.0f + __expf(2.0f * x)); }
template <int CTRL> __device__ __forceinline__ float dpp(float x) { return __builtin_bit_cast(float, __builtin_amdgcn_mov_dpp(__builtin_bit_cast(int, x), CTRL, 0xf, 0xf, true)); }
constexpr int XOR1 = 0xB1, XOR2 = 0x4E, XOR7 = 0x141, XOR8 = 0x128;
__device__ __forceinline__ float sin_hw(float x) { const float r = x * 0.15915494309189535f; return __builtin_amdgcn_sinf(r - floorf(r)); }
__device__ __forceinline__ float sum8(float v) { v += dpp<XOR1>(v); v += dpp<XOR2>(v); v += dpp<XOR7>(v); return v; }
__device__ __forceinline__ float sum16(float v) { v = sum8(v); v += dpp<XOR8>(v); return v; }

#define XB_TMO      128
#define XB_XCNT(j)  (256  + 64 * (j))
#define XB_XSUB(j)  (1280 + 64 * (j))
#define XB_XGEN(j)  (2304 + 64 * (j))
#define XB_TOP      3328
#define XB_TOPGEN   3392
#define XCD_BAR_WORDS 3456
#define XB_SPIN_CAP (1u << 18)

__device__ __forceinline__ unsigned xb_ld(unsigned* p)              { return __hip_atomic_load(p, __ATOMIC_RELAXED, __HIP_MEMORY_SCOPE_AGENT); }
__device__ __forceinline__ unsigned xb_add(unsigned* p, unsigned v) { return __hip_atomic_fetch_add(p, v, __ATOMIC_RELAXED, __HIP_MEMORY_SCOPE_AGENT); }
__device__ __forceinline__ unsigned xb_xcc_id() { return (unsigned)__builtin_amdgcn_s_getreg((3 << 11) | 20) & 0xFu; }
#define XB_SPIN(cond, bar) do { unsigned _sp = 0; while (cond) { __builtin_amdgcn_s_sleep(1); \
    if ((++_sp & 255u) == 0u) { if (xb_ld(&(bar)[XB_TMO])) break; if (_sp > XB_SPIN_CAP) { atomicAdd(&(bar)[XB_TMO], 1u); break; } } } } while (0)

struct XcdBarrier {
    unsigned* bar; unsigned x;
    volatile LAS unsigned* st;
};
__device__ __forceinline__ XcdBarrier xcd_barrier_post(unsigned* bar, volatile LAS unsigned* st) {
    XcdBarrier b; b.bar = bar; b.x = xb_xcc_id(); b.st = st;
    if (threadIdx.x == 0) (void)xb_add(&bar[XB_XCNT(b.x)], 1u);
    return b;
}
__device__ __forceinline__ void xcd_barrier_complete(unsigned* bar, unsigned x, unsigned& nloc, unsigned& nx) {
    const unsigned G = gridDim.x * gridDim.y * gridDim.z;
    unsigned sum, cnt, mine, sp = 0u;
    for (;;) {
        sum = 0u; cnt = 0u; mine = 0u;
#pragma unroll
        for (unsigned j = 0; j < 16; ++j) { const unsigned c = xb_ld(&bar[XB_XCNT(j)]); sum += c; cnt += (c > 0u) ? 1u : 0u; mine = (j == x) ? c : mine; }
        if (sum == G) break;
        __builtin_amdgcn_s_sleep(1);
        if ((++sp & 255u) == 0u) { if (xb_ld(&bar[XB_TMO])) break; if (sp > XB_SPIN_CAP) { atomicAdd(&bar[XB_TMO], 1u); break; } }
    }
    nloc = mine > 0u ? mine : 1u; nx = cnt > 0u ? cnt : 1u;
}
__device__ __forceinline__ void xcd_barrier(const XcdBarrier& b) {
    asm volatile("s_waitcnt vmcnt(0)" ::: "memory");
    __syncthreads();
    if (threadIdx.x == 0) {
        unsigned* bar = b.bar;
        unsigned bx = b.x; asm volatile("" : "+s"(bx));
        __builtin_amdgcn_s_waitcnt(0);
        unsigned nloc = b.st[0], nx = b.st[1];
        if (nloc == 0u) { xcd_barrier_complete(bar, bx, nloc, nx); b.st[0] = nloc; b.st[1] = nx; }
        const unsigned old = xb_add(&bar[XB_XSUB(bx)], 1u);
        const unsigned gen = old / nloc;
        if (old + 1u == (gen + 1u) * nloc) {
            __builtin_amdgcn_fence(__ATOMIC_RELEASE, "agent");
            asm volatile("s_waitcnt vmcnt(0)" ::: "memory");
            const unsigned og = xb_add(&bar[XB_TOP], 1u);
            const unsigned tg = og / nx;
            if (og + 1u == (tg + 1u) * nx) xb_add(&bar[XB_TOPGEN], 1u);
            else XB_SPIN(xb_ld(&bar[XB_TOPGEN]) == tg, bar);
            __builtin_amdgcn_fence(__ATOMIC_ACQUIRE, "agent");
            xb_add(&bar[XB_XGEN(bx)], 1u);
            asm volatile("s_waitcnt vmcnt(0)" ::: "memory");
        } else {
            XB_SPIN(xb_ld(&bar[XB_XGEN(bx)]) == gen, bar);
            __builtin_amdgcn_fence(__ATOMIC_ACQUIRE, "agent");
            asm volatile("s_waitcnt vmcnt(0)" ::: "memory");
        }
    }
    __syncthreads();
}

struct Frame {
    LAS unsigned char* lds;
    volatile LAS unsigned* MISC;
    unsigned* ctl;
    int G;
    const float* const* in;
    float* out; unsigned char* ws;
};
enum { I_X = 0, I_N1G, I_WIN, I_HCW, I_HCB, I_FW1, I_FB1, I_FW2, I_FB2, I_FW3, I_FB3, I_FFREQ, I_FWOUT, I_HSKIP, I_HNG, I_SHIFT, I_W0, I_W2, I_A0, I_A2, I_G2, I_KK, I_KA, I_RK, I_LNG, I_LNB, I_V0, I_V1, I_V2, I_WOUT, I_N2G, I_MW1, I_MW2, I_FING };

__device__ __forceinline__ float wave_max(float v) {
#pragma unroll
    for (int o = 1; o < 64; o <<= 1) v = fmaxf(v, __shfl_xor(v, o));
    return v;
}
__device__ __forceinline__ unsigned q4(float a, float b, float c, float d) {
    const int ia = (int)__builtin_rintf(a), ib = (int)__builtin_rintf(b), ic = (int)__builtin_rintf(c), id = (int)__builtin_rintf(d);
    return (unsigned)(ia & 255) | ((unsigned)(ib & 255) << 8) | ((unsigned)(ic & 255) << 16) | ((unsigned)id << 24);
}
__device__ __forceinline__ float wave_sum(float v) {
#pragma unroll
    for (int o = 1; o < 64; o <<= 1) v += __shfl_xor(v, o);
    return v;
}
typedef float f32x2 __attribute__((ext_vector_type(2)));
constexpr int FN = 2 * T;
constexpr int XPAD = FN + FN / 16 + 16 * (FN / 512);
__device__ __forceinline__ f32x2 cmul(f32x2 a, f32x2 b) { return (f32x2){a.x * b.x - a.y * b.y, a.x * b.y + a.y * b.x}; }
__device__ __forceinline__ f32x2 pk_fma_rot(f32x2 a, f32x2 b, f32x2 t) { f32x2 r;
    asm("v_pk_fma_f32 %0, %1, %2, %3 op_sel:[1,1,0] op_sel_hi:[1,0,1] neg_lo:[0,1,0]" : "=v"(r) : "v"(a), "v"(b), "v"(t)); return r; }
__device__ __forceinline__ f32x2 cmulc(f32x2 a, f32x2 b) { return (f32x2){a.x * b.x + a.y * b.y, a.y * b.x - a.x * b.y}; }
__device__ constexpr float C32[16] = {1.0f, 0.98078528040323043f, 0.92387953251128674f, 0.83146961230254524f, 0.70710678118654752f, 0.55557023301960218f, 0.38268343236508977f, 0.19509032201612825f,
                                      0.0f, -0.19509032201612825f, -0.38268343236508977f, -0.55557023301960218f, -0.70710678118654752f, -0.83146961230254524f, -0.92387953251128674f, -0.98078528040323043f};
__device__ constexpr float S32[16] = {0.0f, 0.19509032201612825f, 0.38268343236508977f, 0.55557023301960218f, 0.70710678118654752f, 0.83146961230254524f, 0.92387953251128674f, 0.98078528040323043f,
                                      1.0f, 0.98078528040323043f, 0.92387953251128674f, 0.83146961230254524f, 0.70710678118654752f, 0.55557023301960218f, 0.38268343236508977f, 0.19509032201612825f};
constexpr int bitrev_c(int v, int bits) { int r = 0; for (int i = 0; i < bits; ++i) r |= ((v >> i) & 1) << (bits - 1 - i); return r; }
template <int R, bool INV> __device__ __forceinline__ void dft_regs(f32x2 (&x)[R]) {
    constexpr int LOG = (R == 32) ? 5 : 4;
#pragma unroll
    for (int s = R / 2; s >= 1; s >>= 1) {
#pragma unroll
        for (int blk = 0; blk < R; blk += 2 * s) {
#pragma unroll
            for (int j = 0; j < s; ++j) {
                const f32x2 a = x[blk + j], b = x[blk + j + s];
                x[blk + j] = a + b;
                f32x2 d = a - b;
                const int m = j * (16 / s);
                if (m == 0) x[blk + j + s] = d;
                else if (m == 8) x[blk + j + s] = INV ? (f32x2){-d.y, d.x} : (f32x2){d.y, -d.x};
                else { const float c = C32[m], sn = INV ? S32[m] : -S32[m];
                    const f32x2 k1 = (f32x2){c, sn}, k2 = (f32x2){-sn, c};
                    x[blk + j + s] = __builtin_shufflevector(d, d, 0, 0) * k1 + __builtin_shufflevector(d, d, 1, 1) * k2; }
            }
        }
    }
    f32x2 y[R];
#pragma unroll
    for (int k = 0; k < R; ++k) y[k] = x[bitrev_c(k, LOG)];
#pragma unroll
    for (int k = 0; k < R; ++k) x[k] = y[k];
}
template <int R, bool INV> __device__ __forceinline__ void twiddle_regs(f32x2 (&x)[R], float frac) {
    asm volatile("" : "+v"(frac));
    const float sn0 = __builtin_amdgcn_sinf(0.5f * frac), cs = __builtin_amdgcn_cosf(0.5f * frac);
    const float sn = INV ? sn0 : -sn0;
    const f32x2 w = (f32x2){cs, sn}, iw = (f32x2){-sn, cs};
    f32x2 w2; { f32x2 t = __builtin_shufflevector(w, w, 0, 0) * w; w2 = pk_fma_rot(w, w, t); }
    f32x2 wa = w, wb = w2;
#pragma unroll
    for (int k = 1; k < R; k += 2) {
        const bool hb = (k + 1 < R), na = (k + 2 < R), nb = (k + 3 < R);
        const f32x2 xa = x[k], xb = hb ? x[k + 1] : x[k];
        const f32x2 tda = __builtin_shufflevector(xa, xa, 0, 0) * wa, tdb = __builtin_shufflevector(xb, xb, 0, 0) * wb;
        const f32x2 tpa = __builtin_shufflevector(wa, wa, 0, 0) * w2, tpb = __builtin_shufflevector(wb, wb, 0, 0) * w2;
        if (hb && na && nb) asm volatile("" :: "v"(tda), "v"(tdb), "v"(tpa), "v"(tpb));
        else asm volatile("" :: "v"(tda));
        x[k] = pk_fma_rot(xa, wa, tda);
        if (hb) x[k + 1] = pk_fma_rot(xb, wb, tdb);
        if (na) wa = pk_fma_rot(wa, w2, tpa);
        if (nb) wb = pk_fma_rot(wb, w2, tpb);
    }
}
#define XP(i) ((i) + ((i) >> 4) + 16 * ((i) >> 9))
constexpr int XBP = 560;
template <bool ZUP> __device__ __forceinline__ void fft_f1(LAS f32x2* X, int t) {
    f32x2 x[32]; const int base = t + (t >> 4);
#pragma unroll
    for (int j = 0; j < 32; ++j) x[j] = (ZUP && j >= 16) ? (f32x2){0.f, 0.f} : X[base + j * XBP];
    dft_regs<32, false>(x);
    twiddle_regs<32, false>(x, (float)t * (1.0f / 8192.0f));
#pragma unroll
    for (int k = 0; k < 32; ++k) X[base + k * XBP] = x[k];
}
__device__ __forceinline__ void fft_f2(LAS f32x2* X, int t) {
    f32x2 x[32]; const int base = (t >> 4) * XBP + (t & 15);
#pragma unroll
    for (int j = 0; j < 32; ++j) x[j] = X[base + j * 17];
    dft_regs<32, false>(x);
    twiddle_regs<32, false>(x, (float)(t & 15) * (1.0f / 256.0f));
#pragma unroll
    for (int k = 0; k < 32; ++k) X[base + k * 17] = x[k];
}
__device__ __forceinline__ void fft_mid(LAS f32x2* X, const f32x2* H, int t) {
#pragma unroll 1
    for (int r = 0; r < 2; ++r) { const int b = t + 512 * r; f32x2 x[16];
        const f32x4* hp = (const f32x4*)(H + 16 * b); f32x4 h[8];
#pragma unroll
        for (int k = 0; k < 8; ++k) h[k] = hp[k];
#pragma unroll
        for (int j = 0; j < 16; ++j) x[j] = X[17 * b + 16 * (b >> 5) + j];
        dft_regs<16, false>(x);
#pragma unroll
        for (int k = 0; k < 8; ++k) { const f32x2 h0 = (f32x2){h[k][0], h[k][1]}, h1 = (f32x2){h[k][2], h[k][3]}, a0 = x[2 * k], a1 = x[2 * k + 1];
            f32x2 t0 = __builtin_shufflevector(a0, a0, 0, 0) * h0, t1 = __builtin_shufflevector(a1, a1, 0, 0) * h1;
            asm volatile("" :: "v"(t0), "v"(t1));
            x[2 * k] = pk_fma_rot(a0, h0, t0); x[2 * k + 1] = pk_fma_rot(a1, h1, t1); }
        dft_regs<16, true>(x);
#pragma unroll
        for (int j = 0; j < 16; ++j) X[17 * b + 16 * (b >> 5) + j] = x[j]; }
}
__device__ __forceinline__ void fft_i2(LAS f32x2* X, int t) {
    f32x2 x[32]; const int base = (t >> 4) * XBP + (t & 15);
#pragma unroll
    for (int k = 0; k < 32; ++k) x[k] = X[base + k * 17];
    twiddle_regs<32, true>(x, (float)(t & 15) * (1.0f / 256.0f));
    dft_regs<32, true>(x);
#pragma unroll
    for (int j = 0; j < 32; ++j) X[base + j * 17] = x[j];
}
__device__ __forceinline__ void fft_i1(LAS f32x2* X, int t) {
    f32x2 x[32]; const int base = t + (t >> 4);
#pragma unroll
    for (int k = 0; k < 32; ++k) x[k] = X[base + k * XBP];
    twiddle_regs<32, true>(x, (float)t * (1.0f / 8192.0f));
    dft_regs<32, true>(x);
#pragma unroll
    for (int j = 0; j < 16; ++j) X[base + j * XBP] = x[j];
}
__device__ __forceinline__ void fft_conv(LAS f32x2* X, const f32x2* H, int tid) {
    __syncthreads(); fft_f1<true>(X, tid);
    __syncthreads(); fft_f2(X, tid);
    __syncthreads(); fft_mid(X, H, tid);
    __syncthreads(); fft_i2(X, tid);
    __syncthreads(); fft_i1(X, tid);
    __syncthreads();
}
__device__ __forceinline__ void hy_spectrum_item(Frame& F, int item) {
    PHASE_TID();
    LAS f32x2* X = (LAS f32x2*)F.lds; LAS float* RED = (LAS float*)(F.lds + XPAD * 8);
    const int o = item >> 9, c = item & 511;
    const float* HF = (const float*)(F.ws + WS_HF);
    const float* f = HF + ((size_t)(o * 2 + 0) * CH + c) * T; const float* bw = HF + ((size_t)(o * 2 + 1) * CH + c) * T;
    f32x2* HS = (f32x2*)(F.ws + WS_YMIX) + (size_t)item * FN;
    __syncthreads();
    f32x2 x[32]; float ss = 0.f; const int base = tid + (tid >> 4);
#pragma unroll
    for (int j = 0; j < 32; ++j) { const int idx = j * 512 + tid; float v;
        if (j < 16) v = f[idx]; else v = (idx == T) ? 0.f : bw[FN - idx];
        ss += v * v; x[j] = (f32x2){v, 0.f}; }
    ss = wave_sum(ss);
    if (lane == 0) RED[wave] = ss;
    dft_regs<32, false>(x);
    twiddle_regs<32, false>(x, (float)tid * (1.0f / 8192.0f));
#pragma unroll
    for (int k = 0; k < 32; ++k) X[base + k * XBP] = x[k];
    __syncthreads();
    float tot = 0.f;
#pragma unroll
    for (int w = 0; w < 8; ++w) tot += RED[w];
    const float sc = (1.0f / sqrtf(tot + 1e-6f)) * (1.0f / (float)FN);
    fft_f2(X, tid);
    __syncthreads();
#pragma unroll 1
    for (int r = 0; r < 2; ++r) { const int b = tid + 512 * r; f32x2 y[16];
#pragma unroll
        for (int j = 0; j < 16; ++j) y[j] = X[17 * b + 16 * (b >> 5) + j];
        dft_regs<16, false>(y);
        f32x4* dst = (f32x4*)(HS + 16 * b);
#pragma unroll
        for (int k = 0; k < 8; ++k) dst[k] = (f32x4){y[2 * k].x * sc, y[2 * k].y * sc, y[2 * k + 1].x * sc, y[2 * k + 1].y * sc}; }
}
__device__ __forceinline__ void p_spectra(Frame& F) { PHASE_TID(); (void)tid; for (int it = bid; it < 2 * CH; it += F.G) hy_spectrum_item(F, it); __syncthreads(); }

struct RowRaw { v4u a, b; unsigned lo, hi; };
__device__ __forceinline__ void hy_row_load(RowRaw& R, const bf16* row, int t0) {
    R.a = *(const v4u*)(row + t0); R.b = *(const v4u*)(row + t0 + 8);
    R.lo = t0 > 0 ? (unsigned)row[t0 - 1] : 0u; R.hi = t0 + 16 < T ? (unsigned)row[t0 + 16] : 0u;
}
__device__ __forceinline__ void hy_u16r(const RowRaw& R, float w0, float w1, float w2, float bias, float (&u)[16]) {
    float p[18];
    p[0] = __builtin_bit_cast(float, R.lo << 16); p[17] = __builtin_bit_cast(float, R.hi << 16);
    const unsigned w[8] = {R.a.x, R.a.y, R.a.z, R.a.w, R.b.x, R.b.y, R.b.z, R.b.w};
#pragma unroll
    for (int i = 0; i < 8; ++i) { p[1 + 2 * i] = bflo(w[i]); p[2 + 2 * i] = bfhi(w[i]); }
#pragma unroll
    for (int i = 0; i < 16; ++i) u[i] = w0 * p[i] + w1 * p[i + 1] + w2 * p[i + 2] + bias;
}
__device__ __forceinline__ void hy_pack_store(bf16* dst, const float (&y)[16]) {
    v4u o0, o1;
    o0.x = pk2(y[0], y[1]); o0.y = pk2(y[2], y[3]); o0.z = pk2(y[4], y[5]); o0.w = pk2(y[6], y[7]);
    o1.x = pk2(y[8], y[9]); o1.y = pk2(y[10], y[11]); o1.z = pk2(y[12], y[13]); o1.w = pk2(y[14], y[15]);
    *(v4u*)dst = o0; *(v4u*)(dst + 8) = o1;
}
__device__ __forceinline__ void hy_fft_item(Frame& F, int l, int item) {
    PHASE_TID(); const int c = item >> 2, bp = item & 3, t0 = 16 * tid, xb = 17 * tid + 16 * (tid >> 5);
    LAS f32x2* X = (LAS f32x2*)F.lds;
    bf16* PHT = (bf16*)(F.ws + WS_PHT);
    bf16* rx1a = PHT + ((size_t)(2 * bp) * HYP + c) * T; bf16* rx1b = rx1a + (size_t)HYP * T;
    bf16* rx2a = PHT + ((size_t)(2 * bp) * HYP + CH + c) * T; bf16* rx2b = rx2a + (size_t)HYP * T;
    const bf16* rva = PHT + ((size_t)(2 * bp) * HYP + 2 * CH + c) * T; const bf16* rvb = rva + (size_t)HYP * T;
    const float* cw = F.in[I_HCW] + (size_t)l * 3 * HYP; const float* cb = F.in[I_HCB] + (size_t)l * HYP;
    const float* skip = F.in[I_HSKIP] + (size_t)l * 2 * CH;
    const f32x2* H0 = (const f32x2*)(F.ws + WS_YMIX) + (size_t)c * FN; const f32x2* H1 = H0 + (size_t)CH * FN;
    __syncthreads();
    RowRaw va, vb, xa, xb2;
    hy_row_load(va, rva, t0); hy_row_load(vb, rvb, t0);
    const float vw0 = cw[2 * CH + c], vw1 = cw[HYP + 2 * CH + c], vw2 = cw[2 * HYP + 2 * CH + c], vbs = cb[2 * CH + c];
    const float x1w0 = cw[c], x1w1 = cw[HYP + c], x1w2 = cw[2 * HYP + c], x1bs = cb[c], x2w0 = cw[CH + c], x2w1 = cw[HYP + CH + c], x2w2 = cw[2 * HYP + CH + c], x2bs = cb[CH + c], s0 = skip[c], s1 = skip[CH + c];
    { float ua[16], ub[16];
      hy_u16r(va, vw0, vw1, vw2, vbs, ua); hy_u16r(vb, vw0, vw1, vw2, vbs, ub);
#pragma unroll
      for (int i = 0; i < 16; ++i) X[xb + i] = (f32x2){ua[i], ub[i]}; }
    hy_row_load(xa, rx1a, t0); hy_row_load(xb2, rx1b, t0);
    fft_conv(X, H0, tid);
    v4u z2a[2], z2b[2];
    { float ua[16], ub[16], za[16], zb[16];
      {
        hy_u16r(va, vw0, vw1, vw2, vbs, ua); hy_u16r(vb, vw0, vw1, vw2, vbs, ub);
#pragma unroll
        for (int i = 0; i < 16; ++i) { const f32x2 y = X[xb + i]; za[i] = y.x + s0 * ua[i]; zb[i] = y.y + s0 * ub[i]; } }
      hy_u16r(xa, x1w0, x1w1, x1w2, x1bs, ua); hy_u16r(xb2, x1w0, x1w1, x1w2, x1bs, ub);
#pragma unroll
      for (int i = 0; i < 16; ++i) { za[i] *= ua[i]; zb[i] *= ub[i]; }
#pragma unroll
      for (int q = 0; q < 2; ++q) { z2a[q].x = pk2(za[8 * q], za[8 * q + 1]); z2a[q].y = pk2(za[8 * q + 2], za[8 * q + 3]); z2a[q].z = pk2(za[8 * q + 4], za[8 * q + 5]); z2a[q].w = pk2(za[8 * q + 6], za[8 * q + 7]);
                                    z2b[q].x = pk2(zb[8 * q], zb[8 * q + 1]); z2b[q].y = pk2(zb[8 * q + 2], zb[8 * q + 3]); z2b[q].z = pk2(zb[8 * q + 4], zb[8 * q + 5]); z2b[q].w = pk2(zb[8 * q + 6], zb[8 * q + 7]); }
#pragma unroll
      for (int i = 0; i < 16; ++i) X[xb + i] = (f32x2){za[i], zb[i]}; }
    hy_row_load(xa, rx2a, t0); hy_row_load(xb2, rx2b, t0);
    fft_conv(X, H1, tid);
    { float ua[16], ub[16];
      hy_u16r(xa, x2w0, x2w1, x2w2, x2bs, ua); hy_u16r(xb2, x2w0, x2w1, x2w2, x2bs, ub);
      float za[16], zb[16];
      const unsigned wa[8] = {z2a[0].x, z2a[0].y, z2a[0].z, z2a[0].w, z2a[1].x, z2a[1].y, z2a[1].z, z2a[1].w}, wb[8] = {z2b[0].x, z2b[0].y, z2b[0].z, z2b[0].w, z2b[1].x, z2b[1].y, z2b[1].z, z2b[1].w};
#pragma unroll
      for (int i = 0; i < 8; ++i) { za[2 * i] = bflo(wa[i]); za[2 * i + 1] = bfhi(wa[i]); zb[2 * i] = bflo(wb[i]); zb[2 * i + 1] = bfhi(wb[i]); }
#pragma unroll
      for (int i = 0; i < 16; ++i) { const f32x2 y = X[xb + i]; za[i] = ua[i] * (y.x + s1 * za[i]); zb[i] = ub[i] * (y.y + s1 * zb[i]); }
      hy_pack_store(rx2a + t0, za); hy_pack_store(rx2b + t0, zb); }
}
typedef short bf16x8 __attribute__((ext_vector_type(8)));
constexpr int CL_ = 64;
constexpr int LDB = 80;
constexpr int LDSG = 144, LDVL = 48;
constexpr int LDF = 65;
constexpr int MB = 64 * LDB * 2;
constexpr int MF = 64 * LDF * 4;
constexpr int O_AH = 0, O_AHT = MB, O_RH = 2 * MB, O_BH = 3 * MB, O_BHT = 4 * MB, O_KH = 5 * MB, O_KHT = 6 * MB, O_VT = 7 * MB;
constexpr int O_TW = 0, O_AD = MB, O_SG = 2 * MB  , O_VL = 2 * MB + 64 * LDSG * 2  ;
constexpr int O_APB = O_KH;
constexpr int O_F = 8 * MB;
constexpr int O_AF = O_F, O_LW = O_F + MF, O_ZV = O_F + 2 * MF;
constexpr int O_XA = O_F, O_XAT = O_F + MB, O_AAK = O_F + 2 * MB, O_ARB = O_F + 3 * MB, O_ARK = O_F + 4 * MB;
constexpr int O_S0B = O_F + ((3 * MF > 5 * MB) ? 3 * MF : 5 * MB);
constexpr int O_UT = O_S0B + MB;
constexpr int O_TB = O_UT, O_M1T = O_BH, O_T0T = O_AH, O_WT = O_KH;
constexpr int O_PL = O_UT + MB;
constexpr int O_PART = O_PL + 256;
constexpr int O_MU = O_PART + 2048;
constexpr int O_CK = O_MU + 1792;
constexpr int O_MC = O_CK + 768;
static_assert(O_ARK + MB <= O_S0B && O_ZV + MF <= O_S0B && O_VL + 64 * LDVL * 2 <= O_F && O_MC + 1792 <= LDSCTL_OFF, "cscan LDS map");

__device__ __forceinline__ unsigned pk2s(float v) { return pk2(v, v); }
#define MFMA16(a, b, c) __builtin_amdgcn_mfma_f32_16x16x32_bf16((a), (b), (c), 0, 0, 0)
__device__ __forceinline__ bf16x8 ldfrag(const LAS unsigned char* base, int ld, int row0, int k0, int fr, int fq) {
    return *(const LAS bf16x8*)(base + ((row0 + fr) * ld + k0 + 8 * fq) * 2);
}
__device__ __forceinline__ void st_tile_bf16(LAS unsigned char* base, int ld, int m0, int n0, int fr, int fq, const f32x4& v) {
#pragma unroll
    for (int jj = 0; jj < 4; ++jj) *(LAS bf16*)(base + ((m0 + 4 * fq + jj) * ld + n0 + fr) * 2) = (bf16)pk2s(v[jj]);
}
__device__ __forceinline__ void st_tile_bf16_T(LAS unsigned char* base, int ld, int m0, int n0, int fr, int fq, const f32x4& v) {
    v2u o; o.x = pk2(v[0], v[1]); o.y = pk2(v[2], v[3]);
    *(LAS v2u*)(base + ((n0 + fr) * ld + m0 + 4 * fq) * 2) = o;
}
#define CFENCE() asm volatile("" ::: "memory")
#define ZFRAG ((bf16x8){0, 0, 0, 0, 0, 0, 0, 0})
__device__ __forceinline__ void ldA(bf16x8 (&a)[2], const LAS unsigned char* A, int mt, int fr, int fq) {
#pragma unroll
    for (int ks = 0; ks < 2; ++ks) a[ks] = ldfrag(A, LDB, 16 * mt, 32 * ks, fr, fq);
}
__device__ __forceinline__ void ldB(bf16x8 (&b)[2][2], const LAS unsigned char* B, int nt0, int fr, int fq) {
#pragma unroll
    for (int ks = 0; ks < 2; ++ks)
#pragma unroll
        for (int j = 0; j < 2; ++j) b[ks][j] = ldfrag(B, LDB, 16 * (nt0 + j), 32 * ks, fr, fq);
}
#define PIN(x) asm volatile("" : "+v"(x))
__device__ __forceinline__ void mmac(bf16x8 (&a)[2], bf16x8 (&b)[2][2], f32x4 (&acc)[2]) {
#pragma unroll
    for (int ks = 0; ks < 2; ++ks) { PIN(a[ks]);
#pragma unroll
        for (int j = 0; j < 2; ++j) { PIN(b[ks][j]); acc[j] = MFMA16(a[ks], b[ks][j], acc[j]); } }
}
__device__ __forceinline__ void mmacT(bf16x8 (&a)[2], bf16x8 (&b)[2][2], f32x4 (&acc)[2]) {
#pragma unroll
    for (int ks = 0; ks < 2; ++ks) { PIN(a[ks]);
#pragma unroll
        for (int j = 0; j < 2; ++j) { PIN(b[ks][j]); acc[j] = MFMA16(b[ks][j], a[ks], acc[j]); } }
}
__device__ __forceinline__ v4u pack8(const float (&v)[8]) { v4u o; o.x = pk2(v[0], v[1]); o.y = pk2(v[2], v[3]); o.z = pk2(v[4], v[5]); o.w = pk2(v[6], v[7]); return o; }
__device__ __forceinline__ bf16x8 wfrag(const float* W, int k0, int col, int fq) {
    float v[8];
#pragma unroll
    for (int e = 0; e < 8; ++e) v[e] = W[(size_t)(k0 + 8 * fq + e) * CH + col];
    return __builtin_bit_cast(bf16x8, pack8(v));
}

struct RawTok { v4u g[7][3]; };
__device__ __forceinline__ void load_raw(RawTok& R, const bf16* PRW, const bf16* VFIRST, int b, int tok, int hc, int ec, int d, int l, bool has_vl) {
    const size_t m = (size_t)b * T + tok; const v4u z = (v4u){0u, 0u, 0u, 0u};
    const int cols[7] = {hc + ec, CH + hc + ec, 2 * CH + hc + ec, 1536 + d * 64 + ec, 1664 + d * 64 + ec, 1792 + ec, 1856 + ec};
#pragma unroll
    for (int g = 0; g < 7; ++g) { if (g >= 5 && d != 0) { R.g[g][0] = z; R.g[g][1] = z; R.g[g][2] = z; continue; }
        const bf16* p = PRW + m * NRW + cols[g];
        R.g[g][1] = *(const v4u*)p; R.g[g][0] = *(const v4u*)(p - NRW); R.g[g][2] = *(const v4u*)(p + NRW); }
    if (__builtin_amdgcn_readfirstlane((int)__builtin_amdgcn_ballot_w64(tok == 0 || tok == T - 1) != 0 || (int)(__builtin_amdgcn_ballot_w64(tok == 0 || tok == T - 1) >> 32) != 0)) {
#pragma unroll
        for (int g = 0; g < 7; ++g) { R.g[g][0] = (tok == 0) ? z : R.g[g][0]; R.g[g][2] = (tok == T - 1) ? z : R.g[g][2]; } }
}
typedef __bf16 bf16x2v __attribute__((ext_vector_type(2)));
__device__ __forceinline__ void mix8r(const v4u (&r)[3], const LAS unsigned* mub, const LAS float* mcb, float (&out)[8]) {
    const v4u ma = *(const LAS v4u*)mub, mb = *(const LAS v4u*)(mub + 4); const f32x4 ca = *(const LAS f32x4*)mcb, cb = *(const LAS f32x4*)(mcb + 4);
    const unsigned mw[8] = {ma.x, ma.y, ma.z, ma.w, mb.x, mb.y, mb.z, mb.w}; const float mc[8] = {ca[0], ca[1], ca[2], ca[3], cb[0], cb[1], cb[2], cb[3]};
    const unsigned pw[4] = {r[0].x, r[0].y, r[0].z, r[0].w}, cw[4] = {r[1].x, r[1].y, r[1].z, r[1].w}, nw[4] = {r[2].x, r[2].y, r[2].z, r[2].w};
#pragma unroll
    for (int i = 0; i < 4; ++i) {
        const unsigned pn0 = __builtin_amdgcn_perm(nw[i], pw[i], 0x05040100u), pn1 = __builtin_amdgcn_perm(nw[i], pw[i], 0x07060302u);
        out[2 * i] = __builtin_amdgcn_fdot2_f32_bf16(__builtin_bit_cast(bf16x2v, pn0), __builtin_bit_cast(bf16x2v, mw[2 * i]), bflo(cw[i]) * mc[2 * i], false);
        out[2 * i + 1] = __builtin_amdgcn_fdot2_f32_bf16(__builtin_bit_cast(bf16x2v, pn1), __builtin_bit_cast(bf16x2v, mw[2 * i + 1]), bfhi(cw[i]) * mc[2 * i + 1], false); }
}
template <bool DO_T, bool DO_X, bool LAST> __device__ __forceinline__ void blk_stage(const LAS unsigned char* X, const LAS unsigned char* XT, const LAS unsigned char* TT, LAS unsigned char* To, LAS unsigned char* T0T,
                                                                                    LAS unsigned char* Xo, LAS unsigned char* XoT, int wave, int fr, int fq) {
    const int bk = wave >> 2, k0 = 32 * bk, m0 = k0 + 16 * ((wave >> 1) & 1), n0 = k0 + 16 * (wave & 1);
    bf16x8 a = ldfrag(X, LDB, m0, k0, fr, fq), tb = a, xb = a; v2u tw = (v2u){0u, 0u};
    if (DO_T) { tb = ldfrag(TT, LDB, n0, k0, fr, fq); tw = *(const LAS v2u*)(TT + ((n0 + fr) * LDB + m0 + 4 * fq) * 2); }
    if (DO_X) xb = ldfrag(XT, LDB, n0, k0, fr, fq);
    CFENCE();
    PIN(a);
    if (DO_T) { f32x4 ta = (f32x4){bflo(tw.x), bfhi(tw.x), bflo(tw.y), bfhi(tw.y)}; PIN(tb); ta = MFMA16(a, tb, ta);
        if (LAST) { st_tile_bf16(To, LDB, m0, n0, fr, fq, ta); if (bk == 0) st_tile_bf16_T(T0T, LDB, m0, n0, fr, fq, ta); }
        else st_tile_bf16_T(To, LDB, m0, n0, fr, fq, ta); }
    if (DO_X) { f32x4 xa = (f32x4){0.f, 0.f, 0.f, 0.f}; PIN(xb); xa = MFMA16(a, xb, xa);
        st_tile_bf16(Xo, LDB, m0, n0, fr, fq, xa); st_tile_bf16_T(XoT, LDB, m0, n0, fr, fq, xa); }
}

template <int HH> __device__ __forceinline__ void m2_half(LAS unsigned char* L, int q, int fr, int fq) {
    const LAS unsigned char* Am = L + ((q < 2) ? O_AH : O_RH); const LAS unsigned char* Bm = L + ((q & 1) ? O_KH : O_BH);
    LAS unsigned char* Om = L + (q == 0 ? O_XA : (q == 1 ? O_AAK : (q == 2 ? O_ARB : O_ARK)));
    constexpr int MT0 = HH ? 1 : 0, MT1 = HH ? 2 : 3, NB = MT1 + 1;
    unsigned zz_ = 0u; asm volatile("" : "+v"(zz_)); const v2u z2 = (v2u){zz_, zz_};
    bf16x8 a[2][2], b[NB][2];
#pragma unroll
    for (int ks = 0; ks < 2; ++ks) { a[0][ks] = ldfrag(Am, LDB, 16 * MT0, 32 * ks, fr, fq); a[1][ks] = ldfrag(Am, LDB, 16 * MT1, 32 * ks, fr, fq); }
#pragma unroll
    for (int nt = 0; nt < NB; ++nt)
#pragma unroll
        for (int ks = 0; ks < 2; ++ks) b[nt][ks] = ldfrag(Bm, LDB, 16 * nt, 32 * ks, fr, fq);
    CFENCE();
#pragma unroll
    for (int mi = 0; mi < 2; ++mi) { const int mtile = mi ? MT1 : MT0;
        PIN(a[mi][0]); PIN(a[mi][1]);
#pragma unroll
        for (int nt = 0; nt < 4; ++nt) {
            if (nt > mtile) {
                *(LAS v2u*)(Om + ((16 * mtile + fr) * LDB + 16 * nt + 4 * fq) * 2) = z2;
                if (q == 0) { *(LAS v2u*)(L + O_XAT + ((16 * nt + fr) * LDB + 16 * mtile + 4 * fq) * 2) = z2; *(LAS v2u*)(L + O_UT + ((16 * nt + fr) * LDB + 16 * mtile + 4 * fq) * 2) = z2; }
                continue; }
            if (mi == 0) { PIN(b[nt][0]); PIN(b[nt][1]); }
            f32x4 at = (f32x4){0.f, 0.f, 0.f, 0.f};
            at = MFMA16(b[nt][0], a[mi][0], at); at = MFMA16(b[nt][1], a[mi][1], at);
            if (nt == mtile) {
#pragma unroll
                for (int jj = 0; jj < 4; ++jj) { const bool keep = (q < 2) ? (4 * fq + jj < fr) : (4 * fq + jj <= fr); if (!keep) at[jj] = 0.f; } }
            { v2u o; o.x = pk2(at[0], at[1]); o.y = pk2(at[2], at[3]); *(LAS v2u*)(Om + ((16 * mtile + fr) * LDB + 16 * nt + 4 * fq) * 2) = o; }
            if ((mtile >> 1) == (nt >> 1)) {
                if (q == 0) { f32x4 an = (f32x4){0.f, 0.f, 0.f, 0.f};
                    an = MFMA16(a[mi][0], b[nt][0], an); an = MFMA16(a[mi][1], b[nt][1], an);
                    f32x4 t1 = an;
                    if (nt == mtile) {
#pragma unroll
                        for (int jj = 0; jj < 4; ++jj) { if (!(fr < 4 * fq + jj)) an[jj] = 0.f; t1[jj] = (fr == 4 * fq + jj) ? 1.0f : an[jj]; } }
                    st_tile_bf16_T(L + O_XAT, LDB, 16 * mtile, 16 * nt, fr, fq, an);
                    st_tile_bf16_T(L + O_UT, LDB, 16 * mtile, 16 * nt, fr, fq, t1); } }
        } }
}

__device__ __forceinline__ void cscan_chain(Frame& F, int l, int unit) {
    PHASE_TID(); const int chain = unit >> 1, seg = unit & 1; const int b = chain >> 4, h = (chain >> 1) & 7, d = chain & 1, hc = h * HD;
    const int fr_o = lane & 15, fq_o = lane >> 4;
    LAS unsigned char* L = F.lds;
    const bf16* PRW = (const bf16*)(F.ws + WS_PRW);
    const float* mu = F.in[I_SHIFT] + (size_t)l * 2 * RWP;
    const bf16* VFIRST = (const bf16*)(F.ws + WS_VFIRST);
    bf16* VOUT = (l == 0) ? (bf16*)(F.ws + WS_VFIRST) : (bf16*)(F.ws + WS_V2);
    bf16* GOUT = (bf16*)(F.ws + WS_G);
    bf16* YS = (bf16*)(F.ws + WS_YS) + (size_t)d * M * CH;
    float* BS = (float*)(F.ws + WS_BS) + (size_t)d * M * NH;
    bf16* YPHI = (bf16*)(F.ws + WS_YPHI) + (size_t)chain * (T / 2) * 64;
    const int lnt = wave & 3, lmt0 = 2 * (wave >> 2);
    if (wave < 4) { const int lcol = hc + 16 * lnt + fr_o; bf16x8* FRAGS = (bf16x8*)(F.ws + WS_FRAG) + ((size_t)chain * 4 + lnt) * 9 * 64 + lane; const float* w2 = F.in[I_W2] + (size_t)(l * 2 + d) * 64 * CH; const float* a2 = F.in[I_A2] + (size_t)(l * 2 + d) * 64 * CH; const float* g2 = F.in[I_G2] + (size_t)l * 128 * CH;
#pragma unroll
      for (int ks = 0; ks < 2; ++ks) { FRAGS[ks * 64] = wfrag(w2, 32 * ks, lcol, fq_o); FRAGS[(2 + ks) * 64] = wfrag(a2, 32 * ks, lcol, fq_o); }
      if (l == 1) FRAGS[4 * 64] = wfrag(F.in[I_V2], 0, lcol, fq_o);
#pragma unroll
      for (int ks = 0; ks < 4; ++ks) if (d == 0) FRAGS[(5 + ks) * 64] = wfrag(g2, 32 * ks, lcol, fq_o); }
    const int lcol_o = hc + 16 * lnt + fr_o;
    const float lc_w0 = F.in[I_W0][(l * 2 + d) * CH + lcol_o], lc_a0 = F.in[I_A0][(l * 2 + d) * CH + lcol_o], lc_v0 = (l == 1) ? F.in[I_V0][lcol_o] : 0.f;
    const int mt = wave >> 1, nt0 = 2 * (wave & 1);
    f32x4 S[2] = {(f32x4){0.f, 0.f, 0.f, 0.f}, (f32x4){0.f, 0.f, 0.f, 0.f}};
    f32x4 Ph[2];
#pragma unroll
    for (int j = 0; j < 2; ++j)
#pragma unroll
        for (int jj = 0; jj < 4; ++jj) Ph[j][jj] = (16 * mt + 4 * fq_o + jj == 16 * (nt0 + j) + fr_o) ? 1.0f : 0.f;
    __syncthreads();
    for (int e = tid; e < MB / 4; e += NTHR) ((LAS unsigned*)(L + O_S0B))[e] = 0u;
    if (tid < 448) { const int g = tid >> 6, j = tid & 63; const int col = (g < 3) ? g * CH + hc + j : (g == 3 ? 1536 + d * 64 + j : (g == 4 ? 1664 + d * 64 + j : 1792 + (tid - 320)));
        const unsigned pm = pk2(mu[col], mu[RWP + col]); ((LAS unsigned*)(L + O_MU))[tid] = pm; ((LAS float*)(L + O_MC))[tid] = 1.0f - bflo(pm) - bfhi(pm); }
    if (tid < 192) { const int g = tid >> 6, j = tid & 63; ((LAS float*)(L + O_CK))[tid] = F.in[g == 0 ? I_KK : (g == 1 ? I_KA : I_RK)][l * CH + hc + j]; }
    RawTok raw;
    { const int et0 = tid >> 3, ec0 = (tid & 7) * 8; const int cf = (d == 0) ? seg * 64 * CL_ : (127 - seg * 64) * CL_; load_raw(raw, PRW, VFIRST, b, (d == 0) ? cf + et0 : cf + 63 - et0, hc, ec0, d, l, (tid & 7) < 4); }
#pragma unroll 1
    for (int ci = 0; ci < T / CL_ / 2; ++ci) {
        int tid = (wave << 6) | (int)__builtin_amdgcn_mbcnt_hi(~0u, __builtin_amdgcn_mbcnt_lo(~0u, 0u)); asm volatile("" : "+v"(tid));
        const int lane = tid & 63, fr = lane & 15, fq = lane >> 4, et = tid >> 3, ec = (tid & 7) * 8;
        const int lcol = hc + 16 * lnt + fr;
        const unsigned char* FRB = F.ws + WS_FRAG + (((size_t)chain * 4 + lnt) * 9 * 64) * 16; unsigned fo = (unsigned)lane * 16u;
#define FRAGS_(k) (*(const bf16x8*)(FRB + fo + (k) * 1024))
        int c0 = (d == 0 ? seg * 64 + ci : 127 - seg * 64 - ci) * CL_; asm volatile("" : "+s"(c0));
        const int tok = (d == 0) ? c0 + et : c0 + 63 - et;
        const size_t m = (size_t)b * T + tok;
        __syncthreads();
        float rr[8], kr[8], vr[8];
        const LAS unsigned* MUB = (const LAS unsigned*)(L + O_MU) + ec; const LAS float* MCB = (const LAS float*)(L + O_MC) + ec;
        v4u vl4 = (v4u){0u, 0u, 0u, 0u}, vf4 = vl4;
        if (l == 1 && (tid & 7) < 4) vl4 = *(const v4u*)(PRW + m * NRW + RWP + ec);
        bf16x8 wf[5];
        {
          if (d == 0) { float g0[8], g1[8];
              mix8r(raw.g[5], MUB + 320, MCB + 320, g0); CFENCE(); mix8r(raw.g[6], MUB + 384, MCB + 384, g1); CFENCE();
#pragma unroll
              for (int e = 0; e < 8; ++e) { g0[e] = sigmoidf_(g0[e]); g1[e] = sigmoidf_(g1[e]); }
              *(LAS v4u*)(L + O_SG + (et * LDSG + ec) * 2) = pack8(g0); *(LAS v4u*)(L + O_SG + (et * LDSG + 64 + ec) * 2) = pack8(g1); }
          float xw[8], xa[8];
          mix8r(raw.g[3], MUB + 192, MCB + 192, xw); CFENCE(); mix8r(raw.g[4], MUB + 256, MCB + 256, xa);
          asm volatile("" : "+v"(fo) : "v"(xw[7]), "v"(xa[7]));
          wf[0] = FRAGS_(0); wf[1] = FRAGS_(1); wf[2] = FRAGS_(2); wf[3] = FRAGS_(3); wf[4] = ZFRAG; if (l == 1) wf[4] = FRAGS_(4);
          CFENCE();
#pragma unroll
          for (int e = 0; e < 8; ++e) xw[e] = tanhf_(xw[e]);
          *(LAS v4u*)(L + O_TW + (et * LDB + ec) * 2) = pack8(xw);
          *(LAS v4u*)(L + O_AD + (et * LDB + ec) * 2) = pack8(xa);
          mix8r(raw.g[0], MUB, MCB, rr); CFENCE(); mix8r(raw.g[1], MUB + 64, MCB + 64, kr); CFENCE(); mix8r(raw.g[2], MUB + 128, MCB + 128, vr);
          if (l == 1 && (tid & 7) < 4) *(LAS v4u*)(L + O_VL + (et * LDVL + ec) * 2) = vl4;
          if (l == 1) vf4 = *(const v4u*)(VFIRST + m * CH + hc + ec); }
        __syncthreads();
        { bf16x8 gf[4];
          gf[0] = ZFRAG; gf[1] = ZFRAG; gf[2] = ZFRAG; gf[3] = ZFRAG;
          if (d == 0) { gf[0] = FRAGS_(5); gf[1] = FRAGS_(6); gf[2] = FRAGS_(7); gf[3] = FRAGS_(8); }
#pragma unroll
          for (int mi = 0; mi < 2; ++mi) { const int m0 = 16 * (lmt0 + mi);
              bf16x8 tw[2], ad[2], vl;
#pragma unroll
              for (int ks = 0; ks < 2; ++ks) { tw[ks] = ldfrag(L + O_TW, LDB, m0, 32 * ks, fr, fq); ad[ks] = ldfrag(L + O_AD, LDB, m0, 32 * ks, fr, fq); }
              vl = ZFRAG; if (l == 1) vl = ldfrag(L + O_VL, LDVL, m0, 0, fr, fq);
              CFENCE();
              f32x4 zw = (f32x4){0.f, 0.f, 0.f, 0.f}, za = zw, zv = zw;
#pragma unroll
              for (int ks = 0; ks < 2; ++ks) { PIN(tw[ks]); zw = MFMA16(tw[ks], wf[ks], zw); PIN(ad[ks]); za = MFMA16(ad[ks], wf[2 + ks], za); }
              if (l == 1) { PIN(vl); zv = MFMA16(vl, wf[4], zv); }
#pragma unroll
              for (int jj = 0; jj < 4; ++jj) { const int s = m0 + 4 * fq + jj, o = (s * LDF + 16 * lnt + fr) * 4;
                  *(LAS float*)(L + O_AF + o) = sigmoidf_(za[jj] + lc_a0);
                  *(LAS float*)(L + O_LW + o) = -0.6065306597126334f * sigmoidf_(zw[jj] + lc_w0); }
              if (l == 1) {
#pragma unroll
                  for (int jj = 0; jj < 4; ++jj) { const int s = m0 + 4 * fq + jj, o = (s * LDF + 16 * lnt + fr) * 4; *(LAS float*)(L + O_ZV + o) = sigmoidf_(zv[jj] + lc_v0); } } }
          if (d == 0) {
#pragma unroll
              for (int mi = 0; mi < 2; ++mi) { const int m0 = 16 * (lmt0 + mi);
                  bf16x8 sg[4];
#pragma unroll
                  for (int ks = 0; ks < 4; ++ks) sg[ks] = ldfrag(L + O_SG, LDSG, m0, 32 * ks, fr, fq);
                  CFENCE();
                  f32x4 zg = (f32x4){0.f, 0.f, 0.f, 0.f};
#pragma unroll
                  for (int ks = 0; ks < 4; ++ks) { PIN(sg[ks]); zg = MFMA16(gf[ks], sg[ks], zg); }
                  { v2u o; o.x = pk2(zg[0], zg[1]); o.y = pk2(zg[2], zg[3]); *(v2u*)(GOUT + ((size_t)b * T + c0 + m0 + fr) * CH + hc + 16 * lnt + 4 * fq) = o; } } } }
        __syncthreads();
        { const int j = tid & 63, sg = tid >> 6; float c[8]; float run = 0.f;
#pragma unroll
          for (int i = 0; i < 8; ++i) { run += *(LAS float*)(L + O_LW + ((8 * sg + i) * LDF + j) * 4); c[i] = run; }
          *(LAS float*)(L + O_PART + (sg * 64 + j) * 4) = run;
          __syncthreads();
          float pre = 0.f;
#pragma unroll
          for (int q = 0; q < 8; ++q) { const float pv = *(LAS float*)(L + O_PART + (q * 64 + j) * 4); pre += (q < sg) ? pv : 0.f; }
#pragma unroll
          for (int i = 0; i < 8; ++i) *(LAS float*)(L + O_LW + ((8 * sg + i) * LDF + j) * 4) = c[i] + pre; }
        __syncthreads();
        { float kkr[8], av[8], cl[8], clm[8], zv[8], kd[8], ss = 0.f, bon = 0.f;
          const unsigned vfw[4] = {vf4.x, vf4.y, vf4.z, vf4.w};
          const LAS float* CKT = (const LAS float*)(L + O_CK) + ec;
          const f32x4 kka = *(const LAS f32x4*)CKT, kkb = *(const LAS f32x4*)(CKT + 4), kaa = *(const LAS f32x4*)(CKT + 64), kab = *(const LAS f32x4*)(CKT + 68), rka = *(const LAS f32x4*)(CKT + 128), rkb = *(const LAS f32x4*)(CKT + 132);
          const int o0 = (et * LDF + ec) * 4, om = (et > 0) ? o0 - LDF * 4 : o0;
#pragma unroll
          for (int e = 0; e < 8; ++e) { av[e] = *(LAS float*)(L + O_AF + o0 + 4 * e); cl[e] = *(LAS float*)(L + O_LW + o0 + 4 * e); clm[e] = *(LAS float*)(L + O_LW + om + 4 * e); zv[e] = 0.f; }
          if (l == 1) {
#pragma unroll
              for (int e = 0; e < 8; ++e) zv[e] = *(LAS float*)(L + O_ZV + o0 + 4 * e); }
          CFENCE();
          const float ckk[8] = {kka[0], kka[1], kka[2], kka[3], kkb[0], kkb[1], kkb[2], kkb[3]}, cka[8] = {kaa[0], kaa[1], kaa[2], kaa[3], kab[0], kab[1], kab[2], kab[3]},
                      crk[8] = {rka[0], rka[1], rka[2], rka[3], rkb[0], rkb[1], rkb[2], rkb[3]};
#pragma unroll
          for (int e = 0; e < 8; ++e) {
              const float vf = (e & 1) ? bfhi(vfw[e >> 1]) : bflo(vfw[e >> 1]); vr[e] = vr[e] + (vf - vr[e]) * zv[e];
              kkr[e] = kr[e] * ckk[e]; ss += kkr[e] * kkr[e];
              kd[e] = kr[e] * (1.0f + (av[e] - 1.0f) * cka[e]); bon += rr[e] * kd[e] * crk[e]; }
          ss = sum8(ss); bon = sum8(bon);
          const float inv = __builtin_amdgcn_rsqf(fmaxf(ss, 1e-24f));
          if ((tid & 7) == 0) BS[m * NH + h] = bon;
          if (d == 0) *(v4u*)(VOUT + m * CH + hc + ec) = pack8(vr);
          float ah[8], bh[8], kh[8], rh[8], Pv[8];
#pragma unroll
          for (int e = 0; e < 8; ++e) {
              const float P = __expf(cl[e]), Pi = __builtin_amdgcn_rcpf(P), Pm = (et > 0) ? __expf(clm[e]) : 1.0f, kk = kkr[e] * inv;
              ah[e] = -kk * Pm; bh[e] = kk * av[e] * Pi; kh[e] = kd[e] * Pi; rh[e] = rr[e] * P; Pv[e] = P; }
          if (et == 63) { *(LAS f32x4*)(L + O_PL + ec * 4) = (f32x4){Pv[0], Pv[1], Pv[2], Pv[3]}; *(LAS f32x4*)(L + O_PL + ec * 4 + 16) = (f32x4){Pv[4], Pv[5], Pv[6], Pv[7]}; }
          *(LAS v4u*)(L + O_AH + (et * LDB + ec) * 2) = pack8(ah); *(LAS v4u*)(L + O_BH + (et * LDB + ec) * 2) = pack8(bh);
          *(LAS v4u*)(L + O_KH + (et * LDB + ec) * 2) = pack8(kh); *(LAS v4u*)(L + O_RH + (et * LDB + ec) * 2) = pack8(rh);
          { unsigned pab[8], pkv[8]; const int c = tid & 7;
#pragma unroll
            for (int e = 0; e < 8; ++e) { pab[e] = pk2(ah[e], bh[e]); pkv[e] = pk2(kh[e], vr[e]); }
#pragma unroll
            for (int sh = 1; sh < 8; sh <<= 1) { const bool on = (c & sh) != 0; unsigned ta[8], tk[8];
#pragma unroll
                for (int e = 0; e < 8; ++e) { ta[e] = on ? pab[(e + sh) & 7] : pab[e]; tk[e] = on ? pkv[(e + sh) & 7] : pkv[e]; }
#pragma unroll
                for (int e = 0; e < 8; ++e) { pab[e] = ta[e]; pkv[e] = tk[e]; } }
#pragma unroll
            for (int e = 0; e < 8; ++e) { const int o = ((ec + ((e + c) & 7)) * LDB + et) * 2;
                *(LAS bf16*)(L + O_AHT + o) = (bf16)(pab[e] & 0xffffu); *(LAS bf16*)(L + O_BHT + o) = (bf16)(pab[e] >> 16);
                *(LAS bf16*)(L + O_KHT + o) = (bf16)(pkv[e] & 0xffffu); *(LAS bf16*)(L + O_VT + o) = (bf16)(pkv[e] >> 16); } } }
        __syncthreads();
        { if (wave & 1) m2_half<1>(L, wave >> 1, fr, fq); else m2_half<0>(L, wave >> 1, fr, fq); }
        __syncthreads();
        if (ci + 1 < T / CL_ / 2) { const int c0n = (d == 0) ? c0 + CL_ : c0 - CL_; load_raw(raw, PRW, VFIRST, b, (d == 0) ? c0n + et : c0n + 63 - et, hc, ec, d, l, (tid & 7) < 4); }
        { blk_stage<false, true, false>(L + O_XA, L + O_XAT, nullptr, nullptr, nullptr, L + O_AH, L + O_KH, wave, fr, fq); }
        __syncthreads();
        { blk_stage<true, true, false>(L + O_AH, L + O_KH, L + O_UT, L + O_BH, nullptr, L + O_XA, L + O_XAT, wave, fr, fq); }
        __syncthreads();
        { blk_stage<true, true, false>(L + O_XA, L + O_XAT, L + O_BH, L + O_UT, nullptr, L + O_AH, L + O_KH, wave, fr, fq); }
        __syncthreads();
        { blk_stage<true, true, false>(L + O_AH, L + O_KH, L + O_UT, L + O_BH, nullptr, L + O_XA, L + O_XAT, wave, fr, fq); }
        __syncthreads();
        { blk_stage<true, false, true>(L + O_XA, L + O_XAT, L + O_BH, L + O_TB, L + O_T0T, nullptr, nullptr, wave, fr, fq); }
        __syncthreads();
        { if (wave < 4) { const int bmt = (wave >> 1) & 1, bnt = wave & 1;
            bf16x8 a0 = ldfrag(L + O_XA, LDB, 32, 0, fr, fq), a1 = ldfrag(L + O_XA, LDB, 48, 0, fr, fq), t1b = ldfrag(L + O_T0T, LDB, 16 * bnt, 0, fr, fq), t22 = ldfrag(L + O_TB, LDB, 32 + 16 * bmt, 32, fr, fq);
            const f32x4 z4 = (f32x4){0.f, 0.f, 0.f, 0.f};
            const f32x4 w0 = MFMA16(a0, t1b, z4), w1 = MFMA16(a1, t1b, z4);
            st_tile_bf16_T(L + O_WT, LDB, 0, 16 * bnt, fr, fq, w0); st_tile_bf16_T(L + O_WT, LDB, 16, 16 * bnt, fr, fq, w1);
            LDS_WAIT();
            const bf16x8 wb = ldfrag(L + O_WT, LDB, 16 * bnt, 0, fr, fq);
            const f32x4 t21 = MFMA16(t22, wb, z4);
            st_tile_bf16(L + O_TB, LDB, 32 + 16 * bmt, 16 * bnt, fr, fq, t21);
        } else { const int bmt = (wave >> 1) & 1, bnt = wave & 1;
            unsigned zz_ = 0u; asm volatile("" : "+v"(zz_)); *(LAS v2u*)(L + O_TB + ((16 * bmt + fr) * LDB + 32 + 16 * bnt + 4 * fq) * 2) = (v2u){zz_, zz_}; } }
        f32x4 y0[2] = {(f32x4){0.f, 0.f, 0.f, 0.f}, (f32x4){0.f, 0.f, 0.f, 0.f}}, g0[2] = {y0[0], y0[0]};
        { f32x4 m1[2] = {(f32x4){0.f, 0.f, 0.f, 0.f}, (f32x4){0.f, 0.f, 0.f, 0.f}};
          bf16x8 aak[2], ark[2], vta[2], vtb[2][2], khb[2][2];
          ldA(aak, L + O_AAK, mt, fr, fq); ldB(vtb, L + O_VT, nt0, fr, fq); ldA(ark, L + O_ARK, mt, fr, fq); ldA(vta, L + O_VT, mt, fr, fq); ldB(khb, L + O_KHT, nt0, fr, fq);
          CFENCE();
          mmac(aak, vtb, m1); mmacT(ark, vtb, y0); mmac(vta, khb, g0);
#pragma unroll
          for (int j = 0; j < 2; ++j) st_tile_bf16_T(L + O_M1T, LDB, 16 * mt, 16 * (nt0 + j), fr, fq, m1[j]); }
        __syncthreads();
        f32x4 u0[2] = {(f32x4){0.f, 0.f, 0.f, 0.f}, (f32x4){0.f, 0.f, 0.f, 0.f}};
        { f32x4 ap[2] = {u0[0], u0[0]};
          bf16x8 tba[2], ahb[2][2], m1b[2][2];
          ldA(tba, L + O_TB, mt, fr, fq); ldB(ahb, L + O_AHT, nt0, fr, fq); ldB(m1b, L + O_M1T, nt0, fr, fq);
          CFENCE();
          mmac(tba, ahb, ap); mmac(tba, m1b, u0);
#pragma unroll
          for (int j = 0; j < 2; ++j) st_tile_bf16(L + O_APB, LDB, 16 * mt, 16 * (nt0 + j), fr, fq, ap[j]);
          if (seg) {
#pragma unroll
              for (int j = 0; j < 2; ++j) st_tile_bf16(L + O_VT, LDB, 16 * mt, 16 * (nt0 + j), fr, fq, Ph[j]); } }
        __syncthreads();
        { bf16x8 apa[2], s0b[2][2], phb[2][2];
          ldA(apa, L + O_APB, mt, fr, fq); ldB(s0b, L + O_S0B, nt0, fr, fq); phb[0][0] = ZFRAG; phb[0][1] = ZFRAG; phb[1][0] = ZFRAG; phb[1][1] = ZFRAG; if (seg) ldB(phb, L + O_VT, nt0, fr, fq);
          CFENCE();
          mmac(apa, s0b, u0);
#pragma unroll
          for (int j = 0; j < 2; ++j) st_tile_bf16_T(L + O_UT, LDB, 16 * mt, 16 * (nt0 + j), fr, fq, u0[j]);
          if (seg) { f32x4 up[2] = {(f32x4){0.f, 0.f, 0.f, 0.f}, (f32x4){0.f, 0.f, 0.f, 0.f}};
              mmac(apa, phb, up);
#pragma unroll
              for (int j = 0; j < 2; ++j) st_tile_bf16_T(L + O_KHT, LDB, 16 * mt, 16 * (nt0 + j), fr, fq, up[j]); } }
        __syncthreads();
        { bf16x8 rha[2], arba[2], uta[2], s0b[2][2], utb[2][2], bhb[2][2]; float plv[2];
          ldA(rha, L + O_RH, mt, fr, fq); ldB(s0b, L + O_S0B, nt0, fr, fq); ldA(arba, L + O_ARB, mt, fr, fq); ldB(utb, L + O_UT, nt0, fr, fq);
#pragma unroll
          for (int j = 0; j < 2; ++j) plv[j] = *(LAS float*)(L + O_PL + (16 * (nt0 + j) + fr) * 4);
          CFENCE();
          mmacT(rha, s0b, y0);
          ldA(uta, L + O_UT, mt, fr, fq); ldB(bhb, L + O_BHT, nt0, fr, fq);
          CFENCE();
          mmacT(arba, utb, y0);
          { const int s = 16 * mt + fr; const int tk = (d == 0) ? c0 + s : c0 + 63 - s;
#pragma unroll
            for (int j = 0; j < 2; ++j) { v2u o; o.x = pk2(y0[j][0], y0[j][1]); o.y = pk2(y0[j][2], y0[j][3]); *(v2u*)(YS + ((size_t)b * T + tk) * CH + hc + 16 * (nt0 + j) + 4 * fq) = o; } }
          f32x4 sn[2] = {g0[0], g0[1]};
          mmac(uta, bhb, sn);
#pragma unroll
          for (int j = 0; j < 2; ++j) S[j] = (S[j] + sn[j]) * plv[j];
          if (seg) { f32x4 yp[2] = {(f32x4){0.f, 0.f, 0.f, 0.f}, (f32x4){0.f, 0.f, 0.f, 0.f}}, pn[2] = {yp[0], yp[0]};
              bf16x8 rh2[2], arb2[2], kha[2], phb[2][2], khb[2][2], bh2[2][2];
              ldA(rh2, L + O_RH, mt, fr, fq); ldB(phb, L + O_VT, nt0, fr, fq); ldA(arb2, L + O_ARB, mt, fr, fq); ldB(khb, L + O_KHT, nt0, fr, fq); ldA(kha, L + O_KHT, mt, fr, fq); ldB(bh2, L + O_BHT, nt0, fr, fq);
              CFENCE();
              mmacT(rh2, phb, yp);
              mmacT(arb2, khb, yp);
              { const int s = 16 * mt + fr; const int tk = (d == 0) ? c0 + s : c0 + 63 - s;
#pragma unroll
                for (int j = 0; j < 2; ++j) { v2u o; o.x = pk2(yp[j][0], yp[j][1]); o.y = pk2(yp[j][2], yp[j][3]); *(v2u*)(YPHI + (size_t)(tk & (T / 2 - 1)) * 64 + 16 * (nt0 + j) + 4 * fq) = o; } }
              mmac(kha, bh2, pn);
#pragma unroll
              for (int j = 0; j < 2; ++j) Ph[j] = (Ph[j] + pn[j]) * plv[j]; } }
        __syncthreads();
#pragma unroll
        for (int j = 0; j < 2; ++j) st_tile_bf16(L + O_S0B, LDB, 16 * mt, 16 * (nt0 + j), fr, fq, S[j]);
    }
    if (seg == 0) { float* SF = (float*)(F.ws + WS_SFIN) + (size_t)chain * 4096;
        int t2 = (int)__builtin_amdgcn_mbcnt_hi(~0u, __builtin_amdgcn_mbcnt_lo(~0u, 0u)); asm volatile("" : "+v"(t2)); const int fr2 = t2 & 15, fq2 = (t2 >> 4) & 3;
#pragma unroll
        for (int j = 0; j < 2; ++j)
#pragma unroll
            for (int jj = 0; jj < 4; ++jj) SF[(16 * mt + 4 * fq2 + jj) * 64 + 16 * (nt0 + j) + fr2] = S[j][jj]; }
    __syncthreads();
}


__device__ __forceinline__ void tr_item(const float* W, int ld, int col0, int nblk, int K, bf16* WT, int row_off, LAS float* scr, int item, int lane, const float* gain = nullptr) {
    const int kb = item / nblk, nb = item % nblk, k0 = 64 * kb, n0 = 32 * nb;
    float wv[32];
#pragma unroll
    for (int i = 0; i < 32; ++i) wv[i] = W[(size_t)(k0 + 2 * i + (lane >> 5)) * ld + col0 + n0 + (lane & 31)];
    if (gain) {
#pragma unroll
        for (int i = 0; i < 32; ++i) wv[i] *= gain[k0 + 2 * i + (lane >> 5)]; }
#pragma unroll
    for (int i = 0; i < 32; ++i) scr[(2 * i + (lane >> 5)) * 33 + (lane & 31)] = wv[i];
    LDS_WAIT(); asm volatile("" ::: "memory");
    const int c = lane & 7;
#pragma unroll
    for (int j = 0; j < 4; ++j) { const int n = (lane >> 3) + 8 * j; const LAS float* s = scr + (8 * c) * 33 + n;
        v4u o; o.x = pk2(s[0 * 33], s[1 * 33]); o.y = pk2(s[2 * 33], s[3 * 33]); o.z = pk2(s[4 * 33], s[5 * 33]); o.w = pk2(s[6 * 33], s[7 * 33]);
        *(v4u*)(WT + (size_t)(row_off + n0 + n) * K + k0 + 8 * c) = o; }
    LDS_WAIT(); asm volatile("" ::: "memory");
}
__device__ __forceinline__ void wq_max_item(const float* W, int ld, int col0, int nblk, unsigned* cmax, int item, int lane) {
    const int kb = item / nblk, nb = item % nblk, k0 = 64 * kb, n0 = 32 * nb; float am = 0.f;
#pragma unroll
    for (int i = 0; i < 32; ++i) am = fmaxf(am, fabsf(W[(size_t)(k0 + 2 * i + (lane >> 5)) * ld + col0 + n0 + (lane & 31)]));
    am = fmaxf(am, __shfl_xor(am, 32));
    if (lane < 32) atomicMax(cmax + n0 + lane, __float_as_uint(am));
}
__device__ __forceinline__ void wq_item(const float* W, int ld, int col0, int nblk, const unsigned* cmax, float* csc, unsigned char* WQ, int row_off, LAS float* scr, int item, int lane) {
    const int kb = item / nblk, nb = item % nblk, k0 = 64 * kb, n0 = 32 * nb;
    float wv[32];
#pragma unroll
    for (int i = 0; i < 32; ++i) wv[i] = W[(size_t)(k0 + 2 * i + (lane >> 5)) * ld + col0 + n0 + (lane & 31)];
#pragma unroll
    for (int i = 0; i < 32; ++i) scr[(2 * i + (lane >> 5)) * 33 + (lane & 31)] = wv[i];
    LDS_WAIT(); asm volatile("" ::: "memory");
    const int c = lane & 7;
#pragma unroll
    for (int j = 0; j < 4; ++j) { const int n = (lane >> 3) + 8 * j; const LAS float* sp = scr + (8 * c) * 33 + n;
        const float cm = __uint_as_float(cmax[n0 + n]), inv = cm > 0.f ? 127.0f / cm : 0.f;
        v2u o; o.x = q4(sp[0 * 33] * inv, sp[1 * 33] * inv, sp[2 * 33] * inv, sp[3 * 33] * inv); o.y = q4(sp[4 * 33] * inv, sp[5 * 33] * inv, sp[6 * 33] * inv, sp[7 * 33] * inv);
        *(v2u*)(WQ + (size_t)(row_off + n0 + n) * D + k0 + 8 * c) = o;
        if (kb == 0 && c == 0) csc[n0 + n] = cm * (1.0f / 127.0f); }
    LDS_WAIT(); asm volatile("" ::: "memory");
}
__device__ __forceinline__ void p_convert(Frame& F) {
    PHASE_TID();
    LAS float* scr = (LAS float*)(F.lds + wave * 16384);
    const int gw = bid * NWAVES + wave, NGW = F.G * NWAVES;
    constexpr int C_HY = 16 * 48, C_RW = 16 * 60, C_V1 = 16, C_O = 16 * 32, C_1 = 16 * 128, C_2 = 64 * 32, C_L = C_HY + C_RW + C_V1 + C_O + C_1 + C_2;
    for (int it = gw; it < NL * C_L; it += NGW) {
        const int l = it / C_L; int r = it % C_L;
        unsigned char* wb = F.ws + WS_W + (size_t)l * W_LAYER;
        const float* win = F.in[I_WIN] + (size_t)l * D * PIN;
        unsigned* cmax = F.ctl + CW_CMAX + l * (HYP + NRW);
        if (r < C_HY) { wq_max_item(win, PIN, 0, 48, cmax, r, lane); continue; } r -= C_HY;
        if (r < C_RW) { wq_max_item(win, PIN, HYP, 60, cmax + HYP, r, lane); continue; } r -= C_RW;
        if (r < C_V1) { if (l == 1) wq_max_item(F.in[I_V1], 32, 0, 1, cmax + HYP + RWP, r, lane); continue; } r -= C_V1;
        if (r < C_O) { tr_item(F.in[I_WOUT] + (size_t)l * D * D, D, 0, 32, D, (bf16*)(wb + W_O), 0, scr, r, lane); continue; } r -= C_O;
        if (r < C_1) { tr_item(F.in[I_MW1] + (size_t)l * D * FF, FF, 0, 128, D, (bf16*)(wb + W_1), 0, scr, r, lane, F.in[I_N2G] + (size_t)l * D); continue; } r -= C_1;
        tr_item(F.in[I_MW2] + (size_t)l * FF * D, D, 0, 32, FF, (bf16*)(wb + W_2), 0, scr, r, lane);
    }
}
__device__ __forceinline__ void p_wquant(Frame& F) {
    PHASE_TID();
    LAS float* scr = (LAS float*)(F.lds + wave * 16384);
    const int gw = bid * NWAVES + wave, NGW = F.G * NWAVES;
    constexpr int C_HY = 16 * 48, C_RW = 16 * 60, C_V1 = 16, C_L = C_HY + C_RW + C_V1;
    for (int it = gw; it < NL * C_L; it += NGW) {
        const int l = it / C_L; int r = it % C_L;
        unsigned char* wb = F.ws + WS_W + (size_t)l * W_LAYER;
        const float* win = F.in[I_WIN] + (size_t)l * D * PIN;
        const unsigned* cmax = F.ctl + CW_CMAX + l * (HYP + NRW); float* csc = (float*)(F.ws + WS_CSC) + l * (HYP + NRW);
        if (r < C_HY) { wq_item(win, PIN, 0, 48, cmax, csc, wb + W_HY, 0, scr, r, lane); continue; } r -= C_HY;
        if (r < C_RW) { wq_item(win, PIN, HYP, 60, cmax + HYP, csc + HYP, wb + W_RW, 0, scr, r, lane); continue; } r -= C_RW;
        if (l == 1) wq_item(F.in[I_V1], 32, 0, 1, cmax + HYP + RWP, csc + HYP + RWP, wb + W_RW, RWP, scr, r, lane);
    }
    for (int l = 0; l < NL; ++l) {
        const int r0 = (l == 0) ? RWP : RWP + 32; const int n16 = (NRW - r0) * D / 16;
        v4u* p = (v4u*)(F.ws + WS_W + (size_t)l * W_LAYER + W_RW + (size_t)r0 * D);
        for (int i = bid * NTHR + tid; i < n16; i += F.G * NTHR) p[i] = (v4u){0u, 0u, 0u, 0u};
        float* csc = (float*)(F.ws + WS_CSC) + l * (HYP + NRW) + HYP;
        if (bid == 0 && tid < NRW - r0) csc[r0 + tid] = 0.f;
    }
}

__device__ __forceinline__ void p_filter_item(Frame& F, int l, int item) {
    LAS float* Z = (LAS float*)F.lds;
    LAS float* H1 = Z + 32 * 36;
    LAS float* H2 = H1 + 32 * 64;
    LAS float* H3 = H2 + 32 * 64;
    PHASE_TID(); const int pos0 = item * 32;
    const float* w1 = F.in[I_FW1] + l * 33 * 64; const float* b1 = F.in[I_FB1] + l * 64;
    const float* w2 = F.in[I_FW2] + l * 64 * 64; const float* b2 = F.in[I_FB2] + l * 64;
    const float* w3 = F.in[I_FW3] + l * 64 * 64; const float* b3 = F.in[I_FB3] + l * 64;
    const float* fq = F.in[I_FFREQ] + l * 3 * 64;
    __syncthreads();
    for (int e = tid; e < 32 * 33; e += NTHR) {
        const int p = e / 33, f = e % 33, pos = pos0 + p; float v;
        if (f == 0) v = (float)pos / (float)(T - 1);
        else { const int band = (f - 1) & 15; const float fr = 1e-4f + (float)band * ((15.0f - 1e-4f) / 15.0f);
            float x = (float)pos * fr * (1.0f / (float)T); x -= floorf(x);
            v = (f <= 16) ? __builtin_amdgcn_cosf(x) : -__builtin_amdgcn_sinf(x); }
        Z[p * 36 + f] = v;
    }
    __syncthreads();
    const int j = tid & 63, pb = tid >> 6;
    { float wc[33];
#pragma unroll
      for (int f = 0; f < 33; ++f) wc[f] = w1[f * 64 + j];
      const float bj = b1[j], fj = fq[j];
#pragma unroll
      for (int i = 0; i < 4; ++i) { const int p = pb + 8 * i; float s = bj;
#pragma unroll
          for (int f = 0; f < 33; ++f) s += Z[p * 36 + f] * wc[f];
          H1[p * 64 + j] = sin_hw(fj * s); } }
    __syncthreads();
#pragma unroll 1
    for (int ly = 0; ly < 2; ++ly) { const float* w = ly ? w3 : w2; const float* bb = ly ? b3 : b2; const LAS float* Hi = ly ? H2 : H1; LAS float* Ho = ly ? H3 : H2;
        float wc[64];
#pragma unroll
        for (int f = 0; f < 64; ++f) wc[f] = w[f * 64 + j];
        const float bj = bb[j], fj = fq[64 + 64 * ly + j];
#pragma unroll
        for (int i = 0; i < 4; ++i) { const int p = pb + 8 * i; float s = bj;
#pragma unroll
            for (int q = 0; q < 16; ++q) { const f32x4 h = *(const LAS f32x4*)(Hi + p * 64 + 4 * q); s += (h[0] * wc[4 * q] + h[1] * wc[4 * q + 1]) + (h[2] * wc[4 * q + 2] + h[3] * wc[4 * q + 3]); }
            Ho[p * 64 + j] = sin_hw(fj * s); }
        __syncthreads(); }
    const int fr = lane & 15, fqd = lane >> 4;
    bf16x8 af[2][2];
#pragma unroll
    for (int mt = 0; mt < 2; ++mt)
#pragma unroll
        for (int ks = 0; ks < 2; ++ks) { const LAS float* hp = H3 + (16 * mt + fr) * 64 + 32 * ks + 8 * fqd; const f32x4 h0 = *(const LAS f32x4*)hp, h1 = *(const LAS f32x4*)(hp + 4);
            const float hv[8] = {h0[0], h0[1], h0[2], h0[3], h1[0], h1[1], h1[2], h1[3]}; af[mt][ks] = __builtin_bit_cast(bf16x8, pack8(hv)); }
    const float* wo = F.in[I_FWOUT] + (size_t)l * 64 * 2048;
    float* HF = (float*)(F.ws + WS_HF);
#pragma unroll 1
    for (int tb = 0; tb < 16; tb += 4) {
        bf16x8 bfr[4][2];
#pragma unroll
        for (int u = 0; u < 4; ++u)
#pragma unroll
            for (int ks = 0; ks < 2; ++ks) { float v[8]; const float* wp = wo + (size_t)(32 * ks + 8 * fqd) * 2048 + 256 * wave + 16 * (tb + u) + fr;
#pragma unroll
                for (int e = 0; e < 8; ++e) v[e] = wp[(size_t)e * 2048];
                bfr[u][ks] = __builtin_bit_cast(bf16x8, pack8(v)); }
#pragma unroll
        for (int u = 0; u < 4; ++u) { const int col = 256 * wave + 16 * (tb + u) + fr, c = col & 511;
            const float delta = 3.0701134573f + (float)c * ((15.350567286f - 3.0701134573f) / 511.0f);
#pragma unroll
            for (int mt = 0; mt < 2; ++mt) { f32x4 acc = (f32x4){0.f, 0.f, 0.f, 0.f};
                acc = MFMA16(af[mt][0], bfr[u][0], acc); acc = MFMA16(af[mt][1], bfr[u][1], acc);
                f32x4 o;
#pragma unroll
                for (int jj = 0; jj < 4; ++jj) { const float t = (float)(pos0 + 16 * mt + 4 * fqd + jj) / (float)(T - 1); o[jj] = acc[jj] * __expf(-t * delta); }
                *(f32x4*)(HF + (size_t)col * T + pos0 + 16 * mt + 4 * fqd) = o; } } }
}
__device__ __forceinline__ void p_filter(Frame& F, int l) { PHASE_TID(); (void)tid; for (int it = bid; it < T / 32; it += F.G) p_filter_item(F, l, it); __syncthreads(); }

template <bool F32IN> __device__ __forceinline__ void p_rmsnorm_q(Frame& F, const void* xin, const float* g, unsigned char* HQ, float* RSC, int m0, int m1) {
    PHASE_TID();
    const int gw = bid * NWAVES + wave, NGW = F.G * NWAVES;
    constexpr int R = F32IN ? 2 : 4;
    f32x4 gv[4];
#pragma unroll
    for (int j = 0; j < 4; ++j) gv[j] = F32IN ? *(const f32x4*)(g + 4 * lane + 256 * j) : *(const f32x4*)(g + 16 * lane + 4 * j);
    for (int mb = m0 + gw; mb < m1; mb += R * NGW) {
        f32x4 xf[F32IN ? R : 1][4]; v4u xw[F32IN ? 1 : R][2];
#pragma unroll
        for (int r = 0; r < R; ++r) { const int m = mb + r * NGW;
            if (F32IN) { const f32x4* xr = (const f32x4*)((const float*)xin + (size_t)m * D) + lane;
#pragma unroll
                for (int j = 0; j < 4; ++j) xf[r][j] = xr[64 * j]; }
            else { const v4u* xr = (const v4u*)((const bf16*)xin + (size_t)m * D + 16 * lane); xw[r][0] = xr[0]; xw[r][1] = xr[1]; } }
        asm volatile("" ::: "memory");
#pragma unroll
        for (int r = 0; r < R; ++r) { const int m = mb + r * NGW;
            f32x4 v[4]; float s = 0.f;
            if (F32IN) {
#pragma unroll
                for (int j = 0; j < 4; ++j) v[j] = xf[r][j]; }
            else { const unsigned ww[8] = {xw[r][0].x, xw[r][0].y, xw[r][0].z, xw[r][0].w, xw[r][1].x, xw[r][1].y, xw[r][1].z, xw[r][1].w};
#pragma unroll
                for (int j = 0; j < 4; ++j) v[j] = (f32x4){bflo(ww[2 * j]), bfhi(ww[2 * j]), bflo(ww[2 * j + 1]), bfhi(ww[2 * j + 1])}; }
#pragma unroll
            for (int j = 0; j < 4; ++j) s += (v[j].x * v[j].x + v[j].y * v[j].y) + (v[j].z * v[j].z + v[j].w * v[j].w);
            const float rstd = 1.0f / sqrtf(wave_sum(s) * (1.0f / D) + RMS_EPS);
            float am = 0.f;
#pragma unroll
            for (int j = 0; j < 4; ++j) { v[j] = v[j] * rstd * gv[j]; am = fmaxf(fmaxf(am, fmaxf(fabsf(v[j].x), fabsf(v[j].y))), fmaxf(fabsf(v[j].z), fabsf(v[j].w))); }
            am = wave_max(am);
            const float inv = am > 0.f ? 127.0f / am : 0.f;
            unsigned qd[4];
#pragma unroll
            for (int j = 0; j < 4; ++j) qd[j] = q4(v[j].x * inv, v[j].y * inv, v[j].z * inv, v[j].w * inv);
            if (F32IN) {
#pragma unroll
                for (int j = 0; j < 4; ++j) *(unsigned*)(HQ + (size_t)m * D + 256 * j + 4 * lane) = qd[j]; }
            else *(v4u*)(HQ + (size_t)m * D + 16 * lane) = (v4u){qd[0], qd[1], qd[2], qd[3]};
            if (lane == 0) RSC[m] = am * (1.0f / 127.0f); }
    }
}
__device__ __forceinline__ void p_rmsnorm_b16(Frame& F, const bf16* x, const float* g, bf16* out, int m0, int m1) {
    PHASE_TID();
    const int gw = bid * NWAVES + wave, NGW = F.G * NWAVES;
    f32x4 gv[4];
#pragma unroll
    for (int j = 0; j < 4; ++j) gv[j] = *(const f32x4*)(g + 16 * lane + 4 * j);
    for (int m = m0 + gw; m < m1; m += NGW) {
        const v4u* xr = (const v4u*)(x + (size_t)m * D + 16 * lane); const v4u w0 = xr[0], w1 = xr[1];
        const unsigned ww[8] = {w0.x, w0.y, w0.z, w0.w, w1.x, w1.y, w1.z, w1.w}; f32x4 v[4]; float s = 0.f;
#pragma unroll
        for (int j = 0; j < 4; ++j) { v[j] = (f32x4){bflo(ww[2 * j]), bfhi(ww[2 * j]), bflo(ww[2 * j + 1]), bfhi(ww[2 * j + 1])}; s += (v[j].x * v[j].x + v[j].y * v[j].y) + (v[j].z * v[j].z + v[j].w * v[j].w); }
        const float rstd = 1.0f / sqrtf(wave_sum(s) * (1.0f / D) + RMS_EPS);
        v4u o[2];
#pragma unroll
        for (int j = 0; j < 2; ++j) { const f32x4 ya = v[2 * j] * rstd * gv[2 * j], yb = v[2 * j + 1] * rstd * gv[2 * j + 1]; o[j].x = pk2(ya.x, ya.y); o[j].y = pk2(ya.z, ya.w); o[j].z = pk2(yb.x, yb.y); o[j].w = pk2(yb.z, yb.w); }
        v4u* op = (v4u*)(out + (size_t)m * D + 16 * lane); op[0] = o[0]; op[1] = o[1];
    }
}
__device__ __forceinline__ void p_finalnorm(Frame& F, const bf16* x, const float* g, float* out) {
    PHASE_TID();
    const int gw = bid * NWAVES + wave, NGW = F.G * NWAVES;
    constexpr int R = 4;
    f32x4 gv[4];
#pragma unroll
    for (int j = 0; j < 4; ++j) gv[j] = *(const f32x4*)(g + 4 * lane + 256 * j);
    for (int mb = gw; mb < M; mb += R * NGW) {
        v2u xw[R][4];
#pragma unroll
        for (int r = 0; r < R; ++r) { const v2u* xr = (const v2u*)(x + (size_t)(mb + r * NGW) * D) + lane;
#pragma unroll
            for (int j = 0; j < 4; ++j) xw[r][j] = xr[64 * j]; }
        asm volatile("" ::: "memory");
#pragma unroll
        for (int r = 0; r < R; ++r) { f32x4 v[4]; float s = 0.f;
#pragma unroll
            for (int j = 0; j < 4; ++j) { v[j] = (f32x4){bflo(xw[r][j].x), bfhi(xw[r][j].x), bflo(xw[r][j].y), bfhi(xw[r][j].y)}; s += (v[j].x * v[j].x + v[j].y * v[j].y) + (v[j].z * v[j].z + v[j].w * v[j].w); }
            const float rstd = 1.0f / sqrtf(wave_sum(s) * (1.0f / D) + RMS_EPS);
            f32x4* o = (f32x4*)(out + (size_t)(mb + r * NGW) * D) + lane;
#pragma unroll
            for (int j = 0; j < 4; ++j) o[64 * j] = v[j] * rstd * gv[j]; }
    }
}
template <bool F32OUT> __device__ __forceinline__ void p_rmsnorm(Frame& F, const float* x, const float* g, void* outp, int m0, int m1) {
    PHASE_TID();
    const int gw = bid * NWAVES + wave, NGW = F.G * NWAVES;
    f32x4 gv[4];
#pragma unroll
    for (int j = 0; j < 4; ++j) gv[j] = *(const f32x4*)(g + 4 * lane + 256 * j);
    for (int m = m0 + gw; m < m1; m += NGW) {
        const f32x4* xr = (const f32x4*)(x + (size_t)m * D) + lane; f32x4 v[4]; float s = 0.f;
#pragma unroll
        for (int j = 0; j < 4; ++j) { v[j] = xr[64 * j]; s += (v[j].x * v[j].x + v[j].y * v[j].y) + (v[j].z * v[j].z + v[j].w * v[j].w); }
        const float rstd = 1.0f / sqrtf(wave_sum(s) * (1.0f / D) + RMS_EPS);
        if (F32OUT) { f32x4* o = (f32x4*)((float*)outp + (size_t)m * D) + lane;
#pragma unroll
            for (int j = 0; j < 4; ++j) o[64 * j] = v[j] * rstd * gv[j]; }
        else { v2u* o = (v2u*)((bf16*)outp + (size_t)m * D) + lane;
#pragma unroll
            for (int j = 0; j < 4; ++j) { const f32x4 y = v[j] * rstd * gv[j]; v2u w; w.x = pk2(y.x, y.y); w.y = pk2(y.z, y.w); o[64 * j] = w; } }
    }
}

constexpr int KPAD = 2 * T + 2 * T / 16;

constexpr int LC = 32;

__device__ __forceinline__ void p_mix(Frame& F, int l) {
    PHASE_TID();
#ifndef NO_SCAN
#ifdef SEQ_SCAN
    if (bid < 128) scan_chain(F, l, bid);
#else
    cscan_chain(F, l, bid);
#endif
#endif
    unsigned* head = F.ctl + CW_QUEUE + 64 * l;
    for (;;) {
        __syncthreads();
        if (tid == 0) F.MISC[16] = __hip_atomic_fetch_add(head, 1u, RLX_AGENT);
        __syncthreads();
        const unsigned it = F.MISC[16];
        if (it >= (unsigned)(4 * CH)) break;
        hy_fft_item(F, l, (int)it);
    }
    __syncthreads();
}

__device__ __forceinline__ void p_post(Frame& F, int l) {
    PHASE_TID();
    const int gw = bid * NWAVES + wave, NGW = F.G * NWAVES;
    bf16* YM = (bf16*)(F.ws + WS_YMIX);
    { LAS float* scr = (LAS float*)(F.lds + wave * 16640);
      const bf16* PHT = (const bf16*)(F.ws + WS_PHT); const float* ng = F.in[I_HNG] + (size_t)l * CH;
      for (int it = gw; it < NB * 8 * (T / 64); it += NGW) { const int tb = it & 127, g = (it >> 7) & 7, b = it >> 10, t0 = tb * 64;
          const bf16* src = PHT + ((size_t)b * HYP + CH + g * 64 + lane) * T + t0;
#pragma unroll
          for (int q = 0; q < 8; ++q) { const v4u w = *(const v4u*)(src + 8 * q); LAS float* d = scr + lane * 65 + 8 * q;
              d[0] = bflo(w.x); d[1] = bfhi(w.x); d[2] = bflo(w.y); d[3] = bfhi(w.y); d[4] = bflo(w.z); d[5] = bfhi(w.z); d[6] = bflo(w.w); d[7] = bfhi(w.w); }
          LDS_WAIT(); asm volatile("" ::: "memory");
          float z[64], ss = 0.f;
#pragma unroll
          for (int cc = 0; cc < 64; ++cc) { z[cc] = scr[cc * 65 + lane]; ss += z[cc] * z[cc]; }
          const float rs = 1.0f / sqrtf(ss * (1.0f / 64.0f) + RMS_EPS);
          bf16* dst = YM + ((size_t)b * T + t0 + lane) * D + g * 64;
#pragma unroll
          for (int q = 0; q < 8; ++q) { v4u o; const float* gq = ng + g * 64 + 8 * q;
              o.x = pk2(z[8 * q] * rs * gq[0], z[8 * q + 1] * rs * gq[1]); o.y = pk2(z[8 * q + 2] * rs * gq[2], z[8 * q + 3] * rs * gq[3]);
              o.z = pk2(z[8 * q + 4] * rs * gq[4], z[8 * q + 5] * rs * gq[5]); o.w = pk2(z[8 * q + 6] * rs * gq[6], z[8 * q + 7] * rs * gq[7]);
              *(v4u*)(dst + 8 * q) = o; }
          LDS_WAIT(); asm volatile("" ::: "memory"); } }
}

struct PostRows { v4u a, c, v, g; float bs; };
__device__ __forceinline__ void post_rows_load(PostRows& R, const bf16* YS0, const bf16* YS1, const bf16* VV, const bf16* GG, const float* BS0, const float* BS1, size_t m, int h, int ec) {
    const size_t o = m * CH + h * HD + ec;
    R.a = *(const v4u*)(YS0 + o); R.c = *(const v4u*)(YS1 + o); R.v = *(const v4u*)(VV + o); R.g = *(const v4u*)(GG + o); R.bs = BS0[m * NH + h] + BS1[m * NH + h];
}
__device__ __forceinline__ void p_postfix(Frame& F, int l) {
    PHASE_TID(); const int fr = lane & 15, fq = lane >> 4, mtw = wave >> 1, ntw = 2 * (wave & 1), et = tid >> 3, ec = (tid & 7) * 8;
    const int bh = bid >> 2, b = bh >> 3, h = bh & 7, tq = bid & 3, dfix = (tq >= 2) ? 0 : 1, chain = (b * NH + h) * 2 + dfix;
    const float* SF = (const float*)(F.ws + WS_SFIN) + (size_t)chain * 4096;
    bf16x8 sfb[2][2];
#pragma unroll
    for (int ks = 0; ks < 2; ++ks)
#pragma unroll
        for (int j = 0; j < 2; ++j) { const float* sp = SF + (16 * (ntw + j) + fr) * 64 + 32 * ks + 8 * fq; const f32x4 s0 = *(const f32x4*)sp, s1 = *(const f32x4*)(sp + 4);
            const float sv[8] = {s0[0], s0[1], s0[2], s0[3], s1[0], s1[1], s1[2], s1[3]}; sfb[ks][j] = __builtin_bit_cast(bf16x8, pack8(sv)); }
    const bf16* YP = (const bf16*)(F.ws + WS_YPHI) + ((size_t)chain * (T / 2) + 16 * mtw + fr) * 64 + 8 * fq;
    const bf16* YS0 = (const bf16*)(F.ws + WS_YS); const bf16* YS1 = YS0 + (size_t)M * CH;
    const bf16* VV = (l == 0) ? (const bf16*)(F.ws + WS_VFIRST) : (const bf16*)(F.ws + WS_V2);
    const bf16* GG = (const bf16*)(F.ws + WS_G); const float* BS0 = (const float*)(F.ws + WS_BS); const float* BS1 = BS0 + (size_t)M * NH;
    bf16* YM = (bf16*)(F.ws + WS_YMIX);
    float lg[8], lb[8];
#pragma unroll
    for (int j = 0; j < 8; ++j) { lg[j] = F.in[I_LNG][l * CH + h * HD + ec + j]; lb[j] = F.in[I_LNB][l * CH + h * HD + ec + j]; }
    LAS float* FX = (LAS float*)F.lds;
    const size_t mb = (size_t)b * T + 64 * (32 * tq) + et;
    __syncthreads();
    PostRows cur; bf16x8 acur[2];
    post_rows_load(cur, YS0, YS1, VV, GG, BS0, BS1, mb, h, ec);
#pragma unroll
    for (int ks = 0; ks < 2; ++ks) acur[ks] = *(const bf16x8*)(YP + (size_t)((32 * tq) & 63) * 64 * 64 + 32 * ks);
#pragma unroll 1
    for (int t = 0; t < 32; ++t) {
        PostRows nxt; bf16x8 anxt[2]; const int tn = (t + 1 < 32) ? t + 1 : t;
        post_rows_load(nxt, YS0, YS1, VV, GG, BS0, BS1, mb + 64 * tn, h, ec);
#pragma unroll
        for (int ks = 0; ks < 2; ++ks) anxt[ks] = *(const bf16x8*)(YP + (size_t)((32 * tq + tn) & 63) * 64 * 64 + 32 * ks);
        { f32x4 acc[2] = {(f32x4){0.f, 0.f, 0.f, 0.f}, (f32x4){0.f, 0.f, 0.f, 0.f}};
#pragma unroll
          for (int ks = 0; ks < 2; ++ks)
#pragma unroll
              for (int j = 0; j < 2; ++j) acc[j] = MFMA16(sfb[ks][j], acur[ks], acc[j]);
          LAS float* fx = FX + (t & 1) * 64 * 68 + (16 * mtw + fr) * 68 + 16 * ntw + 4 * fq;
          *(LAS f32x4*)fx = acc[0]; *(LAS f32x4*)(fx + 16) = acc[1]; }
        __syncthreads();
        { const LAS float* fx = FX + (t & 1) * 64 * 68 + et * 68 + ec; const f32x4 f0 = *(const LAS f32x4*)fx, f1 = *(const LAS f32x4*)(fx + 4);
          const float fv[8] = {f0[0], f0[1], f0[2], f0[3], f1[0], f1[1], f1[2], f1[3]};
          const unsigned aw[4] = {cur.a.x, cur.a.y, cur.a.z, cur.a.w}, cw[4] = {cur.c.x, cur.c.y, cur.c.z, cur.c.w}, vx[4] = {cur.v.x, cur.v.y, cur.v.z, cur.v.w}, gx[4] = {cur.g.x, cur.g.y, cur.g.z, cur.g.w};
          float sv[8], sum = 0.f;
#pragma unroll
          for (int j = 0; j < 4; ++j) { sv[2 * j] = bflo(aw[j]) + bflo(cw[j]) + fv[2 * j]; sv[2 * j + 1] = bfhi(aw[j]) + bfhi(cw[j]) + fv[2 * j + 1]; sum += sv[2 * j] + sv[2 * j + 1]; }
          const float mean = sum8(sum) * (1.0f / 64.0f); float q = 0.f;
#pragma unroll
          for (int j = 0; j < 8; ++j) { sv[j] -= mean; q += sv[j] * sv[j]; }
          const float rs = 1.0f / sqrtf(sum8(q) * (1.0f / 64.0f) + GN_EPS);
          float y[8];
#pragma unroll
          for (int j = 0; j < 4; ++j) { y[2 * j] = (sv[2 * j] * rs * lg[2 * j] + lb[2 * j] + cur.bs * bflo(vx[j])) * bflo(gx[j]);
                                        y[2 * j + 1] = (sv[2 * j + 1] * rs * lg[2 * j + 1] + lb[2 * j + 1] + cur.bs * bfhi(vx[j])) * bfhi(gx[j]); }
          v4u ov; ov.x = pk2(y[0], y[1]); ov.y = pk2(y[2], y[3]); ov.z = pk2(y[4], y[5]); ov.w = pk2(y[6], y[7]);
          *(v4u*)(YM + (mb + 64 * t) * D + CH + h * HD + ec) = ov; }
        cur = nxt; acur[0] = anxt[0]; acur[1] = anxt[1];
    }
    __syncthreads();
}
__device__ __forceinline__ int obid() { int b = blockIdx.x; asm volatile("" : "+s"(b)); return b; }
struct Args { const float* in[34]; float* out; unsigned char* ws; int ph_lo, ph_hi; };
__global__ void __launch_bounds__(NTHR, 2) enc_fwd(Args args) {
    extern __shared__ __attribute__((aligned(16))) unsigned char lds[];
    Frame F;
    F.lds = (LAS unsigned char*)lds;
    F.MISC = (volatile LAS unsigned*)(F.lds + LDSCTL_OFF);
    F.G = gridDim.x;
    F.ws = args.ws; F.out = args.out; F.ctl = (unsigned*)(args.ws + WS_CTL);
    F.in = args.in;
    for (int u = threadIdx.x; u < (LDS_BYTES - LDSCTL_OFF) / 4; u += NTHR) F.MISC[u] = 0u;
    __syncthreads();
    const XcdBarrier bar = xcd_barrier_post(F.ctl + CW_BAR, F.MISC + 8);
#define SEAM() xcd_barrier(bar)

    bf16* HN = (bf16*)(F.ws + WS_HN);
    float* RSS = (float*)(F.ws + WS_RSS);
    unsigned char* HQ = F.ws + WS_HN; float* RSC = (float*)(F.ws + WS_RSC);
    p_convert(F); __syncthreads(); p_filter(F, 0); p_rmsnorm_q<true>(F, F.in[I_X], F.in[I_N1G], HQ, RSC, 0, M / 2);
    SEAM();
    p_wquant(F);
    SEAM();
#pragma unroll 1
    for (int l = 0; l < NL; ++l) {
        unsigned char* wb = F.ws + WS_W + (size_t)l * W_LAYER;
        bf16* X2B = (bf16*)F.out;
        {
#pragma unroll 1
            for (int hf = 0; hf < 2; ++hf) { constexpr int MH = M / 2; const size_t r0 = (size_t)hf * MH;
                if (hf == 0) p_spectra(F);
                const float* CSC = (const float*)(F.ws + WS_CSC) + l * (HYP + NRW);
                { pg8::Gemm g{(const bf16*)(wb + W_HY), (const bf16*)(HQ + r0 * D), HYP, MH, D / 2}; pg8::StaticOrder S; S.init(HYP, MH, F.G, obid());
                  pg8::EpiBf16Q E{(bf16*)(F.ws + WS_PHT) + (size_t)(4 * hf) * HYP * T, (size_t)T, (size_t)HYP * T, 13, CSC, RSC + r0};
                  pg8::gemm_phase<pg8::EpiBf16Q, pg8::StaticOrder, true, true>(F.lds, g, S, E); }
                { pg8::Gemm g{(const bf16*)(HQ + r0 * D), (const bf16*)(wb + W_RW), MH, NRW, D / 2}; pg8::StaticOrder S; S.init(MH, NRW, F.G, obid());
                  pg8::EpiBf16Q E{(bf16*)(F.ws + WS_PRW) + r0 * NRW, (size_t)NRW, 0, 31, RSC + r0, CSC + HYP};
                  pg8::gemm_phase<pg8::EpiBf16Q, pg8::StaticOrder, true, true>(F.lds, g, S, E); }
                if (hf == 0) { if (l == 0) p_rmsnorm_q<true>(F, F.in[I_X], F.in[I_N1G], HQ, RSC, MH, M); else p_rmsnorm_q<false>(F, X2B, F.in[I_N1G] + (size_t)l * D, HQ, RSC, MH, M);
                    SEAM(); } }
        }
        SEAM();
        p_mix(F, l);
        SEAM();
        { p_post(F, l); p_postfix(F, l); }
        SEAM();
        {
            if (l + 1 < NL) p_filter(F, l + 1);
            pg8::Gemm g{(const bf16*)(F.ws + WS_YMIX), (const bf16*)(wb + W_O), M, D, D}; pg8::StaticOrder S; S.init(M, D, F.G, obid());
            if (l == 0) { pg8::EpiRes<1, false> E{F.in[I_X], nullptr, HN, D, RSS}; pg8::gemm_phase<pg8::EpiRes<1, false>, pg8::StaticOrder, true, true>(F.lds, g, S, E); }
            else { pg8::EpiRes<1, true> E{nullptr, X2B, HN, D, RSS}; pg8::gemm_phase<pg8::EpiRes<1, true>, pg8::StaticOrder, true, true>(F.lds, g, S, E); }
        }
        SEAM();
#pragma unroll 1
        for (int ck = 0; ck < MLP_CHUNKS; ++ck) { constexpr int MC = M / MLP_CHUNKS; const size_t r0 = (size_t)ck * MC;
            bf16* HIDc = (bf16*)(F.ws + WS_HID + (size_t)(ck & 1) * MC * FF * 2);
            {
                pg8::Gemm g{HN + r0 * D, (const bf16*)(wb + W_1), MC, FF, D}; pg8::StaticOrder S; S.init(MC, FF, F.G, obid());
                pg8::EpiBf16<1> E{HIDc, (size_t)FF};
                pg8::gemm_phase<pg8::EpiBf16<1>, pg8::StaticOrder, true, true>(F.lds, g, S, E);
            }
            SEAM();
            {
                pg8::Gemm g{HIDc, (const bf16*)(wb + W_2), MC, D, FF}; pg8::StaticOrder S; S.init(MC, D, F.G, obid());
                pg8::EpiRes<2, true> E{nullptr, HN + r0 * D, ((l + 1 < NL) ? X2B : HN) + r0 * D, D, RSS + r0 * 16};
                pg8::gemm_phase<pg8::EpiRes<2, true>, pg8::StaticOrder, true, true>(F.lds, g, S, E);
            }
            if (ck == MLP_CHUNKS - 1 && l + 1 < NL) p_rmsnorm_q<false>(F, X2B, F.in[I_N1G] + (size_t)(l + 1) * D, HQ, RSC, 0, M / 2);
        }
        SEAM();
        if (l + 1 == NL) p_finalnorm(F, HN, F.in[I_FING], F.out);
    }
#undef SEAM
}

extern "C" void kernel_launch(void* const* d_in, const int* in_sizes, int n_in, void* d_out, int out_size, void* d_ws, size_t ws_size, hipStream_t stream) {
    static int grid = 0;
    if (grid == 0) {
        if (n_in != 34 || in_sizes[0] != M * D || out_size != M * D || ws_size < WS_END) {
            fprintf(stderr, "kernel_launch: unexpected problem: n_in %d in0 %d out %d ws %zu (need %zu); nothing launched\n", n_in, n_in > 0 ? in_sizes[0] : -1, out_size, ws_size, (size_t)WS_END); grid = -1; return; }
        int dev = 0, cus = 0, per_cu = 0;
        if (hipGetDevice(&dev) != hipSuccess || hipDeviceGetAttribute(&cus, hipDeviceAttributeMultiprocessorCount, dev) != hipSuccess) { grid = -1; return; }
        if (hipFuncSetAttribute((const void*)enc_fwd, hipFuncAttributeMaxDynamicSharedMemorySize, LDS_BYTES) != hipSuccess) { fprintf(stderr, "kernel_launch: hipFuncSetAttribute failed\n"); grid = -1; return; }
        if (hipOccupancyMaxActiveBlocksPerMultiprocessor(&per_cu, (const void*)enc_fwd, NTHR, LDS_BYTES) != hipSuccess || per_cu < 1)
            fprintf(stderr, "kernel_launch: note: occupancy query reports %d workgroups per CU\n", per_cu);
        (void)hipGetLastError();
        grid = cus;
        if (grid != 256) { fprintf(stderr, "kernel_launch: built for a 256-CU device (got %d); nothing launched\n", cus); grid = -1; return; }
    }
    if (grid < 0) return;
    if (hipMemsetAsync((char*)d_ws + WS_CTL, 0, CTL_ZERO_BYTES, stream) != hipSuccess) return;
    Args a{};
    for (int i = 0; i < 34; ++i) a.in[i] = (const float*)d_in[i];
    a.out = (float*)d_out; a.ws = (unsigned char*)d_ws;
    a.ph_lo = 0; a.ph_hi = 0;
    hipLaunchKernelGGL(enc_fwd, dim3(grid), dim3(NTHR), LDS_BYTES, stream, a);
}
```

```cpp
#include <hip/hip_runtime.h>
#include <cstdio>
#include <cstdint>
namespace pg8 {
#define PG8_LAS __attribute__((address_space(3)))
typedef unsigned short bf16_t;
typedef short bf16x8 __attribute__((ext_vector_type(8)));
typedef float f32x4 __attribute__((ext_vector_type(4)));
typedef int i32x4 __attribute__((ext_vector_type(4)));
template <bool I8> struct AccT { typedef f32x4 t; };
template <> struct AccT<true> { typedef i32x4 t; };
typedef unsigned u32x4 __attribute__((ext_vector_type(4)));
constexpr int BM = 256, BK = 64, HALF = 128, HTB = HALF * BK * 2  , STAGE_BYTES = 8 * HTB, NXCD = 8, WGM = 8;

__host__ __device__ __forceinline__ int lds_byte(int r, int c) { const int st = (r >> 4) * 2 + (c >> 5), rr = r & 15, cc = c & 31, ob = rr * 64 + cc * 2; return st * 1024 + (ob ^ (((ob >> 9) & 1) << 5)); }
__host__ __device__ __forceinline__ void stage_rc(int b, int& R, int& C) { const int st = b / 1024, sb = b % 1024, swz = sb ^ (((sb >> 9) & 1) << 5); R = (st >> 1) * 16 + swz / 64; C = (st & 1) * 32 + (swz % 64) / 2; }
__host__ __device__ __forceinline__ int perm32(int rho) { const int n = rho >> 4, i = rho & 15; return 8 * (i >> 2) + 4 * n + (i & 3); }

struct Unit { int pm, pn; };
struct Gemm { const bf16_t* A; const bf16_t* Bt; int M, N, K; };

struct StaticOrder {
    int nM, nN, nwg, G, c;
    __host__ __device__ void init(int M, int N, int G_, int c_) { nM = M / BM; nN = N / BM; nwg = nM * nN; G = G_; c = c_; }
    __host__ __device__ bool next(int i, Unit& u) const {
        const long L = (long)i * G + c; if (L >= nwg) return false;
        int wgid = (int)L; { const int q = nwg / NXCD, r = nwg % NXCD, xcd = wgid % NXCD, off = wgid / NXCD; wgid = (xcd < r ? xcd * (q + 1) : r * (q + 1) + (xcd - r) * q) + off; }
        const int nig = WGM * nN, gid = wgid / nig, fm = gid * WGM, gsz = (nM - fm) < WGM ? (nM - fm) : WGM;
        u.pm = fm + ((wgid % nig) % gsz); u.pn = (wgid % nig) / gsz; return true;
    }
    __device__ __forceinline__ void a_ready(const Unit&) const {}
    __device__ __forceinline__ void done(const Unit&) const {}
};
typedef float f32x2e __attribute__((ext_vector_type(2))); typedef __bf16 bf16x2e __attribute__((ext_vector_type(2)));
__device__ __forceinline__ unsigned cvt_pk_bf16(float lo, float hi) { return __builtin_bit_cast(unsigned, __builtin_convertvector((f32x2e){lo, hi}, bf16x2e)); }
template <int ACT> struct EpiBf16 {
    static constexpr bool PERM = true, AFTER_DRAIN = false, I8 = false;
    bf16_t* O; size_t ldc; size_t bstride = 0; int tshift = 31;
    __device__ __forceinline__ void operator()(const f32x4 (&acc)[2][2][4][2], const Unit& u, int wr, int wc, int fr, int fq) const {
        const int row0 = u.pm * BM + wr * 64 + fr; const int cb = u.pn * BM; const size_t col0 = (size_t)(cb >> tshift) * bstride + (size_t)(cb & ((1 << tshift) - 1)) + wc * 32 + 8 * fq;
#pragma unroll
        for (int ai = 0; ai < 2; ++ai)
#pragma unroll
            for (int m = 0; m < 4; ++m) { bf16_t* rowp = O + (size_t)(row0 + ai * HALF + m * 16) * ldc + col0;
#pragma unroll
                for (int bj = 0; bj < 2; ++bj) { f32x4 v0 = acc[ai][bj][m][0], v1 = acc[ai][bj][m][1];
                    if (ACT == 1) {
#pragma unroll
                        for (int j = 0; j < 4; ++j) { const float a = fmaxf(v0[j], 0.f), b = fmaxf(v1[j], 0.f); v0[j] = a * a; v1[j] = b * b; } }
                    u32x4 w; w.x = cvt_pk_bf16(v0[0], v0[1]); w.y = cvt_pk_bf16(v0[2], v0[3]); w.z = cvt_pk_bf16(v1[0], v1[1]); w.w = cvt_pk_bf16(v1[2], v1[3]);
                    *(u32x4*)(rowp + bj * HALF) = w;
                    } }
    }
};
struct EpiBf16Q {
    static constexpr bool PERM = true, AFTER_DRAIN = false, I8 = true;
    bf16_t* O; size_t ldc; size_t bstride; int tshift; const float* rs; const float* cs;
    __device__ __forceinline__ void operator()(const i32x4 (&acc)[2][2][4][2], const Unit& u, int wr, int wc, int fr, int fq) const {
        const int row0 = u.pm * BM + wr * 64 + fr; const int cb = u.pn * BM, ci0 = cb + wc * 32 + 8 * fq;
        const size_t col0 = (size_t)(cb >> tshift) * bstride + (size_t)(cb & ((1 << tshift) - 1)) + wc * 32 + 8 * fq;
        f32x4 cv[2][2];
#pragma unroll
        for (int bj = 0; bj < 2; ++bj) { cv[bj][0] = *(const f32x4*)(cs + ci0 + bj * HALF); cv[bj][1] = *(const f32x4*)(cs + ci0 + bj * HALF + 4); }
#pragma unroll
        for (int ai = 0; ai < 2; ++ai)
#pragma unroll
            for (int m = 0; m < 4; ++m) { const int row = row0 + ai * HALF + m * 16; bf16_t* rowp = O + (size_t)row * ldc + col0; const float r = rs[row];
#pragma unroll
                for (int bj = 0; bj < 2; ++bj) { const i32x4 a0 = acc[ai][bj][m][0], a1 = acc[ai][bj][m][1];
                    const f32x4 v0 = (f32x4){(float)a0[0], (float)a0[1], (float)a0[2], (float)a0[3]} * r * cv[bj][0], v1 = (f32x4){(float)a1[0], (float)a1[1], (float)a1[2], (float)a1[3]} * r * cv[bj][1];
                    u32x4 w; w.x = cvt_pk_bf16(v0[0], v0[1]); w.y = cvt_pk_bf16(v0[2], v0[3]); w.z = cvt_pk_bf16(v1[0], v1[1]); w.w = cvt_pk_bf16(v1[2], v1[3]);
                    *(u32x4*)(rowp + bj * HALF) = w; } }
    }
};
__device__ __forceinline__ float rss16(const float* p) { const f32x4 a = *(const f32x4*)p, b = *(const f32x4*)(p + 4), c = *(const f32x4*)(p + 8), d = *(const f32x4*)(p + 12);
    return (((a[0] + a[1]) + (a[2] + a[3])) + ((b[0] + b[1]) + (b[2] + b[3]))) + (((c[0] + c[1]) + (c[2] + c[3])) + ((d[0] + d[1]) + (d[2] + d[3]))); }
template <int MODE, bool RB16> struct EpiRes {
    static constexpr bool PERM = true, AFTER_DRAIN = false, I8 = false;
    const float* R; const bf16_t* RB; bf16_t* O; int ldc; float* rss;
    __device__ __forceinline__ void operator()(const f32x4 (&acc)[2][2][4][2], const Unit& u, int wr, int wc, int fr, int fq) const {
        const int row0 = u.pm * BM + wr * 64 + fr, col0 = u.pn * BM + wc * 32 + 8 * fq;
#pragma unroll
        for (int ai = 0; ai < 2; ++ai)
#pragma unroll
            for (int m = 0; m < 4; ++m) { const int row = row0 + ai * HALF + m * 16; const size_t off = (size_t)row * ldc + col0;
                f32x4 rv[2][2]; float ss = 0.f, sc = 1.0f;
                if (MODE == 2) sc = __builtin_amdgcn_rcpf(rss16(rss + (size_t)row * 16) * (1.0f / 1024.0f) + 1e-5f);
#pragma unroll
                for (int bj = 0; bj < 2; ++bj) {
                    if (RB16) { const u32x4 w = *(const u32x4*)(RB + off + bj * HALF);
                        rv[bj][0] = (f32x4){__builtin_bit_cast(float, w.x << 16), __builtin_bit_cast(float, w.x & 0xffff0000u), __builtin_bit_cast(float, w.y << 16), __builtin_bit_cast(float, w.y & 0xffff0000u)};
                        rv[bj][1] = (f32x4){__builtin_bit_cast(float, w.z << 16), __builtin_bit_cast(float, w.z & 0xffff0000u), __builtin_bit_cast(float, w.w << 16), __builtin_bit_cast(float, w.w & 0xffff0000u)}; }
                    else { rv[bj][0] = *(const f32x4*)(R + off + bj * HALF); rv[bj][1] = *(const f32x4*)(R + off + bj * HALF + 4); } }
#pragma unroll
                for (int bj = 0; bj < 2; ++bj) { f32x4 o0 = acc[ai][bj][m][0], o1 = acc[ai][bj][m][1];
                    if (MODE == 2) { o0 = o0 * sc; o1 = o1 * sc; }
                    o0 = o0 + rv[bj][0]; o1 = o1 + rv[bj][1];
                    if (MODE == 1) ss += ((o0[0] * o0[0] + o0[1] * o0[1]) + (o0[2] * o0[2] + o0[3] * o0[3])) + ((o1[0] * o1[0] + o1[1] * o1[1]) + (o1[2] * o1[2] + o1[3] * o1[3]));
                    u32x4 w; w.x = cvt_pk_bf16(o0[0], o0[1]); w.y = cvt_pk_bf16(o0[2], o0[3]); w.z = cvt_pk_bf16(o1[0], o1[1]); w.w = cvt_pk_bf16(o1[2], o1[3]);
                    *(u32x4*)(O + off + bj * HALF) = w; }
                if (MODE == 1) { ss += __shfl_xor(ss, 16); ss += __shfl_xor(ss, 32); if (fq == 0) rss[(size_t)row * 16 + u.pn * 4 + wc] = ss; }
                asm volatile("" ::: "memory"); }
    }
};

template <bool I8> __device__ __forceinline__ typename AccT<I8>::t pg8_mma16(const bf16x8& a, const bf16x8& b, const typename AccT<I8>::t& c) {
    if constexpr (I8) return __builtin_amdgcn_mfma_i32_16x16x64_i8(__builtin_bit_cast(i32x4, a), __builtin_bit_cast(i32x4, b), c, 0, 0, 0);
    else return __builtin_amdgcn_mfma_f32_16x16x32_bf16(a, b, c, 0, 0, 0);
}
template <class Epi, class Sched, bool ALIGN_EPI = false, bool SP2 = false>
__device__ __forceinline__ void gemm_phase(PG8_LAS unsigned char* lds, const Gemm g, const Sched& S, const Epi& E) {
    int tid = threadIdx.x; asm volatile("" : "+v"(tid));
    const int wid = __builtin_amdgcn_readfirstlane(tid >> 6), lane = tid & 63, wr = wid >> 2, wc = wid & 3, fr = lane & 15, fq = lane >> 4;
    const int K = g.K, nt = K / BK;
    unsigned voffA[2], voffB[2];
#pragma unroll
    for (int i = 0; i < 2; ++i) { int R, C; stage_rc(tid * 16 + i * 8192, R, C); const int Rb = Epi::PERM ? ((R & ~31) + perm32(R & 31)) : R;
        voffA[i] = (unsigned)(R * K + C) * 2u; voffB[i] = (unsigned)(Rb * K + C) * 2u; }
    const size_t kstep = (size_t)(BK * 2);
    const size_t hstep = (size_t)HALF * K * 2;
    const size_t tstep = 2 * hstep;
    const unsigned ldsw = (unsigned)wid * 1024u;
    const int aoff = lds_byte(wr * 64 + fr, fq * 8), boff = lds_byte(wc * 32 + fr, fq * 8);
#define PG8_SA(b, h) (((b) * 2 + (h)) * HTB)
#define PG8_SB(b, h) ((4 + (b) * 2 + (h)) * HTB)
#define PG8_STAGE(bufoff, gbase, voff) do { _Pragma("unroll") for (int _i = 0; _i < 2; ++_i) \
        __builtin_amdgcn_global_load_lds((const unsigned*)((const char*)(gbase) + (voff)[_i]), (PG8_LAS unsigned*)(lds + (bufoff) + ldsw + _i * 8192), 16, 0, 0); } while (0)
#define PG8_LDA(dst, b, h) do { _Pragma("unroll") for (int m = 0; m < 4; ++m) _Pragma("unroll") for (int k = 0; k < 2; ++k) dst[m][k] = *(const PG8_LAS bf16x8*)(lds + PG8_SA(b, h) + aoff + m * 2048 + k * 1024); } while (0)
#define PG8_LDB(dst, b, h) do { _Pragma("unroll") for (int n = 0; n < 2; ++n) _Pragma("unroll") for (int k = 0; k < 2; ++k) dst[n][k] = *(const PG8_LAS bf16x8*)(lds + PG8_SB(b, h) + boff + n * 2048 + k * 1024); } while (0)
#define PG8_MMA(ai, bj, At, Bt) do { __builtin_amdgcn_s_setprio(1); _Pragma("unroll") for (int m = 0; m < 4; ++m) _Pragma("unroll") for (int n = 0; n < 2; ++n) _Pragma("unroll") for (int k = 0; k < 2; ++k) \
        acc[ai][bj][m][n] = pg8_mma16<Epi::I8>(Bt[n][k], At[m][k], acc[ai][bj][m][n]); __builtin_amdgcn_s_setprio(0); } while (0)
#define PG8_WAIT_V(n) asm volatile("s_waitcnt vmcnt(" #n ")" ::: "memory")
#define PG8_WAIT_L(n) asm volatile("s_waitcnt lgkmcnt(" #n ")" ::: "memory")
#define PG8_BAR __builtin_amdgcn_s_barrier()
#define PG8_SCHED __builtin_amdgcn_sched_barrier(0)
    Unit cur, nxt; int ui = 0;
    if (!S.next(0, cur)) return;
    typedef typename AccT<Epi::I8>::t acc_t;
    acc_t acc[2][2][4][2];
#pragma unroll
    for (int a = 0; a < 2; ++a)
#pragma unroll
        for (int b = 0; b < 2; ++b)
#pragma unroll
            for (int m = 0; m < 4; ++m)
#pragma unroll
                for (int n = 0; n < 2; ++n) acc[a][b][m][n] = (acc_t){0, 0, 0, 0};
    bf16x8 At[4][2], B0[2][2], B1[2][2];
    const char* cA = (const char*)g.A + (size_t)cur.pm * tstep; const char* cB = (const char*)g.Bt + (size_t)cur.pn * tstep;
    S.a_ready(cur);
    if constexpr (SP2) {
        PG8_STAGE(PG8_SB(0, 0), cB, voffB); PG8_STAGE(PG8_SB(0, 1), cB + hstep, voffB); PG8_STAGE(PG8_SA(0, 0), cA, voffA); PG8_STAGE(PG8_SA(0, 1), cA + hstep, voffA);
        if (wr == 1) PG8_BAR;
        PG8_WAIT_V(2); PG8_BAR;
        PG8_STAGE(PG8_SB(1, 0), cB + kstep, voffB); PG8_STAGE(PG8_SA(1, 0), cA + kstep, voffA); PG8_STAGE(PG8_SB(1, 1), cB + hstep + kstep, voffB);
        PG8_WAIT_V(6); PG8_BAR;
    } else {
        PG8_STAGE(PG8_SB(0, 0), cB, voffB); PG8_STAGE(PG8_SA(0, 0), cA, voffA); PG8_STAGE(PG8_SB(0, 1), cB + hstep, voffB); PG8_STAGE(PG8_SA(0, 1), cA + hstep, voffA);
        if (wr == 1) PG8_BAR;
        PG8_WAIT_V(4); PG8_BAR;
        PG8_STAGE(PG8_SB(1, 0), cB + kstep, voffB); PG8_STAGE(PG8_SA(1, 0), cA + kstep, voffA); PG8_STAGE(PG8_SB(1, 1), cB + hstep + kstep, voffB);
        PG8_WAIT_V(6); PG8_BAR;
    }
    for (;;) {
        const bool has_next = S.next(ui + 1, nxt);
        const char* nA = has_next ? (const char*)g.A + (size_t)nxt.pm * tstep : cA; const char* nB = has_next ? (const char*)g.Bt + (size_t)nxt.pn * tstep : cB;
        for (int t = 0; t < nt; t += 2) {
            const bool last = (t == nt - 2);
            const char* a1 = cA + (size_t)(t + 1) * kstep;
            const char* a2 = last ? nA : cA + (size_t)(t + 2) * kstep; const char* b2 = last ? nB : cB + (size_t)(t + 2) * kstep;
            const char* a3 = a2 + kstep; const char* b3 = b2 + kstep;
            if (last && has_next) S.a_ready(nxt);
            if constexpr (SP2) {
            PG8_LDB(B0, 0, 0); PG8_LDB(B1, 0, 1); PG8_SCHED; PG8_LDA(At, 0, 0); PG8_STAGE(PG8_SA(1, 1), a1 + hstep, voffA);
            PG8_WAIT_V(8); PG8_WAIT_L(0); PG8_BAR; PG8_MMA(0, 0, At, B0); PG8_MMA(0, 1, At, B1); PG8_BAR; PG8_SCHED;
            PG8_LDA(At, 0, 1); PG8_STAGE(PG8_SB(0, 0), b2, voffB); PG8_STAGE(PG8_SB(0, 1), b2 + hstep, voffB); PG8_STAGE(PG8_SA(0, 0), a2, voffA);
            PG8_WAIT_V(8); PG8_WAIT_L(0); PG8_BAR; PG8_MMA(1, 0, At, B0); PG8_MMA(1, 1, At, B1); PG8_BAR; PG8_SCHED;
            PG8_LDB(B0, 1, 0); PG8_LDB(B1, 1, 1); PG8_SCHED; PG8_LDA(At, 1, 0); PG8_STAGE(PG8_SA(0, 1), a2 + hstep, voffA);
            PG8_WAIT_V(8); PG8_WAIT_L(0); PG8_BAR; PG8_MMA(0, 0, At, B0); PG8_MMA(0, 1, At, B1); PG8_BAR; PG8_SCHED;
            PG8_LDA(At, 1, 1); PG8_STAGE(PG8_SB(1, 0), b3, voffB); PG8_STAGE(PG8_SB(1, 1), b3 + hstep, voffB); PG8_STAGE(PG8_SA(1, 0), a3, voffA);
            PG8_WAIT_V(8); PG8_WAIT_L(0); PG8_BAR; PG8_MMA(1, 0, At, B0); PG8_MMA(1, 1, At, B1); PG8_BAR; PG8_SCHED;
            } else {
            PG8_LDB(B0, 0, 0); PG8_SCHED; PG8_LDA(At, 0, 0); PG8_STAGE(PG8_SA(1, 1), a1 + hstep, voffA);
            PG8_WAIT_L(8); PG8_BAR; PG8_WAIT_L(0); PG8_MMA(0, 0, At, B0); PG8_BAR; PG8_SCHED;
            PG8_LDB(B1, 0, 1); PG8_STAGE(PG8_SB(0, 0), b2, voffB);
            PG8_BAR; PG8_WAIT_L(0); PG8_MMA(0, 1, At, B1); PG8_BAR;
            PG8_LDA(At, 0, 1); PG8_STAGE(PG8_SA(0, 0), a2, voffA);
            PG8_BAR; PG8_WAIT_L(0); PG8_MMA(1, 0, At, B0); PG8_BAR; PG8_SCHED;
            PG8_STAGE(PG8_SB(0, 1), b2 + hstep, voffB);
            PG8_WAIT_V(6); PG8_BAR; PG8_MMA(1, 1, At, B1); PG8_BAR;
            PG8_LDB(B0, 1, 0); PG8_SCHED; PG8_LDA(At, 1, 0); PG8_STAGE(PG8_SA(0, 1), a2 + hstep, voffA);
            PG8_WAIT_L(8); PG8_BAR; PG8_WAIT_L(0); PG8_MMA(0, 0, At, B0); PG8_BAR; PG8_SCHED;
            PG8_LDB(B1, 1, 1); PG8_STAGE(PG8_SB(1, 0), b3, voffB);
            PG8_BAR; PG8_WAIT_L(0); PG8_MMA(0, 1, At, B1); PG8_BAR;
            PG8_LDA(At, 1, 1); PG8_STAGE(PG8_SA(1, 0), a3, voffA);
            PG8_BAR; PG8_WAIT_L(0); PG8_MMA(1, 0, At, B0); PG8_BAR; PG8_SCHED;
            PG8_STAGE(PG8_SB(1, 1), b3 + hstep, voffB);
            PG8_WAIT_V(6); PG8_BAR; PG8_MMA(1, 1, At, B1); PG8_BAR;
            }
        }
        if constexpr (ALIGN_EPI) { if (wr == 0) PG8_BAR; }
        if constexpr (!Epi::AFTER_DRAIN) { E(acc, cur, wr, wc, fr, fq); S.done(cur); }
        if (!has_next) break;
#pragma unroll
        for (int a = 0; a < 2; ++a)
#pragma unroll
            for (int b = 0; b < 2; ++b)
#pragma unroll
                for (int m = 0; m < 4; ++m)
#pragma unroll
                    for (int n = 0; n < 2; ++n) acc[a][b][m][n] = (acc_t){0, 0, 0, 0};
        cur = nxt; cA = nA; cB = nB; ++ui;
        if constexpr (ALIGN_EPI) { if (wr == 1) PG8_BAR; }
    }
    PG8_WAIT_V(0);
    if constexpr (!ALIGN_EPI) { if (wr == 0) PG8_BAR; }
    PG8_BAR;
    if constexpr (Epi::AFTER_DRAIN) { E.fused(acc, cur, wr, wc, fr, fq, lds, wid, lane); S.done(cur); }
#undef PG8_SA
#undef PG8_SB
#undef PG8_STAGE
#undef PG8_LDA
#undef PG8_LDB
#undef PG8_MMA
#undef PG8_WAIT_V
#undef PG8_WAIT_L
#undef PG8_BAR
#undef PG8_SCHED
}
}
constexpr int NWAVES = 8, NTHR = 512;
constexpr int NB = 8, T = 8192, M = NB * T, D = 1024, CH = 512, NH = 8, HD = 64, FF = 4096, NL = 2;
constexpr int PIN = 3456, HYP = 1536, RWP = 1920, NRW = 2048;
constexpr float RMS_EPS = 1e-5f, GN_EPS = 64.0f * 1e-5f;
constexpr int MLP_CHUNKS = 4;
static_assert(MLP_CHUNKS >= 2 && M % (MLP_CHUNKS * 256) == 0, "the next layer's first-half RMSNorm is folded into the last MLP chunk: it needs a barrier between the first half's down GEMMs and that chunk");

constexpr size_t MiB = 1u << 20;
constexpr size_t WS_CTL = 0, CTL_ZERO_BYTES = 1 * MiB;
constexpr size_t WS_W = 2 * MiB;
constexpr size_t W_LAYER = 25 * MiB, W_HY = 0, W_RW = 3 * MiB, W_O = 7 * MiB, W_1 = 9 * MiB, W_2 = 17 * MiB;
constexpr size_t WS_RSC = 52 * MiB;
constexpr size_t WS_CSC = 52 * MiB + 512 * 1024;
constexpr size_t WS_FSC = 52 * MiB;
constexpr size_t WS_RSS = 53 * MiB;
constexpr size_t WS_BS = 53 * MiB;
constexpr size_t WS_FRAG = 57 * MiB;
constexpr size_t WS_SFIN = 62 * MiB;
constexpr size_t WS_YPHI = 64 * MiB;
constexpr size_t WS_HF = 64 * MiB;
constexpr size_t WS_HN = 128 * MiB;
constexpr size_t WS_G = 128 * MiB, WS_V2 = 192 * MiB;
constexpr size_t WS_VFIRST = 256 * MiB;
constexpr size_t WS_PHT = 320 * MiB;
constexpr size_t WS_PRW = 512 * MiB;
constexpr size_t WS_YS = 768 * MiB;
constexpr size_t WS_HID = 320 * MiB;
constexpr size_t WS_YMIX = 896 * MiB;
constexpr size_t WS_END = 1024 * MiB;
constexpr int CW_BAR = 4096;
constexpr int CW_CMAX = 32768;
constexpr int CW_QUEUE = 16384;

constexpr int LDS_BYTES = 163840;
constexpr int LDSCTL_OFF = LDS_BYTES - 512;

#define GAS __attribute__((address_space(1)))
#define LAS __attribute__((address_space(3)))
typedef unsigned short bf16;
typedef unsigned v4u __attribute__((ext_vector_type(4)));
typedef unsigned v2u __attribute__((ext_vector_type(2)));
typedef float f32x4 __attribute__((ext_vector_type(4)));
#define PHASE_TID() int bid = blockIdx.x; asm volatile("" : "+s"(bid)); (void)bid; int tid = threadIdx.x; asm volatile("" : "+v"(tid)); const int lane = tid & 63; const int wave = __builtin_amdgcn_readfirstlane(tid >> 6); (void)lane; (void)wave
#define RLX_AGENT __ATOMIC_RELAXED, __HIP_MEMORY_SCOPE_AGENT
#define LDS_WAIT() asm volatile("s_waitcnt lgkmcnt(0)" ::: "memory")
#define VM_WAIT() asm volatile("s_waitcnt vmcnt(0)" ::: "memory")
typedef float f32x2_ __attribute__((ext_vector_type(2)));
typedef __bf16 bf16x2_ __attribute__((ext_vector_type(2)));
__device__ __forceinline__ unsigned pk2(float lo, float hi) { return __builtin_bit_cast(unsigned, __builtin_convertvector((f32x2_){lo, hi}, bf16x2_)); }
__device__ __forceinline__ unsigned f2bf(float f) { return pk2(f, f) & 0xffffu; }
__device__ __forceinline__ float bf2f(unsigned h) { return __uint_as_float(h << 16); }
__device__ __forceinline__ float bflo(unsigned w) { return __uint_as_float(w << 16); }
__device__ __forceinline__ float bfhi(unsigned w) { return __uint_as_float(w & 0xffff0000u); }
__device__ __forceinline__ float sigmoidf_(float x) { return __builtin_amdgcn_rcpf(1.0f + __expf(-x)); }
__device__ __forceinline__ float tanhf_(float x) { return 1.0f - 2.0f * __builtin_amdgcn_rcpf(1.0f + __expf(2.0f * x)); }
template <int CTRL> __device__ __forceinline__ float dpp(float x) { return __builtin_bit_cast(float, __builtin_amdgcn_mov_dpp(__builtin_bit_cast(int, x), CTRL, 0xf, 0xf, true)); }
constexpr int XOR1 = 0xB1, XOR2 = 0x4E, XOR7 = 0x141, XOR8 = 0x128;
__device__ __forceinline__ float sin_hw(float x) { const float r = x * 0.15915494309189535f; return __builtin_amdgcn_sinf(r - floorf(r)); }
__device__ __forceinline__ float sum8(float v) { v += dpp<XOR1>(v); v += dpp<XOR2>(v); v += dpp<XOR7>(v); return v; }
__device__ __forceinline__ float sum16(float v) { v = sum8(v); v += dpp<XOR8>(v); return v; }

#define XB_TMO      128
#define XB_XCNT(j)  (256  + 64 * (j))
#define XB_XSUB(j)  (1280 + 64 * (j))
#define XB_XGEN(j)  (2304 + 64 * (j))
#define XB_TOP      3328
#define XB_TOPGEN   3392
#define XCD_BAR_WORDS 3456
#define XB_SPIN_CAP (1u << 18)

__device__ __forceinline__ unsigned xb_ld(unsigned* p)              { return __hip_atomic_load(p, __ATOMIC_RELAXED, __HIP_MEMORY_SCOPE_AGENT); }
__device__ __forceinline__ unsigned xb_add(unsigned* p, unsigned v) { return __hip_atomic_fetch_add(p, v, __ATOMIC_RELAXED, __HIP_MEMORY_SCOPE_AGENT); }
__device__ __forceinline__ unsigned xb_xcc_id() { return (unsigned)__builtin_amdgcn_s_getreg((3 << 11) | 20) & 0xFu; }
#define XB_SPIN(cond, bar) do { unsigned _sp = 0; while (cond) { __builtin_amdgcn_s_sleep(1); \
    if ((++_sp & 255u) == 0u) { if (xb_ld(&(bar)[XB_TMO])) break; if (_sp > XB_SPIN_CAP) { atomicAdd(&(bar)[XB_TMO], 1u); break; } } } } while (0)

struct XcdBarrier {
    unsigned* bar; unsigned x;
    volatile LAS unsigned* st;
};
__device__ __forceinline__ XcdBarrier xcd_barrier_post(unsigned* bar, volatile LAS unsigned* st) {
    XcdBarrier b; b.bar = bar; b.x = xb_xcc_id(); b.st = st;
    if (threadIdx.x == 0) (void)xb_add(&bar[XB_XCNT(b.x)], 1u);
    return b;
}
__device__ __forceinline__ void xcd_barrier_complete(unsigned* bar, unsigned x, unsigned& nloc, unsigned& nx) {
    const unsigned G = gridDim.x * gridDim.y * gridDim.z;
    unsigned sum, cnt, mine, sp = 0u;
    for (;;) {
        sum = 0u; cnt = 0u; mine = 0u;
#pragma unroll
        for (unsigned j = 0; j < 16; ++j) { const unsigned c = xb_ld(&bar[XB_XCNT(j)]); sum += c; cnt += (c > 0u) ? 1u : 0u; mine = (j == x) ? c : mine; }
        if (sum == G) break;
        __builtin_amdgcn_s_sleep(1);
        if ((++sp & 255u) == 0u) { if (xb_ld(&bar[XB_TMO])) break; if (sp > XB_SPIN_CAP) { atomicAdd(&bar[XB_TMO], 1u); break; } }
    }
    nloc = mine > 0u ? mine : 1u; nx = cnt > 0u ? cnt : 1u;
}
__device__ __forceinline__ void xcd_barrier(const XcdBarrier& b) {
    asm volatile("s_waitcnt vmcnt(0)" ::: "memory");
    __syncthreads();
    if (threadIdx.x == 0) {
        unsigned* bar = b.bar;
        unsigned bx = b.x; asm volatile("" : "+s"(bx));
        __builtin_amdgcn_s_waitcnt(0);
        unsigned nloc = b.st[0], nx = b.st[1];
        if (nloc == 0u) { xcd_barrier_complete(bar, bx, nloc, nx); b.st[0] = nloc; b.st[1] = nx; }
        const unsigned old = xb_add(&bar[XB_XSUB(bx)], 1u);
        const unsigned gen = old / nloc;
        if (old + 1u == (gen + 1u) * nloc) {
            __builtin_amdgcn_fence(__ATOMIC_RELEASE, "agent");
            asm volatile("s_waitcnt vmcnt(0)" ::: "memory");
            const unsigned og = xb_add(&bar[XB_TOP], 1u);
            const unsigned tg = og / nx;
            if (og + 1u == (tg + 1u) * nx) xb_add(&bar[XB_TOPGEN], 1u);
            else XB_SPIN(xb_ld(&bar[XB_TOPGEN]) == tg, bar);
            __builtin_amdgcn_fence(__ATOMIC_ACQUIRE, "agent");
            xb_add(&bar[XB_XGEN(bx)], 1u);
            asm volatile("s_waitcnt vmcnt(0)" ::: "memory");
        } else {
            XB_SPIN(xb_ld(&bar[XB_XGEN(bx)]) == gen, bar);
            __builtin_amdgcn_fence(__ATOMIC_ACQUIRE, "agent");
            asm volatile("s_waitcnt vmcnt(0)" ::: "memory");
        }
    }
    __syncthreads();
}

struct Frame {
    LAS unsigned char* lds;
    volatile LAS unsigned* MISC;
    unsigned* ctl;
    int G;
    const float* const* in;
    float* out; unsigned char* ws;
};
enum { I_X = 0, I_N1G, I_WIN, I_HCW, I_HCB, I_FW1, I_FB1, I_FW2, I_FB2, I_FW3, I_FB3, I_FFREQ, I_FWOUT, I_HSKIP, I_HNG, I_SHIFT, I_W0, I_W2, I_A0, I_A2, I_G2, I_KK, I_KA, I_RK, I_LNG, I_LNB, I_V0, I_V1, I_V2, I_WOUT, I_N2G, I_MW1, I_MW2, I_FING };

__device__ __forceinline__ float wave_max(float v) {
#pragma unroll
    for (int o = 1; o < 64; o <<= 1) v = fmaxf(v, __shfl_xor(v, o));
    return v;
}
__device__ __forceinline__ unsigned q4(float a, float b, float c, float d) {
    const int ia = (int)__builtin_rintf(a), ib = (int)__builtin_rintf(b), ic = (int)__builtin_rintf(c), id = (int)__builtin_rintf(d);
    return (unsigned)(ia & 255) | ((unsigned)(ib & 255) << 8) | ((unsigned)(ic & 255) << 16) | ((unsigned)id << 24);
}
__device__ __forceinline__ float wave_sum(float v) {
#pragma unroll
    for (int o = 1; o < 64; o <<= 1) v += __shfl_xor(v, o);
    return v;
}
typedef float f32x2 __attribute__((ext_vector_type(2)));
constexpr int FN = 2 * T;
constexpr int XPAD = FN + FN / 16 + 16 * (FN / 512);
__device__ __forceinline__ f32x2 cmul(f32x2 a, f32x2 b) { return (f32x2){a.x * b.x - a.y * b.y, a.x * b.y + a.y * b.x}; }
__device__ __forceinline__ f32x2 pk_fma_rot(f32x2 a, f32x2 b, f32x2 t) { f32x2 r;
    asm("v_pk_fma_f32 %0, %1, %2, %3 op_sel:[1,1,0] op_sel_hi:[1,0,1] neg_lo:[0,1,0]" : "=v"(r) : "v"(a), "v"(b), "v"(t)); return r; }
__device__ __forceinline__ f32x2 pk_add_mib(f32x2 a, f32x2 b) { f32x2 r; asm("v_pk_add_f32 %0, %1, %2 op_sel:[0,1] op_sel_hi:[1,0] neg_hi:[0,1]" : "=v"(r) : "v"(a), "v"(b)); return r; }
__device__ __forceinline__ f32x2 pk_add_pib(f32x2 a, f32x2 b) { f32x2 r; asm("v_pk_add_f32 %0, %1, %2 op_sel:[0,1] op_sel_hi:[1,0] neg_lo:[0,1]" : "=v"(r) : "v"(a), "v"(b)); return r; }
__device__ __forceinline__ f32x2 cmulc(f32x2 a, f32x2 b) { return (f32x2){a.x * b.x + a.y * b.y, a.y * b.x - a.x * b.y}; }
__device__ constexpr float C32[16] = {1.0f, 0.98078528040323043f, 0.92387953251128674f, 0.83146961230254524f, 0.70710678118654752f, 0.55557023301960218f, 0.38268343236508977f, 0.19509032201612825f,
                                      0.0f, -0.19509032201612825f, -0.38268343236508977f, -0.55557023301960218f, -0.70710678118654752f, -0.83146961230254524f, -0.92387953251128674f, -0.98078528040323043f};
__device__ constexpr float S32[16] = {0.0f, 0.19509032201612825f, 0.38268343236508977f, 0.55557023301960218f, 0.70710678118654752f, 0.83146961230254524f, 0.92387953251128674f, 0.98078528040323043f,
                                      1.0f, 0.98078528040323043f, 0.92387953251128674f, 0.83146961230254524f, 0.70710678118654752f, 0.55557023301960218f, 0.38268343236508977f, 0.19509032201612825f};
constexpr int bitrev_c(int v, int bits) { int r = 0; for (int i = 0; i < bits; ++i) r |= ((v >> i) & 1) << (bits - 1 - i); return r; }
#define SH0(v) __builtin_shufflevector(v, v, 0, 0)
#define SH1(v) __builtin_shufflevector(v, v, 1, 1)
template <int R, bool INV, bool STORE = false, int NOUT = R> __device__ __forceinline__ void dft_regs(f32x2 (&x)[R], LAS f32x2* P = nullptr, int stride = 0) {
    constexpr int LOG = (R == 32) ? 5 : 4;
    f32x2 y[R];
#pragma unroll
    for (int k = 0; k < R; ++k) y[k] = x[bitrev_c(k, LOG)];
#pragma unroll
    for (int s = 1; s < R; s <<= 1) {
#pragma unroll
        for (int blk = 0; blk < R; blk += 2 * s) {
            const bool st = STORE && (2 * s == R);
            { const f32x2 a = y[blk], b = y[blk + s]; y[blk] = a + b; y[blk + s] = a - b;
              if (st) { P[0] = y[blk]; if (s < NOUT) P[s * stride] = y[blk + s]; } }
            if (s >= 2) { const f32x2 a = y[blk + s / 2], b = y[blk + s / 2 + s];
                y[blk + s / 2] = INV ? pk_add_pib(a, b) : pk_add_mib(a, b); y[blk + s / 2 + s] = INV ? pk_add_mib(a, b) : pk_add_pib(a, b);
                if (st) { P[(s / 2) * stride] = y[blk + s / 2]; if (s / 2 + s < NOUT) P[(s / 2 + s) * stride] = y[blk + s / 2 + s]; } }
#pragma unroll
            for (int j = 1; j < s / 2; ++j) { const int j2 = s - j, m1 = j * (16 / s), m2 = j2 * (16 / s);
                const float c1 = C32[m1], s1 = INV ? S32[m1] : -S32[m1], c2 = C32[m2], s2 = INV ? S32[m2] : -S32[m2];
                const f32x2 a1 = y[blk + j], b1 = y[blk + j + s], a2 = y[blk + j2], b2 = y[blk + j2 + s];
                const f32x2 p1 = __builtin_elementwise_fma(SH0(b1), (f32x2){c1, s1}, a1), p2 = __builtin_elementwise_fma(SH0(b2), (f32x2){c2, s2}, a2);
                if (st) asm volatile("" :: "v"(p1), "v"(p2) : "memory"); else asm volatile("" :: "v"(p1), "v"(p2));
                const f32x2 q1 = __builtin_elementwise_fma(SH1(b1), (f32x2){-s1, c1}, p1), q2 = __builtin_elementwise_fma(SH1(b2), (f32x2){-s2, c2}, p2);
                asm volatile("" :: "v"(q1), "v"(q2));
                y[blk + j] = q1; y[blk + j2] = q2;
                y[blk + j + s] = __builtin_elementwise_fma(a1, (f32x2){2.0f, 2.0f}, -q1); y[blk + j2 + s] = __builtin_elementwise_fma(a2, (f32x2){2.0f, 2.0f}, -q2);
                if (st) { P[j * stride] = q1; P[j2 * stride] = q2; if (j + s < NOUT) P[(j + s) * stride] = y[blk + j + s]; if (j2 + s < NOUT) P[(j2 + s) * stride] = y[blk + j2 + s]; } }
        }
    }
#pragma unroll
    for (int k = 0; k < R; ++k) x[k] = y[k];
}
template <int R, bool INV, bool STORE = false> __device__ __forceinline__ void twiddle_regs(f32x2 (&x)[R], float frac, LAS f32x2* P = nullptr, int stride = 0) {
    asm volatile("" : "+v"(frac));
    const float sn0 = __builtin_amdgcn_sinf(0.5f * frac), cs = __builtin_amdgcn_cosf(0.5f * frac);
    const float sn = INV ? sn0 : -sn0;
    const f32x2 w = (f32x2){cs, sn}, iw = (f32x2){-sn, cs};
    f32x2 w2; { f32x2 t = __builtin_shufflevector(w, w, 0, 0) * w; w2 = pk_fma_rot(w, w, t); }
    f32x2 wa = w, wb = w2;
    if (STORE) P[0] = x[0];
#pragma unroll
    for (int k = 1; k < R; k += 2) {
        const bool hb = (k + 1 < R), na = (k + 2 < R), nb = (k + 3 < R);
        const f32x2 xa = x[k], xb = hb ? x[k + 1] : x[k];
        const f32x2 tda = __builtin_shufflevector(xa, xa, 0, 0) * wa, tdb = __builtin_shufflevector(xb, xb, 0, 0) * wb;
        const f32x2 tpa = __builtin_shufflevector(wa, wa, 0, 0) * w2, tpb = __builtin_shufflevector(wb, wb, 0, 0) * w2;
        if (hb && na && nb) { if (STORE) asm volatile("" :: "v"(tda), "v"(tdb), "v"(tpa), "v"(tpb) : "memory"); else asm volatile("" :: "v"(tda), "v"(tdb), "v"(tpa), "v"(tpb)); }
        else asm volatile("" :: "v"(tda));
        x[k] = pk_fma_rot(xa, wa, tda);
        if (hb) x[k + 1] = pk_fma_rot(xb, wb, tdb);
        if (STORE) { P[k * stride] = x[k]; if (hb) P[(k + 1) * stride] = x[k + 1]; }
        if (na) wa = pk_fma_rot(wa, w2, tpa);
        if (nb) wb = pk_fma_rot(wb, w2, tpb);
    }
}
#define XP(i) ((i) + ((i) >> 4) + 16 * ((i) >> 9))
constexpr int XBP = 560;
template <bool ZUP> __device__ __forceinline__ void fft_f1(LAS f32x2* X, int t) {
    f32x2 x[32]; const int base = t + (t >> 4);
#pragma unroll
    for (int j = 0; j < 32; ++j) x[j] = (ZUP && j >= 16) ? (f32x2){0.f, 0.f} : X[base + j * XBP];
    dft_regs<32, false>(x);
    twiddle_regs<32, false, true>(x, (float)t * (1.0f / 8192.0f), X + base, XBP);
}
__device__ __forceinline__ void fft_f2(LAS f32x2* X, int t) {
    f32x2 x[32]; const int base = (t >> 4) * XBP + (t & 15);
#pragma unroll
    for (int j = 0; j < 32; ++j) x[j] = X[base + j * 17];
    dft_regs<32, false>(x);
    twiddle_regs<32, false, true>(x, (float)(t & 15) * (1.0f / 256.0f), X + base, 17);
}
__device__ __forceinline__ void fft_mid(LAS f32x2* X, const f32x2* H, int t) {
#pragma unroll 1
    for (int r = 0; r < 2; ++r) { const int b = t + 512 * r; f32x2 x[16];
        const f32x4* hp = (const f32x4*)(H + 16 * b); f32x4 h[8];
#pragma unroll
        for (int k = 0; k < 8; ++k) h[k] = hp[k];
#pragma unroll
        for (int j = 0; j < 16; ++j) x[j] = X[17 * b + 16 * (b >> 5) + j];
        dft_regs<16, false>(x);
#pragma unroll
        for (int k = 0; k < 8; ++k) { const f32x2 h0 = (f32x2){h[k][0], h[k][1]}, h1 = (f32x2){h[k][2], h[k][3]}, a0 = x[2 * k], a1 = x[2 * k + 1];
            f32x2 t0 = __builtin_shufflevector(a0, a0, 0, 0) * h0, t1 = __builtin_shufflevector(a1, a1, 0, 0) * h1;
            asm volatile("" :: "v"(t0), "v"(t1));
            x[2 * k] = pk_fma_rot(a0, h0, t0); x[2 * k + 1] = pk_fma_rot(a1, h1, t1); }
        dft_regs<16, true>(x);
#pragma unroll
        for (int j = 0; j < 16; ++j) X[17 * b + 16 * (b >> 5) + j] = x[j]; }
}
__device__ __forceinline__ void fft_i2(LAS f32x2* X, int t) {
    f32x2 x[32]; const int base = (t >> 4) * XBP + (t & 15);
#pragma unroll
    for (int k = 0; k < 32; ++k) x[k] = X[base + k * 17];
    twiddle_regs<32, true>(x, (float)(t & 15) * (1.0f / 256.0f));
    dft_regs<32, true, true, 32>(x, X + base, 17);
}
__device__ __forceinline__ void fft_i1(LAS f32x2* X, int t) {
    f32x2 x[32]; const int base = t + (t >> 4);
#pragma unroll
    for (int k = 0; k < 32; ++k) x[k] = X[base + k * XBP];
    twiddle_regs<32, true>(x, (float)t * (1.0f / 8192.0f));
    dft_regs<32, true, true, 16>(x, X + base, XBP);
}
__device__ __forceinline__ void fft_conv(LAS f32x2* X, const f32x2* H, int tid) {
    __syncthreads(); fft_f1<true>(X, tid);
    __syncthreads(); fft_f2(X, tid);
    __syncthreads(); fft_mid(X, H, tid);
    __syncthreads(); fft_i2(X, tid);
    __syncthreads(); fft_i1(X, tid);
    __syncthreads();
}
__device__ __forceinline__ void hy_spectrum_item(Frame& F, int item) {
    PHASE_TID();
    LAS f32x2* X = (LAS f32x2*)F.lds; LAS float* RED = (LAS float*)(F.lds + XPAD * 8);
    const int o = item >> 9, c = item & 511;
    const float* HF = (const float*)(F.ws + WS_HF);
    const float* f = HF + ((size_t)(o * 2 + 0) * CH + c) * T; const float* bw = HF + ((size_t)(o * 2 + 1) * CH + c) * T;
    f32x2* HS = (f32x2*)(F.ws + WS_YMIX) + (size_t)item * FN;
    __syncthreads();
    f32x2 x[32]; float ss = 0.f; const int base = tid + (tid >> 4);
#pragma unroll
    for (int j = 0; j < 32; ++j) { const int idx = j * 512 + tid; float v;
        if (j < 16) v = f[idx]; else v = (idx == T) ? 0.f : bw[FN - idx];
        ss += v * v; x[j] = (f32x2){v, 0.f}; }
    ss = wave_sum(ss);
    if (lane == 0) RED[wave] = ss;
    dft_regs<32, false>(x);
    twiddle_regs<32, false>(x, (float)tid * (1.0f / 8192.0f));
#pragma unroll
    for (int k = 0; k < 32; ++k) X[base + k * XBP] = x[k];
    __syncthreads();
    float tot = 0.f;
#pragma unroll
    for (int w = 0; w < 8; ++w) tot += RED[w];
    const float sc = (1.0f / sqrtf(tot + 1e-6f)) * (1.0f / (float)FN);
    fft_f2(X, tid);
    __syncthreads();
#pragma unroll 1
    for (int r = 0; r < 2; ++r) { const int b = tid + 512 * r; f32x2 y[16];
#pragma unroll
        for (int j = 0; j < 16; ++j) y[j] = X[17 * b + 16 * (b >> 5) + j];
        dft_regs<16, false>(y);
        f32x4* dst = (f32x4*)(HS + 16 * b);
#pragma unroll
        for (int k = 0; k < 8; ++k) dst[k] = (f32x4){y[2 * k].x * sc, y[2 * k].y * sc, y[2 * k + 1].x * sc, y[2 * k + 1].y * sc}; }
}
__device__ __forceinline__ void p_spectra(Frame& F) { PHASE_TID(); (void)tid; for (int it = bid; it < 2 * CH; it += F.G) hy_spectrum_item(F, it); __syncthreads(); }

struct RowRaw { v4u a, b; unsigned lo, hi; };
__device__ __forceinline__ void hy_row_load(RowRaw& R, const bf16* row, int t0) {
    R.a = *(const v4u*)(row + t0); R.b = *(const v4u*)(row + t0 + 8);
    R.lo = t0 > 0 ? (unsigned)row[t0 - 1] : 0u; R.hi = t0 + 16 < T ? (unsigned)row[t0 + 16] : 0u;
}
__device__ __forceinline__ void hy_u16r(const RowRaw& R, float w0, float w1, float w2, float bias, float (&u)[16]) {
    float p[18];
    p[0] = __builtin_bit_cast(float, R.lo << 16); p[17] = __builtin_bit_cast(float, R.hi << 16);
    const unsigned w[8] = {R.a.x, R.a.y, R.a.z, R.a.w, R.b.x, R.b.y, R.b.z, R.b.w};
#pragma unroll
    for (int i = 0; i < 8; ++i) { p[1 + 2 * i] = bflo(w[i]); p[2 + 2 * i] = bfhi(w[i]); }
#pragma unroll
    for (int i = 0; i < 16; ++i) u[i] = w0 * p[i] + w1 * p[i + 1] + w2 * p[i + 2] + bias;
}
__device__ __forceinline__ void hy_pack_store(bf16* dst, const float (&y)[16]) {
    v4u o0, o1;
    o0.x = pk2(y[0], y[1]); o0.y = pk2(y[2], y[3]); o0.z = pk2(y[4], y[5]); o0.w = pk2(y[6], y[7]);
    o1.x = pk2(y[8], y[9]); o1.y = pk2(y[10], y[11]); o1.z = pk2(y[12], y[13]); o1.w = pk2(y[14], y[15]);
    *(v4u*)dst = o0; *(v4u*)(dst + 8) = o1;
}
__device__ __forceinline__ void hy_fft_item(Frame& F, int l, int item) {
    PHASE_TID(); const int c = item >> 2, bp = item & 3, t0 = 16 * tid, xb = 17 * tid + 16 * (tid >> 5);
    LAS f32x2* X = (LAS f32x2*)F.lds;
    bf16* PHT = (bf16*)(F.ws + WS_PHT);
    bf16* rx1a = PHT + ((size_t)(2 * bp) * HYP + c) * T; bf16* rx1b = rx1a + (size_t)HYP * T;
    bf16* rx2a = PHT + ((size_t)(2 * bp) * HYP + CH + c) * T; bf16* rx2b = rx2a + (size_t)HYP * T;
    const bf16* rva = PHT + ((size_t)(2 * bp) * HYP + 2 * CH + c) * T; const bf16* rvb = rva + (size_t)HYP * T;
    const float* cw = F.in[I_HCW] + (size_t)l * 3 * HYP; const float* cb = F.in[I_HCB] + (size_t)l * HYP;
    const float* skip = F.in[I_HSKIP] + (size_t)l * 2 * CH;
    const f32x2* H0 = (const f32x2*)(F.ws + WS_YMIX) + (size_t)c * FN; const f32x2* H1 = H0 + (size_t)CH * FN;
    __syncthreads();
    RowRaw va, vb, xa, xb2;
    hy_row_load(va, rva, t0); hy_row_load(vb, rvb, t0);
    const float vw0 = cw[2 * CH + c], vw1 = cw[HYP + 2 * CH + c], vw2 = cw[2 * HYP + 2 * CH + c], vbs = cb[2 * CH + c];
    const float x1w0 = cw[c], x1w1 = cw[HYP + c], x1w2 = cw[2 * HYP + c], x1bs = cb[c], x2w0 = cw[CH + c], x2w1 = cw[HYP + CH + c], x2w2 = cw[2 * HYP + CH + c], x2bs = cb[CH + c], s0 = skip[c], s1 = skip[CH + c];
    { float ua[16], ub[16];
      hy_u16r(va, vw0, vw1, vw2, vbs, ua); hy_u16r(vb, vw0, vw1, vw2, vbs, ub);
#pragma unroll
      for (int i = 0; i < 16; ++i) X[xb + i] = (f32x2){ua[i], ub[i]}; }
    hy_row_load(xa, rx1a, t0); hy_row_load(xb2, rx1b, t0);
    fft_conv(X, H0, tid);
    v4u z2a[2], z2b[2];
    { float ua[16], ub[16], za[16], zb[16];
      {
        hy_u16r(va, vw0, vw1, vw2, vbs, ua); hy_u16r(vb, vw0, vw1, vw2, vbs, ub);
#pragma unroll
        for (int i = 0; i < 16; ++i) { const f32x2 y = X[xb + i]; za[i] = y.x + s0 * ua[i]; zb[i] = y.y + s0 * ub[i]; } }
      hy_u16r(xa, x1w0, x1w1, x1w2, x1bs, ua); hy_u16r(xb2, x1w0, x1w1, x1w2, x1bs, ub);
#pragma unroll
      for (int i = 0; i < 16; ++i) { za[i] *= ua[i]; zb[i] *= ub[i]; }
#pragma unroll
      for (int q = 0; q < 2; ++q) { z2a[q].x = pk2(za[8 * q], za[8 * q + 1]); z2a[q].y = pk2(za[8 * q + 2], za[8 * q + 3]); z2a[q].z = pk2(za[8 * q + 4], za[8 * q + 5]); z2a[q].w = pk2(za[8 * q + 6], za[8 * q + 7]);
                                    z2b[q].x = pk2(zb[8 * q], zb[8 * q + 1]); z2b[q].y = pk2(zb[8 * q + 2], zb[8 * q + 3]); z2b[q].z = pk2(zb[8 * q + 4], zb[8 * q + 5]); z2b[q].w = pk2(zb[8 * q + 6], zb[8 * q + 7]); }
#pragma unroll
      for (int i = 0; i < 16; ++i) X[xb + i] = (f32x2){za[i], zb[i]}; }
    hy_row_load(xa, rx2a, t0); hy_row_load(xb2, rx2b, t0);
    fft_conv(X, H1, tid);
    { float ua[16], ub[16];
      hy_u16r(xa, x2w0, x2w1, x2w2, x2bs, ua); hy_u16r(xb2, x2w0, x2w1, x2w2, x2bs, ub);
      float za[16], zb[16];
      const unsigned wa[8] = {z2a[0].x, z2a[0].y, z2a[0].z, z2a[0].w, z2a[1].x, z2a[1].y, z2a[1].z, z2a[1].w}, wb[8] = {z2b[0].x, z2b[0].y, z2b[0].z, z2b[0].w, z2b[1].x, z2b[1].y, z2b[1].z, z2b[1].w};
#pragma unroll
      for (int i = 0; i < 8; ++i) { za[2 * i] = bflo(wa[i]); za[2 * i + 1] = bfhi(wa[i]); zb[2 * i] = bflo(wb[i]); zb[2 * i + 1] = bfhi(wb[i]); }
#pragma unroll
      for (int i = 0; i < 16; ++i) { const f32x2 y = X[xb + i]; za[i] = ua[i] * (y.x + s1 * za[i]); zb[i] = ub[i] * (y.y + s1 * zb[i]); }
      hy_pack_store(rx2a + t0, za); hy_pack_store(rx2b + t0, zb); }
}
typedef short bf16x8 __attribute__((ext_vector_type(8)));
constexpr int CL_ = 64;
constexpr int LDB = 80;
constexpr int LDSG = 144, LDVL = 48;
constexpr int LDF = 65;
constexpr int MB = 64 * LDB * 2;
constexpr int MF = 64 * LDF * 4;
constexpr int O_AH = 0, O_AHT = MB, O_RH = 2 * MB, O_BH = 3 * MB, O_BHT = 4 * MB, O_KH = 5 * MB, O_KHT = 6 * MB, O_VT = 7 * MB;
constexpr int O_TW = 0, O_AD = MB, O_SG = 2 * MB  , O_VL = 2 * MB + 64 * LDSG * 2  ;
constexpr int O_APB = O_KH;
constexpr int O_F = 8 * MB;
constexpr int O_AF = O_F, O_LW = O_F + MF, O_ZV = O_F + 2 * MF;
constexpr int O_XA = O_F, O_XAT = O_F + MB, O_AAK = O_F + 2 * MB, O_ARB = O_F + 3 * MB, O_ARK = O_F + 4 * MB;
constexpr int O_S0B = O_F + ((3 * MF > 5 * MB) ? 3 * MF : 5 * MB);
constexpr int O_UT = O_S0B + MB;
constexpr int O_TB = O_UT, O_M1T = O_BH, O_T0T = O_AH, O_WT = O_KH;
constexpr int O_PL = O_UT + MB;
constexpr int O_PART = O_PL + 256;
constexpr int O_MU = O_PART + 2048;
constexpr int O_CK = O_MU + 1792;
constexpr int O_MC = O_CK + 768;
static_assert(O_ARK + MB <= O_S0B && O_ZV + MF <= O_S0B && O_VL + 64 * LDVL * 2 <= O_F && O_MC + 1792 <= LDSCTL_OFF, "cscan LDS map");

__device__ __forceinline__ unsigned pk2s(float v) { return pk2(v, v); }
#define MFMA16(a, b, c) __builtin_amdgcn_mfma_f32_16x16x32_bf16((a), (b), (c), 0, 0, 0)
__device__ __forceinline__ bf16x8 ldfrag(const LAS unsigned char* base, int ld, int row0, int k0, int fr, int fq) {
    return *(const LAS bf16x8*)(base + ((row0 + fr) * ld + k0 + 8 * fq) * 2);
}
__device__ __forceinline__ void st_tile_bf16(LAS unsigned char* base, int ld, int m0, int n0, int fr, int fq, const f32x4& v) {
#pragma unroll
    for (int jj = 0; jj < 4; ++jj) *(LAS bf16*)(base + ((m0 + 4 * fq + jj) * ld + n0 + fr) * 2) = (bf16)pk2s(v[jj]);
}
__device__ __forceinline__ void st_tile_bf16_T(LAS unsigned char* base, int ld, int m0, int n0, int fr, int fq, const f32x4& v) {
    v2u o; o.x = pk2(v[0], v[1]); o.y = pk2(v[2], v[3]);
    *(LAS v2u*)(base + ((n0 + fr) * ld + m0 + 4 * fq) * 2) = o;
}
#define CFENCE() asm volatile("" ::: "memory")
#define ZFRAG ((bf16x8){0, 0, 0, 0, 0, 0, 0, 0})
__device__ __forceinline__ void ldA(bf16x8 (&a)[2], const LAS unsigned char* A, int mt, int fr, int fq) {
#pragma unroll
    for (int ks = 0; ks < 2; ++ks) a[ks] = ldfrag(A, LDB, 16 * mt, 32 * ks, fr, fq);
}
__device__ __forceinline__ void ldB(bf16x8 (&b)[2][2], const LAS unsigned char* B, int nt0, int fr, int fq) {
#pragma unroll
    for (int ks = 0; ks < 2; ++ks)
#pragma unroll
        for (int j = 0; j < 2; ++j) b[ks][j] = ldfrag(B, LDB, 16 * (nt0 + j), 32 * ks, fr, fq);
}
#define PIN(x) asm volatile("" : "+v"(x))
__device__ __forceinline__ void mmac(bf16x8 (&a)[2], bf16x8 (&b)[2][2], f32x4 (&acc)[2]) {
#pragma unroll
    for (int ks = 0; ks < 2; ++ks) { PIN(a[ks]);
#pragma unroll
        for (int j = 0; j < 2; ++j) { PIN(b[ks][j]); acc[j] = MFMA16(a[ks], b[ks][j], acc[j]); } }
}
__device__ __forceinline__ void mmacT(bf16x8 (&a)[2], bf16x8 (&b)[2][2], f32x4 (&acc)[2]) {
#pragma unroll
    for (int ks = 0; ks < 2; ++ks) { PIN(a[ks]);
#pragma unroll
        for (int j = 0; j < 2; ++j) { PIN(b[ks][j]); acc[j] = MFMA16(b[ks][j], a[ks], acc[j]); } }
}
__device__ __forceinline__ v4u pack8(const float (&v)[8]) { v4u o; o.x = pk2(v[0], v[1]); o.y = pk2(v[2], v[3]); o.z = pk2(v[4], v[5]); o.w = pk2(v[6], v[7]); return o; }
__device__ __forceinline__ bf16x8 wfrag(const float* W, int k0, int col, int fq) {
    float v[8];
#pragma unroll
    for (int e = 0; e < 8; ++e) v[e] = W[(size_t)(k0 + 8 * fq + e) * CH + col];
    return __builtin_bit_cast(bf16x8, pack8(v));
}

struct RawTok { v4u g[7][3]; };
__device__ __forceinline__ void load_raw(RawTok& R, const bf16* PRW, const bf16* VFIRST, int b, int tok, int hc, int ec, int d, int l, bool has_vl) {
    const size_t m = (size_t)b * T + tok; const v4u z = (v4u){0u, 0u, 0u, 0u};
    const int cols[7] = {hc + ec, CH + hc + ec, 2 * CH + hc + ec, 1536 + d * 64 + ec, 1664 + d * 64 + ec, 1792 + ec, 1856 + ec};
#pragma unroll
    for (int g = 0; g < 7; ++g) { if (g >= 5 && d != 0) { R.g[g][0] = z; R.g[g][1] = z; R.g[g][2] = z; continue; }
        const bf16* p = PRW + m * NRW + cols[g];
        R.g[g][1] = *(const v4u*)p; R.g[g][0] = *(const v4u*)(p - NRW); R.g[g][2] = *(const v4u*)(p + NRW); }
    if (__builtin_amdgcn_readfirstlane((int)__builtin_amdgcn_ballot_w64(tok == 0 || tok == T - 1) != 0 || (int)(__builtin_amdgcn_ballot_w64(tok == 0 || tok == T - 1) >> 32) != 0)) {
#pragma unroll
        for (int g = 0; g < 7; ++g) { R.g[g][0] = (tok == 0) ? z : R.g[g][0]; R.g[g][2] = (tok == T - 1) ? z : R.g[g][2]; } }
}
typedef __bf16 bf16x2v __attribute__((ext_vector_type(2)));
__device__ __forceinline__ void mix8r(const v4u (&r)[3], const LAS unsigned* mub, const LAS float* mcb, float (&out)[8]) {
    const v4u ma = *(const LAS v4u*)mub, mb = *(const LAS v4u*)(mub + 4); const f32x4 ca = *(const LAS f32x4*)mcb, cb = *(const LAS f32x4*)(mcb + 4);
    const unsigned mw[8] = {ma.x, ma.y, ma.z, ma.w, mb.x, mb.y, mb.z, mb.w}; const float mc[8] = {ca[0], ca[1], ca[2], ca[3], cb[0], cb[1], cb[2], cb[3]};
    const unsigned pw[4] = {r[0].x, r[0].y, r[0].z, r[0].w}, cw[4] = {r[1].x, r[1].y, r[1].z, r[1].w}, nw[4] = {r[2].x, r[2].y, r[2].z, r[2].w};
#pragma unroll
    for (int i = 0; i < 4; ++i) {
        const unsigned pn0 = __builtin_amdgcn_perm(nw[i], pw[i], 0x05040100u), pn1 = __builtin_amdgcn_perm(nw[i], pw[i], 0x07060302u);
        out[2 * i] = __builtin_amdgcn_fdot2_f32_bf16(__builtin_bit_cast(bf16x2v, pn0), __builtin_bit_cast(bf16x2v, mw[2 * i]), bflo(cw[i]) * mc[2 * i], false);
        out[2 * i + 1] = __builtin_amdgcn_fdot2_f32_bf16(__builtin_bit_cast(bf16x2v, pn1), __builtin_bit_cast(bf16x2v, mw[2 * i + 1]), bfhi(cw[i]) * mc[2 * i + 1], false); }
}
template <bool DO_T, bool DO_X, bool LAST> __device__ __forceinline__ void blk_stage(const LAS unsigned char* X, const LAS unsigned char* XT, const LAS unsigned char* TT, LAS unsigned char* To, LAS unsigned char* T0T,
                                                                                    LAS unsigned char* Xo, LAS unsigned char* XoT, int wave, int fr, int fq) {
    const int bk = wave >> 2, k0 = 32 * bk, m0 = k0 + 16 * ((wave >> 1) & 1), n0 = k0 + 16 * (wave & 1);
    bf16x8 a = ldfrag(X, LDB, m0, k0, fr, fq), tb = a, xb = a; v2u tw = (v2u){0u, 0u};
    if (DO_T) { tb = ldfrag(TT, LDB, n0, k0, fr, fq); tw = *(const LAS v2u*)(TT + ((n0 + fr) * LDB + m0 + 4 * fq) * 2); }
    if (DO_X) xb = ldfrag(XT, LDB, n0, k0, fr, fq);
    CFENCE();
    PIN(a);
    if (DO_T) { f32x4 ta = (f32x4){bflo(tw.x), bfhi(tw.x), bflo(tw.y), bfhi(tw.y)}; PIN(tb); ta = MFMA16(a, tb, ta);
        if (LAST) { st_tile_bf16(To, LDB, m0, n0, fr, fq, ta); if (bk == 0) st_tile_bf16_T(T0T, LDB, m0, n0, fr, fq, ta); }
        else st_tile_bf16_T(To, LDB, m0, n0, fr, fq, ta); }
    if (DO_X) { f32x4 xa = (f32x4){0.f, 0.f, 0.f, 0.f}; PIN(xb); xa = MFMA16(a, xb, xa);
        st_tile_bf16(Xo, LDB, m0, n0, fr, fq, xa); st_tile_bf16_T(XoT, LDB, m0, n0, fr, fq, xa); }
}

template <int HH> __device__ __forceinline__ void m2_half(LAS unsigned char* L, int q, int fr, int fq) {
    const LAS unsigned char* Am = L + ((q < 2) ? O_AH : O_RH); const LAS unsigned char* Bm = L + ((q & 1) ? O_KH : O_BH);
    LAS unsigned char* Om = L + (q == 0 ? O_XA : (q == 1 ? O_AAK : (q == 2 ? O_ARB : O_ARK)));
    constexpr int MT0 = HH ? 1 : 0, MT1 = HH ? 2 : 3, NB = MT1 + 1;
    unsigned zz_ = 0u; asm volatile("" : "+v"(zz_)); const v2u z2 = (v2u){zz_, zz_};
    bf16x8 a[2][2], b[NB][2];
#pragma unroll
    for (int ks = 0; ks < 2; ++ks) { a[0][ks] = ldfrag(Am, LDB, 16 * MT0, 32 * ks, fr, fq); a[1][ks] = ldfrag(Am, LDB, 16 * MT1, 32 * ks, fr, fq); }
#pragma unroll
    for (int nt = 0; nt < NB; ++nt)
#pragma unroll
        for (int ks = 0; ks < 2; ++ks) b[nt][ks] = ldfrag(Bm, LDB, 16 * nt, 32 * ks, fr, fq);
    CFENCE();
#pragma unroll
    for (int mi = 0; mi < 2; ++mi) { const int mtile = mi ? MT1 : MT0;
        PIN(a[mi][0]); PIN(a[mi][1]);
#pragma unroll
        for (int nt = 0; nt < 4; ++nt) {
            if (nt > mtile) {
                *(LAS v2u*)(Om + ((16 * mtile + fr) * LDB + 16 * nt + 4 * fq) * 2) = z2;
                if (q == 0) { *(LAS v2u*)(L + O_XAT + ((16 * nt + fr) * LDB + 16 * mtile + 4 * fq) * 2) = z2; *(LAS v2u*)(L + O_UT + ((16 * nt + fr) * LDB + 16 * mtile + 4 * fq) * 2) = z2; }
                continue; }
            if (mi == 0) { PIN(b[nt][0]); PIN(b[nt][1]); }
            f32x4 at = (f32x4){0.f, 0.f, 0.f, 0.f};
            at = MFMA16(b[nt][0], a[mi][0], at); at = MFMA16(b[nt][1], a[mi][1], at);
            if (nt == mtile) {
#pragma unroll
                for (int jj = 0; jj < 4; ++jj) { const bool keep = (q < 2) ? (4 * fq + jj < fr) : (4 * fq + jj <= fr); if (!keep) at[jj] = 0.f; } }
            { v2u o; o.x = pk2(at[0], at[1]); o.y = pk2(at[2], at[3]); *(LAS v2u*)(Om + ((16 * mtile + fr) * LDB + 16 * nt + 4 * fq) * 2) = o; }
            if ((mtile >> 1) == (nt >> 1)) {
                if (q == 0) { f32x4 an = (f32x4){0.f, 0.f, 0.f, 0.f};
                    an = MFMA16(a[mi][0], b[nt][0], an); an = MFMA16(a[mi][1], b[nt][1], an);
                    f32x4 t1 = an;
                    if (nt == mtile) {
#pragma unroll
                        for (int jj = 0; jj < 4; ++jj) { if (!(fr < 4 * fq + jj)) an[jj] = 0.f; t1[jj] = (fr == 4 * fq + jj) ? 1.0f : an[jj]; } }
                    st_tile_bf16_T(L + O_XAT, LDB, 16 * mtile, 16 * nt, fr, fq, an);
                    st_tile_bf16_T(L + O_UT, LDB, 16 * mtile, 16 * nt, fr, fq, t1); } }
        } }
}

__device__ __forceinline__ void cscan_chain(Frame& F, int l, int unit) {
    PHASE_TID(); const int chain = unit >> 1, seg = unit & 1; const int b = chain >> 4, h = (chain >> 1) & 7, d = chain & 1, hc = h * HD;
    const int fr_o = lane & 15, fq_o = lane >> 4;
    LAS unsigned char* L = F.lds;
    const bf16* PRW = (const bf16*)(F.ws + WS_PRW);
    const float* mu = F.in[I_SHIFT] + (size_t)l * 2 * RWP;
    const bf16* VFIRST = (const bf16*)(F.ws + WS_VFIRST);
    bf16* VOUT = (l == 0) ? (bf16*)(F.ws + WS_VFIRST) : (bf16*)(F.ws + WS_V2);
    bf16* GOUT = (bf16*)(F.ws + WS_G);
    bf16* YS = (bf16*)(F.ws + WS_YS) + (size_t)d * M * CH;
    float* BS = (float*)(F.ws + WS_BS) + (size_t)d * M * NH;
    bf16* YPHI = (bf16*)(F.ws + WS_YPHI) + (size_t)chain * (T / 2) * 64;
    const int lnt = wave & 3, lmt0 = 2 * (wave >> 2);
    if (wave < 4) { const int lcol = hc + 16 * lnt + fr_o; bf16x8* FRAGS = (bf16x8*)(F.ws + WS_FRAG) + ((size_t)chain * 4 + lnt) * 9 * 64 + lane; const float* w2 = F.in[I_W2] + (size_t)(l * 2 + d) * 64 * CH; const float* a2 = F.in[I_A2] + (size_t)(l * 2 + d) * 64 * CH; const float* g2 = F.in[I_G2] + (size_t)l * 128 * CH;
#pragma unroll
      for (int ks = 0; ks < 2; ++ks) { FRAGS[ks * 64] = wfrag(w2, 32 * ks, lcol, fq_o); FRAGS[(2 + ks) * 64] = wfrag(a2, 32 * ks, lcol, fq_o); }
      if (l == 1) FRAGS[4 * 64] = wfrag(F.in[I_V2], 0, lcol, fq_o);
#pragma unroll
      for (int ks = 0; ks < 4; ++ks) if (d == 0) FRAGS[(5 + ks) * 64] = wfrag(g2, 32 * ks, lcol, fq_o); }
    const int lcol_o = hc + 16 * lnt + fr_o;
    const float lc_w0 = F.in[I_W0][(l * 2 + d) * CH + lcol_o], lc_a0 = F.in[I_A0][(l * 2 + d) * CH + lcol_o], lc_v0 = (l == 1) ? F.in[I_V0][lcol_o] : 0.f;
    const int mt = wave >> 1, nt0 = 2 * (wave & 1);
    f32x4 S[2] = {(f32x4){0.f, 0.f, 0.f, 0.f}, (f32x4){0.f, 0.f, 0.f, 0.f}};
    f32x4 Ph[2];
#pragma unroll
    for (int j = 0; j < 2; ++j)
#pragma unroll
        for (int jj = 0; jj < 4; ++jj) Ph[j][jj] = (16 * mt + 4 * fq_o + jj == 16 * (nt0 + j) + fr_o) ? 1.0f : 0.f;
    __syncthreads();
    for (int e = tid; e < MB / 4; e += NTHR) ((LAS unsigned*)(L + O_S0B))[e] = 0u;
    if (tid < 448) { const int g = tid >> 6, j = tid & 63; const int col = (g < 3) ? g * CH + hc + j : (g == 3 ? 1536 + d * 64 + j : (g == 4 ? 1664 + d * 64 + j : 1792 + (tid - 320)));
        const unsigned pm = pk2(mu[col], mu[RWP + col]); ((LAS unsigned*)(L + O_MU))[tid] = pm; ((LAS float*)(L + O_MC))[tid] = 1.0f - bflo(pm) - bfhi(pm); }
    if (tid < 192) { const int g = tid >> 6, j = tid & 63; ((LAS float*)(L + O_CK))[tid] = F.in[g == 0 ? I_KK : (g == 1 ? I_KA : I_RK)][l * CH + hc + j]; }
    RawTok raw;
    { const int et0 = tid >> 3, ec0 = (tid & 7) * 8; const int cf = (d == 0) ? seg * 64 * CL_ : (127 - seg * 64) * CL_; load_raw(raw, PRW, VFIRST, b, (d == 0) ? cf + et0 : cf + 63 - et0, hc, ec0, d, l, (tid & 7) < 4); }
#pragma unroll 1
    for (int ci = 0; ci < T / CL_ / 2; ++ci) {
        int tid = (wave << 6) | (int)__builtin_amdgcn_mbcnt_hi(~0u, __builtin_amdgcn_mbcnt_lo(~0u, 0u)); asm volatile("" : "+v"(tid));
        const int lane = tid & 63, fr = lane & 15, fq = lane >> 4, et = tid >> 3, ec = (tid & 7) * 8;
        const int lcol = hc + 16 * lnt + fr;
        const unsigned char* FRB = F.ws + WS_FRAG + (((size_t)chain * 4 + lnt) * 9 * 64) * 16; unsigned fo = (unsigned)lane * 16u;
#define FRAGS_(k) (*(const bf16x8*)(FRB + fo + (k) * 1024))
        int c0 = (d == 0 ? seg * 64 + ci : 127 - seg * 64 - ci) * CL_; asm volatile("" : "+s"(c0));
        const int tok = (d == 0) ? c0 + et : c0 + 63 - et;
        const size_t m = (size_t)b * T + tok;
        __syncthreads();
        float rr[8], kr[8], vr[8];
        const LAS unsigned* MUB = (const LAS unsigned*)(L + O_MU) + ec; const LAS float* MCB = (const LAS float*)(L + O_MC) + ec;
        v4u vl4 = (v4u){0u, 0u, 0u, 0u}, vf4 = vl4;
        if (l == 1 && (tid & 7) < 4) vl4 = *(const v4u*)(PRW + m * NRW + RWP + ec);
        bf16x8 wf[5];
        {
          if (d == 0) { float g0[8], g1[8];
              mix8r(raw.g[5], MUB + 320, MCB + 320, g0); CFENCE(); mix8r(raw.g[6], MUB + 384, MCB + 384, g1); CFENCE();
#pragma unroll
              for (int e = 0; e < 8; ++e) { g0[e] = sigmoidf_(g0[e]); g1[e] = sigmoidf_(g1[e]); }
              *(LAS v4u*)(L + O_SG + (et * LDSG + ec) * 2) = pack8(g0); *(LAS v4u*)(L + O_SG + (et * LDSG + 64 + ec) * 2) = pack8(g1); }
          float xw[8], xa[8];
          mix8r(raw.g[3], MUB + 192, MCB + 192, xw); CFENCE(); mix8r(raw.g[4], MUB + 256, MCB + 256, xa);
          asm volatile("" : "+v"(fo) : "v"(xw[7]), "v"(xa[7]));
          wf[0] = FRAGS_(0); wf[1] = FRAGS_(1); wf[2] = FRAGS_(2); wf[3] = FRAGS_(3); wf[4] = ZFRAG; if (l == 1) wf[4] = FRAGS_(4);
          CFENCE();
#pragma unroll
          for (int e = 0; e < 8; ++e) xw[e] = tanhf_(xw[e]);
          *(LAS v4u*)(L + O_TW + (et * LDB + ec) * 2) = pack8(xw);
          *(LAS v4u*)(L + O_AD + (et * LDB + ec) * 2) = pack8(xa);
          mix8r(raw.g[0], MUB, MCB, rr); CFENCE(); mix8r(raw.g[1], MUB + 64, MCB + 64, kr); CFENCE(); mix8r(raw.g[2], MUB + 128, MCB + 128, vr);
          if (l == 1 && (tid & 7) < 4) *(LAS v4u*)(L + O_VL + (et * LDVL + ec) * 2) = vl4;
          if (l == 1) vf4 = *(const v4u*)(VFIRST + m * CH + hc + ec); }
        __syncthreads();
        { bf16x8 gf[4];
          gf[0] = ZFRAG; gf[1] = ZFRAG; gf[2] = ZFRAG; gf[3] = ZFRAG;
          if (d == 0) { gf[0] = FRAGS_(5); gf[1] = FRAGS_(6); gf[2] = FRAGS_(7); gf[3] = FRAGS_(8); }
#pragma unroll
          for (int mi = 0; mi < 2; ++mi) { const int m0 = 16 * (lmt0 + mi);
              bf16x8 tw[2], ad[2], vl;
#pragma unroll
              for (int ks = 0; ks < 2; ++ks) { tw[ks] = ldfrag(L + O_TW, LDB, m0, 32 * ks, fr, fq); ad[ks] = ldfrag(L + O_AD, LDB, m0, 32 * ks, fr, fq); }
              vl = ZFRAG; if (l == 1) vl = ldfrag(L + O_VL, LDVL, m0, 0, fr, fq);
              CFENCE();
              f32x4 zw = (f32x4){0.f, 0.f, 0.f, 0.f}, za = zw, zv = zw;
#pragma unroll
              for (int ks = 0; ks < 2; ++ks) { PIN(tw[ks]); zw = MFMA16(tw[ks], wf[ks], zw); PIN(ad[ks]); za = MFMA16(ad[ks], wf[2 + ks], za); }
              if (l == 1) { PIN(vl); zv = MFMA16(vl, wf[4], zv); }
#pragma unroll
              for (int jj = 0; jj < 4; ++jj) { const int s = m0 + 4 * fq + jj, o = (s * LDF + 16 * lnt + fr) * 4;
                  *(LAS float*)(L + O_AF + o) = sigmoidf_(za[jj] + lc_a0);
                  *(LAS float*)(L + O_LW + o) = -0.6065306597126334f * sigmoidf_(zw[jj] + lc_w0); }
              if (l == 1) {
#pragma unroll
                  for (int jj = 0; jj < 4; ++jj) { const int s = m0 + 4 * fq + jj, o = (s * LDF + 16 * lnt + fr) * 4; *(LAS float*)(L + O_ZV + o) = sigmoidf_(zv[jj] + lc_v0); } } }
          if (d == 0) {
#pragma unroll
              for (int mi = 0; mi < 2; ++mi) { const int m0 = 16 * (lmt0 + mi);
                  bf16x8 sg[4];
#pragma unroll
                  for (int ks = 0; ks < 4; ++ks) sg[ks] = ldfrag(L + O_SG, LDSG, m0, 32 * ks, fr, fq);
                  CFENCE();
                  f32x4 zg = (f32x4){0.f, 0.f, 0.f, 0.f};
#pragma unroll
                  for (int ks = 0; ks < 4; ++ks) { PIN(sg[ks]); zg = MFMA16(gf[ks], sg[ks], zg); }
                  { v2u o; o.x = pk2(zg[0], zg[1]); o.y = pk2(zg[2], zg[3]); *(v2u*)(GOUT + ((size_t)b * T + c0 + m0 + fr) * CH + hc + 16 * lnt + 4 * fq) = o; } } } }
        __syncthreads();
        { const int j = tid & 63, sg = tid >> 6; float c[8]; float run = 0.f;
#pragma unroll
          for (int i = 0; i < 8; ++i) { run += *(LAS float*)(L + O_LW + ((8 * sg + i) * LDF + j) * 4); c[i] = run; }
          *(LAS float*)(L + O_PART + (sg * 64 + j) * 4) = run;
          __syncthreads();
          float pre = 0.f;
#pragma unroll
          for (int q = 0; q < 8; ++q) { const float pv = *(LAS float*)(L + O_PART + (q * 64 + j) * 4); pre += (q < sg) ? pv : 0.f; }
#pragma unroll
          for (int i = 0; i < 8; ++i) *(LAS float*)(L + O_LW + ((8 * sg + i) * LDF + j) * 4) = c[i] + pre; }
        __syncthreads();
        { float kkr[8], av[8], cl[8], clm[8], zv[8], kd[8], ss = 0.f, bon = 0.f;
          const unsigned vfw[4] = {vf4.x, vf4.y, vf4.z, vf4.w};
          const LAS float* CKT = (const LAS float*)(L + O_CK) + ec;
          const f32x4 kka = *(const LAS f32x4*)CKT, kkb = *(const LAS f32x4*)(CKT + 4), kaa = *(const LAS f32x4*)(CKT + 64), kab = *(const LAS f32x4*)(CKT + 68), rka = *(const LAS f32x4*)(CKT + 128), rkb = *(const LAS f32x4*)(CKT + 132);
          const int o0 = (et * LDF + ec) * 4, om = (et > 0) ? o0 - LDF * 4 : o0;
#pragma unroll
          for (int e = 0; e < 8; ++e) { av[e] = *(LAS float*)(L + O_AF + o0 + 4 * e); cl[e] = *(LAS float*)(L + O_LW + o0 + 4 * e); clm[e] = *(LAS float*)(L + O_LW + om + 4 * e); zv[e] = 0.f; }
          if (l == 1) {
#pragma unroll
              for (int e = 0; e < 8; ++e) zv[e] = *(LAS float*)(L + O_ZV + o0 + 4 * e); }
          CFENCE();
          const float ckk[8] = {kka[0], kka[1], kka[2], kka[3], kkb[0], kkb[1], kkb[2], kkb[3]}, cka[8] = {kaa[0], kaa[1], kaa[2], kaa[3], kab[0], kab[1], kab[2], kab[3]},
                      crk[8] = {rka[0], rka[1], rka[2], rka[3], rkb[0], rkb[1], rkb[2], rkb[3]};
#pragma unroll
          for (int e = 0; e < 8; ++e) {
              const float vf = (e & 1) ? bfhi(vfw[e >> 1]) : bflo(vfw[e >> 1]); vr[e] = vr[e] + (vf - vr[e]) * zv[e];
              kkr[e] = kr[e] * ckk[e]; ss += kkr[e] * kkr[e];
              kd[e] = kr[e] * (1.0f + (av[e] - 1.0f) * cka[e]); bon += rr[e] * kd[e] * crk[e]; }
          ss = sum8(ss); bon = sum8(bon);
          const float inv = __builtin_amdgcn_rsqf(fmaxf(ss, 1e-24f));
          if ((tid & 7) == 0) BS[m * NH + h] = bon;
          if (d == 0) *(v4u*)(VOUT + m * CH + hc + ec) = pack8(vr);
          float ah[8], bh[8], kh[8], rh[8], Pv[8];
#pragma unroll
          for (int e = 0; e < 8; ++e) {
              const float P = __expf(cl[e]), Pi = __builtin_amdgcn_rcpf(P), Pm = (et > 0) ? __expf(clm[e]) : 1.0f, kk = kkr[e] * inv;
              ah[e] = -kk * Pm; bh[e] = kk * av[e] * Pi; kh[e] = kd[e] * Pi; rh[e] = rr[e] * P; Pv[e] = P; }
          if (et == 63) { *(LAS f32x4*)(L + O_PL + ec * 4) = (f32x4){Pv[0], Pv[1], Pv[2], Pv[3]}; *(LAS f32x4*)(L + O_PL + ec * 4 + 16) = (f32x4){Pv[4], Pv[5], Pv[6], Pv[7]}; }
          *(LAS v4u*)(L + O_AH + (et * LDB + ec) * 2) = pack8(ah); *(LAS v4u*)(L + O_BH + (et * LDB + ec) * 2) = pack8(bh);
          *(LAS v4u*)(L + O_KH + (et * LDB + ec) * 2) = pack8(kh); *(LAS v4u*)(L + O_RH + (et * LDB + ec) * 2) = pack8(rh);
          { unsigned pab[8], pkv[8]; const int c = tid & 7;
#pragma unroll
            for (int e = 0; e < 8; ++e) { pab[e] = pk2(ah[e], bh[e]); pkv[e] = pk2(kh[e], vr[e]); }
#pragma unroll
            for (int sh = 1; sh < 8; sh <<= 1) { const bool on = (c & sh) != 0; unsigned ta[8], tk[8];
#pragma unroll
                for (int e = 0; e < 8; ++e) { ta[e] = on ? pab[(e + sh) & 7] : pab[e]; tk[e] = on ? pkv[(e + sh) & 7] : pkv[e]; }
#pragma unroll
                for (int e = 0; e < 8; ++e) { pab[e] = ta[e]; pkv[e] = tk[e]; } }
#pragma unroll
            for (int e = 0; e < 8; ++e) { const int o = ((ec + ((e + c) & 7)) * LDB + et) * 2;
                *(LAS bf16*)(L + O_AHT + o) = (bf16)(pab[e] & 0xffffu); *(LAS bf16*)(L + O_BHT + o) = (bf16)(pab[e] >> 16);
                *(LAS bf16*)(L + O_KHT + o) = (bf16)(pkv[e] & 0xffffu); *(LAS bf16*)(L + O_VT + o) = (bf16)(pkv[e] >> 16); } } }
        __syncthreads();
        { if (wave & 1) m2_half<1>(L, wave >> 1, fr, fq); else m2_half<0>(L, wave >> 1, fr, fq); }
        __syncthreads();
        if (ci + 1 < T / CL_ / 2) { const int c0n = (d == 0) ? c0 + CL_ : c0 - CL_; load_raw(raw, PRW, VFIRST, b, (d == 0) ? c0n + et : c0n + 63 - et, hc, ec, d, l, (tid & 7) < 4); }
        { blk_stage<false, true, false>(L + O_XA, L + O_XAT, nullptr, nullptr, nullptr, L + O_AH, L + O_KH, wave, fr, fq); }
        __syncthreads();
        { blk_stage<true, true, false>(L + O_AH, L + O_KH, L + O_UT, L + O_BH, nullptr, L + O_XA, L + O_XAT, wave, fr, fq); }
        __syncthreads();
        { blk_stage<true, true, false>(L + O_XA, L + O_XAT, L + O_BH, L + O_UT, nullptr, L + O_AH, L + O_KH, wave, fr, fq); }
        __syncthreads();
        { blk_stage<true, true, false>(L + O_AH, L + O_KH, L + O_UT, L + O_BH, nullptr, L + O_XA, L + O_XAT, wave, fr, fq); }
        __syncthreads();
        { blk_stage<true, false, true>(L + O_XA, L + O_XAT, L + O_BH, L + O_TB, L + O_T0T, nullptr, nullptr, wave, fr, fq); }
        __syncthreads();
        { if (wave < 4) { const int bmt = (wave >> 1) & 1, bnt = wave & 1;
            bf16x8 a0 = ldfrag(L + O_XA, LDB, 32, 0, fr, fq), a1 = ldfrag(L + O_XA, LDB, 48, 0, fr, fq), t1b = ldfrag(L + O_T0T, LDB, 16 * bnt, 0, fr, fq), t22 = ldfrag(L + O_TB, LDB, 32 + 16 * bmt, 32, fr, fq);
            const f32x4 z4 = (f32x4){0.f, 0.f, 0.f, 0.f};
            const f32x4 w0 = MFMA16(a0, t1b, z4), w1 = MFMA16(a1, t1b, z4);
            st_tile_bf16_T(L + O_WT, LDB, 0, 16 * bnt, fr, fq, w0); st_tile_bf16_T(L + O_WT, LDB, 16, 16 * bnt, fr, fq, w1);
            LDS_WAIT();
            const bf16x8 wb = ldfrag(L + O_WT, LDB, 16 * bnt, 0, fr, fq);
            const f32x4 t21 = MFMA16(t22, wb, z4);
            st_tile_bf16(L + O_TB, LDB, 32 + 16 * bmt, 16 * bnt, fr, fq, t21);
        } else { const int bmt = (wave >> 1) & 1, bnt = wave & 1;
            unsigned zz_ = 0u; asm volatile("" : "+v"(zz_)); *(LAS v2u*)(L + O_TB + ((16 * bmt + fr) * LDB + 32 + 16 * bnt + 4 * fq) * 2) = (v2u){zz_, zz_}; } }
        f32x4 y0[2] = {(f32x4){0.f, 0.f, 0.f, 0.f}, (f32x4){0.f, 0.f, 0.f, 0.f}}, g0[2] = {y0[0], y0[0]};
        { f32x4 m1[2] = {(f32x4){0.f, 0.f, 0.f, 0.f}, (f32x4){0.f, 0.f, 0.f, 0.f}};
          bf16x8 aak[2], ark[2], vta[2], vtb[2][2], khb[2][2];
          ldA(aak, L + O_AAK, mt, fr, fq); ldB(vtb, L + O_VT, nt0, fr, fq); ldA(ark, L + O_ARK, mt, fr, fq); ldA(vta, L + O_VT, mt, fr, fq); ldB(khb, L + O_KHT, nt0, fr, fq);
          CFENCE();
          mmac(aak, vtb, m1); mmacT(ark, vtb, y0); mmac(vta, khb, g0);
#pragma unroll
          for (int j = 0; j < 2; ++j) st_tile_bf16_T(L + O_M1T, LDB, 16 * mt, 16 * (nt0 + j), fr, fq, m1[j]); }
        __syncthreads();
        f32x4 u0[2] = {(f32x4){0.f, 0.f, 0.f, 0.f}, (f32x4){0.f, 0.f, 0.f, 0.f}};
        { f32x4 ap[2] = {u0[0], u0[0]};
          bf16x8 tba[2], ahb[2][2], m1b[2][2];
          ldA(tba, L + O_TB, mt, fr, fq); ldB(ahb, L + O_AHT, nt0, fr, fq); ldB(m1b, L + O_M1T, nt0, fr, fq);
          CFENCE();
          mmac(tba, ahb, ap); mmac(tba, m1b, u0);
#pragma unroll
          for (int j = 0; j < 2; ++j) st_tile_bf16(L + O_APB, LDB, 16 * mt, 16 * (nt0 + j), fr, fq, ap[j]);
          if (seg) {
#pragma unroll
              for (int j = 0; j < 2; ++j) st_tile_bf16(L + O_VT, LDB, 16 * mt, 16 * (nt0 + j), fr, fq, Ph[j]); } }
        __syncthreads();
        { bf16x8 apa[2], s0b[2][2], phb[2][2];
          ldA(apa, L + O_APB, mt, fr, fq); ldB(s0b, L + O_S0B, nt0, fr, fq); phb[0][0] = ZFRAG; phb[0][1] = ZFRAG; phb[1][0] = ZFRAG; phb[1][1] = ZFRAG; if (seg) ldB(phb, L + O_VT, nt0, fr, fq);
          CFENCE();
          mmac(apa, s0b, u0);
#pragma unroll
          for (int j = 0; j < 2; ++j) st_tile_bf16_T(L + O_UT, LDB, 16 * mt, 16 * (nt0 + j), fr, fq, u0[j]);
          if (seg) { f32x4 up[2] = {(f32x4){0.f, 0.f, 0.f, 0.f}, (f32x4){0.f, 0.f, 0.f, 0.f}};
              mmac(apa, phb, up);
#pragma unroll
              for (int j = 0; j < 2; ++j) st_tile_bf16_T(L + O_KHT, LDB, 16 * mt, 16 * (nt0 + j), fr, fq, up[j]); } }
        __syncthreads();
        { bf16x8 rha[2], arba[2], uta[2], s0b[2][2], utb[2][2], bhb[2][2]; float plv[2];
          ldA(rha, L + O_RH, mt, fr, fq); ldB(s0b, L + O_S0B, nt0, fr, fq); ldA(arba, L + O_ARB, mt, fr, fq); ldB(utb, L + O_UT, nt0, fr, fq);
#pragma unroll
          for (int j = 0; j < 2; ++j) plv[j] = *(LAS float*)(L + O_PL + (16 * (nt0 + j) + fr) * 4);
          CFENCE();
          mmacT(rha, s0b, y0);
          ldA(uta, L + O_UT, mt, fr, fq); ldB(bhb, L + O_BHT, nt0, fr, fq);
          CFENCE();
          mmacT(arba, utb, y0);
          { const int s = 16 * mt + fr; const int tk = (d == 0) ? c0 + s : c0 + 63 - s;
#pragma unroll
            for (int j = 0; j < 2; ++j) { v2u o; o.x = pk2(y0[j][0], y0[j][1]); o.y = pk2(y0[j][2], y0[j][3]); *(v2u*)(YS + ((size_t)b * T + tk) * CH + hc + 16 * (nt0 + j) + 4 * fq) = o; } }
          f32x4 sn[2] = {g0[0], g0[1]};
          mmac(uta, bhb, sn);
#pragma unroll
          for (int j = 0; j < 2; ++j) S[j] = (S[j] + sn[j]) * plv[j];
          if (seg) { f32x4 yp[2] = {(f32x4){0.f, 0.f, 0.f, 0.f}, (f32x4){0.f, 0.f, 0.f, 0.f}}, pn[2] = {yp[0], yp[0]};
              bf16x8 rh2[2], arb2[2], kha[2], phb[2][2], khb[2][2], bh2[2][2];
              ldA(rh2, L + O_RH, mt, fr, fq); ldB(phb, L + O_VT, nt0, fr, fq); ldA(arb2, L + O_ARB, mt, fr, fq); ldB(khb, L + O_KHT, nt0, fr, fq); ldA(kha, L + O_KHT, mt, fr, fq); ldB(bh2, L + O_BHT, nt0, fr, fq);
              CFENCE();
              mmacT(rh2, phb, yp);
              mmacT(arb2, khb, yp);
              { const int s = 16 * mt + fr; const int tk = (d == 0) ? c0 + s : c0 + 63 - s;
#pragma unroll
                for (int j = 0; j < 2; ++j) { v2u o; o.x = pk2(yp[j][0], yp[j][1]); o.y = pk2(yp[j][2], yp[j][3]); *(v2u*)(YPHI + (size_t)(tk & (T / 2 - 1)) * 64 + 16 * (nt0 + j) + 4 * fq) = o; } }
              mmac(kha, bh2, pn);
#pragma unroll
              for (int j = 0; j < 2; ++j) Ph[j] = (Ph[j] + pn[j]) * plv[j]; } }
        __syncthreads();
#pragma unroll
        for (int j = 0; j < 2; ++j) st_tile_bf16(L + O_S0B, LDB, 16 * mt, 16 * (nt0 + j), fr, fq, S[j]);
    }
    if (seg == 0) { float* SF = (float*)(F.ws + WS_SFIN) + (size_t)chain * 4096;
        int t2 = (int)__builtin_amdgcn_mbcnt_hi(~0u, __builtin_amdgcn_mbcnt_lo(~0u, 0u)); asm volatile("" : "+v"(t2)); const int fr2 = t2 & 15, fq2 = (t2 >> 4) & 3;
#pragma unroll
        for (int j = 0; j < 2; ++j)
#pragma unroll
            for (int jj = 0; jj < 4; ++jj) SF[(16 * mt + 4 * fq2 + jj) * 64 + 16 * (nt0 + j) + fr2] = S[j][jj]; }
    __syncthreads();
}


__device__ __forceinline__ void tr_item(const float* W, int ld, int col0, int nblk, int K, bf16* WT, int row_off, LAS float* scr, int item, int lane, const float* gain = nullptr) {
    const int kb = item / nblk, nb = item % nblk, k0 = 64 * kb, n0 = 32 * nb;
    float wv[32];
#pragma unroll
    for (int i = 0; i < 32; ++i) wv[i] = W[(size_t)(k0 + 2 * i + (lane >> 5)) * ld + col0 + n0 + (lane & 31)];
    if (gain) {
#pragma unroll
        for (int i = 0; i < 32; ++i) wv[i] *= gain[k0 + 2 * i + (lane >> 5)]; }
#pragma unroll
    for (int i = 0; i < 32; ++i) scr[(2 * i + (lane >> 5)) * 33 + (lane & 31)] = wv[i];
    LDS_WAIT(); asm volatile("" ::: "memory");
    const int c = lane & 7;
#pragma unroll
    for (int j = 0; j < 4; ++j) { const int n = (lane >> 3) + 8 * j; const LAS float* s = scr + (8 * c) * 33 + n;
        v4u o; o.x = pk2(s[0 * 33], s[1 * 33]); o.y = pk2(s[2 * 33], s[3 * 33]); o.z = pk2(s[4 * 33], s[5 * 33]); o.w = pk2(s[6 * 33], s[7 * 33]);
        *(v4u*)(WT + (size_t)(row_off + n0 + n) * K + k0 + 8 * c) = o; }
    LDS_WAIT(); asm volatile("" ::: "memory");
}
__device__ __forceinline__ void wq_max_item(const float* W, int ld, int col0, int nblk, unsigned* cmax, int item, int lane) {
    const int kb = item / nblk, nb = item % nblk, k0 = 64 * kb, n0 = 32 * nb; float am = 0.f;
#pragma unroll
    for (int i = 0; i < 32; ++i) am = fmaxf(am, fabsf(W[(size_t)(k0 + 2 * i + (lane >> 5)) * ld + col0 + n0 + (lane & 31)]));
    am = fmaxf(am, __shfl_xor(am, 32));
    if (lane < 32) atomicMax(cmax + n0 + lane, __float_as_uint(am));
}
__device__ __forceinline__ void wq_item(const float* W, int ld, int col0, int nblk, const unsigned* cmax, float* csc, unsigned char* WQ, int row_off, LAS float* scr, int item, int lane) {
    const int kb = item / nblk, nb = item % nblk, k0 = 64 * kb, n0 = 32 * nb;
    float wv[32];
#pragma unroll
    for (int i = 0; i < 32; ++i) wv[i] = W[(size_t)(k0 + 2 * i + (lane >> 5)) * ld + col0 + n0 + (lane & 31)];
#pragma unroll
    for (int i = 0; i < 32; ++i) scr[(2 * i + (lane >> 5)) * 33 + (lane & 31)] = wv[i];
    LDS_WAIT(); asm volatile("" ::: "memory");
    const int c = lane & 7;
#pragma unroll
    for (int j = 0; j < 4; ++j) { const int n = (lane >> 3) + 8 * j; const LAS float* sp = scr + (8 * c) * 33 + n;
        const float cm = __uint_as_float(cmax[n0 + n]), inv = cm > 0.f ? 127.0f / cm : 0.f;
        v2u o; o.x = q4(sp[0 * 33] * inv, sp[1 * 33] * inv, sp[2 * 33] * inv, sp[3 * 33] * inv); o.y = q4(sp[4 * 33] * inv, sp[5 * 33] * inv, sp[6 * 33] * inv, sp[7 * 33] * inv);
        *(v2u*)(WQ + (size_t)(row_off + n0 + n) * D + k0 + 8 * c) = o;
        if (kb == 0 && c == 0) csc[n0 + n] = cm * (1.0f / 127.0f); }
    LDS_WAIT(); asm volatile("" ::: "memory");
}
__device__ __forceinline__ void p_convert(Frame& F) {
    PHASE_TID();
    LAS float* scr = (LAS float*)(F.lds + wave * 16384);
    const int gw = bid * NWAVES + wave, NGW = F.G * NWAVES;
    constexpr int C_HY = 16 * 48, C_RW = 16 * 60, C_V1 = 16, C_O = 16 * 32, C_1 = 16 * 128, C_2 = 64 * 32, C_L = C_HY + C_RW + C_V1 + C_O + C_1 + C_2;
    for (int it = gw; it < NL * C_L; it += NGW) {
        const int l = it / C_L; int r = it % C_L;
        unsigned char* wb = F.ws + WS_W + (size_t)l * W_LAYER;
        const float* win = F.in[I_WIN] + (size_t)l * D * PIN;
        unsigned* cmax = F.ctl + CW_CMAX + l * (HYP + NRW);
        if (r < C_HY) { wq_max_item(win, PIN, 0, 48, cmax, r, lane); continue; } r -= C_HY;
        if (r < C_RW) { wq_max_item(win, PIN, HYP, 60, cmax + HYP, r, lane); continue; } r -= C_RW;
        if (r < C_V1) { if (l == 1) wq_max_item(F.in[I_V1], 32, 0, 1, cmax + HYP + RWP, r, lane); continue; } r -= C_V1;
        if (r < C_O) { tr_item(F.in[I_WOUT] + (size_t)l * D * D, D, 0, 32, D, (bf16*)(wb + W_O), 0, scr, r, lane); continue; } r -= C_O;
        if (r < C_1) { tr_item(F.in[I_MW1] + (size_t)l * D * FF, FF, 0, 128, D, (bf16*)(wb + W_1), 0, scr, r, lane, F.in[I_N2G] + (size_t)l * D); continue; } r -= C_1;
        tr_item(F.in[I_MW2] + (size_t)l * FF * D, D, 0, 32, FF, (bf16*)(wb + W_2), 0, scr, r, lane);
    }
}
__device__ __forceinline__ void p_wquant(Frame& F) {
    PHASE_TID();
    LAS float* scr = (LAS float*)(F.lds + wave * 16384);
    const int gw = bid * NWAVES + wave, NGW = F.G * NWAVES;
    constexpr int C_HY = 16 * 48, C_RW = 16 * 60, C_V1 = 16, C_L = C_HY + C_RW + C_V1;
    for (int it = gw; it < NL * C_L; it += NGW) {
        const int l = it / C_L; int r = it % C_L;
        unsigned char* wb = F.ws + WS_W + (size_t)l * W_LAYER;
        const float* win = F.in[I_WIN] + (size_t)l * D * PIN;
        const unsigned* cmax = F.ctl + CW_CMAX + l * (HYP + NRW); float* csc = (float*)(F.ws + WS_CSC) + l * (HYP + NRW);
        if (r < C_HY) { wq_item(win, PIN, 0, 48, cmax, csc, wb + W_HY, 0, scr, r, lane); continue; } r -= C_HY;
        if (r < C_RW) { wq_item(win, PIN, HYP, 60, cmax + HYP, csc + HYP, wb + W_RW, 0, scr, r, lane); continue; } r -= C_RW;
        if (l == 1) wq_item(F.in[I_V1], 32, 0, 1, cmax + HYP + RWP, csc + HYP + RWP, wb + W_RW, RWP, scr, r, lane);
    }
    for (int l = 0; l < NL; ++l) {
        const int r0 = (l == 0) ? RWP : RWP + 32; const int n16 = (NRW - r0) * D / 16;
        v4u* p = (v4u*)(F.ws + WS_W + (size_t)l * W_LAYER + W_RW + (size_t)r0 * D);
        for (int i = bid * NTHR + tid; i < n16; i += F.G * NTHR) p[i] = (v4u){0u, 0u, 0u, 0u};
        float* csc = (float*)(F.ws + WS_CSC) + l * (HYP + NRW) + HYP;
        if (bid == 0 && tid < NRW - r0) csc[r0 + tid] = 0.f;
    }
}

__device__ __forceinline__ void p_filter_item(Frame& F, int l, int item) {
    LAS float* Z = (LAS float*)F.lds;
    LAS float* H1 = Z + 32 * 36;
    LAS float* H2 = H1 + 32 * 64;
    LAS float* H3 = H2 + 32 * 64;
    PHASE_TID(); const int pos0 = item * 32;
    const float* w1 = F.in[I_FW1] + l * 33 * 64; const float* b1 = F.in[I_FB1] + l * 64;
    const float* w2 = F.in[I_FW2] + l * 64 * 64; const float* b2 = F.in[I_FB2] + l * 64;
    const float* w3 = F.in[I_FW3] + l * 64 * 64; const float* b3 = F.in[I_FB3] + l * 64;
    const float* fq = F.in[I_FFREQ] + l * 3 * 64;
    __syncthreads();
    for (int e = tid; e < 32 * 33; e += NTHR) {
        const int p = e / 33, f = e % 33, pos = pos0 + p; float v;
        if (f == 0) v = (float)pos / (float)(T - 1);
        else { const int band = (f - 1) & 15; const float fr = 1e-4f + (float)band * ((15.0f - 1e-4f) / 15.0f);
            float x = (float)pos * fr * (1.0f / (float)T); x -= floorf(x);
            v = (f <= 16) ? __builtin_amdgcn_cosf(x) : -__builtin_amdgcn_sinf(x); }
        Z[p * 36 + f] = v;
    }
    __syncthreads();
    const int j = tid & 63, pb = tid >> 6;
    { float wc[33];
#pragma unroll
      for (int f = 0; f < 33; ++f) wc[f] = w1[f * 64 + j];
      const float bj = b1[j], fj = fq[j];
#pragma unroll
      for (int i = 0; i < 4; ++i) { const int p = pb + 8 * i; float s = bj;
#pragma unroll
          for (int f = 0; f < 33; ++f) s += Z[p * 36 + f] * wc[f];
          H1[p * 64 + j] = sin_hw(fj * s); } }
    __syncthreads();
#pragma unroll 1
    for (int ly = 0; ly < 2; ++ly) { const float* w = ly ? w3 : w2; const float* bb = ly ? b3 : b2; const LAS float* Hi = ly ? H2 : H1; LAS float* Ho = ly ? H3 : H2;
        float wc[64];
#pragma unroll
        for (int f = 0; f < 64; ++f) wc[f] = w[f * 64 + j];
        const float bj = bb[j], fj = fq[64 + 64 * ly + j];
#pragma unroll
        for (int i = 0; i < 4; ++i) { const int p = pb + 8 * i; float s = bj;
#pragma unroll
            for (int q = 0; q < 16; ++q) { const f32x4 h = *(const LAS f32x4*)(Hi + p * 64 + 4 * q); s += (h[0] * wc[4 * q] + h[1] * wc[4 * q + 1]) + (h[2] * wc[4 * q + 2] + h[3] * wc[4 * q + 3]); }
            Ho[p * 64 + j] = sin_hw(fj * s); }
        __syncthreads(); }
    const int fr = lane & 15, fqd = lane >> 4;
    bf16x8 af[2][2];
#pragma unroll
    for (int mt = 0; mt < 2; ++mt)
#pragma unroll
        for (int ks = 0; ks < 2; ++ks) { const LAS float* hp = H3 + (16 * mt + fr) * 64 + 32 * ks + 8 * fqd; const f32x4 h0 = *(const LAS f32x4*)hp, h1 = *(const LAS f32x4*)(hp + 4);
            const float hv[8] = {h0[0], h0[1], h0[2], h0[3], h1[0], h1[1], h1[2], h1[3]}; af[mt][ks] = __builtin_bit_cast(bf16x8, pack8(hv)); }
    const float* wo = F.in[I_FWOUT] + (size_t)l * 64 * 2048;
    float* HF = (float*)(F.ws + WS_HF);
#pragma unroll 1
    for (int tb = 0; tb < 16; tb += 4) {
        bf16x8 bfr[4][2];
#pragma unroll
        for (int u = 0; u < 4; ++u)
#pragma unroll
            for (int ks = 0; ks < 2; ++ks) { float v[8]; const float* wp = wo + (size_t)(32 * ks + 8 * fqd) * 2048 + 256 * wave + 16 * (tb + u) + fr;
#pragma unroll
                for (int e = 0; e < 8; ++e) v[e] = wp[(size_t)e * 2048];
                bfr[u][ks] = __builtin_bit_cast(bf16x8, pack8(v)); }
#pragma unroll
        for (int u = 0; u < 4; ++u) { const int col = 256 * wave + 16 * (tb + u) + fr, c = col & 511;
            const float delta = 3.0701134573f + (float)c * ((15.350567286f - 3.0701134573f) / 511.0f);
#pragma unroll
            for (int mt = 0; mt < 2; ++mt) { f32x4 acc = (f32x4){0.f, 0.f, 0.f, 0.f};
                acc = MFMA16(af[mt][0], bfr[u][0], acc); acc = MFMA16(af[mt][1], bfr[u][1], acc);
                f32x4 o;
#pragma unroll
                for (int jj = 0; jj < 4; ++jj) { const float t = (float)(pos0 + 16 * mt + 4 * fqd + jj) / (float)(T - 1); o[jj] = acc[jj] * __expf(-t * delta); }
                *(f32x4*)(HF + (size_t)col * T + pos0 + 16 * mt + 4 * fqd) = o; } } }
}
__device__ __forceinline__ void p_filter(Frame& F, int l) { PHASE_TID(); (void)tid; for (int it = bid; it < T / 32; it += F.G) p_filter_item(F, l, it); __syncthreads(); }

template <bool F32IN> __device__ __forceinline__ void p_rmsnorm_q(Frame& F, const void* xin, const float* g, unsigned char* HQ, float* RSC, int m0, int m1) {
    PHASE_TID();
    const int gw = bid * NWAVES + wave, NGW = F.G * NWAVES;
    constexpr int R = F32IN ? 2 : 4;
    f32x4 gv[4];
#pragma unroll
    for (int j = 0; j < 4; ++j) gv[j] = F32IN ? *(const f32x4*)(g + 4 * lane + 256 * j) : *(const f32x4*)(g + 16 * lane + 4 * j);
    for (int mb = m0 + gw; mb < m1; mb += R * NGW) {
        f32x4 xf[F32IN ? R : 1][4]; v4u xw[F32IN ? 1 : R][2];
#pragma unroll
        for (int r = 0; r < R; ++r) { const int m = mb + r * NGW;
            if (F32IN) { const f32x4* xr = (const f32x4*)((const float*)xin + (size_t)m * D) + lane;
#pragma unroll
                for (int j = 0; j < 4; ++j) xf[r][j] = xr[64 * j]; }
            else { const v4u* xr = (const v4u*)((const bf16*)xin + (size_t)m * D + 16 * lane); xw[r][0] = xr[0]; xw[r][1] = xr[1]; } }
        asm volatile("" ::: "memory");
#pragma unroll
        for (int r = 0; r < R; ++r) { const int m = mb + r * NGW;
            f32x4 v[4]; float s = 0.f;
            if (F32IN) {
#pragma unroll
                for (int j = 0; j < 4; ++j) v[j] = xf[r][j]; }
            else { const unsigned ww[8] = {xw[r][0].x, xw[r][0].y, xw[r][0].z, xw[r][0].w, xw[r][1].x, xw[r][1].y, xw[r][1].z, xw[r][1].w};
#pragma unroll
                for (int j = 0; j < 4; ++j) v[j] = (f32x4){bflo(ww[2 * j]), bfhi(ww[2 * j]), bflo(ww[2 * j + 1]), bfhi(ww[2 * j + 1])}; }
#pragma unroll
            for (int j = 0; j < 4; ++j) s += (v[j].x * v[j].x + v[j].y * v[j].y) + (v[j].z * v[j].z + v[j].w * v[j].w);
            const float rstd = 1.0f / sqrtf(wave_sum(s) * (1.0f / D) + RMS_EPS);
            float am = 0.f;
#pragma unroll
            for (int j = 0; j < 4; ++j) { v[j] = v[j] * rstd * gv[j]; am = fmaxf(fmaxf(am, fmaxf(fabsf(v[j].x), fabsf(v[j].y))), fmaxf(fabsf(v[j].z), fabsf(v[j].w))); }
            am = wave_max(am);
            const float inv = am > 0.f ? 127.0f / am : 0.f;
            unsigned qd[4];
#pragma unroll
            for (int j = 0; j < 4; ++j) qd[j] = q4(v[j].x * inv, v[j].y * inv, v[j].z * inv, v[j].w * inv);
            if (F32IN) {
#pragma unroll
                for (int j = 0; j < 4; ++j) *(unsigned*)(HQ + (size_t)m * D + 256 * j + 4 * lane) = qd[j]; }
            else *(v4u*)(HQ + (size_t)m * D + 16 * lane) = (v4u){qd[0], qd[1], qd[2], qd[3]};
            if (lane == 0) RSC[m] = am * (1.0f / 127.0f); }
    }
}
__device__ __forceinline__ void p_rmsnorm_b16(Frame& F, const bf16* x, const float* g, bf16* out, int m0, int m1) {
    PHASE_TID();
    const int gw = bid * NWAVES + wave, NGW = F.G * NWAVES;
    f32x4 gv[4];
#pragma unroll
    for (int j = 0; j < 4; ++j) gv[j] = *(const f32x4*)(g + 16 * lane + 4 * j);
    for (int m = m0 + gw; m < m1; m += NGW) {
        const v4u* xr = (const v4u*)(x + (size_t)m * D + 16 * lane); const v4u w0 = xr[0], w1 = xr[1];
        const unsigned ww[8] = {w0.x, w0.y, w0.z, w0.w, w1.x, w1.y, w1.z, w1.w}; f32x4 v[4]; float s = 0.f;
#pragma unroll
        for (int j = 0; j < 4; ++j) { v[j] = (f32x4){bflo(ww[2 * j]), bfhi(ww[2 * j]), bflo(ww[2 * j + 1]), bfhi(ww[2 * j + 1])}; s += (v[j].x * v[j].x + v[j].y * v[j].y) + (v[j].z * v[j].z + v[j].w * v[j].w); }
        const float rstd = 1.0f / sqrtf(wave_sum(s) * (1.0f / D) + RMS_EPS);
        v4u o[2];
#pragma unroll
        for (int j = 0; j < 2; ++j) { const f32x4 ya = v[2 * j] * rstd * gv[2 * j], yb = v[2 * j + 1] * rstd * gv[2 * j + 1]; o[j].x = pk2(ya.x, ya.y); o[j].y = pk2(ya.z, ya.w); o[j].z = pk2(yb.x, yb.y); o[j].w = pk2(yb.z, yb.w); }
        v4u* op = (v4u*)(out + (size_t)m * D + 16 * lane); op[0] = o[0]; op[1] = o[1];
    }
}
__device__ __forceinline__ void p_finalnorm(Frame& F, const bf16* x, const float* g, float* out) {
    PHASE_TID();
    const int gw = bid * NWAVES + wave, NGW = F.G * NWAVES;
    constexpr int R = 4;
    f32x4 gv[4];
#pragma unroll
    for (int j = 0; j < 4; ++j) gv[j] = *(const f32x4*)(g + 4 * lane + 256 * j);
    for (int mb = gw; mb < M; mb += R * NGW) {
        v2u xw[R][4];
#pragma unroll
        for (int r = 0; r < R; ++r) { const v2u* xr = (const v2u*)(x + (size_t)(mb + r * NGW) * D) + lane;
#pragma unroll
            for (int j = 0; j < 4; ++j) xw[r][j] = xr[64 * j]; }
        asm volatile("" ::: "memory");
#pragma unroll
        for (int r = 0; r < R; ++r) { f32x4 v[4]; float s = 0.f;
#pragma unroll
            for (int j = 0; j < 4; ++j) { v[j] = (f32x4){bflo(xw[r][j].x), bfhi(xw[r][j].x), bflo(xw[r][j].y), bfhi(xw[r][j].y)}; s += (v[j].x * v[j].x + v[j].y * v[j].y) + (v[j].z * v[j].z + v[j].w * v[j].w); }
            const float rstd = 1.0f / sqrtf(wave_sum(s) * (1.0f / D) + RMS_EPS);
            f32x4* o = (f32x4*)(out + (size_t)(mb + r * NGW) * D) + lane;
#pragma unroll
            for (int j = 0; j < 4; ++j) o[64 * j] = v[j] * rstd * gv[j]; }
    }
}
template <bool F32OUT> __device__ __forceinline__ void p_rmsnorm(Frame& F, const float* x, const float* g, void* outp, int m0, int m1) {
    PHASE_TID();
    const int gw = bid * NWAVES + wave, NGW = F.G * NWAVES;
    f32x4 gv[4];
#pragma unroll
    for (int j = 0; j < 4; ++j) gv[j] = *(const f32x4*)(g + 4 * lane + 256 * j);
    for (int m = m0 + gw; m < m1; m += NGW) {
        const f32x4* xr = (const f32x4*)(x + (size_t)m * D) + lane; f32x4 v[4]; float s = 0.f;
#pragma unroll
        for (int j = 0; j < 4; ++j) { v[j] = xr[64 * j]; s += (v[j].x * v[j].x + v[j].y * v[j].y) + (v[j].z * v[j].z + v[j].w * v[j].w); }
        const float rstd = 1.0f / sqrtf(wave_sum(s) * (1.0f / D) + RMS_EPS);
        if (F32OUT) { f32x4* o = (f32x4*)((float*)outp + (size_t)m * D) + lane;
#pragma unroll
            for (int j = 0; j < 4; ++j) o[64 * j] = v[j] * rstd * gv[j]; }
        else { v2u* o = (v2u*)((bf16*)outp + (size_t)m * D) + lane;
#pragma unroll
            for (int j = 0; j < 4; ++j) { const f32x4 y = v[j] * rstd * gv[j]; v2u w; w.x = pk2(y.x, y.y); w.y = pk2(y.z, y.w); o[64 * j] = w; } }
    }
}

constexpr int KPAD = 2 * T + 2 * T / 16;

constexpr int LC = 32;

__device__ __forceinline__ void p_mix(Frame& F, int l) {
    PHASE_TID();
#ifndef NO_SCAN
#ifdef SEQ_SCAN
    if (bid < 128) scan_chain(F, l, bid);
#else
    cscan_chain(F, l, bid);
#endif
#endif
    unsigned* head = F.ctl + CW_QUEUE + 64 * l;
    for (;;) {
        __syncthreads();
        if (tid == 0) F.MISC[16] = __hip_atomic_fetch_add(head, 1u, RLX_AGENT);
        __syncthreads();
        const unsigned it = F.MISC[16];
        if (it >= (unsigned)(4 * CH)) break;
        hy_fft_item(F, l, (int)it);
    }
    __syncthreads();
}

__device__ __forceinline__ void p_post(Frame& F, int l) {
    PHASE_TID();
    const int gw = bid * NWAVES + wave, NGW = F.G * NWAVES;
    bf16* YM = (bf16*)(F.ws + WS_YMIX);
    { LAS float* scr = (LAS float*)(F.lds + wave * 16640);
      const bf16* PHT = (const bf16*)(F.ws + WS_PHT); const float* ng = F.in[I_HNG] + (size_t)l * CH;
      for (int it = gw; it < NB * 8 * (T / 64); it += NGW) { const int tb = it & 127, g = (it >> 7) & 7, b = it >> 10, t0 = tb * 64;
          const bf16* src = PHT + ((size_t)b * HYP + CH + g * 64 + lane) * T + t0;
#pragma unroll
          for (int q = 0; q < 8; ++q) { const v4u w = *(const v4u*)(src + 8 * q); LAS float* d = scr + lane * 65 + 8 * q;
              d[0] = bflo(w.x); d[1] = bfhi(w.x); d[2] = bflo(w.y); d[3] = bfhi(w.y); d[4] = bflo(w.z); d[5] = bfhi(w.z); d[6] = bflo(w.w); d[7] = bfhi(w.w); }
          LDS_WAIT(); asm volatile("" ::: "memory");
          float z[64], ss = 0.f;
#pragma unroll
          for (int cc = 0; cc < 64; ++cc) { z[cc] = scr[cc * 65 + lane]; ss += z[cc] * z[cc]; }
          const float rs = 1.0f / sqrtf(ss * (1.0f / 64.0f) + RMS_EPS);
          bf16* dst = YM + ((size_t)b * T + t0 + lane) * D + g * 64;
#pragma unroll
          for (int q = 0; q < 8; ++q) { v4u o; const float* gq = ng + g * 64 + 8 * q;
              o.x = pk2(z[8 * q] * rs * gq[0], z[8 * q + 1] * rs * gq[1]); o.y = pk2(z[8 * q + 2] * rs * gq[2], z[8 * q + 3] * rs * gq[3]);
              o.z = pk2(z[8 * q + 4] * rs * gq[4], z[8 * q + 5] * rs * gq[5]); o.w = pk2(z[8 * q + 6] * rs * gq[6], z[8 * q + 7] * rs * gq[7]);
              *(v4u*)(dst + 8 * q) = o; }
          LDS_WAIT(); asm volatile("" ::: "memory"); } }
}

struct PostRows { v4u a, c, v, g; float bs; };
__device__ __forceinline__ void post_rows_load(PostRows& R, const bf16* YS0, const bf16* YS1, const bf16* VV, const bf16* GG, const float* BS0, const float* BS1, size_t m, int h, int ec) {
    const size_t o = m * CH + h * HD + ec;
    R.a = *(const v4u*)(YS0 + o); R.c = *(const v4u*)(YS1 + o); R.v = *(const v4u*)(VV + o); R.g = *(const v4u*)(GG + o); R.bs = BS0[m * NH + h] + BS1[m * NH + h];
}
__device__ __forceinline__ void p_postfix(Frame& F, int l) {
    PHASE_TID(); const int fr = lane & 15, fq = lane >> 4, mtw = wave >> 1, ntw = 2 * (wave & 1), et = tid >> 3, ec = (tid & 7) * 8;
    const int bh = bid >> 2, b = bh >> 3, h = bh & 7, tq = bid & 3, dfix = (tq >= 2) ? 0 : 1, chain = (b * NH + h) * 2 + dfix;
    const float* SF = (const float*)(F.ws + WS_SFIN) + (size_t)chain * 4096;
    bf16x8 sfb[2][2];
#pragma unroll
    for (int ks = 0; ks < 2; ++ks)
#pragma unroll
        for (int j = 0; j < 2; ++j) { const float* sp = SF + (16 * (ntw + j) + fr) * 64 + 32 * ks + 8 * fq; const f32x4 s0 = *(const f32x4*)sp, s1 = *(const f32x4*)(sp + 4);
            const float sv[8] = {s0[0], s0[1], s0[2], s0[3], s1[0], s1[1], s1[2], s1[3]}; sfb[ks][j] = __builtin_bit_cast(bf16x8, pack8(sv)); }
    const bf16* YP = (const bf16*)(F.ws + WS_YPHI) + ((size_t)chain * (T / 2) + 16 * mtw + fr) * 64 + 8 * fq;
    const bf16* YS0 = (const bf16*)(F.ws + WS_YS); const bf16* YS1 = YS0 + (size_t)M * CH;
    const bf16* VV = (l == 0) ? (const bf16*)(F.ws + WS_VFIRST) : (const bf16*)(F.ws + WS_V2);
    const bf16* GG = (const bf16*)(F.ws + WS_G); const float* BS0 = (const float*)(F.ws + WS_BS); const float* BS1 = BS0 + (size_t)M * NH;
    bf16* YM = (bf16*)(F.ws + WS_YMIX);
    float lg[8], lb[8];
#pragma unroll
    for (int j = 0; j < 8; ++j) { lg[j] = F.in[I_LNG][l * CH + h * HD + ec + j]; lb[j] = F.in[I_LNB][l * CH + h * HD + ec + j]; }
    LAS float* FX = (LAS float*)F.lds;
    const size_t mb = (size_t)b * T + 64 * (32 * tq) + et;
    __syncthreads();
    PostRows cur; bf16x8 acur[2];
    post_rows_load(cur, YS0, YS1, VV, GG, BS0, BS1, mb, h, ec);
#pragma unroll
    for (int ks = 0; ks < 2; ++ks) acur[ks] = *(const bf16x8*)(YP + (size_t)((32 * tq) & 63) * 64 * 64 + 32 * ks);
#pragma unroll 1
    for (int t = 0; t < 32; ++t) {
        PostRows nxt; bf16x8 anxt[2]; const int tn = (t + 1 < 32) ? t + 1 : t;
        post_rows_load(nxt, YS0, YS1, VV, GG, BS0, BS1, mb + 64 * tn, h, ec);
#pragma unroll
        for (int ks = 0; ks < 2; ++ks) anxt[ks] = *(const bf16x8*)(YP + (size_t)((32 * tq + tn) & 63) * 64 * 64 + 32 * ks);
        { f32x4 acc[2] = {(f32x4){0.f, 0.f, 0.f, 0.f}, (f32x4){0.f, 0.f, 0.f, 0.f}};
#pragma unroll
          for (int ks = 0; ks < 2; ++ks)
#pragma unroll
              for (int j = 0; j < 2; ++j) acc[j] = MFMA16(sfb[ks][j], acur[ks], acc[j]);
          LAS float* fx = FX + (t & 1) * 64 * 68 + (16 * mtw + fr) * 68 + 16 * ntw + 4 * fq;
          *(LAS f32x4*)fx = acc[0]; *(LAS f32x4*)(fx + 16) = acc[1]; }
        __syncthreads();
        { const LAS float* fx = FX + (t & 1) * 64 * 68 + et * 68 + ec; const f32x4 f0 = *(const LAS f32x4*)fx, f1 = *(const LAS f32x4*)(fx + 4);
          const float fv[8] = {f0[0], f0[1], f0[2], f0[3], f1[0], f1[1], f1[2], f1[3]};
          const unsigned aw[4] = {cur.a.x, cur.a.y, cur.a.z, cur.a.w}, cw[4] = {cur.c.x, cur.c.y, cur.c.z, cur.c.w}, vx[4] = {cur.v.x, cur.v.y, cur.v.z, cur.v.w}, gx[4] = {cur.g.x, cur.g.y, cur.g.z, cur.g.w};
          float sv[8], sum = 0.f;
#pragma unroll
          for (int j = 0; j < 4; ++j) { sv[2 * j] = bflo(aw[j]) + bflo(cw[j]) + fv[2 * j]; sv[2 * j + 1] = bfhi(aw[j]) + bfhi(cw[j]) + fv[2 * j + 1]; sum += sv[2 * j] + sv[2 * j + 1]; }
          const float mean = sum8(sum) * (1.0f / 64.0f); float q = 0.f;
#pragma unroll
          for (int j = 0; j < 8; ++j) { sv[j] -= mean; q += sv[j] * sv[j]; }
          const float rs = 1.0f / sqrtf(sum8(q) * (1.0f / 64.0f) + GN_EPS);
          float y[8];
#pragma unroll
          for (int j = 0; j < 4; ++j) { y[2 * j] = (sv[2 * j] * rs * lg[2 * j] + lb[2 * j] + cur.bs * bflo(vx[j])) * bflo(gx[j]);
                                        y[2 * j + 1] = (sv[2 * j + 1] * rs * lg[2 * j + 1] + lb[2 * j + 1] + cur.bs * bfhi(vx[j])) * bfhi(gx[j]); }
          v4u ov; ov.x = pk2(y[0], y[1]); ov.y = pk2(y[2], y[3]); ov.z = pk2(y[4], y[5]); ov.w = pk2(y[6], y[7]);
          *(v4u*)(YM + (mb + 64 * t) * D + CH + h * HD + ec) = ov; }
        cur = nxt; acur[0] = anxt[0]; acur[1] = anxt[1];
    }
    __syncthreads();
}
__device__ __forceinline__ int obid() { int b = blockIdx.x; asm volatile("" : "+s"(b)); return b; }
struct Args { const float* in[34]; float* out; unsigned char* ws; int ph_lo, ph_hi; };
__global__ void __launch_bounds__(NTHR, 2) enc_fwd(Args args) {
    extern __shared__ __attribute__((aligned(16))) unsigned char lds[];
    Frame F;
    F.lds = (LAS unsigned char*)lds;
    F.MISC = (volatile LAS unsigned*)(F.lds + LDSCTL_OFF);
    F.G = gridDim.x;
    F.ws = args.ws; F.out = args.out; F.ctl = (unsigned*)(args.ws + WS_CTL);
    F.in = args.in;
    for (int u = threadIdx.x; u < (LDS_BYTES - LDSCTL_OFF) / 4; u += NTHR) F.MISC[u] = 0u;
    __syncthreads();
    const XcdBarrier bar = xcd_barrier_post(F.ctl + CW_BAR, F.MISC + 8);
#define SEAM() xcd_barrier(bar)

    bf16* HN = (bf16*)(F.ws + WS_HN);
    float* RSS = (float*)(F.ws + WS_RSS);
    unsigned char* HQ = F.ws + WS_HN; float* RSC = (float*)(F.ws + WS_RSC);
    p_convert(F); __syncthreads(); p_filter(F, 0); p_rmsnorm_q<true>(F, F.in[I_X], F.in[I_N1G], HQ, RSC, 0, M / 2);
    SEAM();
    p_wquant(F);
    SEAM();
#pragma unroll 1
    for (int l = 0; l < NL; ++l) {
        unsigned char* wb = F.ws + WS_W + (size_t)l * W_LAYER;
        bf16* X2B = (bf16*)F.out;
        {
#pragma unroll 1
            for (int hf = 0; hf < 2; ++hf) { constexpr int MH = M / 2; const size_t r0 = (size_t)hf * MH;
                if (hf == 0) p_spectra(F);
                const float* CSC = (const float*)(F.ws + WS_CSC) + l * (HYP + NRW);
                { pg8::Gemm g{(const bf16*)(wb + W_HY), (const bf16*)(HQ + r0 * D), HYP, MH, D / 2}; pg8::StaticOrder S; S.init(HYP, MH, F.G, obid());
                  pg8::EpiBf16Q E{(bf16*)(F.ws + WS_PHT) + (size_t)(4 * hf) * HYP * T, (size_t)T, (size_t)HYP * T, 13, CSC, RSC + r0};
                  pg8::gemm_phase<pg8::EpiBf16Q, pg8::StaticOrder, true, true>(F.lds, g, S, E); }
                { pg8::Gemm g{(const bf16*)(HQ + r0 * D), (const bf16*)(wb + W_RW), MH, NRW, D / 2}; pg8::StaticOrder S; S.init(MH, NRW, F.G, obid());
                  pg8::EpiBf16Q E{(bf16*)(F.ws + WS_PRW) + r0 * NRW, (size_t)NRW, 0, 31, RSC + r0, CSC + HYP};
                  pg8::gemm_phase<pg8::EpiBf16Q, pg8::StaticOrder, true, true>(F.lds, g, S, E); }
                if (hf == 0) { if (l == 0) p_rmsnorm_q<true>(F, F.in[I_X], F.in[I_N1G], HQ, RSC, MH, M); else p_rmsnorm_q<false>(F, X2B, F.in[I_N1G] + (size_t)l * D, HQ, RSC, MH, M);
                    SEAM(); } }
        }
        SEAM();
        p_mix(F, l);
        SEAM();
        { p_post(F, l); p_postfix(F, l); }
        SEAM();
        {
            if (l + 1 < NL) p_filter(F, l + 1);
            pg8::Gemm g{(const bf16*)(F.ws + WS_YMIX), (const bf16*)(wb + W_O), M, D, D}; pg8::StaticOrder S; S.init(M, D, F.G, obid());
            if (l == 0) { pg8::EpiRes<1, false> E{F.in[I_X], nullptr, HN, D, RSS}; pg8::gemm_phase<pg8::EpiRes<1, false>, pg8::StaticOrder, true, true>(F.lds, g, S, E); }
            else { pg8::EpiRes<1, true> E{nullptr, X2B, HN, D, RSS}; pg8::gemm_phase<pg8::EpiRes<1, true>, pg8::StaticOrder, true, true>(F.lds, g, S, E); }
        }
        SEAM();
#pragma unroll 1
        for (int ck = 0; ck < MLP_CHUNKS; ++ck) { constexpr int MC = M / MLP_CHUNKS; const size_t r0 = (size_t)ck * MC;
            bf16* HIDc = (bf16*)(F.ws + WS_HID + (size_t)(ck & 1) * MC * FF * 2);
            {
                pg8::Gemm g{HN + r0 * D, (const bf16*)(wb + W_1), MC, FF, D}; pg8::StaticOrder S; S.init(MC, FF, F.G, obid());
                pg8::EpiBf16<1> E{HIDc, (size_t)FF};
                pg8::gemm_phase<pg8::EpiBf16<1>, pg8::StaticOrder, true, true>(F.lds, g, S, E);
            }
            SEAM();
            {
                pg8::Gemm g{HIDc, (const bf16*)(wb + W_2), MC, D, FF}; pg8::StaticOrder S; S.init(MC, D, F.G, obid());
                pg8::EpiRes<2, true> E{nullptr, HN + r0 * D, ((l + 1 < NL) ? X2B : HN) + r0 * D, D, RSS + r0 * 16};
                pg8::gemm_phase<pg8::EpiRes<2, true>, pg8::StaticOrder, true, true>(F.lds, g, S, E);
            }
            if (ck == MLP_CHUNKS - 1 && l + 1 < NL) p_rmsnorm_q<false>(F, X2B, F.in[I_N1G] + (size_t)(l + 1) * D, HQ, RSC, 0, M / 2);
        }
        SEAM();
        if (l + 1 == NL) p_finalnorm(F, HN, F.in[I_FING], F.out);
    }
#undef SEAM
}

extern "C" void kernel_launch(void* const* d_in, const int* in_sizes, int n_in, void* d_out, int out_size, void* d_ws, size_t ws_size, hipStream_t stream) {
    static int grid = 0;
    if (grid == 0) {
        if (n_in != 34 || in_sizes[0] != M * D || out_size != M * D || ws_size < WS_END) {
            fprintf(stderr, "kernel_launch: unexpected problem: n_in %d in0 %d out %d ws %zu (need %zu); nothing launched\n", n_in, n_in > 0 ? in_sizes[0] : -1, out_size, ws_size, (size_t)WS_END); grid = -1; return; }
        int dev = 0, cus = 0, per_cu = 0;
        if (hipGetDevice(&dev) != hipSuccess || hipDeviceGetAttribute(&cus, hipDeviceAttributeMultiprocessorCount, dev) != hipSuccess) { grid = -1; return; }
        if (hipFuncSetAttribute((const void*)enc_fwd, hipFuncAttributeMaxDynamicSharedMemorySize, LDS_BYTES) != hipSuccess) { fprintf(stderr, "kernel_launch: hipFuncSetAttribute failed\n"); grid = -1; return; }
        if (hipOccupancyMaxActiveBlocksPerMultiprocessor(&per_cu, (const void*)enc_fwd, NTHR, LDS_BYTES) != hipSuccess || per_cu < 1)
            fprintf(stderr, "kernel_launch: note: occupancy query reports %d workgroups per CU\n", per_cu);
        (void)hipGetLastError();
        grid = cus;
        if (grid != 256) { fprintf(stderr, "kernel_launch: built for a 256-CU device (got %d); nothing launched\n", cus); grid = -1; return; }
    }
    if (grid < 0) return;
    if (hipMemsetAsync((char*)d_ws + WS_CTL, 0, CTL_ZERO_BYTES, stream) != hipSuccess) return;
    Args a{};
    for (int i = 0; i < 34; ++i) a.in[i] = (const float*)d_in[i];
    a.out = (float*)d_out; a.ws = (unsigned char*)d_ws;
    a.ph_lo = 0; a.ph_hi = 0;
    hipLaunchKernelGGL(enc_fwd, dim3(grid), dim3(NTHR), LDS_BYTES, stream, a);
}
```

```cpp
#include <hip/hip_runtime.h>
#include <cstdio>
#include <cstdint>
namespace pg8 {
#define PG8_LAS __attribute__((address_space(3)))
typedef unsigned short bf16_t;
typedef short bf16x8 __attribute__((ext_vector_type(8)));
typedef float f32x4 __attribute__((ext_vector_type(4)));
typedef int i32x4 __attribute__((ext_vector_type(4)));
template <bool I8> struct AccT { typedef f32x4 t; };
template <> struct AccT<true> { typedef i32x4 t; };
typedef unsigned u32x4 __attribute__((ext_vector_type(4)));
constexpr int BM = 256, BK = 64, HALF = 128, HTB = HALF * BK * 2  , STAGE_BYTES = 8 * HTB, NXCD = 8, WGM = 8;

__host__ __device__ __forceinline__ int lds_byte(int r, int c) { const int st = (r >> 4) * 2 + (c >> 5), rr = r & 15, cc = c & 31, ob = rr * 64 + cc * 2; return st * 1024 + (ob ^ (((ob >> 9) & 1) << 5)); }
__host__ __device__ __forceinline__ void stage_rc(int b, int& R, int& C) { const int st = b / 1024, sb = b % 1024, swz = sb ^ (((sb >> 9) & 1) << 5); R = (st >> 1) * 16 + swz / 64; C = (st & 1) * 32 + (swz % 64) / 2; }
__host__ __device__ __forceinline__ int perm32(int rho) { const int n = rho >> 4, i = rho & 15; return 8 * (i >> 2) + 4 * n + (i & 3); }

struct Unit { int pm, pn; };
struct Gemm { const bf16_t* A; const bf16_t* Bt; int M, N, K; };

struct StaticOrder {
    int nM, nN, nwg, G, c;
    __host__ __device__ void init(int M, int N, int G_, int c_) { nM = M / BM; nN = N / BM; nwg = nM * nN; G = G_; c = c_; }
    __host__ __device__ bool next(int i, Unit& u) const {
        const long L = (long)i * G + c; if (L >= nwg) return false;
        int wgid = (int)L; { const int q = nwg / NXCD, r = nwg % NXCD, xcd = wgid % NXCD, off = wgid / NXCD; wgid = (xcd < r ? xcd * (q + 1) : r * (q + 1) + (xcd - r) * q) + off; }
        const int nig = WGM * nN, gid = wgid / nig, fm = gid * WGM, gsz = (nM - fm) < WGM ? (nM - fm) : WGM;
        u.pm = fm + ((wgid % nig) % gsz); u.pn = (wgid % nig) / gsz; return true;
    }
    __device__ __forceinline__ void a_ready(const Unit&) const {}
    __device__ __forceinline__ void done(const Unit&) const {}
};
typedef float f32x2e __attribute__((ext_vector_type(2))); typedef __bf16 bf16x2e __attribute__((ext_vector_type(2)));
__device__ __forceinline__ unsigned cvt_pk_bf16(float lo, float hi) { return __builtin_bit_cast(unsigned, __builtin_convertvector((f32x2e){lo, hi}, bf16x2e)); }
template <int ACT> struct EpiBf16 {
    static constexpr bool PERM = true, AFTER_DRAIN = false, I8 = false;
    bf16_t* O; size_t ldc; size_t bstride = 0; int tshift = 31;
    __device__ __forceinline__ void operator()(const f32x4 (&acc)[2][2][4][2], const Unit& u, int wr, int wc, int fr, int fq) const {
        const int row0 = u.pm * BM + wr * 64 + fr; const int cb = u.pn * BM; const size_t col0 = (size_t)(cb >> tshift) * bstride + (size_t)(cb & ((1 << tshift) - 1)) + wc * 32 + 8 * fq;
#pragma unroll
        for (int ai = 0; ai < 2; ++ai)
#pragma unroll
            for (int m = 0; m < 4; ++m) { bf16_t* rowp = O + (size_t)(row0 + ai * HALF + m * 16) * ldc + col0;
#pragma unroll
                for (int bj = 0; bj < 2; ++bj) { f32x4 v0 = acc[ai][bj][m][0], v1 = acc[ai][bj][m][1];
                    if (ACT == 1) {
#pragma unroll
                        for (int j = 0; j < 4; ++j) { const float a = fmaxf(v0[j], 0.f), b = fmaxf(v1[j], 0.f); v0[j] = a * a; v1[j] = b * b; } }
                    u32x4 w; w.x = cvt_pk_bf16(v0[0], v0[1]); w.y = cvt_pk_bf16(v0[2], v0[3]); w.z = cvt_pk_bf16(v1[0], v1[1]); w.w = cvt_pk_bf16(v1[2], v1[3]);
                    *(u32x4*)(rowp + bj * HALF) = w;
                    } }
    }
};
struct EpiBf16Q {
    static constexpr bool PERM = true, AFTER_DRAIN = false, I8 = true;
    bf16_t* O; size_t ldc; size_t bstride; int tshift; const float* rs; const float* cs;
    __device__ __forceinline__ void operator()(const i32x4 (&acc)[2][2][4][2], const Unit& u, int wr, int wc, int fr, int fq) const {
        const int row0 = u.pm * BM + wr * 64 + fr; const int cb = u.pn * BM, ci0 = cb + wc * 32 + 8 * fq;
        const size_t col0 = (size_t)(cb >> tshift) * bstride + (size_t)(cb & ((1 << tshift) - 1)) + wc * 32 + 8 * fq;
        f32x4 cv[2][2];
#pragma unroll
        for (int bj = 0; bj < 2; ++bj) { cv[bj][0] = *(const f32x4*)(cs + ci0 + bj * HALF); cv[bj][1] = *(const f32x4*)(cs + ci0 + bj * HALF + 4); }
#pragma unroll
        for (int ai = 0; ai < 2; ++ai)
#pragma unroll
            for (int m = 0; m < 4; ++m) { const int row = row0 + ai * HALF + m * 16; bf16_t* rowp = O + (size_t)row * ldc + col0; const float r = rs[row];
#pragma unroll
                for (int bj = 0; bj < 2; ++bj) { const i32x4 a0 = acc[ai][bj][m][0], a1 = acc[ai][bj][m][1];
                    const f32x4 v0 = (f32x4){(float)a0[0], (float)a0[1], (float)a0[2], (float)a0[3]} * r * cv[bj][0], v1 = (f32x4){(float)a1[0], (float)a1[1], (float)a1[2], (float)a1[3]} * r * cv[bj][1];
                    u32x4 w; w.x = cvt_pk_bf16(v0[0], v0[1]); w.y = cvt_pk_bf16(v0[2], v0[3]); w.z = cvt_pk_bf16(v1[0], v1[1]); w.w = cvt_pk_bf16(v1[2], v1[3]);
                    *(u32x4*)(rowp + bj * HALF) = w; } }
    }
};
__device__ __forceinline__ float rss16(const float* p) { const f32x4 a = *(const f32x4*)p, b = *(const f32x4*)(p + 4), c = *(const f32x4*)(p + 8), d = *(const f32x4*)(p + 12);
    return (((a[0] + a[1]) + (a[2] + a[3])) + ((b[0] + b[1]) + (b[2] + b[3]))) + (((c[0] + c[1]) + (c[2] + c[3])) + ((d[0] + d[1]) + (d[2] + d[3]))); }
template <int MODE, bool RB16> struct EpiRes {
    static constexpr bool PERM = true, AFTER_DRAIN = false, I8 = false;
    const float* R; const bf16_t* RB; bf16_t* O; int ldc; float* rss;
    __device__ __forceinline__ void operator()(const f32x4 (&acc)[2][2][4][2], const Unit& u, int wr, int wc, int fr, int fq) const {
        const int row0 = u.pm * BM + wr * 64 + fr, col0 = u.pn * BM + wc * 32 + 8 * fq;
#pragma unroll
        for (int ai = 0; ai < 2; ++ai)
#pragma unroll
            for (int m = 0; m < 4; ++m) { const int row = row0 + ai * HALF + m * 16; const size_t off = (size_t)row * ldc + col0;
                f32x4 rv[2][2]; float ss = 0.f, sc = 1.0f;
                if (MODE == 2) sc = __builtin_amdgcn_rcpf(rss16(rss + (size_t)row * 16) * (1.0f / 1024.0f) + 1e-5f);
#pragma unroll
                for (int bj = 0; bj < 2; ++bj) {
                    if (RB16) { const u32x4 w = *(const u32x4*)(RB + off + bj * HALF);
                        rv[bj][0] = (f32x4){__builtin_bit_cast(float, w.x << 16), __builtin_bit_cast(float, w.x & 0xffff0000u), __builtin_bit_cast(float, w.y << 16), __builtin_bit_cast(float, w.y & 0xffff0000u)};
                        rv[bj][1] = (f32x4){__builtin_bit_cast(float, w.z << 16), __builtin_bit_cast(float, w.z & 0xffff0000u), __builtin_bit_cast(float, w.w << 16), __builtin_bit_cast(float, w.w & 0xffff0000u)}; }
                    else { rv[bj][0] = *(const f32x4*)(R + off + bj * HALF); rv[bj][1] = *(const f32x4*)(R + off + bj * HALF + 4); } }
#pragma unroll
                for (int bj = 0; bj < 2; ++bj) { f32x4 o0 = acc[ai][bj][m][0], o1 = acc[ai][bj][m][1];
                    if (MODE == 2) { o0 = o0 * sc; o1 = o1 * sc; }
                    o0 = o0 + rv[bj][0]; o1 = o1 + rv[bj][1];
                    if (MODE == 1) ss += ((o0[0] * o0[0] + o0[1] * o0[1]) + (o0[2] * o0[2] + o0[3] * o0[3])) + ((o1[0] * o1[0] + o1[1] * o1[1]) + (o1[2] * o1[2] + o1[3] * o1[3]));
                    u32x4 w; w.x = cvt_pk_bf16(o0[0], o0[1]); w.y = cvt_pk_bf16(o0[2], o0[3]); w.z = cvt_pk_bf16(o1[0], o1[1]); w.w = cvt_pk_bf16(o1[2], o1[3]);
                    *(u32x4*)(O + off + bj * HALF) = w; }
                if (MODE == 1) { ss += __shfl_xor(ss, 16); ss += __shfl_xor(ss, 32); if (fq == 0) rss[(size_t)row * 16 + u.pn * 4 + wc] = ss; }
                asm volatile("" ::: "memory"); }
    }
};

template <bool I8> __device__ __forceinline__ typename AccT<I8>::t pg8_mma16(const bf16x8& a, const bf16x8& b, const typename AccT<I8>::t& c) {
    if constexpr (I8) return __builtin_amdgcn_mfma_i32_16x16x64_i8(__builtin_bit_cast(i32x4, a), __builtin_bit_cast(i32x4, b), c, 0, 0, 0);
    else return __builtin_amdgcn_mfma_f32_16x16x32_bf16(a, b, c, 0, 0, 0);
}
template <class Epi, class Sched, bool ALIGN_EPI = false, bool SP2 = false>
__device__ __forceinline__ void gemm_phase(PG8_LAS unsigned char* lds, const Gemm g, const Sched& S, const Epi& E) {
    int tid = threadIdx.x; asm volatile("" : "+v"(tid));
    const int wid = __builtin_amdgcn_readfirstlane(tid >> 6), lane = tid & 63, wr = wid >> 2, wc = wid & 3, fr = lane & 15, fq = lane >> 4;
    const int K = g.K, nt = K / BK;
    unsigned voffA[2], voffB[2];
#pragma unroll
    for (int i = 0; i < 2; ++i) { int R, C; stage_rc(tid * 16 + i * 8192, R, C); const int Rb = Epi::PERM ? ((R & ~31) + perm32(R & 31)) : R;
        voffA[i] = (unsigned)(R * K + C) * 2u; voffB[i] = (unsigned)(Rb * K + C) * 2u; }
    const size_t kstep = (size_t)(BK * 2);
    const size_t hstep = (size_t)HALF * K * 2;
    const size_t tstep = 2 * hstep;
    const unsigned ldsw = (unsigned)wid * 1024u;
    const int aoff = lds_byte(wr * 64 + fr, fq * 8), boff = lds_byte(wc * 32 + fr, fq * 8);
#define PG8_SA(b, h) (((b) * 2 + (h)) * HTB)
#define PG8_SB(b, h) ((4 + (b) * 2 + (h)) * HTB)
#define PG8_STAGE(bufoff, gbase, voff) do { _Pragma("unroll") for (int _i = 0; _i < 2; ++_i) \
        __builtin_amdgcn_global_load_lds((const unsigned*)((const char*)(gbase) + (voff)[_i]), (PG8_LAS unsigned*)(lds + (bufoff) + ldsw + _i * 8192), 16, 0, 0); } while (0)
#define PG8_LDA(dst, b, h) do { _Pragma("unroll") for (int m = 0; m < 4; ++m) _Pragma("unroll") for (int k = 0; k < 2; ++k) dst[m][k] = *(const PG8_LAS bf16x8*)(lds + PG8_SA(b, h) + aoff + m * 2048 + k * 1024); } while (0)
#define PG8_LDB(dst, b, h) do { _Pragma("unroll") for (int n = 0; n < 2; ++n) _Pragma("unroll") for (int k = 0; k < 2; ++k) dst[n][k] = *(const PG8_LAS bf16x8*)(lds + PG8_SB(b, h) + boff + n * 2048 + k * 1024); } while (0)
#define PG8_MMA(ai, bj, At, Bt) do { __builtin_amdgcn_s_setprio(1); _Pragma("unroll") for (int m = 0; m < 4; ++m) _Pragma("unroll") for (int n = 0; n < 2; ++n) _Pragma("unroll") for (int k = 0; k < 2; ++k) \
        acc[ai][bj][m][n] = pg8_mma16<Epi::I8>(Bt[n][k], At[m][k], acc[ai][bj][m][n]); __builtin_amdgcn_s_setprio(0); } while (0)
#define PG8_WAIT_V(n) asm volatile("s_waitcnt vmcnt(" #n ")" ::: "memory")
#define PG8_WAIT_L(n) asm volatile("s_waitcnt lgkmcnt(" #n ")" ::: "memory")
#define PG8_BAR __builtin_amdgcn_s_barrier()
#define PG8_SCHED __builtin_amdgcn_sched_barrier(0)
    Unit cur, nxt; int ui = 0;
    if (!S.next(0, cur)) return;
    typedef typename AccT<Epi::I8>::t acc_t;
    acc_t acc[2][2][4][2];
#pragma unroll
    for (int a = 0; a < 2; ++a)
#pragma unroll
        for (int b = 0; b < 2; ++b)
#pragma unroll
            for (int m = 0; m < 4; ++m)
#pragma unroll
                for (int n = 0; n < 2; ++n) acc[a][b][m][n] = (acc_t){0, 0, 0, 0};
    bf16x8 At[4][2], B0[2][2], B1[2][2];
    const char* cA = (const char*)g.A + (size_t)cur.pm * tstep; const char* cB = (const char*)g.Bt + (size_t)cur.pn * tstep;
    S.a_ready(cur);
    if constexpr (SP2) {
        PG8_STAGE(PG8_SB(0, 0), cB, voffB); PG8_STAGE(PG8_SB(0, 1), cB + hstep, voffB); PG8_STAGE(PG8_SA(0, 0), cA, voffA); PG8_STAGE(PG8_SA(0, 1), cA + hstep, voffA);
        if (wr == 1) PG8_BAR;
        PG8_WAIT_V(2); PG8_BAR;
        PG8_STAGE(PG8_SB(1, 0), cB + kstep, voffB); PG8_STAGE(PG8_SA(1, 0), cA + kstep, voffA); PG8_STAGE(PG8_SB(1, 1), cB + hstep + kstep, voffB);
        PG8_WAIT_V(6); PG8_BAR;
    } else {
        PG8_STAGE(PG8_SB(0, 0), cB, voffB); PG8_STAGE(PG8_SA(0, 0), cA, voffA); PG8_STAGE(PG8_SB(0, 1), cB + hstep, voffB); PG8_STAGE(PG8_SA(0, 1), cA + hstep, voffA);
        if (wr == 1) PG8_BAR;
        PG8_WAIT_V(4); PG8_BAR;
        PG8_STAGE(PG8_SB(1, 0), cB + kstep, voffB); PG8_STAGE(PG8_SA(1, 0), cA + kstep, voffA); PG8_STAGE(PG8_SB(1, 1), cB + hstep + kstep, voffB);
        PG8_WAIT_V(6); PG8_BAR;
    }
    for (;;) {
        const bool has_next = S.next(ui + 1, nxt);
        const char* nA = has_next ? (const char*)g.A + (size_t)nxt.pm * tstep : cA; const char* nB = has_next ? (const char*)g.Bt + (size_t)nxt.pn * tstep : cB;
        for (int t = 0; t < nt; t += 2) {
            const bool last = (t == nt - 2);
            const char* a1 = cA + (size_t)(t + 1) * kstep;
            const char* a2 = last ? nA : cA + (size_t)(t + 2) * kstep; const char* b2 = last ? nB : cB + (size_t)(t + 2) * kstep;
            const char* a3 = a2 + kstep; const char* b3 = b2 + kstep;
            if (last && has_next) S.a_ready(nxt);
            if constexpr (SP2) {
            PG8_LDB(B0, 0, 0); PG8_LDB(B1, 0, 1); PG8_SCHED; PG8_LDA(At, 0, 0); PG8_STAGE(PG8_SA(1, 1), a1 + hstep, voffA);
            PG8_WAIT_V(8); PG8_WAIT_L(0); PG8_BAR; PG8_MMA(0, 0, At, B0); PG8_MMA(0, 1, At, B1); PG8_BAR; PG8_SCHED;
            PG8_LDA(At, 0, 1); PG8_STAGE(PG8_SB(0, 0), b2, voffB); PG8_STAGE(PG8_SB(0, 1), b2 + hstep, voffB); PG8_STAGE(PG8_SA(0, 0), a2, voffA);
            PG8_WAIT_V(8); PG8_WAIT_L(0); PG8_BAR; PG8_MMA(1, 0, At, B0); PG8_MMA(1, 1, At, B1); PG8_BAR; PG8_SCHED;
            PG8_LDB(B0, 1, 0); PG8_LDB(B1, 1, 1); PG8_SCHED; PG8_LDA(At, 1, 0); PG8_STAGE(PG8_SA(0, 1), a2 + hstep, voffA);
            PG8_WAIT_V(8); PG8_WAIT_L(0); PG8_BAR; PG8_MMA(0, 0, At, B0); PG8_MMA(0, 1, At, B1); PG8_BAR; PG8_SCHED;
            PG8_LDA(At, 1, 1); PG8_STAGE(PG8_SB(1, 0), b3, voffB); PG8_STAGE(PG8_SB(1, 1), b3 + hstep, voffB); PG8_STAGE(PG8_SA(1, 0), a3, voffA);
            PG8_WAIT_V(8); PG8_WAIT_L(0); PG8_BAR; PG8_MMA(1, 0, At, B0); PG8_MMA(1, 1, At, B1); PG8_BAR; PG8_SCHED;
            } else {
            PG8_LDB(B0, 0, 0); PG8_SCHED; PG8_LDA(At, 0, 0); PG8_STAGE(PG8_SA(1, 1), a1 + hstep, voffA);
            PG8_WAIT_L(8); PG8_BAR; PG8_WAIT_L(0); PG8_MMA(0, 0, At, B0); PG8_BAR; PG8_SCHED;
            PG8_LDB(B1, 0, 1); PG8_STAGE(PG8_SB(0, 0), b2, voffB);
            PG8_BAR; PG8_WAIT_L(0); PG8_MMA(0, 1, At, B1); PG8_BAR;
            PG8_LDA(At, 0, 1); PG8_STAGE(PG8_SA(0, 0), a2, voffA);
            PG8_BAR; PG8_WAIT_L(0); PG8_MMA(1, 0, At, B0); PG8_BAR; PG8_SCHED;
            PG8_STAGE(PG8_SB(0, 1), b2 + hstep, voffB);
            PG8_WAIT_V(6); PG8_BAR; PG8_MMA(1, 1, At, B1); PG8_BAR;
            PG8_LDB(B0, 1, 0); PG8_SCHED; PG8_LDA(At, 1, 0); PG8_STAGE(PG8_SA(0, 1), a2 + hstep, voffA);
            PG8_WAIT_L(8); PG8_BAR; PG8_WAIT_L(0); PG8_MMA(0, 0, At, B0); PG8_BAR; PG8_SCHED;
            PG8_LDB(B1, 1, 1); PG8_STAGE(PG8_SB(1, 0), b3, voffB);
            PG8_BAR; PG8_WAIT_L(0); PG8_MMA(0, 1, At, B1); PG8_BAR;
            PG8_LDA(At, 1, 1); PG8_STAGE(PG8_SA(1, 0), a3, voffA);
            PG8_BAR; PG8_WAIT_L(0); PG8_MMA(1, 0, At, B0); PG8_BAR; PG8_SCHED;
            PG8_STAGE(PG8_SB(1, 1), b3 + hstep, voffB);
            PG8_WAIT_V(6); PG8_BAR; PG8_MMA(1, 1, At, B1); PG8_BAR;
            }
        }
        if constexpr (ALIGN_EPI) { if (wr == 0) PG8_BAR; }
        if constexpr (!Epi::AFTER_DRAIN) { E(acc, cur, wr, wc, fr, fq); S.done(cur); }
        if (!has_next) break;
#pragma unroll
        for (int a = 0; a < 2; ++a)
#pragma unroll
            for (int b = 0; b < 2; ++b)
#pragma unroll
                for (int m = 0; m < 4; ++m)
#pragma unroll
                    for (int n = 0; n < 2; ++n) acc[a][b][m][n] = (acc_t){0, 0, 0, 0};
        cur = nxt; cA = nA; cB = nB; ++ui;
        if constexpr (ALIGN_EPI) { if (wr == 1) PG8_BAR; }
    }
    PG8_WAIT_V(0);
    if constexpr (!ALIGN_EPI) { if (wr == 0) PG8_BAR; }
    PG8_BAR;
    if constexpr (Epi::AFTER_DRAIN) { E.fused(acc, cur, wr, wc, fr, fq, lds, wid, lane); S.done(cur); }
#undef PG8_SA
#undef PG8_SB
#undef PG8_STAGE
#undef PG8_LDA
#undef PG8_LDB
#undef PG8_MMA
#undef PG8_WAIT_V
#undef PG8_WAIT_L
#undef PG8_BAR
#undef PG8_SCHED
}
}
constexpr int NWAVES = 8, NTHR = 512;
constexpr int NB = 8, T = 8192, M = NB * T, D = 1024, CH = 512, NH = 8, HD = 64, FF = 4096, NL = 2;
constexpr int PIN = 3456, HYP = 1536, RWP = 1920, NRW = 2048;
constexpr float RMS_EPS = 1e-5f, GN_EPS = 64.0f * 1e-5f;
constexpr int MLP_CHUNKS = 4;
static_assert(MLP_CHUNKS >= 2 && M % (MLP_CHUNKS * 256) == 0, "the next layer's first-half RMSNorm is folded into the last MLP chunk: it needs a barrier between the first half's down GEMMs and that chunk");

constexpr size_t MiB = 1u << 20;
constexpr size_t WS_CTL = 0, CTL_ZERO_BYTES = 1 * MiB;
constexpr size_t WS_W = 2 * MiB;
constexpr size_t W_LAYER = 25 * MiB, W_HY = 0, W_RW = 3 * MiB, W_O = 7 * MiB, W_1 = 9 * MiB, W_2 = 17 * MiB;
constexpr size_t WS_RSC = 52 * MiB;
constexpr size_t WS_CSC = 52 * MiB + 512 * 1024;
constexpr size_t WS_FSC = 52 * MiB;
constexpr size_t WS_RSS = 53 * MiB;
constexpr size_t WS_BS = 53 * MiB;
constexpr size_t WS_FRAG = 57 * MiB;
constexpr size_t WS_SFIN = 62 * MiB;
constexpr size_t WS_YPHI = 64 * MiB;
constexpr size_t WS_HF = 64 * MiB;
constexpr size_t WS_HN = 128 * MiB;
constexpr size_t WS_G = 128 * MiB, WS_V2 = 192 * MiB;
constexpr size_t WS_VFIRST = 256 * MiB;
constexpr size_t WS_PHT = 320 * MiB;
constexpr size_t WS_PRW = 512 * MiB;
constexpr size_t WS_YS = 768 * MiB;
constexpr size_t WS_HID = 320 * MiB;
constexpr size_t WS_YMIX = 896 * MiB;
constexpr size_t WS_END = 1024 * MiB;
constexpr int CW_BAR = 4096;
constexpr int CW_CMAX = 32768;
constexpr int CW_QUEUE = 16384;

constexpr int LDS_BYTES = 163840;
constexpr int LDSCTL_OFF = LDS_BYTES - 512;

#define GAS __attribute__((address_space(1)))
#define LAS __attribute__((address_space(3)))
typedef unsigned short bf16;
typedef unsigned v4u __attribute__((ext_vector_type(4)));
typedef unsigned v2u __attribute__((ext_vector_type(2)));
typedef float f32x4 __attribute__((ext_vector_type(4)));
#define PHASE_TID() int bid = blockIdx.x; asm volatile("" : "+s"(bid)); (void)bid; int tid = threadIdx.x; asm volatile("" : "+v"(tid)); const int lane = tid & 63; const int wave = __builtin_amdgcn_readfirstlane(tid >> 6); (void)lane; (void)wave
#define RLX_AGENT __ATOMIC_RELAXED, __HIP_MEMORY_SCOPE_AGENT
#define LDS_WAIT() asm volatile("s_waitcnt lgkmcnt(0)" ::: "memory")
#define VM_WAIT() asm volatile("s_waitcnt vmcnt(0)" ::: "memory")
typedef float f32x2_ __attribute__((ext_vector_type(2)));
typedef __bf16 bf16x2_ __attribute__((ext_vector_type(2)));
__device__ __forceinline__ unsigned pk2(float lo, float hi) { return __builtin_bit_cast(unsigned, __builtin_convertvector((f32x2_){lo, hi}, bf16x2_)); }
__device__ __forceinline__ unsigned f2bf(float f) { return pk2(f, f) & 0xffffu; }
__device__ __forceinline__ float bf2f(unsigned h) { return __uint_as_float(h << 16); }
__device__ __forceinline__ float bflo(unsigned w) { return __uint_as_float(w << 16); }
__device__ __forceinline__ float bfhi(unsigned w) { return __uint_as_float(w & 0xffff0000u); }
__device__ __forceinline__ float sigmoidf_(float x) { return __builtin_amdgcn_rcpf(1.0f + __expf(-x)); }
__device__ __forceinline__ float tanhf_(float x) { return 1.0f - 2.0f * __builtin_amdgcn_rcpf(1.0f + __expf(2.0f * x)); }
template <int CTRL> __device__ __forceinline__ float dpp(float x) { return __builtin_bit_cast(float, __builtin_amdgcn_mov_dpp(__builtin_bit_cast(int, x), CTRL, 0xf, 0xf, true)); }
constexpr int XOR1 = 0xB1, XOR2 = 0x4E, XOR7 = 0x141, XOR8 = 0x128;
__device__ __forceinline__ float sin_hw(float x) { const float r = x * 0.15915494309189535f; return __builtin_amdgcn_sinf(r - floorf(r)); }
__device__ __forceinline__ float sum8(float v) { v += dpp<XOR1>(v); v += dpp<XOR2>(v); v += dpp<XOR7>(v); return v; }
__device__ __forceinline__ float sum16(float v) { v = sum8(v); v += dpp<XOR8>(v); return v; }

#define XB_TMO      128
#define XB_XCNT(j)  (256  + 64 * (j))
#define XB_XSUB(j)  (1280 + 64 * (j))
#define XB_XGEN(j)  (2304 + 64 * (j))
#define XB_TOP      3328
#define XB_TOPGEN   3392
#define XCD_BAR_WORDS 3456
#define XB_SPIN_CAP (1u << 18)

__device__ __forceinline__ unsigned xb_ld(unsigned* p)              { return __hip_atomic_load(p, __ATOMIC_RELAXED, __HIP_MEMORY_SCOPE_AGENT); }
__device__ __forceinline__ unsigned xb_add(unsigned* p, unsigned v) { return __hip_atomic_fetch_add(p, v, __ATOMIC_RELAXED, __HIP_MEMORY_SCOPE_AGENT); }
__device__ __forceinline__ unsigned xb_xcc_id() { return (unsigned)__builtin_amdgcn_s_getreg((3 << 11) | 20) & 0xFu; }
#define XB_SPIN(cond, bar) do { unsigned _sp = 0; while (cond) { __builtin_amdgcn_s_sleep(1); \
    if ((++_sp & 255u) == 0u) { if (xb_ld(&(bar)[XB_TMO])) break; if (_sp > XB_SPIN_CAP) { atomicAdd(&(bar)[XB_TMO], 1u); break; } } } } while (0)

struct XcdBarrier {
    unsigned* bar; unsigned x;
    volatile LAS unsigned* st;
};
__device__ __forceinline__ XcdBarrier xcd_barrier_post(unsigned* bar, volatile LAS unsigned* st) {
    XcdBarrier b; b.bar = bar; b.x = xb_xcc_id(); b.st = st;
    if (threadIdx.x == 0) (void)xb_add(&bar[XB_XCNT(b.x)], 1u);
    return b;
}
__device__ __forceinline__ void xcd_barrier_complete(unsigned* bar, unsigned x, unsigned& nloc, unsigned& nx) {
    const unsigned G = gridDim.x * gridDim.y * gridDim.z;
    unsigned sum, cnt, mine, sp = 0u;
    for (;;) {
        sum = 0u; cnt = 0u; mine = 0u;
#pragma unroll
        for (unsigned j = 0; j < 16; ++j) { const unsigned c = xb_ld(&bar[XB_XCNT(j)]); sum += c; cnt += (c > 0u) ? 1u : 0u; mine = (j == x) ? c : mine; }
        if (sum == G) break;
        __builtin_amdgcn_s_sleep(1);
        if ((++sp & 255u) == 0u) { if (xb_ld(&bar[XB_TMO])) break; if (sp > XB_SPIN_CAP) { atomicAdd(&bar[XB_TMO], 1u); break; } }
    }
    nloc = mine > 0u ? mine : 1u; nx = cnt > 0u ? cnt : 1u;
}
__device__ __forceinline__ void xcd_barrier(const XcdBarrier& b) {
    asm volatile("s_waitcnt vmcnt(0)" ::: "memory");
    __syncthreads();
    if (threadIdx.x == 0) {
        unsigned* bar = b.bar;
        unsigned bx = b.x; asm volatile("" : "+s"(bx));
        __builtin_amdgcn_s_waitcnt(0);
        unsigned nloc = b.st[0], nx = b.st[1];
        if (nloc == 0u) { xcd_barrier_complete(bar, bx, nloc, nx); b.st[0] = nloc; b.st[1] = nx; }
        const unsigned old = xb_add(&bar[XB_XSUB(bx)], 1u);
        const unsigned gen = old / nloc;
        if (old + 1u == (gen + 1u) * nloc) {
            __builtin_amdgcn_fence(__ATOMIC_RELEASE, "agent");
            asm volatile("s_waitcnt vmcnt(0)" ::: "memory");
            const unsigned og = xb_add(&bar[XB_TOP], 1u);
            const unsigned tg = og / nx;
            if (og + 1u == (tg + 1u) * nx) xb_add(&bar[XB_TOPGEN], 1u);
            else XB_SPIN(xb_ld(&bar[XB_TOPGEN]) == tg, bar);
            __builtin_amdgcn_fence(__ATOMIC_ACQUIRE, "agent");
            xb_add(&bar[XB_XGEN(bx)], 1u);
            asm volatile("s_waitcnt vmcnt(0)" ::: "memory");
        } else {
            XB_SPIN(xb_ld(&bar[XB_XGEN(bx)]) == gen, bar);
            __builtin_amdgcn_fence(__ATOMIC_ACQUIRE, "agent");
            asm volatile("s_waitcnt vmcnt(0)" ::: "memory");
        }
    }
    __syncthreads();
}

struct Frame {
    LAS unsigned char* lds;
    volatile LAS unsigned* MISC;
    unsigned* ctl;
    int G;
    const float* const* in;
    float* out; unsigned char* ws;
};
enum { I_X = 0, I_N1G, I_WIN, I_HCW, I_HCB, I_FW1, I_FB1, I_FW2, I_FB2, I_FW3, I_FB3, I_FFREQ, I_FWOUT, I_HSKIP, I_HNG, I_SHIFT, I_W0, I_W2, I_A0, I_A2, I_G2, I_KK, I_KA, I_RK, I_LNG, I_LNB, I_V0, I_V1, I_V2, I_WOUT, I_N2G, I_MW1, I_MW2, I_FING };

__device__ __forceinline__ float wave_max(float v) {
#pragma unroll
    for (int o = 1; o < 64; o <<= 1) v = fmaxf(v, __shfl_xor(v, o));
    return v;
}
__device__ __forceinline__ unsigned q4(float a, float b, float c, float d) {
    const int ia = (int)__builtin_rintf(a), ib = (int)__builtin_rintf(b), ic = (int)__builtin_rintf(c), id = (int)__builtin_rintf(d);
    return (unsigned)(ia & 255) | ((unsigned)(ib & 255) << 8) | ((unsigned)(ic & 255) << 16) | ((unsigned)id << 24);
}
__device__ __forceinline__ float wave_sum(float v) {
#pragma unroll
    for (int o = 1; o < 64; o <<= 1) v += __shfl_xor(v, o);
    return v;
}
typedef float f32x2 __attribute__((ext_vector_type(2)));
constexpr int FN = 2 * T;
constexpr int XPAD = FN + FN / 16 + 16 * (FN / 512);
__device__ __forceinline__ f32x2 cmul(f32x2 a, f32x2 b) { return (f32x2){a.x * b.x - a.y * b.y, a.x * b.y + a.y * b.x}; }
__device__ __forceinline__ f32x2 pk_fma_rot(f32x2 a, f32x2 b, f32x2 t) { f32x2 r;
    asm("v_pk_fma_f32 %0, %1, %2, %3 op_sel:[1,1,0] op_sel_hi:[1,0,1] neg_lo:[0,1,0]" : "=v"(r) : "v"(a), "v"(b), "v"(t)); return r; }
__device__ __forceinline__ f32x2 pk_add_mib(f32x2 a, f32x2 b) { f32x2 r; asm("v_pk_add_f32 %0, %1, %2 op_sel:[0,1] op_sel_hi:[1,0] neg_hi:[0,1]" : "=v"(r) : "v"(a), "v"(b)); return r; }
__device__ __forceinline__ f32x2 pk_add_pib(f32x2 a, f32x2 b) { f32x2 r; asm("v_pk_add_f32 %0, %1, %2 op_sel:[0,1] op_sel_hi:[1,0] neg_lo:[0,1]" : "=v"(r) : "v"(a), "v"(b)); return r; }
__device__ __forceinline__ f32x2 cmulc(f32x2 a, f32x2 b) { return (f32x2){a.x * b.x + a.y * b.y, a.y * b.x - a.x * b.y}; }
__device__ constexpr float C32[16] = {1.0f, 0.98078528040323043f, 0.92387953251128674f, 0.83146961230254524f, 0.70710678118654752f, 0.55557023301960218f, 0.38268343236508977f, 0.19509032201612825f,
                                      0.0f, -0.19509032201612825f, -0.38268343236508977f, -0.55557023301960218f, -0.70710678118654752f, -0.83146961230254524f, -0.92387953251128674f, -0.98078528040323043f};
__device__ constexpr float S32[16] = {0.0f, 0.19509032201612825f, 0.38268343236508977f, 0.55557023301960218f, 0.70710678118654752f, 0.83146961230254524f, 0.92387953251128674f, 0.98078528040323043f,
                                      1.0f, 0.98078528040323043f, 0.92387953251128674f, 0.83146961230254524f, 0.70710678118654752f, 0.55557023301960218f, 0.38268343236508977f, 0.19509032201612825f};
constexpr int bitrev_c(int v, int bits) { int r = 0; for (int i = 0; i < bits; ++i) r |= ((v >> i) & 1) << (bits - 1 - i); return r; }
#define SH0(v) __builtin_shufflevector(v, v, 0, 0)
#define SH1(v) __builtin_shufflevector(v, v, 1, 1)
template <int R, bool INV, bool STORE = false, int NOUT = R> __device__ __forceinline__ void dft_regs(f32x2 (&x)[R], LAS f32x2* P = nullptr, int stride = 0) {
    constexpr int LOG = (R == 32) ? 5 : 4;
    f32x2 y[R];
#pragma unroll
    for (int k = 0; k < R; ++k) y[k] = x[bitrev_c(k, LOG)];
#pragma unroll
    for (int s = 1; s < R; s <<= 1) {
#pragma unroll
        for (int blk = 0; blk < R; blk += 2 * s) {
            const bool st = STORE && (2 * s == R);
            { const f32x2 a = y[blk], b = y[blk + s]; y[blk] = a + b; y[blk + s] = a - b;
              if (st) { P[0] = y[blk]; if (s < NOUT) P[s * stride] = y[blk + s]; } }
            if (s >= 2) { const f32x2 a = y[blk + s / 2], b = y[blk + s / 2 + s];
                y[blk + s / 2] = INV ? pk_add_pib(a, b) : pk_add_mib(a, b); y[blk + s / 2 + s] = INV ? pk_add_mib(a, b) : pk_add_pib(a, b);
                if (st) { P[(s / 2) * stride] = y[blk + s / 2]; if (s / 2 + s < NOUT) P[(s / 2 + s) * stride] = y[blk + s / 2 + s]; } }
#pragma unroll
            for (int j = 1; j < s / 2; ++j) { const int j2 = s - j, m1 = j * (16 / s), m2 = j2 * (16 / s);
                const float c1 = C32[m1], s1 = INV ? S32[m1] : -S32[m1], c2 = C32[m2], s2 = INV ? S32[m2] : -S32[m2];
                const f32x2 a1 = y[blk + j], b1 = y[blk + j + s], a2 = y[blk + j2], b2 = y[blk + j2 + s];
                const f32x2 p1 = __builtin_elementwise_fma(SH0(b1), (f32x2){c1, s1}, a1), p2 = __builtin_elementwise_fma(SH0(b2), (f32x2){c2, s2}, a2);
                if (st) asm volatile("" :: "v"(p1), "v"(p2) : "memory"); else asm volatile("" :: "v"(p1), "v"(p2));
                const f32x2 q1 = __builtin_elementwise_fma(SH1(b1), (f32x2){-s1, c1}, p1), q2 = __builtin_elementwise_fma(SH1(b2), (f32x2){-s2, c2}, p2);
                asm volatile("" :: "v"(q1), "v"(q2));
                y[blk + j] = q1; y[blk + j2] = q2;
                y[blk + j + s] = __builtin_elementwise_fma(a1, (f32x2){2.0f, 2.0f}, -q1); y[blk + j2 + s] = __builtin_elementwise_fma(a2, (f32x2){2.0f, 2.0f}, -q2);
                if (st) { P[j * stride] = q1; P[j2 * stride] = q2; if (j + s < NOUT) P[(j + s) * stride] = y[blk + j + s]; if (j2 + s < NOUT) P[(j2 + s) * stride] = y[blk + j2 + s]; } }
        }
    }
#pragma unroll
    for (int k = 0; k < R; ++k) x[k] = y[k];
}
template <int R, bool INV, bool STORE = false> __device__ __forceinline__ void twiddle_regs(f32x2 (&x)[R], float frac, LAS f32x2* P = nullptr, int stride = 0) {
    asm volatile("" : "+v"(frac));
    const float sn0 = __builtin_amdgcn_sinf(0.5f * frac), cs = __builtin_amdgcn_cosf(0.5f * frac);
    const float sn = INV ? sn0 : -sn0;
    const f32x2 w = (f32x2){cs, sn}, iw = (f32x2){-sn, cs};
    f32x2 w2; { f32x2 t = __builtin_shufflevector(w, w, 0, 0) * w; w2 = pk_fma_rot(w, w, t); }
    f32x2 wa = w, wb = w2;
    if (STORE) P[0] = x[0];
#pragma unroll
    for (int k = 1; k < R; k += 2) {
        const bool hb = (k + 1 < R), na = (k + 2 < R), nb = (k + 3 < R);
        const f32x2 xa = x[k], xb = hb ? x[k + 1] : x[k];
        const f32x2 tda = __builtin_shufflevector(xa, xa, 0, 0) * wa, tdb = __builtin_shufflevector(xb, xb, 0, 0) * wb;
        const f32x2 tpa = __builtin_shufflevector(wa, wa, 0, 0) * w2, tpb = __builtin_shufflevector(wb, wb, 0, 0) * w2;
        if (hb && na && nb) { if (STORE) asm volatile("" :: "v"(tda), "v"(tdb), "v"(tpa), "v"(tpb) : "memory"); else asm volatile("" :: "v"(tda), "v"(tdb), "v"(tpa), "v"(tpb)); }
        else asm volatile("" :: "v"(tda));
        x[k] = pk_fma_rot(xa, wa, tda);
        if (hb) x[k + 1] = pk_fma_rot(xb, wb, tdb);
        if (STORE) { P[k * stride] = x[k]; if (hb) P[(k + 1) * stride] = x[k + 1]; }
        if (na) wa = pk_fma_rot(wa, w2, tpa);
        if (nb) wb = pk_fma_rot(wb, w2, tpb);
    }
}
#define XP(i) ((i) + ((i) >> 4) + 16 * ((i) >> 9))
constexpr int XBP = 560;
template <bool ZUP> __device__ __forceinline__ void fft_f1(LAS f32x2* X, int t) {
    f32x2 x[32]; const int base = t + (t >> 4);
#pragma unroll
    for (int j = 0; j < 32; ++j) x[j] = (ZUP && j >= 16) ? (f32x2){0.f, 0.f} : X[base + j * XBP];
    dft_regs<32, false>(x);
    twiddle_regs<32, false, true>(x, (float)t * (1.0f / 8192.0f), X + base, XBP);
}
__device__ __forceinline__ void fft_f2(LAS f32x2* X, int t) {
    f32x2 x[32]; const int base = (t >> 4) * XBP + (t & 15);
#pragma unroll
    for (int j = 0; j < 32; ++j) x[j] = X[base + j * 17];
    dft_regs<32, false>(x);
    twiddle_regs<32, false, true>(x, (float)(t & 15) * (1.0f / 256.0f), X + base, 17);
}
__device__ __forceinline__ void fft_mid(LAS f32x2* X, const f32x2* H, int t) {
#pragma unroll 1
    for (int r = 0; r < 2; ++r) { const int b = (t >> 6) * 128 + (t & 63) + 64 * r; f32x2 x[16];
        const f32x4* hp = (const f32x4*)(H + 16 * b); f32x4 h[8];
#pragma unroll
        for (int k = 0; k < 8; ++k) h[k] = hp[k];
#pragma unroll
        for (int j = 0; j < 16; ++j) x[j] = X[17 * b + 16 * (b >> 5) + j];
        dft_regs<16, false>(x);
#pragma unroll
        for (int k = 0; k < 8; ++k) { const f32x2 h0 = (f32x2){h[k][0], h[k][1]}, h1 = (f32x2){h[k][2], h[k][3]}, a0 = x[2 * k], a1 = x[2 * k + 1];
            f32x2 t0 = __builtin_shufflevector(a0, a0, 0, 0) * h0, t1 = __builtin_shufflevector(a1, a1, 0, 0) * h1;
            asm volatile("" :: "v"(t0), "v"(t1));
            x[2 * k] = pk_fma_rot(a0, h0, t0); x[2 * k + 1] = pk_fma_rot(a1, h1, t1); }
        dft_regs<16, true>(x);
#pragma unroll
        for (int j = 0; j < 16; ++j) X[17 * b + 16 * (b >> 5) + j] = x[j]; }
}
__device__ __forceinline__ void fft_i2(LAS f32x2* X, int t) {
    f32x2 x[32]; const int base = (t >> 4) * XBP + (t & 15);
#pragma unroll
    for (int k = 0; k < 32; ++k) x[k] = X[base + k * 17];
    twiddle_regs<32, true>(x, (float)(t & 15) * (1.0f / 256.0f));
    dft_regs<32, true, true, 32>(x, X + base, 17);
}
__device__ __forceinline__ void fft_i1(LAS f32x2* X, int t) {
    f32x2 x[32]; const int base = t + (t >> 4);
#pragma unroll
    for (int k = 0; k < 32; ++k) x[k] = X[base + k * XBP];
    twiddle_regs<32, true>(x, (float)t * (1.0f / 8192.0f));
    dft_regs<32, true, true, 16>(x, X + base, XBP);
}
__device__ __forceinline__ void fft_conv(LAS f32x2* X, const f32x2* H, int tid) {
    __syncthreads(); fft_f1<true>(X, tid);
    __syncthreads(); fft_f2(X, tid);
    LDS_WAIT(); asm volatile("" ::: "memory"); fft_mid(X, H, tid);
    LDS_WAIT(); asm volatile("" ::: "memory"); fft_i2(X, tid);
    __syncthreads(); fft_i1(X, tid);
    __syncthreads();
}
__device__ __forceinline__ void hy_spectrum_item(Frame& F, int item) {
    PHASE_TID();
    LAS f32x2* X = (LAS f32x2*)F.lds; LAS float* RED = (LAS float*)(F.lds + XPAD * 8);
    const int o = item >> 9, c = item & 511;
    const float* HF = (const float*)(F.ws + WS_HF);
    const float* f = HF + ((size_t)(o * 2 + 0) * CH + c) * T; const float* bw = HF + ((size_t)(o * 2 + 1) * CH + c) * T;
    f32x2* HS = (f32x2*)(F.ws + WS_YMIX) + (size_t)item * FN;
    __syncthreads();
    f32x2 x[32]; float ss = 0.f; const int base = tid + (tid >> 4);
#pragma unroll
    for (int j = 0; j < 32; ++j) { const int idx = j * 512 + tid; float v;
        if (j < 16) v = f[idx]; else v = (idx == T) ? 0.f : bw[FN - idx];
        ss += v * v; x[j] = (f32x2){v, 0.f}; }
    ss = wave_sum(ss);
    if (lane == 0) RED[wave] = ss;
    dft_regs<32, false>(x);
    twiddle_regs<32, false>(x, (float)tid * (1.0f / 8192.0f));
#pragma unroll
    for (int k = 0; k < 32; ++k) X[base + k * XBP] = x[k];
    __syncthreads();
    float tot = 0.f;
#pragma unroll
    for (int w = 0; w < 8; ++w) tot += RED[w];
    const float sc = (1.0f / sqrtf(tot + 1e-6f)) * (1.0f / (float)FN);
    fft_f2(X, tid);
    __syncthreads();
#pragma unroll 1
    for (int r = 0; r < 2; ++r) { const int b = tid + 512 * r; f32x2 y[16];
#pragma unroll
        for (int j = 0; j < 16; ++j) y[j] = X[17 * b + 16 * (b >> 5) + j];
        dft_regs<16, false>(y);
        f32x4* dst = (f32x4*)(HS + 16 * b);
#pragma unroll
        for (int k = 0; k < 8; ++k) dst[k] = (f32x4){y[2 * k].x * sc, y[2 * k].y * sc, y[2 * k + 1].x * sc, y[2 * k + 1].y * sc}; }
}
__device__ __forceinline__ void p_spectra(Frame& F) { PHASE_TID(); (void)tid; for (int it = bid; it < 2 * CH; it += F.G) hy_spectrum_item(F, it); __syncthreads(); }

struct RowRaw { v4u a, b; unsigned lo, hi; };
__device__ __forceinline__ void hy_row_load(RowRaw& R, const bf16* row, int t0) {
    R.a = *(const v4u*)(row + t0); R.b = *(const v4u*)(row + t0 + 8);
    R.lo = t0 > 0 ? (unsigned)row[t0 - 1] : 0u; R.hi = t0 + 16 < T ? (unsigned)row[t0 + 16] : 0u;
}
__device__ __forceinline__ void hy_u16r(const RowRaw& R, float w0, float w1, float w2, float bias, float (&u)[16]) {
    float p[18];
    p[0] = __builtin_bit_cast(float, R.lo << 16); p[17] = __builtin_bit_cast(float, R.hi << 16);
    const unsigned w[8] = {R.a.x, R.a.y, R.a.z, R.a.w, R.b.x, R.b.y, R.b.z, R.b.w};
#pragma unroll
    for (int i = 0; i < 8; ++i) { p[1 + 2 * i] = bflo(w[i]); p[2 + 2 * i] = bfhi(w[i]); }
#pragma unroll
    for (int i = 0; i < 16; ++i) u[i] = w0 * p[i] + w1 * p[i + 1] + w2 * p[i + 2] + bias;
}
__device__ __forceinline__ void hy_pack_store(bf16* dst, const float (&y)[16]) {
    v4u o0, o1;
    o0.x = pk2(y[0], y[1]); o0.y = pk2(y[2], y[3]); o0.z = pk2(y[4], y[5]); o0.w = pk2(y[6], y[7]);
    o1.x = pk2(y[8], y[9]); o1.y = pk2(y[10], y[11]); o1.z = pk2(y[12], y[13]); o1.w = pk2(y[14], y[15]);
    *(v4u*)dst = o0; *(v4u*)(dst + 8) = o1;
}
__device__ __forceinline__ void hy_fft_item(Frame& F, int l, int item) {
    PHASE_TID(); const int c = item >> 2, bp = item & 3, t0 = 16 * tid, xb = 17 * tid + 16 * (tid >> 5);
    LAS f32x2* X = (LAS f32x2*)F.lds;
    bf16* PHT = (bf16*)(F.ws + WS_PHT);
    bf16* rx1a = PHT + ((size_t)(2 * bp) * HYP + c) * T; bf16* rx1b = rx1a + (size_t)HYP * T;
    bf16* rx2a = PHT + ((size_t)(2 * bp) * HYP + CH + c) * T; bf16* rx2b = rx2a + (size_t)HYP * T;
    const bf16* rva = PHT + ((size_t)(2 * bp) * HYP + 2 * CH + c) * T; const bf16* rvb = rva + (size_t)HYP * T;
    const float* cw = F.in[I_HCW] + (size_t)l * 3 * HYP; const float* cb = F.in[I_HCB] + (size_t)l * HYP;
    const float* skip = F.in[I_HSKIP] + (size_t)l * 2 * CH;
    const f32x2* H0 = (const f32x2*)(F.ws + WS_YMIX) + (size_t)c * FN; const f32x2* H1 = H0 + (size_t)CH * FN;
    __syncthreads();
    RowRaw va, vb, xa, xb2;
    hy_row_load(va, rva, t0); hy_row_load(vb, rvb, t0);
    const float vw0 = cw[2 * CH + c], vw1 = cw[HYP + 2 * CH + c], vw2 = cw[2 * HYP + 2 * CH + c], vbs = cb[2 * CH + c];
    const float x1w0 = cw[c], x1w1 = cw[HYP + c], x1w2 = cw[2 * HYP + c], x1bs = cb[c], x2w0 = cw[CH + c], x2w1 = cw[HYP + CH + c], x2w2 = cw[2 * HYP + CH + c], x2bs = cb[CH + c], s0 = skip[c], s1 = skip[CH + c];
    { float ua[16], ub[16];
      hy_u16r(va, vw0, vw1, vw2, vbs, ua); hy_u16r(vb, vw0, vw1, vw2, vbs, ub);
#pragma unroll
      for (int i = 0; i < 16; ++i) X[xb + i] = (f32x2){ua[i], ub[i]}; }
    hy_row_load(xa, rx1a, t0); hy_row_load(xb2, rx1b, t0);
    fft_conv(X, H0, tid);
    v4u z2a[2], z2b[2];
    { float ua[16], ub[16], za[16], zb[16];
      {
        hy_u16r(va, vw0, vw1, vw2, vbs, ua); hy_u16r(vb, vw0, vw1, vw2, vbs, ub);
#pragma unroll
        for (int i = 0; i < 16; ++i) { const f32x2 y = X[xb + i]; za[i] = y.x + s0 * ua[i]; zb[i] = y.y + s0 * ub[i]; } }
      hy_u16r(xa, x1w0, x1w1, x1w2, x1bs, ua); hy_u16r(xb2, x1w0, x1w1, x1w2, x1bs, ub);
#pragma unroll
      for (int i = 0; i < 16; ++i) { za[i] *= ua[i]; zb[i] *= ub[i]; }
#pragma unroll
      for (int q = 0; q < 2; ++q) { z2a[q].x = pk2(za[8 * q], za[8 * q + 1]); z2a[q].y = pk2(za[8 * q + 2], za[8 * q + 3]); z2a[q].z = pk2(za[8 * q + 4], za[8 * q + 5]); z2a[q].w = pk2(za[8 * q + 6], za[8 * q + 7]);
                                    z2b[q].x = pk2(zb[8 * q], zb[8 * q + 1]); z2b[q].y = pk2(zb[8 * q + 2], zb[8 * q + 3]); z2b[q].z = pk2(zb[8 * q + 4], zb[8 * q + 5]); z2b[q].w = pk2(zb[8 * q + 6], zb[8 * q + 7]); }
#pragma unroll
      for (int i = 0; i < 16; ++i) X[xb + i] = (f32x2){za[i], zb[i]}; }
    hy_row_load(xa, rx2a, t0); hy_row_load(xb2, rx2b, t0);
    fft_conv(X, H1, tid);
    { float ua[16], ub[16];
      hy_u16r(xa, x2w0, x2w1, x2w2, x2bs, ua); hy_u16r(xb2, x2w0, x2w1, x2w2, x2bs, ub);
      float za[16], zb[16];
      const unsigned wa[8] = {z2a[0].x, z2a[0].y, z2a[0].z, z2a[0].w, z2a[1].x, z2a[1].y, z2a[1].z, z2a[1].w}, wb[8] = {z2b[0].x, z2b[0].y, z2b[0].z, z2b[0].w, z2b[1].x, z2b[1].y, z2b[1].z, z2b[1].w};
#pragma unroll
      for (int i = 0; i < 8; ++i) { za[2 * i] = bflo(wa[i]); za[2 * i + 1] = bfhi(wa[i]); zb[2 * i] = bflo(wb[i]); zb[2 * i + 1] = bfhi(wb[i]); }
#pragma unroll
      for (int i = 0; i < 16; ++i) { const f32x2 y = X[xb + i]; za[i] = ua[i] * (y.x + s1 * za[i]); zb[i] = ub[i] * (y.y + s1 * zb[i]); }
      hy_pack_store(rx2a + t0, za); hy_pack_store(rx2b + t0, zb); }
}
typedef short bf16x8 __attribute__((ext_vector_type(8)));
constexpr int CL_ = 64;
constexpr int LDB = 80;
constexpr int LDSG = 144, LDVL = 48;
constexpr int LDF = 65;
constexpr int MB = 64 * LDB * 2;
constexpr int MF = 64 * LDF * 4;
constexpr int O_AH = 0, O_AHT = MB, O_RH = 2 * MB, O_BH = 3 * MB, O_BHT = 4 * MB, O_KH = 5 * MB, O_KHT = 6 * MB, O_VT = 7 * MB;
constexpr int O_TW = 0, O_AD = MB, O_SG = 2 * MB  , O_VL = 2 * MB + 64 * LDSG * 2  ;
constexpr int O_APB = O_KH;
constexpr int O_F = 8 * MB;
constexpr int O_AF = O_F, O_LW = O_F + MF, O_ZV = O_F + 2 * MF;
constexpr int O_XA = O_F, O_XAT = O_F + MB, O_AAK = O_F + 2 * MB, O_ARB = O_F + 3 * MB, O_ARK = O_F + 4 * MB;
constexpr int O_S0B = O_F + ((3 * MF > 5 * MB) ? 3 * MF : 5 * MB);
constexpr int O_UT = O_S0B + MB;
constexpr int O_TB = O_UT, O_M1T = O_BH, O_T0T = O_AH, O_WT = O_KH;
constexpr int O_PL = O_UT + MB;
constexpr int O_PART = O_PL + 256;
constexpr int O_MU = O_PART + 2048;
constexpr int O_CK = O_MU + 1792;
constexpr int O_MC = O_CK + 768;
static_assert(O_ARK + MB <= O_S0B && O_ZV + MF <= O_S0B && O_VL + 64 * LDVL * 2 <= O_F && O_MC + 1792 <= LDSCTL_OFF, "cscan LDS map");

__device__ __forceinline__ unsigned pk2s(float v) { return pk2(v, v); }
#define MFMA16(a, b, c) __builtin_amdgcn_mfma_f32_16x16x32_bf16((a), (b), (c), 0, 0, 0)
__device__ __forceinline__ bf16x8 ldfrag(const LAS unsigned char* base, int ld, int row0, int k0, int fr, int fq) {
    return *(const LAS bf16x8*)(base + ((row0 + fr) * ld + k0 + 8 * fq) * 2);
}
__device__ __forceinline__ void st_tile_bf16(LAS unsigned char* base, int ld, int m0, int n0, int fr, int fq, const f32x4& v) {
#pragma unroll
    for (int jj = 0; jj < 4; ++jj) *(LAS bf16*)(base + ((m0 + 4 * fq + jj) * ld + n0 + fr) * 2) = (bf16)pk2s(v[jj]);
}
__device__ __forceinline__ void st_tile_bf16_T(LAS unsigned char* base, int ld, int m0, int n0, int fr, int fq, const f32x4& v) {
    v2u o; o.x = pk2(v[0], v[1]); o.y = pk2(v[2], v[3]);
    *(LAS v2u*)(base + ((n0 + fr) * ld + m0 + 4 * fq) * 2) = o;
}
#define CFENCE() asm volatile("" ::: "memory")
#define ZFRAG ((bf16x8){0, 0, 0, 0, 0, 0, 0, 0})
__device__ __forceinline__ void ldA(bf16x8 (&a)[2], const LAS unsigned char* A, int mt, int fr, int fq) {
#pragma unroll
    for (int ks = 0; ks < 2; ++ks) a[ks] = ldfrag(A, LDB, 16 * mt, 32 * ks, fr, fq);
}
__device__ __forceinline__ void ldB(bf16x8 (&b)[2][2], const LAS unsigned char* B, int nt0, int fr, int fq) {
#pragma unroll
    for (int ks = 0; ks < 2; ++ks)
#pragma unroll
        for (int j = 0; j < 2; ++j) b[ks][j] = ldfrag(B, LDB, 16 * (nt0 + j), 32 * ks, fr, fq);
}
#define PIN(x) asm volatile("" : "+v"(x))
__device__ __forceinline__ void mmac(bf16x8 (&a)[2], bf16x8 (&b)[2][2], f32x4 (&acc)[2]) {
#pragma unroll
    for (int ks = 0; ks < 2; ++ks) { PIN(a[ks]);
#pragma unroll
        for (int j = 0; j < 2; ++j) { PIN(b[ks][j]); acc[j] = MFMA16(a[ks], b[ks][j], acc[j]); } }
}
__device__ __forceinline__ void mmacT(bf16x8 (&a)[2], bf16x8 (&b)[2][2], f32x4 (&acc)[2]) {
#pragma unroll
    for (int ks = 0; ks < 2; ++ks) { PIN(a[ks]);
#pragma unroll
        for (int j = 0; j < 2; ++j) { PIN(b[ks][j]); acc[j] = MFMA16(b[ks][j], a[ks], acc[j]); } }
}
__device__ __forceinline__ v4u pack8(const float (&v)[8]) { v4u o; o.x = pk2(v[0], v[1]); o.y = pk2(v[2], v[3]); o.z = pk2(v[4], v[5]); o.w = pk2(v[6], v[7]); return o; }
__device__ __forceinline__ bf16x8 wfrag(const float* W, int k0, int col, int fq) {
    float v[8];
#pragma unroll
    for (int e = 0; e < 8; ++e) v[e] = W[(size_t)(k0 + 8 * fq + e) * CH + col];
    return __builtin_bit_cast(bf16x8, pack8(v));
}

struct RawTok { v4u g[7][3]; };
__device__ __forceinline__ void load_raw(RawTok& R, const bf16* PRW, const bf16* VFIRST, int b, int tok, int hc, int ec, int d, int l, bool has_vl) {
    const size_t m = (size_t)b * T + tok; const v4u z = (v4u){0u, 0u, 0u, 0u};
    const int cols[7] = {hc + ec, CH + hc + ec, 2 * CH + hc + ec, 1536 + d * 64 + ec, 1664 + d * 64 + ec, 1792 + ec, 1856 + ec};
#pragma unroll
    for (int g = 0; g < 7; ++g) { if (g >= 5 && d != 0) { R.g[g][0] = z; R.g[g][1] = z; R.g[g][2] = z; continue; }
        const bf16* p = PRW + m * NRW + cols[g];
        R.g[g][1] = *(const v4u*)p; R.g[g][0] = *(const v4u*)(p - NRW); R.g[g][2] = *(const v4u*)(p + NRW); }
    if (__builtin_amdgcn_readfirstlane((int)__builtin_amdgcn_ballot_w64(tok == 0 || tok == T - 1) != 0 || (int)(__builtin_amdgcn_ballot_w64(tok == 0 || tok == T - 1) >> 32) != 0)) {
#pragma unroll
        for (int g = 0; g < 7; ++g) { R.g[g][0] = (tok == 0) ? z : R.g[g][0]; R.g[g][2] = (tok == T - 1) ? z : R.g[g][2]; } }
}
typedef __bf16 bf16x2v __attribute__((ext_vector_type(2)));
__device__ __forceinline__ void mix8r(const v4u (&r)[3], const LAS unsigned* mub, const LAS float* mcb, float (&out)[8]) {
    const v4u ma = *(const LAS v4u*)mub, mb = *(const LAS v4u*)(mub + 4); const f32x4 ca = *(const LAS f32x4*)mcb, cb = *(const LAS f32x4*)(mcb + 4);
    const unsigned mw[8] = {ma.x, ma.y, ma.z, ma.w, mb.x, mb.y, mb.z, mb.w}; const float mc[8] = {ca[0], ca[1], ca[2], ca[3], cb[0], cb[1], cb[2], cb[3]};
    const unsigned pw[4] = {r[0].x, r[0].y, r[0].z, r[0].w}, cw[4] = {r[1].x, r[1].y, r[1].z, r[1].w}, nw[4] = {r[2].x, r[2].y, r[2].z, r[2].w};
#pragma unroll
    for (int i = 0; i < 4; ++i) {
        const unsigned pn0 = __builtin_amdgcn_perm(nw[i], pw[i], 0x05040100u), pn1 = __builtin_amdgcn_perm(nw[i], pw[i], 0x07060302u);
        out[2 * i] = __builtin_amdgcn_fdot2_f32_bf16(__builtin_bit_cast(bf16x2v, pn0), __builtin_bit_cast(bf16x2v, mw[2 * i]), bflo(cw[i]) * mc[2 * i], false);
        out[2 * i + 1] = __builtin_amdgcn_fdot2_f32_bf16(__builtin_bit_cast(bf16x2v, pn1), __builtin_bit_cast(bf16x2v, mw[2 * i + 1]), bfhi(cw[i]) * mc[2 * i + 1], false); }
}
template <bool DO_T, bool DO_X, bool LAST> __device__ __forceinline__ void blk_stage(const LAS unsigned char* X, const LAS unsigned char* XT, const LAS unsigned char* TT, LAS unsigned char* To, LAS unsigned char* T0T,
                                                                                    LAS unsigned char* Xo, LAS unsigned char* XoT, int wave, int fr, int fq) {
    const int bk = wave >> 2, k0 = 32 * bk, m0 = k0 + 16 * ((wave >> 1) & 1), n0 = k0 + 16 * (wave & 1);
    bf16x8 a = ldfrag(X, LDB, m0, k0, fr, fq), tb = a, xb = a; v2u tw = (v2u){0u, 0u};
    if (DO_T) { tb = ldfrag(TT, LDB, n0, k0, fr, fq); tw = *(const LAS v2u*)(TT + ((n0 + fr) * LDB + m0 + 4 * fq) * 2); }
    if (DO_X) xb = ldfrag(XT, LDB, n0, k0, fr, fq);
    CFENCE();
    PIN(a);
    if (DO_T) { f32x4 ta = (f32x4){bflo(tw.x), bfhi(tw.x), bflo(tw.y), bfhi(tw.y)}; PIN(tb); ta = MFMA16(a, tb, ta);
        if (LAST) { st_tile_bf16(To, LDB, m0, n0, fr, fq, ta); if (bk == 0) st_tile_bf16_T(T0T, LDB, m0, n0, fr, fq, ta); }
        else st_tile_bf16_T(To, LDB, m0, n0, fr, fq, ta); }
    if (DO_X) { f32x4 xa = (f32x4){0.f, 0.f, 0.f, 0.f}; PIN(xb); xa = MFMA16(a, xb, xa);
        st_tile_bf16(Xo, LDB, m0, n0, fr, fq, xa); st_tile_bf16_T(XoT, LDB, m0, n0, fr, fq, xa); }
}

template <int HH> __device__ __forceinline__ void m2_half(LAS unsigned char* L, int q, int fr, int fq) {
    const LAS unsigned char* Am = L + ((q < 2) ? O_AH : O_RH); const LAS unsigned char* Bm = L + ((q & 1) ? O_KH : O_BH);
    LAS unsigned char* Om = L + (q == 0 ? O_XA : (q == 1 ? O_AAK : (q == 2 ? O_ARB : O_ARK)));
    constexpr int MT0 = HH ? 1 : 0, MT1 = HH ? 2 : 3, NB = MT1 + 1;
    unsigned zz_ = 0u; asm volatile("" : "+v"(zz_)); const v2u z2 = (v2u){zz_, zz_};
    bf16x8 a[2][2], b[NB][2];
#pragma unroll
    for (int ks = 0; ks < 2; ++ks) { a[0][ks] = ldfrag(Am, LDB, 16 * MT0, 32 * ks, fr, fq); a[1][ks] = ldfrag(Am, LDB, 16 * MT1, 32 * ks, fr, fq); }
#pragma unroll
    for (int nt = 0; nt < NB; ++nt)
#pragma unroll
        for (int ks = 0; ks < 2; ++ks) b[nt][ks] = ldfrag(Bm, LDB, 16 * nt, 32 * ks, fr, fq);
    CFENCE();
#pragma unroll
    for (int mi = 0; mi < 2; ++mi) { const int mtile = mi ? MT1 : MT0;
        PIN(a[mi][0]); PIN(a[mi][1]);
#pragma unroll
        for (int nt = 0; nt < 4; ++nt) {
            if (nt > mtile) {
                *(LAS v2u*)(Om + ((16 * mtile + fr) * LDB + 16 * nt + 4 * fq) * 2) = z2;
                if (q == 0) { *(LAS v2u*)(L + O_XAT + ((16 * nt + fr) * LDB + 16 * mtile + 4 * fq) * 2) = z2; *(LAS v2u*)(L + O_UT + ((16 * nt + fr) * LDB + 16 * mtile + 4 * fq) * 2) = z2; }
                continue; }
            if (mi == 0) { PIN(b[nt][0]); PIN(b[nt][1]); }
            f32x4 at = (f32x4){0.f, 0.f, 0.f, 0.f};
            at = MFMA16(b[nt][0], a[mi][0], at); at = MFMA16(b[nt][1], a[mi][1], at);
            if (nt == mtile) {
#pragma unroll
                for (int jj = 0; jj < 4; ++jj) { const bool keep = (q < 2) ? (4 * fq + jj < fr) : (4 * fq + jj <= fr); if (!keep) at[jj] = 0.f; } }
            { v2u o; o.x = pk2(at[0], at[1]); o.y = pk2(at[2], at[3]); *(LAS v2u*)(Om + ((16 * mtile + fr) * LDB + 16 * nt + 4 * fq) * 2) = o; }
            if ((mtile >> 1) == (nt >> 1)) {
                if (q == 0) { f32x4 an = (f32x4){0.f, 0.f, 0.f, 0.f};
                    an = MFMA16(a[mi][0], b[nt][0], an); an = MFMA16(a[mi][1], b[nt][1], an);
                    f32x4 t1 = an;
                    if (nt == mtile) {
#pragma unroll
                        for (int jj = 0; jj < 4; ++jj) { if (!(fr < 4 * fq + jj)) an[jj] = 0.f; t1[jj] = (fr == 4 * fq + jj) ? 1.0f : an[jj]; } }
                    st_tile_bf16_T(L + O_XAT, LDB, 16 * mtile, 16 * nt, fr, fq, an);
                    st_tile_bf16_T(L + O_UT, LDB, 16 * mtile, 16 * nt, fr, fq, t1); } }
        } }
}

__device__ __forceinline__ void cscan_chain(Frame& F, int l, int unit) {
    PHASE_TID(); const int chain = unit >> 1, seg = unit & 1; const int b = chain >> 4, h = (chain >> 1) & 7, d = chain & 1, hc = h * HD;
    const int fr_o = lane & 15, fq_o = lane >> 4;
    LAS unsigned char* L = F.lds;
    const bf16* PRW = (const bf16*)(F.ws + WS_PRW);
    const float* mu = F.in[I_SHIFT] + (size_t)l * 2 * RWP;
    const bf16* VFIRST = (const bf16*)(F.ws + WS_VFIRST);
    bf16* VOUT = (l == 0) ? (bf16*)(F.ws + WS_VFIRST) : (bf16*)(F.ws + WS_V2);
    bf16* GOUT = (bf16*)(F.ws + WS_G);
    bf16* YS = (bf16*)(F.ws + WS_YS) + (size_t)d * M * CH;
    float* BS = (float*)(F.ws + WS_BS) + (size_t)d * M * NH;
    bf16* YPHI = (bf16*)(F.ws + WS_YPHI) + (size_t)chain * (T / 2) * 64;
    const int lnt = wave & 3, lmt0 = 2 * (wave >> 2);
    if (wave < 4) { const int lcol = hc + 16 * lnt + fr_o; bf16x8* FRAGS = (bf16x8*)(F.ws + WS_FRAG) + ((size_t)chain * 4 + lnt) * 9 * 64 + lane; const float* w2 = F.in[I_W2] + (size_t)(l * 2 + d) * 64 * CH; const float* a2 = F.in[I_A2] + (size_t)(l * 2 + d) * 64 * CH; const float* g2 = F.in[I_G2] + (size_t)l * 128 * CH;
#pragma unroll
      for (int ks = 0; ks < 2; ++ks) { FRAGS[ks * 64] = wfrag(w2, 32 * ks, lcol, fq_o); FRAGS[(2 + ks) * 64] = wfrag(a2, 32 * ks, lcol, fq_o); }
      if (l == 1) FRAGS[4 * 64] = wfrag(F.in[I_V2], 0, lcol, fq_o);
#pragma unroll
      for (int ks = 0; ks < 4; ++ks) if (d == 0) FRAGS[(5 + ks) * 64] = wfrag(g2, 32 * ks, lcol, fq_o); }
    const int lcol_o = hc + 16 * lnt + fr_o;
    const float lc_w0 = F.in[I_W0][(l * 2 + d) * CH + lcol_o], lc_a0 = F.in[I_A0][(l * 2 + d) * CH + lcol_o], lc_v0 = (l == 1) ? F.in[I_V0][lcol_o] : 0.f;
    const int mt = wave >> 1, nt0 = 2 * (wave & 1);
    f32x4 S[2] = {(f32x4){0.f, 0.f, 0.f, 0.f}, (f32x4){0.f, 0.f, 0.f, 0.f}};
    f32x4 Ph[2];
#pragma unroll
    for (int j = 0; j < 2; ++j)
#pragma unroll
        for (int jj = 0; jj < 4; ++jj) Ph[j][jj] = (16 * mt + 4 * fq_o + jj == 16 * (nt0 + j) + fr_o) ? 1.0f : 0.f;
    __syncthreads();
    for (int e = tid; e < MB / 4; e += NTHR) ((LAS unsigned*)(L + O_S0B))[e] = 0u;
    if (tid < 448) { const int g = tid >> 6, j = tid & 63; const int col = (g < 3) ? g * CH + hc + j : (g == 3 ? 1536 + d * 64 + j : (g == 4 ? 1664 + d * 64 + j : 1792 + (tid - 320)));
        const unsigned pm = pk2(mu[col], mu[RWP + col]); ((LAS unsigned*)(L + O_MU))[tid] = pm; ((LAS float*)(L + O_MC))[tid] = 1.0f - bflo(pm) - bfhi(pm); }
    if (tid < 192) { const int g = tid >> 6, j = tid & 63; ((LAS float*)(L + O_CK))[tid] = F.in[g == 0 ? I_KK : (g == 1 ? I_KA : I_RK)][l * CH + hc + j]; }
    RawTok raw;
    { const int et0 = tid >> 3, ec0 = (tid & 7) * 8; const int cf = (d == 0) ? seg * 64 * CL_ : (127 - seg * 64) * CL_; load_raw(raw, PRW, VFIRST, b, (d == 0) ? cf + et0 : cf + 63 - et0, hc, ec0, d, l, (tid & 7) < 4); }
#pragma unroll 1
    for (int ci = 0; ci < T / CL_ / 2; ++ci) {
        int tid = (wave << 6) | (int)__builtin_amdgcn_mbcnt_hi(~0u, __builtin_amdgcn_mbcnt_lo(~0u, 0u)); asm volatile("" : "+v"(tid));
        const int lane = tid & 63, fr = lane & 15, fq = lane >> 4, et = tid >> 3, ec = (tid & 7) * 8;
        const int lcol = hc + 16 * lnt + fr;
        const unsigned char* FRB = F.ws + WS_FRAG + (((size_t)chain * 4 + lnt) * 9 * 64) * 16; unsigned fo = (unsigned)lane * 16u;
#define FRAGS_(k) (*(const bf16x8*)(FRB + fo + (k) * 1024))
        int c0 = (d == 0 ? seg * 64 + ci : 127 - seg * 64 - ci) * CL_; asm volatile("" : "+s"(c0));
        const int tok = (d == 0) ? c0 + et : c0 + 63 - et;
        const size_t m = (size_t)b * T + tok;
        __syncthreads();
        float rr[8], kr[8], vr[8];
        const LAS unsigned* MUB = (const LAS unsigned*)(L + O_MU) + ec; const LAS float* MCB = (const LAS float*)(L + O_MC) + ec;
        v4u vl4 = (v4u){0u, 0u, 0u, 0u}, vf4 = vl4;
        if (l == 1 && (tid & 7) < 4) vl4 = *(const v4u*)(PRW + m * NRW + RWP + ec);
        bf16x8 wf[5];
        {
          if (d == 0) { float g0[8], g1[8];
              mix8r(raw.g[5], MUB + 320, MCB + 320, g0); CFENCE(); mix8r(raw.g[6], MUB + 384, MCB + 384, g1); CFENCE();
#pragma unroll
              for (int e = 0; e < 8; ++e) { g0[e] = sigmoidf_(g0[e]); g1[e] = sigmoidf_(g1[e]); }
              *(LAS v4u*)(L + O_SG + (et * LDSG + ec) * 2) = pack8(g0); *(LAS v4u*)(L + O_SG + (et * LDSG + 64 + ec) * 2) = pack8(g1); }
          float xw[8], xa[8];
          mix8r(raw.g[3], MUB + 192, MCB + 192, xw); CFENCE(); mix8r(raw.g[4], MUB + 256, MCB + 256, xa);
          asm volatile("" : "+v"(fo) : "v"(xw[7]), "v"(xa[7]));
          wf[0] = FRAGS_(0); wf[1] = FRAGS_(1); wf[2] = FRAGS_(2); wf[3] = FRAGS_(3); wf[4] = ZFRAG; if (l == 1) wf[4] = FRAGS_(4);
          CFENCE();
#pragma unroll
          for (int e = 0; e < 8; ++e) xw[e] = tanhf_(xw[e]);
          *(LAS v4u*)(L + O_TW + (et * LDB + ec) * 2) = pack8(xw);
          *(LAS v4u*)(L + O_AD + (et * LDB + ec) * 2) = pack8(xa);
          mix8r(raw.g[0], MUB, MCB, rr); CFENCE(); mix8r(raw.g[1], MUB + 64, MCB + 64, kr); CFENCE(); mix8r(raw.g[2], MUB + 128, MCB + 128, vr);
          if (l == 1 && (tid & 7) < 4) *(LAS v4u*)(L + O_VL + (et * LDVL + ec) * 2) = vl4;
          if (l == 1) vf4 = *(const v4u*)(VFIRST + m * CH + hc + ec); }
        __syncthreads();
        { bf16x8 gf[4];
          gf[0] = ZFRAG; gf[1] = ZFRAG; gf[2] = ZFRAG; gf[3] = ZFRAG;
          if (d == 0) { gf[0] = FRAGS_(5); gf[1] = FRAGS_(6); gf[2] = FRAGS_(7); gf[3] = FRAGS_(8); }
#pragma unroll
          for (int mi = 0; mi < 2; ++mi) { const int m0 = 16 * (lmt0 + mi);
              bf16x8 tw[2], ad[2], vl;
#pragma unroll
              for (int ks = 0; ks < 2; ++ks) { tw[ks] = ldfrag(L + O_TW, LDB, m0, 32 * ks, fr, fq); ad[ks] = ldfrag(L + O_AD, LDB, m0, 32 * ks, fr, fq); }
              vl = ZFRAG; if (l == 1) vl = ldfrag(L + O_VL, LDVL, m0, 0, fr, fq);
              CFENCE();
              f32x4 zw = (f32x4){0.f, 0.f, 0.f, 0.f}, za = zw, zv = zw;
#pragma unroll
              for (int ks = 0; ks < 2; ++ks) { PIN(tw[ks]); zw = MFMA16(tw[ks], wf[ks], zw); PIN(ad[ks]); za = MFMA16(ad[ks], wf[2 + ks], za); }
              if (l == 1) { PIN(vl); zv = MFMA16(vl, wf[4], zv); }
#pragma unroll
              for (int jj = 0; jj < 4; ++jj) { const int s = m0 + 4 * fq + jj, o = (s * LDF + 16 * lnt + fr) * 4;
                  *(LAS float*)(L + O_AF + o) = sigmoidf_(za[jj] + lc_a0);
                  *(LAS float*)(L + O_LW + o) = -0.6065306597126334f * sigmoidf_(zw[jj] + lc_w0); }
              if (l == 1) {
#pragma unroll
                  for (int jj = 0; jj < 4; ++jj) { const int s = m0 + 4 * fq + jj, o = (s * LDF + 16 * lnt + fr) * 4; *(LAS float*)(L + O_ZV + o) = sigmoidf_(zv[jj] + lc_v0); } } }
          if (d == 0) {
#pragma unroll
              for (int mi = 0; mi < 2; ++mi) { const int m0 = 16 * (lmt0 + mi);
                  bf16x8 sg[4];
#pragma unroll
                  for (int ks = 0; ks < 4; ++ks) sg[ks] = ldfrag(L + O_SG, LDSG, m0, 32 * ks, fr, fq);
                  CFENCE();
                  f32x4 zg = (f32x4){0.f, 0.f, 0.f, 0.f};
#pragma unroll
                  for (int ks = 0; ks < 4; ++ks) { PIN(sg[ks]); zg = MFMA16(gf[ks], sg[ks], zg); }
                  { v2u o; o.x = pk2(zg[0], zg[1]); o.y = pk2(zg[2], zg[3]); *(v2u*)(GOUT + ((size_t)b * T + c0 + m0 + fr) * CH + hc + 16 * lnt + 4 * fq) = o; } } } }
        __syncthreads();
        { const int j = tid & 63, sg = tid >> 6; float c[8]; float run = 0.f;
#pragma unroll
          for (int i = 0; i < 8; ++i) { run += *(LAS float*)(L + O_LW + ((8 * sg + i) * LDF + j) * 4); c[i] = run; }
          *(LAS float*)(L + O_PART + (sg * 64 + j) * 4) = run;
          __syncthreads();
          float pre = 0.f;
#pragma unroll
          for (int q = 0; q < 8; ++q) { const float pv = *(LAS float*)(L + O_PART + (q * 64 + j) * 4); pre += (q < sg) ? pv : 0.f; }
#pragma unroll
          for (int i = 0; i < 8; ++i) *(LAS float*)(L + O_LW + ((8 * sg + i) * LDF + j) * 4) = c[i] + pre; }
        __syncthreads();
        { float kkr[8], av[8], cl[8], clm[8], zv[8], kd[8], ss = 0.f, bon = 0.f;
          const unsigned vfw[4] = {vf4.x, vf4.y, vf4.z, vf4.w};
          const LAS float* CKT = (const LAS float*)(L + O_CK) + ec;
          const f32x4 kka = *(const LAS f32x4*)CKT, kkb = *(const LAS f32x4*)(CKT + 4), kaa = *(const LAS f32x4*)(CKT + 64), kab = *(const LAS f32x4*)(CKT + 68), rka = *(const LAS f32x4*)(CKT + 128), rkb = *(const LAS f32x4*)(CKT + 132);
          const int o0 = (et * LDF + ec) * 4, om = (et > 0) ? o0 - LDF * 4 : o0;
#pragma unroll
          for (int e = 0; e < 8; ++e) { av[e] = *(LAS float*)(L + O_AF + o0 + 4 * e); cl[e] = *(LAS float*)(L + O_LW + o0 + 4 * e); clm[e] = *(LAS float*)(L + O_LW + om + 4 * e); zv[e] = 0.f; }
          if (l == 1) {
#pragma unroll
              for (int e = 0; e < 8; ++e) zv[e] = *(LAS float*)(L + O_ZV + o0 + 4 * e); }
          CFENCE();
          const float ckk[8] = {kka[0], kka[1], kka[2], kka[3], kkb[0], kkb[1], kkb[2], kkb[3]}, cka[8] = {kaa[0], kaa[1], kaa[2], kaa[3], kab[0], kab[1], kab[2], kab[3]},
                      crk[8] = {rka[0], rka[1], rka[2], rka[3], rkb[0], rkb[1], rkb[2], rkb[3]};
#pragma unroll
          for (int e = 0; e < 8; ++e) {
              const float vf = (e & 1) ? bfhi(vfw[e >> 1]) : bflo(vfw[e >> 1]); vr[e] = vr[e] + (vf - vr[e]) * zv[e];
              kkr[e] = kr[e] * ckk[e]; ss += kkr[e] * kkr[e];
              kd[e] = kr[e] * (1.0f + (av[e] - 1.0f) * cka[e]); bon += rr[e] * kd[e] * crk[e]; }
          ss = sum8(ss); bon = sum8(bon);
          const float inv = __builtin_amdgcn_rsqf(fmaxf(ss, 1e-24f));
          if ((tid & 7) == 0) BS[m * NH + h] = bon;
          if (d == 0) *(v4u*)(VOUT + m * CH + hc + ec) = pack8(vr);
          float ah[8], bh[8], kh[8], rh[8], Pv[8];
#pragma unroll
          for (int e = 0; e < 8; ++e) {
              const float P = __expf(cl[e]), Pi = __builtin_amdgcn_rcpf(P), Pm = (et > 0) ? __expf(clm[e]) : 1.0f, kk = kkr[e] * inv;
              ah[e] = -kk * Pm; bh[e] = kk * av[e] * Pi; kh[e] = kd[e] * Pi; rh[e] = rr[e] * P; Pv[e] = P; }
          if (et == 63) { *(LAS f32x4*)(L + O_PL + ec * 4) = (f32x4){Pv[0], Pv[1], Pv[2], Pv[3]}; *(LAS f32x4*)(L + O_PL + ec * 4 + 16) = (f32x4){Pv[4], Pv[5], Pv[6], Pv[7]}; }
          *(LAS v4u*)(L + O_AH + (et * LDB + ec) * 2) = pack8(ah); *(LAS v4u*)(L + O_BH + (et * LDB + ec) * 2) = pack8(bh);
          *(LAS v4u*)(L + O_KH + (et * LDB + ec) * 2) = pack8(kh); *(LAS v4u*)(L + O_RH + (et * LDB + ec) * 2) = pack8(rh);
          { unsigned pab[8], pkv[8]; const int c = tid & 7;
#pragma unroll
            for (int e = 0; e < 8; ++e) { pab[e] = pk2(ah[e], bh[e]); pkv[e] = pk2(kh[e], vr[e]); }
#pragma unroll
            for (int sh = 1; sh < 8; sh <<= 1) { const bool on = (c & sh) != 0; unsigned ta[8], tk[8];
#pragma unroll
                for (int e = 0; e < 8; ++e) { ta[e] = on ? pab[(e + sh) & 7] : pab[e]; tk[e] = on ? pkv[(e + sh) & 7] : pkv[e]; }
#pragma unroll
                for (int e = 0; e < 8; ++e) { pab[e] = ta[e]; pkv[e] = tk[e]; } }
#pragma unroll
            for (int e = 0; e < 8; ++e) { const int o = ((ec + ((e + c) & 7)) * LDB + et) * 2;
                *(LAS bf16*)(L + O_AHT + o) = (bf16)(pab[e] & 0xffffu); *(LAS bf16*)(L + O_BHT + o) = (bf16)(pab[e] >> 16);
                *(LAS bf16*)(L + O_KHT + o) = (bf16)(pkv[e] & 0xffffu); *(LAS bf16*)(L + O_VT + o) = (bf16)(pkv[e] >> 16); } } }
        __syncthreads();
        { if (wave & 1) m2_half<1>(L, wave >> 1, fr, fq); else m2_half<0>(L, wave >> 1, fr, fq); }
        __syncthreads();
        if (ci + 1 < T / CL_ / 2) { const int c0n = (d == 0) ? c0 + CL_ : c0 - CL_; load_raw(raw, PRW, VFIRST, b, (d == 0) ? c0n + et : c0n + 63 - et, hc, ec, d, l, (tid & 7) < 4); }
        { blk_stage<false, true, false>(L + O_XA, L + O_XAT, nullptr, nullptr, nullptr, L + O_AH, L + O_KH, wave, fr, fq); }
        __syncthreads();
        { blk_stage<true, true, false>(L + O_AH, L + O_KH, L + O_UT, L + O_BH, nullptr, L + O_XA, L + O_XAT, wave, fr, fq); }
        __syncthreads();
        { blk_stage<true, true, false>(L + O_XA, L + O_XAT, L + O_BH, L + O_UT, nullptr, L + O_AH, L + O_KH, wave, fr, fq); }
        __syncthreads();
        { blk_stage<true, true, false>(L + O_AH, L + O_KH, L + O_UT, L + O_BH, nullptr, L + O_XA, L + O_XAT, wave, fr, fq); }
        __syncthreads();
        { blk_stage<true, false, true>(L + O_XA, L + O_XAT, L + O_BH, L + O_TB, L + O_T0T, nullptr, nullptr, wave, fr, fq); }
        __syncthreads();
        { if (wave < 4) { const int bmt = (wave >> 1) & 1, bnt = wave & 1;
            bf16x8 a0 = ldfrag(L + O_XA, LDB, 32, 0, fr, fq), a1 = ldfrag(L + O_XA, LDB, 48, 0, fr, fq), t1b = ldfrag(L + O_T0T, LDB, 16 * bnt, 0, fr, fq), t22 = ldfrag(L + O_TB, LDB, 32 + 16 * bmt, 32, fr, fq);
            const f32x4 z4 = (f32x4){0.f, 0.f, 0.f, 0.f};
            const f32x4 w0 = MFMA16(a0, t1b, z4), w1 = MFMA16(a1, t1b, z4);
            st_tile_bf16_T(L + O_WT, LDB, 0, 16 * bnt, fr, fq, w0); st_tile_bf16_T(L + O_WT, LDB, 16, 16 * bnt, fr, fq, w1);
            LDS_WAIT();
            const bf16x8 wb = ldfrag(L + O_WT, LDB, 16 * bnt, 0, fr, fq);
            const f32x4 t21 = MFMA16(t22, wb, z4);
            st_tile_bf16(L + O_TB, LDB, 32 + 16 * bmt, 16 * bnt, fr, fq, t21);
        } else { const int bmt = (wave >> 1) & 1, bnt = wave & 1;
            unsigned zz_ = 0u; asm volatile("" : "+v"(zz_)); *(LAS v2u*)(L + O_TB + ((16 * bmt + fr) * LDB + 32 + 16 * bnt + 4 * fq) * 2) = (v2u){zz_, zz_}; } }
        f32x4 y0[2] = {(f32x4){0.f, 0.f, 0.f, 0.f}, (f32x4){0.f, 0.f, 0.f, 0.f}}, g0[2] = {y0[0], y0[0]};
        { f32x4 m1[2] = {(f32x4){0.f, 0.f, 0.f, 0.f}, (f32x4){0.f, 0.f, 0.f, 0.f}};
          bf16x8 aak[2], ark[2], vta[2], vtb[2][2], khb[2][2];
          ldA(aak, L + O_AAK, mt, fr, fq); ldB(vtb, L + O_VT, nt0, fr, fq); ldA(ark, L + O_ARK, mt, fr, fq); ldA(vta, L + O_VT, mt, fr, fq); ldB(khb, L + O_KHT, nt0, fr, fq);
          CFENCE();
          mmac(aak, vtb, m1); mmacT(ark, vtb, y0); mmac(vta, khb, g0);
#pragma unroll
          for (int j = 0; j < 2; ++j) st_tile_bf16_T(L + O_M1T, LDB, 16 * mt, 16 * (nt0 + j), fr, fq, m1[j]); }
        __syncthreads();
        f32x4 u0[2] = {(f32x4){0.f, 0.f, 0.f, 0.f}, (f32x4){0.f, 0.f, 0.f, 0.f}};
        { f32x4 ap[2] = {u0[0], u0[0]};
          bf16x8 tba[2], ahb[2][2], m1b[2][2];
          ldA(tba, L + O_TB, mt, fr, fq); ldB(ahb, L + O_AHT, nt0, fr, fq); ldB(m1b, L + O_M1T, nt0, fr, fq);
          CFENCE();
          mmac(tba, ahb, ap); mmac(tba, m1b, u0);
#pragma unroll
          for (int j = 0; j < 2; ++j) st_tile_bf16(L + O_APB, LDB, 16 * mt, 16 * (nt0 + j), fr, fq, ap[j]);
          if (seg) {
#pragma unroll
              for (int j = 0; j < 2; ++j) st_tile_bf16(L + O_VT, LDB, 16 * mt, 16 * (nt0 + j), fr, fq, Ph[j]); } }
        __syncthreads();
        { bf16x8 apa[2], s0b[2][2], phb[2][2];
          ldA(apa, L + O_APB, mt, fr, fq); ldB(s0b, L + O_S0B, nt0, fr, fq); phb[0][0] = ZFRAG; phb[0][1] = ZFRAG; phb[1][0] = ZFRAG; phb[1][1] = ZFRAG; if (seg) ldB(phb, L + O_VT, nt0, fr, fq);
          CFENCE();
          mmac(apa, s0b, u0);
#pragma unroll
          for (int j = 0; j < 2; ++j) st_tile_bf16_T(L + O_UT, LDB, 16 * mt, 16 * (nt0 + j), fr, fq, u0[j]);
          if (seg) { f32x4 up[2] = {(f32x4){0.f, 0.f, 0.f, 0.f}, (f32x4){0.f, 0.f, 0.f, 0.f}};
              mmac(apa, phb, up);
#pragma unroll
              for (int j = 0; j < 2; ++j) st_tile_bf16_T(L + O_KHT, LDB, 16 * mt, 16 * (nt0 + j), fr, fq, up[j]); } }
        __syncthreads();
        { bf16x8 rha[2], arba[2], uta[2], s0b[2][2], utb[2][2], bhb[2][2]; float plv[2];
          ldA(rha, L + O_RH, mt, fr, fq); ldB(s0b, L + O_S0B, nt0, fr, fq); ldA(arba, L + O_ARB, mt, fr, fq); ldB(utb, L + O_UT, nt0, fr, fq);
#pragma unroll
          for (int j = 0; j < 2; ++j) plv[j] = *(LAS float*)(L + O_PL + (16 * (nt0 + j) + fr) * 4);
          CFENCE();
          mmacT(rha, s0b, y0);
          ldA(uta, L + O_UT, mt, fr, fq); ldB(bhb, L + O_BHT, nt0, fr, fq);
          CFENCE();
          mmacT(arba, utb, y0);
          { const int s = 16 * mt + fr; const int tk = (d == 0) ? c0 + s : c0 + 63 - s;
#pragma unroll
            for (int j = 0; j < 2; ++j) { v2u o; o.x = pk2(y0[j][0], y0[j][1]); o.y = pk2(y0[j][2], y0[j][3]); *(v2u*)(YS + ((size_t)b * T + tk) * CH + hc + 16 * (nt0 + j) + 4 * fq) = o; } }
          f32x4 sn[2] = {g0[0], g0[1]};
          mmac(uta, bhb, sn);
#pragma unroll
          for (int j = 0; j < 2; ++j) S[j] = (S[j] + sn[j]) * plv[j];
          if (seg) { f32x4 yp[2] = {(f32x4){0.f, 0.f, 0.f, 0.f}, (f32x4){0.f, 0.f, 0.f, 0.f}}, pn[2] = {yp[0], yp[0]};
              bf16x8 rh2[2], arb2[2], kha[2], phb[2][2], khb[2][2], bh2[2][2];
              ldA(rh2, L + O_RH, mt, fr, fq); ldB(phb, L + O_VT, nt0, fr, fq); ldA(arb2, L + O_ARB, mt, fr, fq); ldB(khb, L + O_KHT, nt0, fr, fq); ldA(kha, L + O_KHT, mt, fr, fq); ldB(bh2, L + O_BHT, nt0, fr, fq);
              CFENCE();
              mmacT(rh2, phb, yp);
              mmacT(arb2, khb, yp);
              { const int s = 16 * mt + fr; const int tk = (d == 0) ? c0 + s : c0 + 63 - s;
#pragma unroll
                for (int j = 0; j < 2; ++j) { v2u o; o.x = pk2(yp[j][0], yp[j][1]); o.y = pk2(yp[j][2], yp[j][3]); *(v2u*)(YPHI + (size_t)(tk & (T / 2 - 1)) * 64 + 16 * (nt0 + j) + 4 * fq) = o; } }
              mmac(kha, bh2, pn);
#pragma unroll
              for (int j = 0; j < 2; ++j) Ph[j] = (Ph[j] + pn[j]) * plv[j]; } }
        __syncthreads();
#pragma unroll
        for (int j = 0; j < 2; ++j) st_tile_bf16(L + O_S0B, LDB, 16 * mt, 16 * (nt0 + j), fr, fq, S[j]);
    }
    if (seg == 0) { float* SF = (float*)(F.ws + WS_SFIN) + (size_t)chain * 4096;
        int t2 = (int)__builtin_amdgcn_mbcnt_hi(~0u, __builtin_amdgcn_mbcnt_lo(~0u, 0u)); asm volatile("" : "+v"(t2)); const int fr2 = t2 & 15, fq2 = (t2 >> 4) & 3;
#pragma unroll
        for (int j = 0; j < 2; ++j)
#pragma unroll
            for (int jj = 0; jj < 4; ++jj) SF[(16 * mt + 4 * fq2 + jj) * 64 + 16 * (nt0 + j) + fr2] = S[j][jj]; }
    __syncthreads();
}


__device__ __forceinline__ void tr_item(const float* W, int ld, int col0, int nblk, int K, bf16* WT, int row_off, LAS float* scr, int item, int lane, const float* gain = nullptr) {
    const int kb = item / nblk, nb = item % nblk, k0 = 64 * kb, n0 = 32 * nb;
    float wv[32];
#pragma unroll
    for (int i = 0; i < 32; ++i) wv[i] = W[(size_t)(k0 + 2 * i + (lane >> 5)) * ld + col0 + n0 + (lane & 31)];
    if (gain) {
#pragma unroll
        for (int i = 0; i < 32; ++i) wv[i] *= gain[k0 + 2 * i + (lane >> 5)]; }
#pragma unroll
    for (int i = 0; i < 32; ++i) scr[(2 * i + (lane >> 5)) * 33 + (lane & 31)] = wv[i];
    LDS_WAIT(); asm volatile("" ::: "memory");
    const int c = lane & 7;
#pragma unroll
    for (int j = 0; j < 4; ++j) { const int n = (lane >> 3) + 8 * j; const LAS float* s = scr + (8 * c) * 33 + n;
        v4u o; o.x = pk2(s[0 * 33], s[1 * 33]); o.y = pk2(s[2 * 33], s[3 * 33]); o.z = pk2(s[4 * 33], s[5 * 33]); o.w = pk2(s[6 * 33], s[7 * 33]);
        *(v4u*)(WT + (size_t)(row_off + n0 + n) * K + k0 + 8 * c) = o; }
    LDS_WAIT(); asm volatile("" ::: "memory");
}
__device__ __forceinline__ void wq_max_item(const float* W, int ld, int col0, int nblk, unsigned* cmax, int item, int lane) {
    const int kb = item / nblk, nb = item % nblk, k0 = 64 * kb, n0 = 32 * nb; float am = 0.f;
#pragma unroll
    for (int i = 0; i < 32; ++i) am = fmaxf(am, fabsf(W[(size_t)(k0 + 2 * i + (lane >> 5)) * ld + col0 + n0 + (lane & 31)]));
    am = fmaxf(am, __shfl_xor(am, 32));
    if (lane < 32) atomicMax(cmax + n0 + lane, __float_as_uint(am));
}
__device__ __forceinline__ void wq_item(const float* W, int ld, int col0, int nblk, const unsigned* cmax, float* csc, unsigned char* WQ, int row_off, LAS float* scr, int item, int lane) {
    const int kb = item / nblk, nb = item % nblk, k0 = 64 * kb, n0 = 32 * nb;
    float wv[32];
#pragma unroll
    for (int i = 0; i < 32; ++i) wv[i] = W[(size_t)(k0 + 2 * i + (lane >> 5)) * ld + col0 + n0 + (lane & 31)];
#pragma unroll
    for (int i = 0; i < 32; ++i) scr[(2 * i + (lane >> 5)) * 33 + (lane & 31)] = wv[i];
    LDS_WAIT(); asm volatile("" ::: "memory");
    const int c = lane & 7;
#pragma unroll
    for (int j = 0; j < 4; ++j) { const int n = (lane >> 3) + 8 * j; const LAS float* sp = scr + (8 * c) * 33 + n;
        const float cm = __uint_as_float(cmax[n0 + n]), inv = cm > 0.f ? 127.0f / cm : 0.f;
        v2u o; o.x = q4(sp[0 * 33] * inv, sp[1 * 33] * inv, sp[2 * 33] * inv, sp[3 * 33] * inv); o.y = q4(sp[4 * 33] * inv, sp[5 * 33] * inv, sp[6 * 33] * inv, sp[7 * 33] * inv);
        *(v2u*)(WQ + (size_t)(row_off + n0 + n) * D + k0 + 8 * c) = o;
        if (kb == 0 && c == 0) csc[n0 + n] = cm * (1.0f / 127.0f); }
    LDS_WAIT(); asm volatile("" ::: "memory");
}
__device__ __forceinline__ void p_convert(Frame& F) {
    PHASE_TID();
    LAS float* scr = (LAS float*)(F.lds + wave * 16384);
    const int gw = bid * NWAVES + wave, NGW = F.G * NWAVES;
    constexpr int C_HY = 16 * 48, C_RW = 16 * 60, C_V1 = 16, C_O = 16 * 32, C_1 = 16 * 128, C_2 = 64 * 32, C_L = C_HY + C_RW + C_V1 + C_O + C_1 + C_2;
    for (int it = gw; it < NL * C_L; it += NGW) {
        const int l = it / C_L; int r = it % C_L;
        unsigned char* wb = F.ws + WS_W + (size_t)l * W_LAYER;
        const float* win = F.in[I_WIN] + (size_t)l * D * PIN;
        unsigned* cmax = F.ctl + CW_CMAX + l * (HYP + NRW);
        if (r < C_HY) { wq_max_item(win, PIN, 0, 48, cmax, r, lane); continue; } r -= C_HY;
        if (r < C_RW) { wq_max_item(win, PIN, HYP, 60, cmax + HYP, r, lane); continue; } r -= C_RW;
        if (r < C_V1) { if (l == 1) wq_max_item(F.in[I_V1], 32, 0, 1, cmax + HYP + RWP, r, lane); continue; } r -= C_V1;
        if (r < C_O) { tr_item(F.in[I_WOUT] + (size_t)l * D * D, D, 0, 32, D, (bf16*)(wb + W_O), 0, scr, r, lane); continue; } r -= C_O;
        if (r < C_1) { tr_item(F.in[I_MW1] + (size_t)l * D * FF, FF, 0, 128, D, (bf16*)(wb + W_1), 0, scr, r, lane, F.in[I_N2G] + (size_t)l * D); continue; } r -= C_1;
        tr_item(F.in[I_MW2] + (size_t)l * FF * D, D, 0, 32, FF, (bf16*)(wb + W_2), 0, scr, r, lane);
    }
}
__device__ __forceinline__ void p_wquant(Frame& F) {
    PHASE_TID();
    LAS float* scr = (LAS float*)(F.lds + wave * 16384);
    const int gw = bid * NWAVES + wave, NGW = F.G * NWAVES;
    constexpr int C_HY = 16 * 48, C_RW = 16 * 60, C_V1 = 16, C_L = C_HY + C_RW + C_V1;
    for (int it = gw; it < NL * C_L; it += NGW) {
        const int l = it / C_L; int r = it % C_L;
        unsigned char* wb = F.ws + WS_W + (size_t)l * W_LAYER;
        const float* win = F.in[I_WIN] + (size_t)l * D * PIN;
        const unsigned* cmax = F.ctl + CW_CMAX + l * (HYP + NRW); float* csc = (float*)(F.ws + WS_CSC) + l * (HYP + NRW);
        if (r < C_HY) { wq_item(win, PIN, 0, 48, cmax, csc, wb + W_HY, 0, scr, r, lane); continue; } r -= C_HY;
        if (r < C_RW) { wq_item(win, PIN, HYP, 60, cmax + HYP, csc + HYP, wb + W_RW, 0, scr, r, lane); continue; } r -= C_RW;
        if (l == 1) wq_item(F.in[I_V1], 32, 0, 1, cmax + HYP + RWP, csc + HYP + RWP, wb + W_RW, RWP, scr, r, lane);
    }
    for (int l = 0; l < NL; ++l) {
        const int r0 = (l == 0) ? RWP : RWP + 32; const int n16 = (NRW - r0) * D / 16;
        v4u* p = (v4u*)(F.ws + WS_W + (size_t)l * W_LAYER + W_RW + (size_t)r0 * D);
        for (int i = bid * NTHR + tid; i < n16; i += F.G * NTHR) p[i] = (v4u){0u, 0u, 0u, 0u};
        float* csc = (float*)(F.ws + WS_CSC) + l * (HYP + NRW) + HYP;
        if (bid == 0 && tid < NRW - r0) csc[r0 + tid] = 0.f;
    }
}

__device__ __forceinline__ void p_filter_item(Frame& F, int l, int item) {
    LAS float* Z = (LAS float*)F.lds;
    LAS float* H1 = Z + 32 * 36;
    LAS float* H2 = H1 + 32 * 64;
    LAS float* H3 = H2 + 32 * 64;
    PHASE_TID(); const int pos0 = item * 32;
    const float* w1 = F.in[I_FW1] + l * 33 * 64; const float* b1 = F.in[I_FB1] + l * 64;
    const float* w2 = F.in[I_FW2] + l * 64 * 64; const float* b2 = F.in[I_FB2] + l * 64;
    const float* w3 = F.in[I_FW3] + l * 64 * 64; const float* b3 = F.in[I_FB3] + l * 64;
    const float* fq = F.in[I_FFREQ] + l * 3 * 64;
    __syncthreads();
    for (int e = tid; e < 32 * 33; e += NTHR) {
        const int p = e / 33, f = e % 33, pos = pos0 + p; float v;
        if (f == 0) v = (float)pos / (float)(T - 1);
        else { const int band = (f - 1) & 15; const float fr = 1e-4f + (float)band * ((15.0f - 1e-4f) / 15.0f);
            float x = (float)pos * fr * (1.0f / (float)T); x -= floorf(x);
            v = (f <= 16) ? __builtin_amdgcn_cosf(x) : -__builtin_amdgcn_sinf(x); }
        Z[p * 36 + f] = v;
    }
    __syncthreads();
    const int j = tid & 63, pb = tid >> 6;
    { float wc[33];
#pragma unroll
      for (int f = 0; f < 33; ++f) wc[f] = w1[f * 64 + j];
      const float bj = b1[j], fj = fq[j];
#pragma unroll
      for (int i = 0; i < 4; ++i) { const int p = pb + 8 * i; float s = bj;
#pragma unroll
          for (int f = 0; f < 33; ++f) s += Z[p * 36 + f] * wc[f];
          H1[p * 64 + j] = sin_hw(fj * s); } }
    __syncthreads();
#pragma unroll 1
    for (int ly = 0; ly < 2; ++ly) { const float* w = ly ? w3 : w2; const float* bb = ly ? b3 : b2; const LAS float* Hi = ly ? H2 : H1; LAS float* Ho = ly ? H3 : H2;
        float wc[64];
#pragma unroll
        for (int f = 0; f < 64; ++f) wc[f] = w[f * 64 + j];
        const float bj = bb[j], fj = fq[64 + 64 * ly + j];
#pragma unroll
        for (int i = 0; i < 4; ++i) { const int p = pb + 8 * i; float s = bj;
#pragma unroll
            for (int q = 0; q < 16; ++q) { const f32x4 h = *(const LAS f32x4*)(Hi + p * 64 + 4 * q); s += (h[0] * wc[4 * q] + h[1] * wc[4 * q + 1]) + (h[2] * wc[4 * q + 2] + h[3] * wc[4 * q + 3]); }
            Ho[p * 64 + j] = sin_hw(fj * s); }
        __syncthreads(); }
    const int fr = lane & 15, fqd = lane >> 4;
    bf16x8 af[2][2];
#pragma unroll
    for (int mt = 0; mt < 2; ++mt)
#pragma unroll
        for (int ks = 0; ks < 2; ++ks) { const LAS float* hp = H3 + (16 * mt + fr) * 64 + 32 * ks + 8 * fqd; const f32x4 h0 = *(const LAS f32x4*)hp, h1 = *(const LAS f32x4*)(hp + 4);
            const float hv[8] = {h0[0], h0[1], h0[2], h0[3], h1[0], h1[1], h1[2], h1[3]}; af[mt][ks] = __builtin_bit_cast(bf16x8, pack8(hv)); }
    const float* wo = F.in[I_FWOUT] + (size_t)l * 64 * 2048;
    float* HF = (float*)(F.ws + WS_HF);
#pragma unroll 1
    for (int tb = 0; tb < 16; tb += 4) {
        bf16x8 bfr[4][2];
#pragma unroll
        for (int u = 0; u < 4; ++u)
#pragma unroll
            for (int ks = 0; ks < 2; ++ks) { float v[8]; const float* wp = wo + (size_t)(32 * ks + 8 * fqd) * 2048 + 256 * wave + 16 * (tb + u) + fr;
#pragma unroll
                for (int e = 0; e < 8; ++e) v[e] = wp[(size_t)e * 2048];
                bfr[u][ks] = __builtin_bit_cast(bf16x8, pack8(v)); }
#pragma unroll
        for (int u = 0; u < 4; ++u) { const int col = 256 * wave + 16 * (tb + u) + fr, c = col & 511;
            const float delta = 3.0701134573f + (float)c * ((15.350567286f - 3.0701134573f) / 511.0f);
#pragma unroll
            for (int mt = 0; mt < 2; ++mt) { f32x4 acc = (f32x4){0.f, 0.f, 0.f, 0.f};
                acc = MFMA16(af[mt][0], bfr[u][0], acc); acc = MFMA16(af[mt][1], bfr[u][1], acc);
                f32x4 o;
#pragma unroll
                for (int jj = 0; jj < 4; ++jj) { const float t = (float)(pos0 + 16 * mt + 4 * fqd + jj) / (float)(T - 1); o[jj] = acc[jj] * __expf(-t * delta); }
                *(f32x4*)(HF + (size_t)col * T + pos0 + 16 * mt + 4 * fqd) = o; } } }
}
__device__ __forceinline__ void p_filter(Frame& F, int l) { PHASE_TID(); (void)tid; for (int it = bid; it < T / 32; it += F.G) p_filter_item(F, l, it); __syncthreads(); }

template <bool F32IN> __device__ __forceinline__ void p_rmsnorm_q(Frame& F, const void* xin, const float* g, unsigned char* HQ, float* RSC, int m0, int m1) {
    PHASE_TID();
    const int gw = bid * NWAVES + wave, NGW = F.G * NWAVES;
    constexpr int R = F32IN ? 2 : 4;
    f32x4 gv[4];
#pragma unroll
    for (int j = 0; j < 4; ++j) gv[j] = F32IN ? *(const f32x4*)(g + 4 * lane + 256 * j) : *(const f32x4*)(g + 16 * lane + 4 * j);
    for (int mb = m0 + gw; mb < m1; mb += R * NGW) {
        f32x4 xf[F32IN ? R : 1][4]; v4u xw[F32IN ? 1 : R][2];
#pragma unroll
        for (int r = 0; r < R; ++r) { const int m = mb + r * NGW;
            if (F32IN) { const f32x4* xr = (const f32x4*)((const float*)xin + (size_t)m * D) + lane;
#pragma unroll
                for (int j = 0; j < 4; ++j) xf[r][j] = xr[64 * j]; }
            else { const v4u* xr = (const v4u*)((const bf16*)xin + (size_t)m * D + 16 * lane); xw[r][0] = xr[0]; xw[r][1] = xr[1]; } }
        asm volatile("" ::: "memory");
#pragma unroll
        for (int r = 0; r < R; ++r) { const int m = mb + r * NGW;
            f32x4 v[4]; float s = 0.f;
            if (F32IN) {
#pragma unroll
                for (int j = 0; j < 4; ++j) v[j] = xf[r][j]; }
            else { const unsigned ww[8] = {xw[r][0].x, xw[r][0].y, xw[r][0].z, xw[r][0].w, xw[r][1].x, xw[r][1].y, xw[r][1].z, xw[r][1].w};
#pragma unroll
                for (int j = 0; j < 4; ++j) v[j] = (f32x4){bflo(ww[2 * j]), bfhi(ww[2 * j]), bflo(ww[2 * j + 1]), bfhi(ww[2 * j + 1])}; }
#pragma unroll
            for (int j = 0; j < 4; ++j) s += (v[j].x * v[j].x + v[j].y * v[j].y) + (v[j].z * v[j].z + v[j].w * v[j].w);
            const float rstd = 1.0f / sqrtf(wave_sum(s) * (1.0f / D) + RMS_EPS);
            float am = 0.f;
#pragma unroll
            for (int j = 0; j < 4; ++j) { v[j] = v[j] * rstd * gv[j]; am = fmaxf(fmaxf(am, fmaxf(fabsf(v[j].x), fabsf(v[j].y))), fmaxf(fabsf(v[j].z), fabsf(v[j].w))); }
            am = wave_max(am);
            const float inv = am > 0.f ? 127.0f / am : 0.f;
            unsigned qd[4];
#pragma unroll
            for (int j = 0; j < 4; ++j) qd[j] = q4(v[j].x * inv, v[j].y * inv, v[j].z * inv, v[j].w * inv);
            if (F32IN) {
#pragma unroll
                for (int j = 0; j < 4; ++j) *(unsigned*)(HQ + (size_t)m * D + 256 * j + 4 * lane) = qd[j]; }
            else *(v4u*)(HQ + (size_t)m * D + 16 * lane) = (v4u){qd[0], qd[1], qd[2], qd[3]};
            if (lane == 0) RSC[m] = am * (1.0f / 127.0f); }
    }
}
__device__ __forceinline__ void p_rmsnorm_b16(Frame& F, const bf16* x, const float* g, bf16* out, int m0, int m1) {
    PHASE_TID();
    const int gw = bid * NWAVES + wave, NGW = F.G * NWAVES;
    f32x4 gv[4];
#pragma unroll
    for (int j = 0; j < 4; ++j) gv[j] = *(const f32x4*)(g + 16 * lane + 4 * j);
    for (int m = m0 + gw; m < m1; m += NGW) {
        const v4u* xr = (const v4u*)(x + (size_t)m * D + 16 * lane); const v4u w0 = xr[0], w1 = xr[1];
        const unsigned ww[8] = {w0.x, w0.y, w0.z, w0.w, w1.x, w1.y, w1.z, w1.w}; f32x4 v[4]; float s = 0.f;
#pragma unroll
        for (int j = 0; j < 4; ++j) { v[j] = (f32x4){bflo(ww[2 * j]), bfhi(ww[2 * j]), bflo(ww[2 * j + 1]), bfhi(ww[2 * j + 1])}; s += (v[j].x * v[j].x + v[j].y * v[j].y) + (v[j].z * v[j].z + v[j].w * v[j].w); }
        const float rstd = 1.0f / sqrtf(wave_sum(s) * (1.0f / D) + RMS_EPS);
        v4u o[2];
#pragma unroll
        for (int j = 0; j < 2; ++j) { const f32x4 ya = v[2 * j] * rstd * gv[2 * j], yb = v[2 * j + 1] * rstd * gv[2 * j + 1]; o[j].x = pk2(ya.x, ya.y); o[j].y = pk2(ya.z, ya.w); o[j].z = pk2(yb.x, yb.y); o[j].w = pk2(yb.z, yb.w); }
        v4u* op = (v4u*)(out + (size_t)m * D + 16 * lane); op[0] = o[0]; op[1] = o[1];
    }
}
__device__ __forceinline__ void p_finalnorm(Frame& F, const bf16* x, const float* g, float* out) {
    PHASE_TID();
    const int gw = bid * NWAVES + wave, NGW = F.G * NWAVES;
    constexpr int R = 4;
    f32x4 gv[4];
#pragma unroll
    for (int j = 0; j < 4; ++j) gv[j] = *(const f32x4*)(g + 4 * lane + 256 * j);
    for (int mb = gw; mb < M; mb += R * NGW) {
        v2u xw[R][4];
#pragma unroll
        for (int r = 0; r < R; ++r) { const v2u* xr = (const v2u*)(x + (size_t)(mb + r * NGW) * D) + lane;
#pragma unroll
            for (int j = 0; j < 4; ++j) xw[r][j] = xr[64 * j]; }
        asm volatile("" ::: "memory");
#pragma unroll
        for (int r = 0; r < R; ++r) { f32x4 v[4]; float s = 0.f;
#pragma unroll
            for (int j = 0; j < 4; ++j) { v[j] = (f32x4){bflo(xw[r][j].x), bfhi(xw[r][j].x), bflo(xw[r][j].y), bfhi(xw[r][j].y)}; s += (v[j].x * v[j].x + v[j].y * v[j].y) + (v[j].z * v[j].z + v[j].w * v[j].w); }
            const float rstd = 1.0f / sqrtf(wave_sum(s) * (1.0f / D) + RMS_EPS);
            f32x4* o = (f32x4*)(out + (size_t)(mb + r * NGW) * D) + lane;
#pragma unroll
            for (int j = 0; j < 4; ++j) o[64 * j] = v[j] * rstd * gv[j]; }
    }
}
template <bool F32OUT> __device__ __forceinline__ void p_rmsnorm(Frame& F, const float* x, const float* g, void* outp, int m0, int m1) {
    PHASE_TID();
    const int gw = bid * NWAVES + wave, NGW = F.G * NWAVES;
    f32x4 gv[4];
#pragma unroll
    for (int j = 0; j < 4; ++j) gv[j] = *(const f32x4*)(g + 4 * lane + 256 * j);
    for (int m = m0 + gw; m < m1; m += NGW) {
        const f32x4* xr = (const f32x4*)(x + (size_t)m * D) + lane; f32x4 v[4]; float s = 0.f;
#pragma unroll
        for (int j = 0; j < 4; ++j) { v[j] = xr[64 * j]; s += (v[j].x * v[j].x + v[j].y * v[j].y) + (v[j].z * v[j].z + v[j].w * v[j].w); }
        const float rstd = 1.0f / sqrtf(wave_sum(s) * (1.0f / D) + RMS_EPS);
        if (F32OUT) { f32x4* o = (f32x4*)((float*)outp + (size_t)m * D) + lane;
#pragma unroll
            for (int j = 0; j < 4; ++j) o[64 * j] = v[j] * rstd * gv[j]; }
        else { v2u* o = (v2u*)((bf16*)outp + (size_t)m * D) + lane;
#pragma unroll
            for (int j = 0; j < 4; ++j) { const f32x4 y = v[j] * rstd * gv[j]; v2u w; w.x = pk2(y.x, y.y); w.y = pk2(y.z, y.w); o[64 * j] = w; } }
    }
}

constexpr int KPAD = 2 * T + 2 * T / 16;

constexpr int LC = 32;

__device__ __forceinline__ void p_mix(Frame& F, int l) {
    PHASE_TID();
#ifndef NO_SCAN
#ifdef SEQ_SCAN
    if (bid < 128) scan_chain(F, l, bid);
#else
    cscan_chain(F, l, bid);
#endif
#endif
    unsigned* head = F.ctl + CW_QUEUE + 64 * l;
    for (;;) {
        __syncthreads();
        if (tid == 0) F.MISC[16] = __hip_atomic_fetch_add(head, 1u, RLX_AGENT);
        __syncthreads();
        const unsigned it = F.MISC[16];
        if (it >= (unsigned)(4 * CH)) break;
        hy_fft_item(F, l, (int)it);
    }
    __syncthreads();
}

__device__ __forceinline__ void p_post(Frame& F, int l) {
    PHASE_TID();
    const int gw = bid * NWAVES + wave, NGW = F.G * NWAVES;
    bf16* YM = (bf16*)(F.ws + WS_YMIX);
    { LAS float* scr = (LAS float*)(F.lds + wave * 16640);
      const bf16* PHT = (const bf16*)(F.ws + WS_PHT); const float* ng = F.in[I_HNG] + (size_t)l * CH;
      for (int it = gw; it < NB * 8 * (T / 64); it += NGW) { const int tb = it & 127, g = (it >> 7) & 7, b = it >> 10, t0 = tb * 64;
          const bf16* src = PHT + ((size_t)b * HYP + CH + g * 64 + lane) * T + t0;
#pragma unroll
          for (int q = 0; q < 8; ++q) { const v4u w = *(const v4u*)(src + 8 * q); LAS float* d = scr + lane * 65 + 8 * q;
              d[0] = bflo(w.x); d[1] = bfhi(w.x); d[2] = bflo(w.y); d[3] = bfhi(w.y); d[4] = bflo(w.z); d[5] = bfhi(w.z); d[6] = bflo(w.w); d[7] = bfhi(w.w); }
          LDS_WAIT(); asm volatile("" ::: "memory");
          float z[64], ss = 0.f;
#pragma unroll
          for (int cc = 0; cc < 64; ++cc) { z[cc] = scr[cc * 65 + lane]; ss += z[cc] * z[cc]; }
          const float rs = 1.0f / sqrtf(ss * (1.0f / 64.0f) + RMS_EPS);
          bf16* dst = YM + ((size_t)b * T + t0 + lane) * D + g * 64;
#pragma unroll
          for (int q = 0; q < 8; ++q) { v4u o; const float* gq = ng + g * 64 + 8 * q;
              o.x = pk2(z[8 * q] * rs * gq[0], z[8 * q + 1] * rs * gq[1]); o.y = pk2(z[8 * q + 2] * rs * gq[2], z[8 * q + 3] * rs * gq[3]);
              o.z = pk2(z[8 * q + 4] * rs * gq[4], z[8 * q + 5] * rs * gq[5]); o.w = pk2(z[8 * q + 6] * rs * gq[6], z[8 * q + 7] * rs * gq[7]);
              *(v4u*)(dst + 8 * q) = o; }
          LDS_WAIT(); asm volatile("" ::: "memory"); } }
}

struct PostRows { v4u a, c, v, g; float bs; };
__device__ __forceinline__ void post_rows_load(PostRows& R, const bf16* YS0, const bf16* YS1, const bf16* VV, const bf16* GG, const float* BS0, const float* BS1, size_t m, int h, int ec) {
    const size_t o = m * CH + h * HD + ec;
    R.a = *(const v4u*)(YS0 + o); R.c = *(const v4u*)(YS1 + o); R.v = *(const v4u*)(VV + o); R.g = *(const v4u*)(GG + o); R.bs = BS0[m * NH + h] + BS1[m * NH + h];
}
__device__ __forceinline__ void p_postfix(Frame& F, int l) {
    PHASE_TID(); const int fr = lane & 15, fq = lane >> 4, mtw = wave >> 1, ntw = 2 * (wave & 1), et = tid >> 3, ec = (tid & 7) * 8;
    const int bh = bid >> 2, b = bh >> 3, h = bh & 7, tq = bid & 3, dfix = (tq >= 2) ? 0 : 1, chain = (b * NH + h) * 2 + dfix;
    const float* SF = (const float*)(F.ws + WS_SFIN) + (size_t)chain * 4096;
    bf16x8 sfb[2][2];
#pragma unroll
    for (int ks = 0; ks < 2; ++ks)
#pragma unroll
        for (int j = 0; j < 2; ++j) { const float* sp = SF + (16 * (ntw + j) + fr) * 64 + 32 * ks + 8 * fq; const f32x4 s0 = *(const f32x4*)sp, s1 = *(const f32x4*)(sp + 4);
            const float sv[8] = {s0[0], s0[1], s0[2], s0[3], s1[0], s1[1], s1[2], s1[3]}; sfb[ks][j] = __builtin_bit_cast(bf16x8, pack8(sv)); }
    const bf16* YP = (const bf16*)(F.ws + WS_YPHI) + ((size_t)chain * (T / 2) + 16 * mtw + fr) * 64 + 8 * fq;
    const bf16* YS0 = (const bf16*)(F.ws + WS_YS); const bf16* YS1 = YS0 + (size_t)M * CH;
    const bf16* VV = (l == 0) ? (const bf16*)(F.ws + WS_VFIRST) : (const bf16*)(F.ws + WS_V2);
    const bf16* GG = (const bf16*)(F.ws + WS_G); const float* BS0 = (const float*)(F.ws + WS_BS); const float* BS1 = BS0 + (size_t)M * NH;
    bf16* YM = (bf16*)(F.ws + WS_YMIX);
    float lg[8], lb[8];
#pragma unroll
    for (int j = 0; j < 8; ++j) { lg[j] = F.in[I_LNG][l * CH + h * HD + ec + j]; lb[j] = F.in[I_LNB][l * CH + h * HD + ec + j]; }
    LAS float* FX = (LAS float*)F.lds;
    const size_t mb = (size_t)b * T + 64 * (32 * tq) + et;
    __syncthreads();
    PostRows cur; bf16x8 acur[2];
    post_rows_load(cur, YS0, YS1, VV, GG, BS0, BS1, mb, h, ec);
#pragma unroll
    for (int ks = 0; ks < 2; ++ks) acur[ks] = *(const bf16x8*)(YP + (size_t)((32 * tq) & 63) * 64 * 64 + 32 * ks);
#pragma unroll 1
    for (int t = 0; t < 32; ++t) {
        PostRows nxt; bf16x8 anxt[2]; const int tn = (t + 1 < 32) ? t + 1 : t;
        post_rows_load(nxt, YS0, YS1, VV, GG, BS0, BS1, mb + 64 * tn, h, ec);
#pragma unroll
        for (int ks = 0; ks < 2; ++ks) anxt[ks] = *(const bf16x8*)(YP + (size_t)((32 * tq + tn) & 63) * 64 * 64 + 32 * ks);
        { f32x4 acc[2] = {(f32x4){0.f, 0.f, 0.f, 0.f}, (f32x4){0.f, 0.f, 0.f, 0.f}};
#pragma unroll
          for (int ks = 0; ks < 2; ++ks)
#pragma unroll
              for (int j = 0; j < 2; ++j) acc[j] = MFMA16(sfb[ks][j], acur[ks], acc[j]);
          LAS float* fx = FX + (t & 1) * 64 * 68 + (16 * mtw + fr) * 68 + 16 * ntw + 4 * fq;
          *(LAS f32x4*)fx = acc[0]; *(LAS f32x4*)(fx + 16) = acc[1]; }
        __syncthreads();
        { const LAS float* fx = FX + (t & 1) * 64 * 68 + et * 68 + ec; const f32x4 f0 = *(const LAS f32x4*)fx, f1 = *(const LAS f32x4*)(fx + 4);
          const float fv[8] = {f0[0], f0[1], f0[2], f0[3], f1[0], f1[1], f1[2], f1[3]};
          const unsigned aw[4] = {cur.a.x, cur.a.y, cur.a.z, cur.a.w}, cw[4] = {cur.c.x, cur.c.y, cur.c.z, cur.c.w}, vx[4] = {cur.v.x, cur.v.y, cur.v.z, cur.v.w}, gx[4] = {cur.g.x, cur.g.y, cur.g.z, cur.g.w};
          float sv[8], sum = 0.f;
#pragma unroll
          for (int j = 0; j < 4; ++j) { sv[2 * j] = bflo(aw[j]) + bflo(cw[j]) + fv[2 * j]; sv[2 * j + 1] = bfhi(aw[j]) + bfhi(cw[j]) + fv[2 * j + 1]; sum += sv[2 * j] + sv[2 * j + 1]; }
          const float mean = sum8(sum) * (1.0f / 64.0f); float q = 0.f;
#pragma unroll
          for (int j = 0; j < 8; ++j) { sv[j] -= mean; q += sv[j] * sv[j]; }
          const float rs = 1.0f / sqrtf(sum8(q) * (1.0f / 64.0f) + GN_EPS);
          float y[8];
#pragma unroll
          for (int j = 0; j < 4; ++j) { y[2 * j] = (sv[2 * j] * rs * lg[2 * j] + lb[2 * j] + cur.bs * bflo(vx[j])) * bflo(gx[j]);
                                        y[2 * j + 1] = (sv[2 * j + 1] * rs * lg[2 * j + 1] + lb[2 * j + 1] + cur.bs * bfhi(vx[j])) * bfhi(gx[j]); }
          v4u ov; ov.x = pk2(y[0], y[1]); ov.y = pk2(y[2], y[3]); ov.z = pk2(y[4], y[5]); ov.w = pk2(y[6], y[7]);
          *(v4u*)(YM + (mb + 64 * t) * D + CH + h * HD + ec) = ov; }
        cur = nxt; acur[0] = anxt[0]; acur[1] = anxt[1];
    }
    __syncthreads();
}
__device__ __forceinline__ int obid() { int b = blockIdx.x; asm volatile("" : "+s"(b)); return b; }
struct Args { const float* in[34]; float* out; unsigned char* ws; int ph_lo, ph_hi; };
__global__ void __launch_bounds__(NTHR, 2) enc_fwd(Args args) {
    extern __shared__ __attribute__((aligned(16))) unsigned char lds[];
    Frame F;
    F.lds = (LAS unsigned char*)lds;
    F.MISC = (volatile LAS unsigned*)(F.lds + LDSCTL_OFF);
    F.G = gridDim.x;
    F.ws = args.ws; F.out = args.out; F.ctl = (unsigned*)(args.ws + WS_CTL);
    F.in = args.in;
    for (int u = threadIdx.x; u < (LDS_BYTES - LDSCTL_OFF) / 4; u += NTHR) F.MISC[u] = 0u;
    __syncthreads();
    const XcdBarrier bar = xcd_barrier_post(F.ctl + CW_BAR, F.MISC + 8);
#define SEAM() xcd_barrier(bar)

    bf16* HN = (bf16*)(F.ws + WS_HN);
    float* RSS = (float*)(F.ws + WS_RSS);
    unsigned char* HQ = F.ws + WS_HN; float* RSC = (float*)(F.ws + WS_RSC);
    p_convert(F); __syncthreads(); p_filter(F, 0); p_rmsnorm_q<true>(F, F.in[I_X], F.in[I_N1G], HQ, RSC, 0, M / 2);
    SEAM();
    p_wquant(F);
    SEAM();
#pragma unroll 1
    for (int l = 0; l < NL; ++l) {
        unsigned char* wb = F.ws + WS_W + (size_t)l * W_LAYER;
        bf16* X2B = (bf16*)F.out;
        {
#pragma unroll 1
            for (int hf = 0; hf < 2; ++hf) { constexpr int MH = M / 2; const size_t r0 = (size_t)hf * MH;
                if (hf == 0) p_spectra(F);
                const float* CSC = (const float*)(F.ws + WS_CSC) + l * (HYP + NRW);
                { pg8::Gemm g{(const bf16*)(wb + W_HY), (const bf16*)(HQ + r0 * D), HYP, MH, D / 2}; pg8::StaticOrder S; S.init(HYP, MH, F.G, obid());
                  pg8::EpiBf16Q E{(bf16*)(F.ws + WS_PHT) + (size_t)(4 * hf) * HYP * T, (size_t)T, (size_t)HYP * T, 13, CSC, RSC + r0};
                  pg8::gemm_phase<pg8::EpiBf16Q, pg8::StaticOrder, true, true>(F.lds, g, S, E); }
                { pg8::Gemm g{(const bf16*)(HQ + r0 * D), (const bf16*)(wb + W_RW), MH, NRW, D / 2}; pg8::StaticOrder S; S.init(MH, NRW, F.G, obid());
                  pg8::EpiBf16Q E{(bf16*)(F.ws + WS_PRW) + r0 * NRW, (size_t)NRW, 0, 31, RSC + r0, CSC + HYP};
                  pg8::gemm_phase<pg8::EpiBf16Q, pg8::StaticOrder, true, true>(F.lds, g, S, E); }
                if (hf == 0) { if (l == 0) p_rmsnorm_q<true>(F, F.in[I_X], F.in[I_N1G], HQ, RSC, MH, M); else p_rmsnorm_q<false>(F, X2B, F.in[I_N1G] + (size_t)l * D, HQ, RSC, MH, M);
                    SEAM(); } }
        }
        SEAM();
        p_mix(F, l);
        SEAM();
        { p_post(F, l); p_postfix(F, l); }
        SEAM();
        {
            if (l + 1 < NL) p_filter(F, l + 1);
            pg8::Gemm g{(const bf16*)(F.ws + WS_YMIX), (const bf16*)(wb + W_O), M, D, D}; pg8::StaticOrder S; S.init(M, D, F.G, obid());
            if (l == 0) { pg8::EpiRes<1, false> E{F.in[I_X], nullptr, HN, D, RSS}; pg8::gemm_phase<pg8::EpiRes<1, false>, pg8::StaticOrder, true, true>(F.lds, g, S, E); }
            else { pg8::EpiRes<1, true> E{nullptr, X2B, HN, D, RSS}; pg8::gemm_phase<pg8::EpiRes<1, true>, pg8::StaticOrder, true, true>(F.lds, g, S, E); }
        }
        SEAM();
#pragma unroll 1
        for (int ck = 0; ck < MLP_CHUNKS; ++ck) { constexpr int MC = M / MLP_CHUNKS; const size_t r0 = (size_t)ck * MC;
            bf16* HIDc = (bf16*)(F.ws + WS_HID + (size_t)(ck & 1) * MC * FF * 2);
            {
                pg8::Gemm g{HN + r0 * D, (const bf16*)(wb + W_1), MC, FF, D}; pg8::StaticOrder S; S.init(MC, FF, F.G, obid());
                pg8::EpiBf16<1> E{HIDc, (size_t)FF};
                pg8::gemm_phase<pg8::EpiBf16<1>, pg8::StaticOrder, true, true>(F.lds, g, S, E);
            }
            SEAM();
            {
                pg8::Gemm g{HIDc, (const bf16*)(wb + W_2), MC, D, FF}; pg8::StaticOrder S; S.init(MC, D, F.G, obid());
                pg8::EpiRes<2, true> E{nullptr, HN + r0 * D, ((l + 1 < NL) ? X2B : HN) + r0 * D, D, RSS + r0 * 16};
                pg8::gemm_phase<pg8::EpiRes<2, true>, pg8::StaticOrder, true, true>(F.lds, g, S, E);
            }
            if (ck == MLP_CHUNKS - 1 && l + 1 < NL) p_rmsnorm_q<false>(F, X2B, F.in[I_N1G] + (size_t)(l + 1) * D, HQ, RSC, 0, M / 2);
        }
        SEAM();
        if (l + 1 == NL) p_finalnorm(F, HN, F.in[I_FING], F.out);
    }
#undef SEAM
}

extern "C" void kernel_launch(void* const* d_in, const int* in_sizes, int n_in, void* d_out, int out_size, void* d_ws, size_t ws_size, hipStream_t stream) {
    static int grid = 0;
    if (grid == 0) {
        if (n_in != 34 || in_sizes[0] != M * D || out_size != M * D || ws_size < WS_END) {
            fprintf(stderr, "kernel_launch: unexpected problem: n_in %d in0 %d out %d ws %zu (need %zu); nothing launched\n", n_in, n_in > 0 ? in_sizes[0] : -1, out_size, ws_size, (size_t)WS_END); grid = -1; return; }
        int dev = 0, cus = 0, per_cu = 0;
        if (hipGetDevice(&dev) != hipSuccess || hipDeviceGetAttribute(&cus, hipDeviceAttributeMultiprocessorCount, dev) != hipSuccess) { grid = -1; return; }
        if (hipFuncSetAttribute((const void*)enc_fwd, hipFuncAttributeMaxDynamicSharedMemorySize, LDS_BYTES) != hipSuccess) { fprintf(stderr, "kernel_launch: hipFuncSetAttribute failed\n"); grid = -1; return; }
        if (hipOccupancyMaxActiveBlocksPerMultiprocessor(&per_cu, (const void*)enc_fwd, NTHR, LDS_BYTES) != hipSuccess || per_cu < 1)
            fprintf(stderr, "kernel_launch: note: occupancy query reports %d workgroups per CU\n", per_cu);
        (void)hipGetLastError();
        grid = cus;
        if (grid != 256) { fprintf(stderr, "kernel_launch: built for a 256-CU device (got %d); nothing launched\n", cus); grid = -1; return; }
    }
    if (grid < 0) return;
    if (hipMemsetAsync((char*)d_ws + WS_CTL, 0, CTL_ZERO_BYTES, stream) != hipSuccess) return;
    Args a{};
    for (int i = 0; i < 34; ++i) a.in[i] = (const float*)d_in[i];
    a.out = (float*)d_out; a.ws = (unsigned char*)d_ws;
    a.ph_lo = 0; a.ph_hi = 0;
    hipLaunchKernelGGL(enc_fwd, dim3(grid), dim3(NTHR), LDS_BYTES, stream, a);
}
```

```cpp
#include <hip/hip_runtime.h>
#include <cstdio>
#include <cstdint>
namespace pg8 {
#define PG8_LAS __attribute__((address_space(3)))
typedef unsigned short bf16_t;
typedef short bf16x8 __attribute__((ext_vector_type(8)));
typedef float f32x4 __attribute__((ext_vector_type(4)));
typedef int i32x4 __attribute__((ext_vector_type(4)));
template <bool I8> struct AccT { typedef f32x4 t; };
template <> struct AccT<true> { typedef i32x4 t; };
typedef unsigned u32x4 __attribute__((ext_vector_type(4)));
constexpr int BM = 256, BK = 64, HALF = 128, HTB = HALF * BK * 2  , STAGE_BYTES = 8 * HTB, NXCD = 8, WGM = 8;

__host__ __device__ __forceinline__ int lds_byte(int r, int c) { const int st = (r >> 4) * 2 + (c >> 5), rr = r & 15, cc = c & 31, ob = rr * 64 + cc * 2; return st * 1024 + (ob ^ (((ob >> 9) & 1) << 5)); }
__host__ __device__ __forceinline__ void stage_rc(int b, int& R, int& C) { const int st = b / 1024, sb = b % 1024, swz = sb ^ (((sb >> 9) & 1) << 5); R = (st >> 1) * 16 + swz / 64; C = (st & 1) * 32 + (swz % 64) / 2; }
__host__ __device__ __forceinline__ int perm32(int rho) { const int n = rho >> 4, i = rho & 15; return 8 * (i >> 2) + 4 * n + (i & 3); }

struct Unit { int pm, pn; };
struct Gemm { const bf16_t* A; const bf16_t* Bt; int M, N, K; };

struct StaticOrder {
    int nM, nN, nwg, G, c;
    __host__ __device__ void init(int M, int N, int G_, int c_) { nM = M / BM; nN = N / BM; nwg = nM * nN; G = G_; c = c_; }
    __host__ __device__ bool next(int i, Unit& u) const {
        const long L = (long)i * G + c; if (L >= nwg) return false;
        int wgid = (int)L; { const int q = nwg / NXCD, r = nwg % NXCD, xcd = wgid % NXCD, off = wgid / NXCD; wgid = (xcd < r ? xcd * (q + 1) : r * (q + 1) + (xcd - r) * q) + off; }
        const int nig = WGM * nN, gid = wgid / nig, fm = gid * WGM, gsz = (nM - fm) < WGM ? (nM - fm) : WGM;
        u.pm = fm + ((wgid % nig) % gsz); u.pn = (wgid % nig) / gsz; return true;
    }
    __device__ __forceinline__ void a_ready(const Unit&) const {}
    __device__ __forceinline__ void done(const Unit&) const {}
};
typedef float f32x2e __attribute__((ext_vector_type(2))); typedef __bf16 bf16x2e __attribute__((ext_vector_type(2)));
__device__ __forceinline__ unsigned cvt_pk_bf16(float lo, float hi) { return __builtin_bit_cast(unsigned, __builtin_convertvector((f32x2e){lo, hi}, bf16x2e)); }
template <int ACT> struct EpiBf16 {
    static constexpr bool PERM = true, AFTER_DRAIN = false, I8 = false;
    bf16_t* O; size_t ldc; size_t bstride = 0; int tshift = 31;
    __device__ __forceinline__ void operator()(const f32x4 (&acc)[2][2][4][2], const Unit& u, int wr, int wc, int fr, int fq) const {
        const int row0 = u.pm * BM + wr * 64 + fr; const int cb = u.pn * BM; const size_t col0 = (size_t)(cb >> tshift) * bstride + (size_t)(cb & ((1 << tshift) - 1)) + wc * 32 + 8 * fq;
#pragma unroll
        for (int ai = 0; ai < 2; ++ai)
#pragma unroll
            for (int m = 0; m < 4; ++m) { bf16_t* rowp = O + (size_t)(row0 + ai * HALF + m * 16) * ldc + col0;
#pragma unroll
                for (int bj = 0; bj < 2; ++bj) { f32x4 v0 = acc[ai][bj][m][0], v1 = acc[ai][bj][m][1];
                    if (ACT == 1) {
#pragma unroll
                        for (int j = 0; j < 4; ++j) { const float a = fmaxf(v0[j], 0.f), b = fmaxf(v1[j], 0.f); v0[j] = a * a; v1[j] = b * b; } }
                    u32x4 w; w.x = cvt_pk_bf16(v0[0], v0[1]); w.y = cvt_pk_bf16(v0[2], v0[3]); w.z = cvt_pk_bf16(v1[0], v1[1]); w.w = cvt_pk_bf16(v1[2], v1[3]);
                    *(u32x4*)(rowp + bj * HALF) = w;
                    } }
    }
};
struct EpiBf16Q {
    static constexpr bool PERM = true, AFTER_DRAIN = false, I8 = true;
    bf16_t* O; size_t ldc; size_t bstride; int tshift; const float* rs; const float* cs;
    __device__ __forceinline__ void operator()(const i32x4 (&acc)[2][2][4][2], const Unit& u, int wr, int wc, int fr, int fq) const {
        const int row0 = u.pm * BM + wr * 64 + fr; const int cb = u.pn * BM, ci0 = cb + wc * 32 + 8 * fq;
        const size_t col0 = (size_t)(cb >> tshift) * bstride + (size_t)(cb & ((1 << tshift) - 1)) + wc * 32 + 8 * fq;
        f32x4 cv[2][2];
#pragma unroll
        for (int bj = 0; bj < 2; ++bj) { cv[bj][0] = *(const f32x4*)(cs + ci0 + bj * HALF); cv[bj][1] = *(const f32x4*)(cs + ci0 + bj * HALF + 4); }
#pragma unroll
        for (int ai = 0; ai < 2; ++ai)
#pragma unroll
            for (int m = 0; m < 4; ++m) { const int row = row0 + ai * HALF + m * 16; bf16_t* rowp = O + (size_t)row * ldc + col0; const float r = rs[row];
#pragma unroll
                for (int bj = 0; bj < 2; ++bj) { const i32x4 a0 = acc[ai][bj][m][0], a1 = acc[ai][bj][m][1];
                    const f32x4 v0 = (f32x4){(float)a0[0], (float)a0[1], (float)a0[2], (float)a0[3]} * r * cv[bj][0], v1 = (f32x4){(float)a1[0], (float)a1[1], (float)a1[2], (float)a1[3]} * r * cv[bj][1];
                    u32x4 w; w.x = cvt_pk_bf16(v0[0], v0[1]); w.y = cvt_pk_bf16(v0[2], v0[3]); w.z = cvt_pk_bf16(v1[0], v1[1]); w.w = cvt_pk_bf16(v1[2], v1[3]);
                    *(u32x4*)(rowp + bj * HALF) = w; } }
    }
};
__device__ __forceinline__ float rss16(const float* p) { const f32x4 a = *(const f32x4*)p, b = *(const f32x4*)(p + 4), c = *(const f32x4*)(p + 8), d = *(const f32x4*)(p + 12);
    return (((a[0] + a[1]) + (a[2] + a[3])) + ((b[0] + b[1]) + (b[2] + b[3]))) + (((c[0] + c[1]) + (c[2] + c[3])) + ((d[0] + d[1]) + (d[2] + d[3]))); }
template <int MODE, bool RB16> struct EpiRes {
    static constexpr bool PERM = true, AFTER_DRAIN = false, I8 = false;
    const float* R; const bf16_t* RB; bf16_t* O; int ldc; float* rss;
    __device__ __forceinline__ void operator()(const f32x4 (&acc)[2][2][4][2], const Unit& u, int wr, int wc, int fr, int fq) const {
        const int row0 = u.pm * BM + wr * 64 + fr, col0 = u.pn * BM + wc * 32 + 8 * fq;
#pragma unroll
        for (int ai = 0; ai < 2; ++ai)
#pragma unroll
            for (int m = 0; m < 4; ++m) { const int row = row0 + ai * HALF + m * 16; const size_t off = (size_t)row * ldc + col0;
                f32x4 rv[2][2]; float ss = 0.f, sc = 1.0f;
                if (MODE == 2) sc = __builtin_amdgcn_rcpf(rss16(rss + (size_t)row * 16) * (1.0f / 1024.0f) + 1e-5f);
#pragma unroll
                for (int bj = 0; bj < 2; ++bj) {
                    if (RB16) { const u32x4 w = *(const u32x4*)(RB + off + bj * HALF);
                        rv[bj][0] = (f32x4){__builtin_bit_cast(float, w.x << 16), __builtin_bit_cast(float, w.x & 0xffff0000u), __builtin_bit_cast(float, w.y << 16), __builtin_bit_cast(float, w.y & 0xffff0000u)};
                        rv[bj][1] = (f32x4){__builtin_bit_cast(float, w.z << 16), __builtin_bit_cast(float, w.z & 0xffff0000u), __builtin_bit_cast(float, w.w << 16), __builtin_bit_cast(float, w.w & 0xffff0000u)}; }
                    else { rv[bj][0] = *(const f32x4*)(R + off + bj * HALF); rv[bj][1] = *(const f32x4*)(R + off + bj * HALF + 4); } }
#pragma unroll
                for (int bj = 0; bj < 2; ++bj) { f32x4 o0 = acc[ai][bj][m][0], o1 = acc[ai][bj][m][1];
                    if (MODE == 2) { o0 = o0 * sc; o1 = o1 * sc; }
                    o0 = o0 + rv[bj][0]; o1 = o1 + rv[bj][1];
                    if (MODE == 1) ss += ((o0[0] * o0[0] + o0[1] * o0[1]) + (o0[2] * o0[2] + o0[3] * o0[3])) + ((o1[0] * o1[0] + o1[1] * o1[1]) + (o1[2] * o1[2] + o1[3] * o1[3]));
                    u32x4 w; w.x = cvt_pk_bf16(o0[0], o0[1]); w.y = cvt_pk_bf16(o0[2], o0[3]); w.z = cvt_pk_bf16(o1[0], o1[1]); w.w = cvt_pk_bf16(o1[2], o1[3]);
                    *(u32x4*)(O + off + bj * HALF) = w; }
                if (MODE == 1) { ss += __shfl_xor(ss, 16); ss += __shfl_xor(ss, 32); if (fq == 0) rss[(size_t)row * 16 + u.pn * 4 + wc] = ss; }
                asm volatile("" ::: "memory"); }
    }
};

template <bool I8> __device__ __forceinline__ typename AccT<I8>::t pg8_mma16(const bf16x8& a, const bf16x8& b, const typename AccT<I8>::t& c) {
    if constexpr (I8) return __builtin_amdgcn_mfma_i32_16x16x64_i8(__builtin_bit_cast(i32x4, a), __builtin_bit_cast(i32x4, b), c, 0, 0, 0);
    else return __builtin_amdgcn_mfma_f32_16x16x32_bf16(a, b, c, 0, 0, 0);
}
template <class Epi, class Sched, bool ALIGN_EPI = false, bool SP2 = false>
__device__ __forceinline__ void gemm_phase(PG8_LAS unsigned char* lds, const Gemm g, const Sched& S, const Epi& E) {
    int tid = threadIdx.x; asm volatile("" : "+v"(tid));
    const int wid = __builtin_amdgcn_readfirstlane(tid >> 6), lane = tid & 63, wr = wid >> 2, wc = wid & 3, fr = lane & 15, fq = lane >> 4;
    const int K = g.K, nt = K / BK;
    unsigned voffA[2], voffB[2];
#pragma unroll
    for (int i = 0; i < 2; ++i) { int R, C; stage_rc(tid * 16 + i * 8192, R, C); const int Rb = Epi::PERM ? ((R & ~31) + perm32(R & 31)) : R;
        voffA[i] = (unsigned)(R * K + C) * 2u; voffB[i] = (unsigned)(Rb * K + C) * 2u; }
    const size_t kstep = (size_t)(BK * 2);
    const size_t hstep = (size_t)HALF * K * 2;
    const size_t tstep = 2 * hstep;
    const unsigned ldsw = (unsigned)wid * 1024u;
    const int aoff = lds_byte(wr * 64 + fr, fq * 8), boff = lds_byte(wc * 32 + fr, fq * 8);
#define PG8_SA(b, h) (((b) * 2 + (h)) * HTB)
#define PG8_SB(b, h) ((4 + (b) * 2 + (h)) * HTB)
#define PG8_STAGE(bufoff, gbase, voff) do { _Pragma("unroll") for (int _i = 0; _i < 2; ++_i) \
        __builtin_amdgcn_global_load_lds((const unsigned*)((const char*)(gbase) + (voff)[_i]), (PG8_LAS unsigned*)(lds + (bufoff) + ldsw + _i * 8192), 16, 0, 0); } while (0)
#define PG8_LDA(dst, b, h) do { _Pragma("unroll") for (int m = 0; m < 4; ++m) _Pragma("unroll") for (int k = 0; k < 2; ++k) dst[m][k] = *(const PG8_LAS bf16x8*)(lds + PG8_SA(b, h) + aoff + m * 2048 + k * 1024); } while (0)
#define PG8_LDB(dst, b, h) do { _Pragma("unroll") for (int n = 0; n < 2; ++n) _Pragma("unroll") for (int k = 0; k < 2; ++k) dst[n][k] = *(const PG8_LAS bf16x8*)(lds + PG8_SB(b, h) + boff + n * 2048 + k * 1024); } while (0)
#define PG8_MMA(ai, bj, At, Bt) do { __builtin_amdgcn_s_setprio(1); _Pragma("unroll") for (int m = 0; m < 4; ++m) _Pragma("unroll") for (int n = 0; n < 2; ++n) _Pragma("unroll") for (int k = 0; k < 2; ++k) \
        acc[ai][bj][m][n] = pg8_mma16<Epi::I8>(Bt[n][k], At[m][k], acc[ai][bj][m][n]); __builtin_amdgcn_s_setprio(0); } while (0)
#define PG8_WAIT_V(n) asm volatile("s_waitcnt vmcnt(" #n ")" ::: "memory")
#define PG8_WAIT_L(n) asm volatile("s_waitcnt lgkmcnt(" #n ")" ::: "memory")
#define PG8_BAR __builtin_amdgcn_s_barrier()
#define PG8_SCHED __builtin_amdgcn_sched_barrier(0)
    Unit cur, nxt; int ui = 0;
    if (!S.next(0, cur)) return;
    typedef typename AccT<Epi::I8>::t acc_t;
    acc_t acc[2][2][4][2];
#pragma unroll
    for (int a = 0; a < 2; ++a)
#pragma unroll
        for (int b = 0; b < 2; ++b)
#pragma unroll
            for (int m = 0; m < 4; ++m)
#pragma unroll
                for (int n = 0; n < 2; ++n) acc[a][b][m][n] = (acc_t){0, 0, 0, 0};
    bf16x8 At[4][2], B0[2][2], B1[2][2];
    const char* cA = (const char*)g.A + (size_t)cur.pm * tstep; const char* cB = (const char*)g.Bt + (size_t)cur.pn * tstep;
    S.a_ready(cur);
    if constexpr (SP2) {
        PG8_STAGE(PG8_SB(0, 0), cB, voffB); PG8_STAGE(PG8_SB(0, 1), cB + hstep, voffB); PG8_STAGE(PG8_SA(0, 0), cA, voffA); PG8_STAGE(PG8_SA(0, 1), cA + hstep, voffA);
        if (wr == 1) PG8_BAR;
        PG8_WAIT_V(2); PG8_BAR;
        PG8_STAGE(PG8_SB(1, 0), cB + kstep, voffB); PG8_STAGE(PG8_SA(1, 0), cA + kstep, voffA); PG8_STAGE(PG8_SB(1, 1), cB + hstep + kstep, voffB);
        PG8_WAIT_V(6); PG8_BAR;
    } else {
        PG8_STAGE(PG8_SB(0, 0), cB, voffB); PG8_STAGE(PG8_SA(0, 0), cA, voffA); PG8_STAGE(PG8_SB(0, 1), cB + hstep, voffB); PG8_STAGE(PG8_SA(0, 1), cA + hstep, voffA);
        if (wr == 1) PG8_BAR;
        PG8_WAIT_V(4); PG8_BAR;
        PG8_STAGE(PG8_SB(1, 0), cB + kstep, voffB); PG8_STAGE(PG8_SA(1, 0), cA + kstep, voffA); PG8_STAGE(PG8_SB(1, 1), cB + hstep + kstep, voffB);
        PG8_WAIT_V(6); PG8_BAR;
    }
    for (;;) {
        const bool has_next = S.next(ui + 1, nxt);
        const char* nA = has_next ? (const char*)g.A + (size_t)nxt.pm * tstep : cA; const char* nB = has_next ? (const char*)g.Bt + (size_t)nxt.pn * tstep : cB;
        for (int t = 0; t < nt; t += 2) {
            const bool last = (t == nt - 2);
            const char* a1 = cA + (size_t)(t + 1) * kstep;
            const char* a2 = last ? nA : cA + (size_t)(t + 2) * kstep; const char* b2 = last ? nB : cB + (size_t)(t + 2) * kstep;
            const char* a3 = a2 + kstep; const char* b3 = b2 + kstep;
            if (last && has_next) S.a_ready(nxt);
            if constexpr (SP2) {
            PG8_LDB(B0, 0, 0); PG8_LDB(B1, 0, 1); PG8_SCHED; PG8_LDA(At, 0, 0); PG8_STAGE(PG8_SA(1, 1), a1 + hstep, voffA);
            PG8_WAIT_V(8); PG8_WAIT_L(0); PG8_BAR; PG8_MMA(0, 0, At, B0); PG8_MMA(0, 1, At, B1); PG8_BAR; PG8_SCHED;
            PG8_LDA(At, 0, 1); PG8_STAGE(PG8_SB(0, 0), b2, voffB); PG8_STAGE(PG8_SB(0, 1), b2 + hstep, voffB); PG8_STAGE(PG8_SA(0, 0), a2, voffA);
            PG8_WAIT_V(8); PG8_WAIT_L(0); PG8_BAR; PG8_MMA(1, 0, At, B0); PG8_MMA(1, 1, At, B1); PG8_BAR; PG8_SCHED;
            PG8_LDB(B0, 1, 0); PG8_LDB(B1, 1, 1); PG8_SCHED; PG8_LDA(At, 1, 0); PG8_STAGE(PG8_SA(0, 1), a2 + hstep, voffA);
            PG8_WAIT_V(8); PG8_WAIT_L(0); PG8_BAR; PG8_MMA(0, 0, At, B0); PG8_MMA(0, 1, At, B1); PG8_BAR; PG8_SCHED;
            PG8_LDA(At, 1, 1); PG8_STAGE(PG8_SB(1, 0), b3, voffB); PG8_STAGE(PG8_SB(1, 1), b3 + hstep, voffB); PG8_STAGE(PG8_SA(1, 0), a3, voffA);
            PG8_WAIT_V(8); PG8_WAIT_L(0); PG8_BAR; PG8_MMA(1, 0, At, B0); PG8_MMA(1, 1, At, B1); PG8_BAR; PG8_SCHED;
            } else {
            PG8_LDB(B0, 0, 0); PG8_SCHED; PG8_LDA(At, 0, 0); PG8_STAGE(PG8_SA(1, 1), a1 + hstep, voffA);
            PG8_WAIT_L(8); PG8_BAR; PG8_WAIT_L(0); PG8_MMA(0, 0, At, B0); PG8_BAR; PG8_SCHED;
            PG8_LDB(B1, 0, 1); PG8_STAGE(PG8_SB(0, 0), b2, voffB);
            PG8_BAR; PG8_WAIT_L(0); PG8_MMA(0, 1, At, B1); PG8_BAR;
            PG8_LDA(At, 0, 1); PG8_STAGE(PG8_SA(0, 0), a2, voffA);
            PG8_BAR; PG8_WAIT_L(0); PG8_MMA(1, 0, At, B0); PG8_BAR; PG8_SCHED;
            PG8_STAGE(PG8_SB(0, 1), b2 + hstep, voffB);
            PG8_WAIT_V(6); PG8_BAR; PG8_MMA(1, 1, At, B1); PG8_BAR;
            PG8_LDB(B0, 1, 0); PG8_SCHED; PG8_LDA(At, 1, 0); PG8_STAGE(PG8_SA(0, 1), a2 + hstep, voffA);
            PG8_WAIT_L(8); PG8_BAR; PG8_WAIT_L(0); PG8_MMA(0, 0, At, B0); PG8_BAR; PG8_SCHED;
            PG8_LDB(B1, 1, 1); PG8_STAGE(PG8_SB(1, 0), b3, voffB);
            PG8_BAR; PG8_WAIT_L(0); PG8_MMA(0, 1, At, B1); PG8_BAR;
            PG8_LDA(At, 1, 1); PG8_STAGE(PG8_SA(1, 0), a3, voffA);
            PG8_BAR; PG8_WAIT_L(0); PG8_MMA(1, 0, At, B0); PG8_BAR; PG8_SCHED;
            PG8_STAGE(PG8_SB(1, 1), b3 + hstep, voffB);
            PG8_WAIT_V(6); PG8_BAR; PG8_MMA(1, 1, At, B1); PG8_BAR;
            }
        }
        if constexpr (ALIGN_EPI) { if (wr == 0) PG8_BAR; }
        if constexpr (!Epi::AFTER_DRAIN) { E(acc, cur, wr, wc, fr, fq); S.done(cur); }
        if (!has_next) break;
#pragma unroll
        for (int a = 0; a < 2; ++a)
#pragma unroll
            for (int b = 0; b < 2; ++b)
#pragma unroll
                for (int m = 0; m < 4; ++m)
#pragma unroll
                    for (int n = 0; n < 2; ++n) acc[a][b][m][n] = (acc_t){0, 0, 0, 0};
        cur = nxt; cA = nA; cB = nB; ++ui;
        if constexpr (ALIGN_EPI) { if (wr == 1) PG8_BAR; }
    }
    PG8_WAIT_V(0);
    if constexpr (!ALIGN_EPI) { if (wr == 0) PG8_BAR; }
    PG8_BAR;
    if constexpr (Epi::AFTER_DRAIN) { E.fused(acc, cur, wr, wc, fr, fq, lds, wid, lane); S.done(cur); }
#undef PG8_SA
#undef PG8_SB
#undef PG8_STAGE
#undef PG8_LDA
#undef PG8_LDB
#undef PG8_MMA
#undef PG8_WAIT_V
#undef PG8_WAIT_L
#undef PG8_BAR
#undef PG8_SCHED
}
}
constexpr int NWAVES = 8, NTHR = 512;
constexpr int NB = 8, T = 8192, M = NB * T, D = 1024, CH = 512, NH = 8, HD = 64, FF = 4096, NL = 2;
constexpr int PIN = 3456, HYP = 1536, RWP = 1920, NRW = 2048;
constexpr float RMS_EPS = 1e-5f, GN_EPS = 64.0f * 1e-5f;
constexpr int MLP_CHUNKS = 4;
static_assert(MLP_CHUNKS >= 2 && M % (MLP_CHUNKS * 256) == 0, "the next layer's first-half RMSNorm is folded into the last MLP chunk: it needs a barrier between the first half's down GEMMs and that chunk");

constexpr size_t MiB = 1u << 20;
constexpr size_t WS_CTL = 0, CTL_ZERO_BYTES = 1 * MiB;
constexpr size_t WS_W = 2 * MiB;
constexpr size_t W_LAYER = 25 * MiB, W_HY = 0, W_RW = 3 * MiB, W_O = 7 * MiB, W_1 = 9 * MiB, W_2 = 17 * MiB;
constexpr size_t WS_RSC = 52 * MiB;
constexpr size_t WS_CSC = 52 * MiB + 512 * 1024;
constexpr size_t WS_FSC = 52 * MiB;
constexpr size_t WS_RSS = 53 * MiB;
constexpr size_t WS_BS = 53 * MiB;
constexpr size_t WS_FRAG = 57 * MiB;
constexpr size_t WS_SFIN = 62 * MiB;
constexpr size_t WS_YPHI = 64 * MiB;
constexpr size_t WS_HF = 64 * MiB;
constexpr size_t WS_HN = 128 * MiB;
constexpr size_t WS_G = 128 * MiB, WS_V2 = 192 * MiB;
constexpr size_t WS_VFIRST = 256 * MiB;
constexpr size_t WS_PHT = 320 * MiB;
constexpr size_t WS_PRW = 512 * MiB;
constexpr size_t WS_YS = 768 * MiB;
constexpr size_t WS_HID = 320 * MiB;
constexpr size_t WS_YMIX = 896 * MiB;
constexpr size_t WS_END = 1024 * MiB;
constexpr int CW_BAR = 4096;
constexpr int CW_CMAX = 32768;
constexpr int CW_QUEUE = 16384;

constexpr int LDS_BYTES = 163840;
constexpr int LDSCTL_OFF = LDS_BYTES - 512;

#define GAS __attribute__((address_space(1)))
#define LAS __attribute__((address_space(3)))
typedef unsigned short bf16;
typedef unsigned v4u __attribute__((ext_vector_type(4)));
typedef unsigned v2u __attribute__((ext_vector_type(2)));
typedef float f32x4 __attribute__((ext_vector_type(4)));
#define PHASE_TID() int bid = blockIdx.x; asm volatile("" : "+s"(bid)); (void)bid; int tid = threadIdx.x; asm volatile("" : "+v"(tid)); const int lane = tid & 63; const int wave = __builtin_amdgcn_readfirstlane(tid >> 6); (void)lane; (void)wave
#define RLX_AGENT __ATOMIC_RELAXED, __HIP_MEMORY_SCOPE_AGENT
#define LDS_WAIT() asm volatile("s_waitcnt lgkmcnt(0)" ::: "memory")
#define VM_WAIT() asm volatile("s_waitcnt vmcnt(0)" ::: "memory")
typedef float f32x2_ __attribute__((ext_vector_type(2)));
typedef __bf16 bf16x2_ __attribute__((ext_vector_type(2)));
__device__ __forceinline__ unsigned pk2(float lo, float hi) { return __builtin_bit_cast(unsigned, __builtin_convertvector((f32x2_){lo, hi}, bf16x2_)); }
__device__ __forceinline__ unsigned f2bf(float f) { return pk2(f, f) & 0xffffu; }
__device__ __forceinline__ float bf2f(unsigned h) { return __uint_as_float(h << 16); }
__device__ __forceinline__ float bflo(unsigned w) { return __uint_as_float(w << 16); }
__device__ __forceinline__ float bfhi(unsigned w) { return __uint_as_float(w & 0xffff0000u); }
__device__ __forceinline__ float sigmoidf_(float x) { return __builtin_amdgcn_rcpf(1.0f + __expf(-x)); }
__device__ __forceinline__ float tanhf_(float x) { return 1.0f - 2.0f * __builtin_amdgcn_rcpf(1.0f + __expf(2.0f * x)); }
template <int CTRL> __device__ __forceinline__ float dpp(float x) { return __builtin_bit_cast(float, __builtin_amdgcn_mov_dpp(__builtin_bit_cast(int, x), CTRL, 0xf, 0xf, true)); }
constexpr int XOR1 = 0xB1, XOR2 = 0x4E, XOR7 = 0x141, XOR8 = 0x128;
__device__ __forceinline__ float sin_hw(float x) { const float r = x * 0.15915494309189535f; return __builtin_amdgcn_sinf(r - floorf(r)); }
__device__ __forceinline__ float sum8(float v) { v += dpp<XOR1>(v); v += dpp<XOR2>(v); v += dpp<XOR7>(v); return v; }
__device__ __forceinline__ float sum16(float v) { v = sum8(v); v += dpp<XOR8>(v); return v; }

#define XB_TMO      128
#define XB_XCNT(j)  (256  + 64 * (j))
#define XB_XSUB(j)  (1280 + 64 * (j))
#define XB_XGEN(j)  (2304 + 64 * (j))
#define XB_TOP      3328
#define XB_TOPGEN   3392
#define XCD_BAR_WORDS 3456
#define XB_SPIN_CAP (1u << 18)

__device__ __forceinline__ unsigned xb_ld(unsigned* p)              { return __hip_atomic_load(p, __ATOMIC_RELAXED, __HIP_MEMORY_SCOPE_AGENT); }
__device__ __forceinline__ unsigned xb_add(unsigned* p, unsigned v) { return __hip_atomic_fetch_add(p, v, __ATOMIC_RELAXED, __HIP_MEMORY_SCOPE_AGENT); }
__device__ __forceinline__ unsigned xb_xcc_id() { return (unsigned)__builtin_amdgcn_s_getreg((3 << 11) | 20) & 0xFu; }
#define XB_SPIN(cond, bar) do { unsigned _sp = 0; while (cond) { __builtin_amdgcn_s_sleep(1); \
    if ((++_sp & 255u) == 0u) { if (xb_ld(&(bar)[XB_TMO])) break; if (_sp > XB_SPIN_CAP) { atomicAdd(&(bar)[XB_TMO], 1u); break; } } } } while (0)

struct XcdBarrier {
    unsigned* bar; unsigned x;
    volatile LAS unsigned* st;
};
__device__ __forceinline__ XcdBarrier xcd_barrier_post(unsigned* bar, volatile LAS unsigned* st) {
    XcdBarrier b; b.bar = bar; b.x = xb_xcc_id(); b.st = st;
    if (threadIdx.x == 0) (void)xb_add(&bar[XB_XCNT(b.x)], 1u);
    return b;
}
__device__ __forceinline__ void xcd_barrier_complete(unsigned* bar, unsigned x, unsigned& nloc, unsigned& nx) {
    const unsigned G = gridDim.x * gridDim.y * gridDim.z;
    unsigned sum, cnt, mine, sp = 0u;
    for (;;) {
        sum = 0u; cnt = 0u; mine = 0u;
#pragma unroll
        for (unsigned j = 0; j < 16; ++j) { const unsigned c = xb_ld(&bar[XB_XCNT(j)]); sum += c; cnt += (c > 0u) ? 1u : 0u; mine = (j == x) ? c : mine; }
        if (sum == G) break;
        __builtin_amdgcn_s_sleep(1);
        if ((++sp & 255u) == 0u) { if (xb_ld(&bar[XB_TMO])) break; if (sp > XB_SPIN_CAP) { atomicAdd(&bar[XB_TMO], 1u); break; } }
    }
    nloc = mine > 0u ? mine : 1u; nx = cnt > 0u ? cnt : 1u;
}
__device__ __forceinline__ void xcd_barrier(const XcdBarrier& b) {
    asm volatile("s_waitcnt vmcnt(0)" ::: "memory");
    __syncthreads();
    if (threadIdx.x == 0) {
        unsigned* bar = b.bar;
        unsigned bx = b.x; asm volatile("" : "+s"(bx));
        __builtin_amdgcn_s_waitcnt(0);
        unsigned nloc = b.st[0], nx = b.st[1];
        if (nloc == 0u) { xcd_barrier_complete(bar, bx, nloc, nx); b.st[0] = nloc; b.st[1] = nx; }
        const unsigned old = xb_add(&bar[XB_XSUB(bx)], 1u);
        const unsigned gen = old / nloc;
        if (old + 1u == (gen + 1u) * nloc) {
            __builtin_amdgcn_fence(__ATOMIC_RELEASE, "agent");
            asm volatile("s_waitcnt vmcnt(0)" ::: "memory");
            const unsigned og = xb_add(&bar[XB_TOP], 1u);
            const unsigned tg = og / nx;
            if (og + 1u == (tg + 1u) * nx) xb_add(&bar[XB_TOPGEN], 1u);
            else XB_SPIN(xb_ld(&bar[XB_TOPGEN]) == tg, bar);
            __builtin_amdgcn_fence(__ATOMIC_ACQUIRE, "agent");
            xb_add(&bar[XB_XGEN(bx)], 1u);
            asm volatile("s_waitcnt vmcnt(0)" ::: "memory");
        } else {
            XB_SPIN(xb_ld(&bar[XB_XGEN(bx)]) == gen, bar);
            __builtin_amdgcn_fence(__ATOMIC_ACQUIRE, "agent");
            asm volatile("s_waitcnt vmcnt(0)" ::: "memory");
        }
    }
    __syncthreads();
}

struct Frame {
    LAS unsigned char* lds;
    volatile LAS unsigned* MISC;
    unsigned* ctl;
    int G;
    const float* const* in;
    float* out; unsigned char* ws;
};
enum { I_X = 0, I_N1G, I_WIN, I_HCW, I_HCB, I_FW1, I_FB1, I_FW2, I_FB2, I_FW3, I_FB3, I_FFREQ, I_FWOUT, I_HSKIP, I_HNG, I_SHIFT, I_W0, I_W2, I_A0, I_A2, I_G2, I_KK, I_KA, I_RK, I_LNG, I_LNB, I_V0, I_V1, I_V2, I_WOUT, I_N2G, I_MW1, I_MW2, I_FING };

__device__ __forceinline__ float wave_max(float v) {
#pragma unroll
    for (int o = 1; o < 64; o <<= 1) v = fmaxf(v, __shfl_xor(v, o));
    return v;
}
__device__ __forceinline__ unsigned q4(float a, float b, float c, float d) {
    const int ia = (int)__builtin_rintf(a), ib = (int)__builtin_rintf(b), ic = (int)__builtin_rintf(c), id = (int)__builtin_rintf(d);
    return (unsigned)(ia & 255) | ((unsigned)(ib & 255) << 8) | ((unsigned)(ic & 255) << 16) | ((unsigned)id << 24);
}
__device__ __forceinline__ float wave_sum(float v) {
#pragma unroll
    for (int o = 1; o < 64; o <<= 1) v += __shfl_xor(v, o);
    return v;
}
typedef float f32x2 __attribute__((ext_vector_type(2)));
constexpr int FN = 2 * T;
constexpr int XPAD = FN + FN / 16 + 16 * (FN / 512);
__device__ __forceinline__ f32x2 cmul(f32x2 a, f32x2 b) { return (f32x2){a.x * b.x - a.y * b.y, a.x * b.y + a.y * b.x}; }
__device__ __forceinline__ f32x2 pk_fma_rot(f32x2 a, f32x2 b, f32x2 t) { f32x2 r;
    asm("v_pk_fma_f32 %0, %1, %2, %3 op_sel:[1,1,0] op_sel_hi:[1,0,1] neg_lo:[0,1,0]" : "=v"(r) : "v"(a), "v"(b), "v"(t)); return r; }
__device__ __forceinline__ f32x2 pk_add_mib(f32x2 a, f32x2 b) { f32x2 r; asm("v_pk_add_f32 %0, %1, %2 op_sel:[0,1] op_sel_hi:[1,0] neg_hi:[0,1]" : "=v"(r) : "v"(a), "v"(b)); return r; }
__device__ __forceinline__ f32x2 pk_add_pib(f32x2 a, f32x2 b) { f32x2 r; asm("v_pk_add_f32 %0, %1, %2 op_sel:[0,1] op_sel_hi:[1,0] neg_lo:[0,1]" : "=v"(r) : "v"(a), "v"(b)); return r; }
__device__ __forceinline__ f32x2 cmulc(f32x2 a, f32x2 b) { return (f32x2){a.x * b.x + a.y * b.y, a.y * b.x - a.x * b.y}; }
__device__ constexpr float C32[16] = {1.0f, 0.98078528040323043f, 0.92387953251128674f, 0.83146961230254524f, 0.70710678118654752f, 0.55557023301960218f, 0.38268343236508977f, 0.19509032201612825f,
                                      0.0f, -0.19509032201612825f, -0.38268343236508977f, -0.55557023301960218f, -0.70710678118654752f, -0.83146961230254524f, -0.92387953251128674f, -0.98078528040323043f};
__device__ constexpr float S32[16] = {0.0f, 0.19509032201612825f, 0.38268343236508977f, 0.55557023301960218f, 0.70710678118654752f, 0.83146961230254524f, 0.92387953251128674f, 0.98078528040323043f,
                                      1.0f, 0.98078528040323043f, 0.92387953251128674f, 0.83146961230254524f, 0.70710678118654752f, 0.55557023301960218f, 0.38268343236508977f, 0.19509032201612825f};
constexpr int bitrev_c(int v, int bits) { int r = 0; for (int i = 0; i < bits; ++i) r |= ((v >> i) & 1) << (bits - 1 - i); return r; }
#define SH0(v) __builtin_shufflevector(v, v, 0, 0)
#define SH1(v) __builtin_shufflevector(v, v, 1, 1)
template <int R, bool INV, bool STORE = false, int NOUT = R> __device__ __forceinline__ void dft_regs(f32x2 (&x)[R], LAS f32x2* P = nullptr, int stride = 0) {
    constexpr int LOG = (R == 32) ? 5 : 4;
    f32x2 y[R];
#pragma unroll
    for (int k = 0; k < R; ++k) y[k] = x[bitrev_c(k, LOG)];
#pragma unroll
    for (int s = 1; s < R; s <<= 1) {
#pragma unroll
        for (int blk = 0; blk < R; blk += 2 * s) {
            const bool st = STORE && (2 * s == R);
            { const f32x2 a = y[blk], b = y[blk + s]; y[blk] = a + b; y[blk + s] = a - b;
              if (st) { P[0] = y[blk]; if (s < NOUT) P[s * stride] = y[blk + s]; } }
            if (s >= 2) { const f32x2 a = y[blk + s / 2], b = y[blk + s / 2 + s];
                y[blk + s / 2] = INV ? pk_add_pib(a, b) : pk_add_mib(a, b); y[blk + s / 2 + s] = INV ? pk_add_mib(a, b) : pk_add_pib(a, b);
                if (st) { P[(s / 2) * stride] = y[blk + s / 2]; if (s / 2 + s < NOUT) P[(s / 2 + s) * stride] = y[blk + s / 2 + s]; } }
#pragma unroll
            for (int j = 1; j < s / 2; ++j) { const int j2 = s - j, m1 = j * (16 / s), m2 = j2 * (16 / s);
                const float c1 = C32[m1], s1 = INV ? S32[m1] : -S32[m1], c2 = C32[m2], s2 = INV ? S32[m2] : -S32[m2];
                const f32x2 a1 = y[blk + j], b1 = y[blk + j + s], a2 = y[blk + j2], b2 = y[blk + j2 + s];
                const f32x2 p1 = __builtin_elementwise_fma(SH0(b1), (f32x2){c1, s1}, a1), p2 = __builtin_elementwise_fma(SH0(b2), (f32x2){c2, s2}, a2);
                if (st) asm volatile("" :: "v"(p1), "v"(p2) : "memory"); else asm volatile("" :: "v"(p1), "v"(p2));
                const f32x2 q1 = __builtin_elementwise_fma(SH1(b1), (f32x2){-s1, c1}, p1), q2 = __builtin_elementwise_fma(SH1(b2), (f32x2){-s2, c2}, p2);
                asm volatile("" :: "v"(q1), "v"(q2));
                y[blk + j] = q1; y[blk + j2] = q2;
                y[blk + j + s] = __builtin_elementwise_fma(a1, (f32x2){2.0f, 2.0f}, -q1); y[blk + j2 + s] = __builtin_elementwise_fma(a2, (f32x2){2.0f, 2.0f}, -q2);
                if (st) { P[j * stride] = q1; P[j2 * stride] = q2; if (j + s < NOUT) P[(j + s) * stride] = y[blk + j + s]; if (j2 + s < NOUT) P[(j2 + s) * stride] = y[blk + j2 + s]; } }
        }
    }
#pragma unroll
    for (int k = 0; k < R; ++k) x[k] = y[k];
}
template <int R, bool INV, bool STORE = false> __device__ __forceinline__ void twiddle_regs(f32x2 (&x)[R], float frac, LAS f32x2* P = nullptr, int stride = 0) {
    asm volatile("" : "+v"(frac));
    const float sn0 = __builtin_amdgcn_sinf(0.5f * frac), cs = __builtin_amdgcn_cosf(0.5f * frac);
    const float sn = INV ? sn0 : -sn0;
    const f32x2 w = (f32x2){cs, sn}, iw = (f32x2){-sn, cs};
    f32x2 w2; { f32x2 t = __builtin_shufflevector(w, w, 0, 0) * w; w2 = pk_fma_rot(w, w, t); }
    f32x2 wa = w, wb = w2;
    if (STORE) P[0] = x[0];
#pragma unroll
    for (int k = 1; k < R; k += 2) {
        const bool hb = (k + 1 < R), na = (k + 2 < R), nb = (k + 3 < R);
        const f32x2 xa = x[k], xb = hb ? x[k + 1] : x[k];
        const f32x2 tda = __builtin_shufflevector(xa, xa, 0, 0) * wa, tdb = __builtin_shufflevector(xb, xb, 0, 0) * wb;
        const f32x2 tpa = __builtin_shufflevector(wa, wa, 0, 0) * w2, tpb = __builtin_shufflevector(wb, wb, 0, 0) * w2;
        if (hb && na && nb) { if (STORE) asm volatile("" :: "v"(tda), "v"(tdb), "v"(tpa), "v"(tpb) : "memory"); else asm volatile("" :: "v"(tda), "v"(tdb), "v"(tpa), "v"(tpb)); }
        else asm volatile("" :: "v"(tda));
        x[k] = pk_fma_rot(xa, wa, tda);
        if (hb) x[k + 1] = pk_fma_rot(xb, wb, tdb);
        if (STORE) { P[k * stride] = x[k]; if (hb) P[(k + 1) * stride] = x[k + 1]; }
        if (na) wa = pk_fma_rot(wa, w2, tpa);
        if (nb) wb = pk_fma_rot(wb, w2, tpb);
    }
}
#define XP(i) ((i) + ((i) >> 4) + 16 * ((i) >> 9))
constexpr int XBP = 560;
template <bool ZUP> __device__ __forceinline__ void fft_f1(LAS f32x2* X, int t) {
    f32x2 x[32]; const int base = t + (t >> 4);
#pragma unroll
    for (int j = 0; j < 32; ++j) x[j] = (ZUP && j >= 16) ? (f32x2){0.f, 0.f} : X[base + j * XBP];
    dft_regs<32, false>(x);
    twiddle_regs<32, false, true>(x, (float)t * (1.0f / 8192.0f), X + base, XBP);
}
__device__ __forceinline__ void fft_f2(LAS f32x2* X, int t) {
    f32x2 x[32]; const int base = (t >> 4) * XBP + (t & 15);
#pragma unroll
    for (int j = 0; j < 32; ++j) x[j] = X[base + j * 17];
    dft_regs<32, false>(x);
    twiddle_regs<32, false, true>(x, (float)(t & 15) * (1.0f / 256.0f), X + base, 17);
}
__device__ __forceinline__ void fft_mid(LAS f32x2* X, const f32x2* H, int t) {
#pragma unroll 1
    for (int r = 0; r < 2; ++r) { const int b = (t >> 6) * 128 + (t & 63) + 64 * r; f32x2 x[16];
        const f32x4* hp = (const f32x4*)(H + 16 * b); f32x4 h[8];
#pragma unroll
        for (int k = 0; k < 8; ++k) h[k] = hp[k];
#pragma unroll
        for (int j = 0; j < 16; ++j) x[j] = X[17 * b + 16 * (b >> 5) + j];
        dft_regs<16, false>(x);
#pragma unroll
        for (int k = 0; k < 8; ++k) { const f32x2 h0 = (f32x2){h[k][0], h[k][1]}, h1 = (f32x2){h[k][2], h[k][3]}, a0 = x[2 * k], a1 = x[2 * k + 1];
            f32x2 t0 = __builtin_shufflevector(a0, a0, 0, 0) * h0, t1 = __builtin_shufflevector(a1, a1, 0, 0) * h1;
            asm volatile("" :: "v"(t0), "v"(t1));
            x[2 * k] = pk_fma_rot(a0, h0, t0); x[2 * k + 1] = pk_fma_rot(a1, h1, t1); }
        dft_regs<16, true>(x);
#pragma unroll
        for (int j = 0; j < 16; ++j) X[17 * b + 16 * (b >> 5) + j] = x[j]; }
}
__device__ __forceinline__ void fft_i2(LAS f32x2* X, int t) {
    f32x2 x[32]; const int base = (t >> 4) * XBP + (t & 15);
#pragma unroll
    for (int k = 0; k < 32; ++k) x[k] = X[base + k * 17];
    twiddle_regs<32, true>(x, (float)(t & 15) * (1.0f / 256.0f));
    dft_regs<32, true, true, 32>(x, X + base, 17);
}
__device__ __forceinline__ void fft_i1(LAS f32x2* X, int t) {
    f32x2 x[32]; const int base = t + (t >> 4);
#pragma unroll
    for (int k = 0; k < 32; ++k) x[k] = X[base + k * XBP];
    twiddle_regs<32, true>(x, (float)t * (1.0f / 8192.0f));
    dft_regs<32, true, true, 16>(x, X + base, XBP);
}
__device__ __forceinline__ void fft_conv(LAS f32x2* X, const f32x2* H, int tid) {
    __syncthreads(); fft_f1<true>(X, tid);
    __syncthreads(); fft_f2(X, tid);
    LDS_WAIT(); asm volatile("" ::: "memory"); fft_mid(X, H, tid);
    LDS_WAIT(); asm volatile("" ::: "memory"); fft_i2(X, tid);
    __syncthreads(); fft_i1(X, tid);
    __syncthreads();
}
__device__ __forceinline__ void hy_spectrum_item(Frame& F, int item) {
    PHASE_TID();
    LAS f32x2* X = (LAS f32x2*)F.lds; LAS float* RED = (LAS float*)(F.lds + XPAD * 8);
    const int o = item >> 9, c = item & 511;
    const float* HF = (const float*)(F.ws + WS_HF);
    const float* f = HF + ((size_t)(o * 2 + 0) * CH + c) * T; const float* bw = HF + ((size_t)(o * 2 + 1) * CH + c) * T;
    f32x2* HS = (f32x2*)(F.ws + WS_YMIX) + (size_t)item * FN;
    __syncthreads();
    f32x2 x[32]; float ss = 0.f; const int base = tid + (tid >> 4);
#pragma unroll
    for (int j = 0; j < 32; ++j) { const int idx = j * 512 + tid; float v;
        if (j < 16) v = f[idx]; else v = (idx == T) ? 0.f : bw[FN - idx];
        ss += v * v; x[j] = (f32x2){v, 0.f}; }
    ss = wave_sum(ss);
    if (lane == 0) RED[wave] = ss;
    dft_regs<32, false>(x);
    twiddle_regs<32, false>(x, (float)tid * (1.0f / 8192.0f));
#pragma unroll
    for (int k = 0; k < 32; ++k) X[base + k * XBP] = x[k];
    __syncthreads();
    float tot = 0.f;
#pragma unroll
    for (int w = 0; w < 8; ++w) tot += RED[w];
    const float sc = (1.0f / sqrtf(tot + 1e-6f)) * (1.0f / (float)FN);
    fft_f2(X, tid);
    __syncthreads();
#pragma unroll 1
    for (int r = 0; r < 2; ++r) { const int b = tid + 512 * r; f32x2 y[16];
#pragma unroll
        for (int j = 0; j < 16; ++j) y[j] = X[17 * b + 16 * (b >> 5) + j];
        dft_regs<16, false>(y);
        f32x4* dst = (f32x4*)(HS + 16 * b);
#pragma unroll
        for (int k = 0; k < 8; ++k) dst[k] = (f32x4){y[2 * k].x * sc, y[2 * k].y * sc, y[2 * k + 1].x * sc, y[2 * k + 1].y * sc}; }
}
__device__ __forceinline__ void p_spectra(Frame& F) { PHASE_TID(); (void)tid; for (int it = bid; it < 2 * CH; it += F.G) hy_spectrum_item(F, it); __syncthreads(); }

struct RowRaw { v4u a, b; unsigned lo, hi; };
__device__ __forceinline__ void hy_row_load(RowRaw& R, const bf16* row, int t0) {
    R.a = *(const v4u*)(row + t0); R.b = *(const v4u*)(row + t0 + 8);
    R.lo = t0 > 0 ? (unsigned)row[t0 - 1] : 0u; R.hi = t0 + 16 < T ? (unsigned)row[t0 + 16] : 0u;
}
__device__ __forceinline__ void hy_u16r(const RowRaw& R, float w0, float w1, float w2, float bias, float (&u)[16]) {
    float p[18];
    p[0] = __builtin_bit_cast(float, R.lo << 16); p[17] = __builtin_bit_cast(float, R.hi << 16);
    const unsigned w[8] = {R.a.x, R.a.y, R.a.z, R.a.w, R.b.x, R.b.y, R.b.z, R.b.w};
#pragma unroll
    for (int i = 0; i < 8; ++i) { p[1 + 2 * i] = bflo(w[i]); p[2 + 2 * i] = bfhi(w[i]); }
#pragma unroll
    for (int i = 0; i < 16; ++i) u[i] = w0 * p[i] + w1 * p[i + 1] + w2 * p[i + 2] + bias;
}
__device__ __forceinline__ void hy_pack_store(bf16* dst, const float (&y)[16]) {
    v4u o0, o1;
    o0.x = pk2(y[0], y[1]); o0.y = pk2(y[2], y[3]); o0.z = pk2(y[4], y[5]); o0.w = pk2(y[6], y[7]);
    o1.x = pk2(y[8], y[9]); o1.y = pk2(y[10], y[11]); o1.z = pk2(y[12], y[13]); o1.w = pk2(y[14], y[15]);
    *(v4u*)dst = o0; *(v4u*)(dst + 8) = o1;
}
__device__ __forceinline__ void hy_fft_item(Frame& F, int l, int item) {
    PHASE_TID(); const int c = item >> 2, bp = item & 3, t0 = 16 * tid, xb = 17 * tid + 16 * (tid >> 5);
    LAS f32x2* X = (LAS f32x2*)F.lds;
    bf16* PHT = (bf16*)(F.ws + WS_PHT);
    bf16* rx1a = PHT + ((size_t)(2 * bp) * HYP + c) * T; bf16* rx1b = rx1a + (size_t)HYP * T;
    bf16* rx2a = PHT + ((size_t)(2 * bp) * HYP + CH + c) * T; bf16* rx2b = rx2a + (size_t)HYP * T;
    const bf16* rva = PHT + ((size_t)(2 * bp) * HYP + 2 * CH + c) * T; const bf16* rvb = rva + (size_t)HYP * T;
    const float* cw = F.in[I_HCW] + (size_t)l * 3 * HYP; const float* cb = F.in[I_HCB] + (size_t)l * HYP;
    const float* skip = F.in[I_HSKIP] + (size_t)l * 2 * CH;
    const f32x2* H0 = (const f32x2*)(F.ws + WS_YMIX) + (size_t)c * FN; const f32x2* H1 = H0 + (size_t)CH * FN;
    __syncthreads();
    RowRaw va, vb, xa, xb2;
    hy_row_load(va, rva, t0); hy_row_load(vb, rvb, t0);
    const float vw0 = cw[2 * CH + c], vw1 = cw[HYP + 2 * CH + c], vw2 = cw[2 * HYP + 2 * CH + c], vbs = cb[2 * CH + c];
    const float x1w0 = cw[c], x1w1 = cw[HYP + c], x1w2 = cw[2 * HYP + c], x1bs = cb[c], x2w0 = cw[CH + c], x2w1 = cw[HYP + CH + c], x2w2 = cw[2 * HYP + CH + c], x2bs = cb[CH + c], s0 = skip[c], s1 = skip[CH + c];
    { float ua[16], ub[16];
      hy_u16r(va, vw0, vw1, vw2, vbs, ua); hy_u16r(vb, vw0, vw1, vw2, vbs, ub);
#pragma unroll
      for (int i = 0; i < 16; ++i) X[xb + i] = (f32x2){ua[i], ub[i]}; }
    hy_row_load(xa, rx1a, t0); hy_row_load(xb2, rx1b, t0);
    fft_conv(X, H0, tid);
    v4u z2a[2], z2b[2];
    { float ua[16], ub[16], za[16], zb[16];
      {
        hy_u16r(va, vw0, vw1, vw2, vbs, ua); hy_u16r(vb, vw0, vw1, vw2, vbs, ub);
#pragma unroll
        for (int i = 0; i < 16; ++i) { const f32x2 y = X[xb + i]; za[i] = y.x + s0 * ua[i]; zb[i] = y.y + s0 * ub[i]; } }
      hy_u16r(xa, x1w0, x1w1, x1w2, x1bs, ua); hy_u16r(xb2, x1w0, x1w1, x1w2, x1bs, ub);
#pragma unroll
      for (int i = 0; i < 16; ++i) { za[i] *= ua[i]; zb[i] *= ub[i]; }
#pragma unroll
      for (int q = 0; q < 2; ++q) { z2a[q].x = pk2(za[8 * q], za[8 * q + 1]); z2a[q].y = pk2(za[8 * q + 2], za[8 * q + 3]); z2a[q].z = pk2(za[8 * q + 4], za[8 * q + 5]); z2a[q].w = pk2(za[8 * q + 6], za[8 * q + 7]);
                                    z2b[q].x = pk2(zb[8 * q], zb[8 * q + 1]); z2b[q].y = pk2(zb[8 * q + 2], zb[8 * q + 3]); z2b[q].z = pk2(zb[8 * q + 4], zb[8 * q + 5]); z2b[q].w = pk2(zb[8 * q + 6], zb[8 * q + 7]); }
#pragma unroll
      for (int i = 0; i < 16; ++i) X[xb + i] = (f32x2){za[i], zb[i]}; }
    hy_row_load(xa, rx2a, t0); hy_row_load(xb2, rx2b, t0);
    fft_conv(X, H1, tid);
    { float ua[16], ub[16];
      hy_u16r(xa, x2w0, x2w1, x2w2, x2bs, ua); hy_u16r(xb2, x2w0, x2w1, x2w2, x2bs, ub);
      float za[16], zb[16];
      const unsigned wa[8] = {z2a[0].x, z2a[0].y, z2a[0].z, z2a[0].w, z2a[1].x, z2a[1].y, z2a[1].z, z2a[1].w}, wb[8] = {z2b[0].x, z2b[0].y, z2b[0].z, z2b[0].w, z2b[1].x, z2b[1].y, z2b[1].z, z2b[1].w};
#pragma unroll
      for (int i = 0; i < 8; ++i) { za[2 * i] = bflo(wa[i]); za[2 * i + 1] = bfhi(wa[i]); zb[2 * i] = bflo(wb[i]); zb[2 * i + 1] = bfhi(wb[i]); }
#pragma unroll
      for (int i = 0; i < 16; ++i) { const f32x2 y = X[xb + i]; za[i] = ua[i] * (y.x + s1 * za[i]); zb[i] = ub[i] * (y.y + s1 * zb[i]); }
      hy_pack_store(rx2a + t0, za); hy_pack_store(rx2b + t0, zb); }
}
typedef short bf16x8 __attribute__((ext_vector_type(8)));
constexpr int CL_ = 64;
constexpr int LDB = 80;
constexpr int LDSG = 144, LDVL = 48;
constexpr int LDF = 65;
constexpr int MB = 64 * LDB * 2;
constexpr int MF = 64 * LDF * 4;
constexpr int O_AH = 0, O_AHT = MB, O_RH = 2 * MB, O_BH = 3 * MB, O_BHT = 4 * MB, O_KH = 5 * MB, O_KHT = 6 * MB, O_VT = 7 * MB;
constexpr int O_TW = 0, O_AD = MB, O_SG = 2 * MB  , O_VL = 2 * MB + 64 * LDSG * 2  ;
constexpr int O_APB = O_KH;
constexpr int O_F = 8 * MB;
constexpr int O_AF = O_F, O_LW = O_F + MF, O_ZV = O_F + 2 * MF;
constexpr int O_XA = O_F, O_XAT = O_F + MB, O_AAK = O_F + 2 * MB, O_ARB = O_F + 3 * MB, O_ARK = O_F + 4 * MB;
constexpr int O_S0B = O_F + ((3 * MF > 5 * MB) ? 3 * MF : 5 * MB);
constexpr int O_UT = O_S0B + MB;
constexpr int O_TB = O_UT, O_M1T = O_BH, O_T0T = O_AH, O_WT = O_KH;
constexpr int O_PL = O_UT + MB;
constexpr int O_PART = O_PL + 256;
constexpr int O_MU = O_PART + 2048;
constexpr int O_CK = O_MU + 1792;
constexpr int O_MC = O_CK + 768;
static_assert(O_ARK + MB <= O_S0B && O_ZV + MF <= O_S0B && O_VL + 64 * LDVL * 2 <= O_F && O_MC + 1792 <= LDSCTL_OFF, "cscan LDS map");

__device__ __forceinline__ unsigned pk2s(float v) { return pk2(v, v); }
#define MFMA16(a, b, c) __builtin_amdgcn_mfma_f32_16x16x32_bf16((a), (b), (c), 0, 0, 0)
__device__ __forceinline__ bf16x8 ldfrag(const LAS unsigned char* base, int ld, int row0, int k0, int fr, int fq) {
    return *(const LAS bf16x8*)(base + ((row0 + fr) * ld + k0 + 8 * fq) * 2);
}
__device__ __forceinline__ void st_tile_bf16(LAS unsigned char* base, int ld, int m0, int n0, int fr, int fq, const f32x4& v) {
#pragma unroll
    for (int jj = 0; jj < 4; ++jj) *(LAS bf16*)(base + ((m0 + 4 * fq + jj) * ld + n0 + fr) * 2) = (bf16)pk2s(v[jj]);
}
__device__ __forceinline__ void st_tile_bf16_T(LAS unsigned char* base, int ld, int m0, int n0, int fr, int fq, const f32x4& v) {
    v2u o; o.x = pk2(v[0], v[1]); o.y = pk2(v[2], v[3]);
    *(LAS v2u*)(base + ((n0 + fr) * ld + m0 + 4 * fq) * 2) = o;
}
#define CFENCE() asm volatile("" ::: "memory")
#define ZFRAG ((bf16x8){0, 0, 0, 0, 0, 0, 0, 0})
__device__ __forceinline__ void ldA(bf16x8 (&a)[2], const LAS unsigned char* A, int mt, int fr, int fq) {
#pragma unroll
    for (int ks = 0; ks < 2; ++ks) a[ks] = ldfrag(A, LDB, 16 * mt, 32 * ks, fr, fq);
}
__device__ __forceinline__ void ldB(bf16x8 (&b)[2][2], const LAS unsigned char* B, int nt0, int fr, int fq) {
#pragma unroll
    for (int ks = 0; ks < 2; ++ks)
#pragma unroll
        for (int j = 0; j < 2; ++j) b[ks][j] = ldfrag(B, LDB, 16 * (nt0 + j), 32 * ks, fr, fq);
}
#define PIN(x) asm volatile("" : "+v"(x))
__device__ __forceinline__ void mmac(bf16x8 (&a)[2], bf16x8 (&b)[2][2], f32x4 (&acc)[2]) {
#pragma unroll
    for (int ks = 0; ks < 2; ++ks) { PIN(a[ks]);
#pragma unroll
        for (int j = 0; j < 2; ++j) { PIN(b[ks][j]); acc[j] = MFMA16(a[ks], b[ks][j], acc[j]); } }
}
__device__ __forceinline__ void mmacT(bf16x8 (&a)[2], bf16x8 (&b)[2][2], f32x4 (&acc)[2]) {
#pragma unroll
    for (int ks = 0; ks < 2; ++ks) { PIN(a[ks]);
#pragma unroll
        for (int j = 0; j < 2; ++j) { PIN(b[ks][j]); acc[j] = MFMA16(b[ks][j], a[ks], acc[j]); } }
}
__device__ __forceinline__ v4u pack8(const float (&v)[8]) { v4u o; o.x = pk2(v[0], v[1]); o.y = pk2(v[2], v[3]); o.z = pk2(v[4], v[5]); o.w = pk2(v[6], v[7]); return o; }
__device__ __forceinline__ bf16x8 wfrag(const float* W, int k0, int col, int fq) {
    float v[8];
#pragma unroll
    for (int e = 0; e < 8; ++e) v[e] = W[(size_t)(k0 + 8 * fq + e) * CH + col];
    return __builtin_bit_cast(bf16x8, pack8(v));
}

struct RawTok { v4u g[7][3]; };
__device__ __forceinline__ void load_raw(RawTok& R, const bf16* PRW, const bf16* VFIRST, int b, int tok, int hc, int ec, int d, int l, bool has_vl) {
    const size_t m = (size_t)b * T + tok; const v4u z = (v4u){0u, 0u, 0u, 0u};
    const int cols[7] = {hc + ec, CH + hc + ec, 2 * CH + hc + ec, 1536 + d * 64 + ec, 1664 + d * 64 + ec, 1792 + ec, 1856 + ec};
#pragma unroll
    for (int g = 0; g < 7; ++g) { if (g >= 5 && d != 0) { R.g[g][0] = z; R.g[g][1] = z; R.g[g][2] = z; continue; }
        const bf16* p = PRW + m * NRW + cols[g];
        R.g[g][1] = *(const v4u*)p; R.g[g][0] = *(const v4u*)(p - NRW); R.g[g][2] = *(const v4u*)(p + NRW); }
    if (__builtin_amdgcn_readfirstlane((int)__builtin_amdgcn_ballot_w64(tok == 0 || tok == T - 1) != 0 || (int)(__builtin_amdgcn_ballot_w64(tok == 0 || tok == T - 1) >> 32) != 0)) {
#pragma unroll
        for (int g = 0; g < 7; ++g) { R.g[g][0] = (tok == 0) ? z : R.g[g][0]; R.g[g][2] = (tok == T - 1) ? z : R.g[g][2]; } }
}
typedef __bf16 bf16x2v __attribute__((ext_vector_type(2)));
__device__ __forceinline__ void mix8r(const v4u (&r)[3], const LAS unsigned* mub, const LAS float* mcb, float (&out)[8]) {
    const v4u ma = *(const LAS v4u*)mub, mb = *(const LAS v4u*)(mub + 4); const f32x4 ca = *(const LAS f32x4*)mcb, cb = *(const LAS f32x4*)(mcb + 4);
    const unsigned mw[8] = {ma.x, ma.y, ma.z, ma.w, mb.x, mb.y, mb.z, mb.w}; const float mc[8] = {ca[0], ca[1], ca[2], ca[3], cb[0], cb[1], cb[2], cb[3]};
    const unsigned pw[4] = {r[0].x, r[0].y, r[0].z, r[0].w}, cw[4] = {r[1].x, r[1].y, r[1].z, r[1].w}, nw[4] = {r[2].x, r[2].y, r[2].z, r[2].w};
#pragma unroll
    for (int i = 0; i < 4; ++i) {
        const unsigned pn0 = __builtin_amdgcn_perm(nw[i], pw[i], 0x05040100u), pn1 = __builtin_amdgcn_perm(nw[i], pw[i], 0x07060302u);
        out[2 * i] = __builtin_amdgcn_fdot2_f32_bf16(__builtin_bit_cast(bf16x2v, pn0), __builtin_bit_cast(bf16x2v, mw[2 * i]), bflo(cw[i]) * mc[2 * i], false);
        out[2 * i + 1] = __builtin_amdgcn_fdot2_f32_bf16(__builtin_bit_cast(bf16x2v, pn1), __builtin_bit_cast(bf16x2v, mw[2 * i + 1]), bfhi(cw[i]) * mc[2 * i + 1], false); }
}
template <bool DO_T, bool DO_X, bool LAST> __device__ __forceinline__ void blk_stage(const LAS unsigned char* X, const LAS unsigned char* XT, const LAS unsigned char* TT, LAS unsigned char* To, LAS unsigned char* T0T,
                                                                                    LAS unsigned char* Xo, LAS unsigned char* XoT, int wave, int fr, int fq) {
    const int bk = wave >> 2, k0 = 32 * bk, m0 = k0 + 16 * ((wave >> 1) & 1), n0 = k0 + 16 * (wave & 1);
    bf16x8 a = ldfrag(X, LDB, m0, k0, fr, fq), tb = a, xb = a; v2u tw = (v2u){0u, 0u};
    if (DO_T) { tb = ldfrag(TT, LDB, n0, k0, fr, fq); tw = *(const LAS v2u*)(TT + ((n0 + fr) * LDB + m0 + 4 * fq) * 2); }
    if (DO_X) xb = ldfrag(XT, LDB, n0, k0, fr, fq);
    CFENCE();
    PIN(a);
    if (DO_T) { f32x4 ta = (f32x4){bflo(tw.x), bfhi(tw.x), bflo(tw.y), bfhi(tw.y)}; PIN(tb); ta = MFMA16(a, tb, ta);
        if (LAST) { st_tile_bf16(To, LDB, m0, n0, fr, fq, ta); if (bk == 0) st_tile_bf16_T(T0T, LDB, m0, n0, fr, fq, ta); }
        else st_tile_bf16_T(To, LDB, m0, n0, fr, fq, ta); }
    if (DO_X) { f32x4 xa = (f32x4){0.f, 0.f, 0.f, 0.f}; PIN(xb); xa = MFMA16(a, xb, xa);
        st_tile_bf16(Xo, LDB, m0, n0, fr, fq, xa); st_tile_bf16_T(XoT, LDB, m0, n0, fr, fq, xa); }
}

__device__ __forceinline__ bf16x8 pack2(const f32x4& lo, const f32x4& hi) { v4u p; p.x = pk2(lo[0], lo[1]); p.y = pk2(lo[2], lo[3]); p.z = pk2(hi[0], hi[1]); p.w = pk2(hi[2], hi[3]); return __builtin_bit_cast(bf16x8, p); }
__device__ __forceinline__ void inv_block_regs(LAS unsigned char* L, int bk, int fr, int fq) {
    const int k0 = 32 * bk; const f32x4 z4 = (f32x4){0.f, 0.f, 0.f, 0.f};
    const bf16x8 fa0 = ldfrag(L + O_XA, LDB, k0, k0, fr, fq), fa1 = ldfrag(L + O_XA, LDB, k0 + 16, k0, fr, fq), fb0 = ldfrag(L + O_XAT, LDB, k0, k0, fr, fq), fb1 = ldfrag(L + O_XAT, LDB, k0 + 16, k0, fr, fq);
    f32x4 t00, t10, t11;
    { const v2u w00 = *(const LAS v2u*)(L + O_UT + ((k0 + fr) * LDB + k0 + 4 * fq) * 2), w10 = *(const LAS v2u*)(L + O_UT + ((k0 + fr) * LDB + k0 + 16 + 4 * fq) * 2), w11 = *(const LAS v2u*)(L + O_UT + ((k0 + 16 + fr) * LDB + k0 + 16 + 4 * fq) * 2);
      t00 = (f32x4){bflo(w00.x), bfhi(w00.x), bflo(w00.y), bfhi(w00.y)}; t10 = (f32x4){bflo(w10.x), bfhi(w10.x), bflo(w10.y), bfhi(w10.y)}; t11 = (f32x4){bflo(w11.x), bfhi(w11.x), bflo(w11.y), bfhi(w11.y)}; }
    CFENCE();
    f32x4 x00 = MFMA16(fa0, fb0, z4), x10 = MFMA16(fa1, fb0, z4), x11 = MFMA16(fa1, fb1, z4);
    f32x4 y00 = MFMA16(fb0, fa0, z4), y01 = MFMA16(fb0, fa1, z4), y11 = MFMA16(fb1, fa1, z4);
#pragma unroll
    for (int st = 0; st < 4; ++st) {
        const bf16x8 px0 = pack2(x00, x10), px1 = pack2(z4, x11), py0 = pack2(y00, z4), py1 = pack2(y01, y11), pt0 = pack2(t00, t10), pt1 = pack2(z4, t11);
        t00 = MFMA16(py0, pt0, t00); t10 = MFMA16(py1, pt0, t10); t11 = MFMA16(py1, pt1, t11);
        if (st < 3) {
            const f32x4 n00 = MFMA16(py0, px0, z4), n10 = MFMA16(py1, px0, z4), n11 = MFMA16(py1, px1, z4);
            const f32x4 m00 = MFMA16(px0, py0, z4), m01 = MFMA16(px0, py1, z4), m11 = MFMA16(px1, py1, z4);
            x00 = n00; x10 = n10; x11 = n11; y00 = m00; y01 = m01; y11 = m11; }
    }
    st_tile_bf16(L + O_TB, LDB, k0, k0, fr, fq, t00); st_tile_bf16(L + O_TB, LDB, k0 + 16, k0, fr, fq, t10); st_tile_bf16(L + O_TB, LDB, k0 + 16, k0 + 16, fr, fq, t11); st_tile_bf16(L + O_TB, LDB, k0, k0 + 16, fr, fq, z4);
    if (bk == 0) { st_tile_bf16_T(L + O_T0T, LDB, 0, 0, fr, fq, t00); st_tile_bf16_T(L + O_T0T, LDB, 16, 0, fr, fq, t10); st_tile_bf16_T(L + O_T0T, LDB, 16, 16, fr, fq, t11); st_tile_bf16_T(L + O_T0T, LDB, 0, 16, fr, fq, z4); }
}

template <int HH> __device__ __forceinline__ void m2_half(LAS unsigned char* L, int q, int fr, int fq) {
    const LAS unsigned char* Am = L + ((q < 2) ? O_AH : O_RH); const LAS unsigned char* Bm = L + ((q & 1) ? O_KH : O_BH);
    LAS unsigned char* Om = L + (q == 0 ? O_XA : (q == 1 ? O_AAK : (q == 2 ? O_ARB : O_ARK)));
    constexpr int MT0 = HH ? 1 : 0, MT1 = HH ? 2 : 3, NB = MT1 + 1;
    unsigned zz_ = 0u; asm volatile("" : "+v"(zz_)); const v2u z2 = (v2u){zz_, zz_};
    bf16x8 a[2][2], b[NB][2];
#pragma unroll
    for (int ks = 0; ks < 2; ++ks) { a[0][ks] = ldfrag(Am, LDB, 16 * MT0, 32 * ks, fr, fq); a[1][ks] = ldfrag(Am, LDB, 16 * MT1, 32 * ks, fr, fq); }
#pragma unroll
    for (int nt = 0; nt < NB; ++nt)
#pragma unroll
        for (int ks = 0; ks < 2; ++ks) b[nt][ks] = ldfrag(Bm, LDB, 16 * nt, 32 * ks, fr, fq);
    CFENCE();
#pragma unroll
    for (int mi = 0; mi < 2; ++mi) { const int mtile = mi ? MT1 : MT0;
        PIN(a[mi][0]); PIN(a[mi][1]);
#pragma unroll
        for (int nt = 0; nt < 4; ++nt) {
            if (nt > mtile) {
                *(LAS v2u*)(Om + ((16 * mtile + fr) * LDB + 16 * nt + 4 * fq) * 2) = z2;
                if (q == 0) { *(LAS v2u*)(L + O_XAT + ((16 * nt + fr) * LDB + 16 * mtile + 4 * fq) * 2) = z2; *(LAS v2u*)(L + O_UT + ((16 * nt + fr) * LDB + 16 * mtile + 4 * fq) * 2) = z2; }
                continue; }
            if (mi == 0) { PIN(b[nt][0]); PIN(b[nt][1]); }
            f32x4 at = (f32x4){0.f, 0.f, 0.f, 0.f};
            at = MFMA16(b[nt][0], a[mi][0], at); at = MFMA16(b[nt][1], a[mi][1], at);
            if (nt == mtile) {
#pragma unroll
                for (int jj = 0; jj < 4; ++jj) { const bool keep = (q < 2) ? (4 * fq + jj < fr) : (4 * fq + jj <= fr); if (!keep) at[jj] = 0.f; } }
            { v2u o; o.x = pk2(at[0], at[1]); o.y = pk2(at[2], at[3]); *(LAS v2u*)(Om + ((16 * mtile + fr) * LDB + 16 * nt + 4 * fq) * 2) = o; }
            if ((mtile >> 1) == (nt >> 1)) {
                if (q == 0) { f32x4 an = (f32x4){0.f, 0.f, 0.f, 0.f};
                    an = MFMA16(a[mi][0], b[nt][0], an); an = MFMA16(a[mi][1], b[nt][1], an);
                    f32x4 t1 = an;
                    if (nt == mtile) {
#pragma unroll
                        for (int jj = 0; jj < 4; ++jj) { if (!(fr < 4 * fq + jj)) an[jj] = 0.f; t1[jj] = (fr == 4 * fq + jj) ? 1.0f : an[jj]; } }
                    st_tile_bf16_T(L + O_XAT, LDB, 16 * mtile, 16 * nt, fr, fq, an);
                    st_tile_bf16_T(L + O_UT, LDB, 16 * mtile, 16 * nt, fr, fq, t1); } }
        } }
}

__device__ __forceinline__ void cscan_chain(Frame& F, int l, int unit) {
    PHASE_TID(); const int chain = unit >> 1, seg = unit & 1; const int b = chain >> 4, h = (chain >> 1) & 7, d = chain & 1, hc = h * HD;
    const int fr_o = lane & 15, fq_o = lane >> 4;
    LAS unsigned char* L = F.lds;
    const bf16* PRW = (const bf16*)(F.ws + WS_PRW);
    const float* mu = F.in[I_SHIFT] + (size_t)l * 2 * RWP;
    const bf16* VFIRST = (const bf16*)(F.ws + WS_VFIRST);
    bf16* VOUT = (l == 0) ? (bf16*)(F.ws + WS_VFIRST) : (bf16*)(F.ws + WS_V2);
    bf16* GOUT = (bf16*)(F.ws + WS_G);
    bf16* YS = (bf16*)(F.ws + WS_YS) + (size_t)d * M * CH;
    float* BS = (float*)(F.ws + WS_BS) + (size_t)d * M * NH;
    bf16* YPHI = (bf16*)(F.ws + WS_YPHI) + (size_t)chain * (T / 2) * 64;
    const int lnt = wave & 3, lmt0 = 2 * (wave >> 2);
    if (wave < 4) { const int lcol = hc + 16 * lnt + fr_o; bf16x8* FRAGS = (bf16x8*)(F.ws + WS_FRAG) + ((size_t)chain * 4 + lnt) * 9 * 64 + lane; const float* w2 = F.in[I_W2] + (size_t)(l * 2 + d) * 64 * CH; const float* a2 = F.in[I_A2] + (size_t)(l * 2 + d) * 64 * CH; const float* g2 = F.in[I_G2] + (size_t)l * 128 * CH;
#pragma unroll
      for (int ks = 0; ks < 2; ++ks) { FRAGS[ks * 64] = wfrag(w2, 32 * ks, lcol, fq_o); FRAGS[(2 + ks) * 64] = wfrag(a2, 32 * ks, lcol, fq_o); }
      if (l == 1) FRAGS[4 * 64] = wfrag(F.in[I_V2], 0, lcol, fq_o);
#pragma unroll
      for (int ks = 0; ks < 4; ++ks) if (d == 0) FRAGS[(5 + ks) * 64] = wfrag(g2, 32 * ks, lcol, fq_o); }
    const int lcol_o = hc + 16 * lnt + fr_o;
    const float lc_w0 = F.in[I_W0][(l * 2 + d) * CH + lcol_o], lc_a0 = F.in[I_A0][(l * 2 + d) * CH + lcol_o], lc_v0 = (l == 1) ? F.in[I_V0][lcol_o] : 0.f;
    const int mt = wave >> 1, nt0 = 2 * (wave & 1);
    f32x4 S[2] = {(f32x4){0.f, 0.f, 0.f, 0.f}, (f32x4){0.f, 0.f, 0.f, 0.f}};
    f32x4 Ph[2];
#pragma unroll
    for (int j = 0; j < 2; ++j)
#pragma unroll
        for (int jj = 0; jj < 4; ++jj) Ph[j][jj] = (16 * mt + 4 * fq_o + jj == 16 * (nt0 + j) + fr_o) ? 1.0f : 0.f;
    __syncthreads();
    for (int e = tid; e < MB / 4; e += NTHR) ((LAS unsigned*)(L + O_S0B))[e] = 0u;
    if (tid < 448) { const int g = tid >> 6, j = tid & 63; const int col = (g < 3) ? g * CH + hc + j : (g == 3 ? 1536 + d * 64 + j : (g == 4 ? 1664 + d * 64 + j : 1792 + (tid - 320)));
        const unsigned pm = pk2(mu[col], mu[RWP + col]); ((LAS unsigned*)(L + O_MU))[tid] = pm; ((LAS float*)(L + O_MC))[tid] = 1.0f - bflo(pm) - bfhi(pm); }
    if (tid < 192) { const int g = tid >> 6, j = tid & 63; ((LAS float*)(L + O_CK))[tid] = F.in[g == 0 ? I_KK : (g == 1 ? I_KA : I_RK)][l * CH + hc + j]; }
    RawTok raw;
    { const int et0 = tid >> 3, ec0 = (tid & 7) * 8; const int cf = (d == 0) ? seg * 64 * CL_ : (127 - seg * 64) * CL_; load_raw(raw, PRW, VFIRST, b, (d == 0) ? cf + et0 : cf + 63 - et0, hc, ec0, d, l, (tid & 7) < 4); }
#pragma unroll 1
    for (int ci = 0; ci < T / CL_ / 2; ++ci) {
        int tid = (wave << 6) | (int)__builtin_amdgcn_mbcnt_hi(~0u, __builtin_amdgcn_mbcnt_lo(~0u, 0u)); asm volatile("" : "+v"(tid));
        const int lane = tid & 63, fr = lane & 15, fq = lane >> 4, et = tid >> 3, ec = (tid & 7) * 8;
        const int lcol = hc + 16 * lnt + fr;
        const unsigned char* FRB = F.ws + WS_FRAG + (((size_t)chain * 4 + lnt) * 9 * 64) * 16; unsigned fo = (unsigned)lane * 16u;
#define FRAGS_(k) (*(const bf16x8*)(FRB + fo + (k) * 1024))
        int c0 = (d == 0 ? seg * 64 + ci : 127 - seg * 64 - ci) * CL_; asm volatile("" : "+s"(c0));
        const int tok = (d == 0) ? c0 + et : c0 + 63 - et;
        const size_t m = (size_t)b * T + tok;
        __syncthreads();
        float rr[8], kr[8], vr[8];
        const LAS unsigned* MUB = (const LAS unsigned*)(L + O_MU) + ec; const LAS float* MCB = (const LAS float*)(L + O_MC) + ec;
        v4u vl4 = (v4u){0u, 0u, 0u, 0u}, vf4 = vl4;
        if (l == 1 && (tid & 7) < 4) vl4 = *(const v4u*)(PRW + m * NRW + RWP + ec);
        bf16x8 wf[5];
        {
          if (d == 0) { float g0[8], g1[8];
              mix8r(raw.g[5], MUB + 320, MCB + 320, g0); CFENCE(); mix8r(raw.g[6], MUB + 384, MCB + 384, g1); CFENCE();
#pragma unroll
              for (int e = 0; e < 8; ++e) { g0[e] = sigmoidf_(g0[e]); g1[e] = sigmoidf_(g1[e]); }
              *(LAS v4u*)(L + O_SG + (et * LDSG + ec) * 2) = pack8(g0); *(LAS v4u*)(L + O_SG + (et * LDSG + 64 + ec) * 2) = pack8(g1); }
          float xw[8], xa[8];
          mix8r(raw.g[3], MUB + 192, MCB + 192, xw); CFENCE(); mix8r(raw.g[4], MUB + 256, MCB + 256, xa);
          asm volatile("" : "+v"(fo) : "v"(xw[7]), "v"(xa[7]));
          wf[0] = FRAGS_(0); wf[1] = FRAGS_(1); wf[2] = FRAGS_(2); wf[3] = FRAGS_(3); wf[4] = ZFRAG; if (l == 1) wf[4] = FRAGS_(4);
          CFENCE();
#pragma unroll
          for (int e = 0; e < 8; ++e) xw[e] = tanhf_(xw[e]);
          *(LAS v4u*)(L + O_TW + (et * LDB + ec) * 2) = pack8(xw);
          *(LAS v4u*)(L + O_AD + (et * LDB + ec) * 2) = pack8(xa);
          mix8r(raw.g[0], MUB, MCB, rr); CFENCE(); mix8r(raw.g[1], MUB + 64, MCB + 64, kr); CFENCE(); mix8r(raw.g[2], MUB + 128, MCB + 128, vr);
          if (l == 1 && (tid & 7) < 4) *(LAS v4u*)(L + O_VL + (et * LDVL + ec) * 2) = vl4;
          if (l == 1) vf4 = *(const v4u*)(VFIRST + m * CH + hc + ec); }
        __syncthreads();
        { bf16x8 gf[4];
          gf[0] = ZFRAG; gf[1] = ZFRAG; gf[2] = ZFRAG; gf[3] = ZFRAG;
          if (d == 0) { gf[0] = FRAGS_(5); gf[1] = FRAGS_(6); gf[2] = FRAGS_(7); gf[3] = FRAGS_(8); }
#pragma unroll
          for (int mi = 0; mi < 2; ++mi) { const int m0 = 16 * (lmt0 + mi);
              bf16x8 tw[2], ad[2], vl;
#pragma unroll
              for (int ks = 0; ks < 2; ++ks) { tw[ks] = ldfrag(L + O_TW, LDB, m0, 32 * ks, fr, fq); ad[ks] = ldfrag(L + O_AD, LDB, m0, 32 * ks, fr, fq); }
              vl = ZFRAG; if (l == 1) vl = ldfrag(L + O_VL, LDVL, m0, 0, fr, fq);
              CFENCE();
              f32x4 zw = (f32x4){0.f, 0.f, 0.f, 0.f}, za = zw, zv = zw;
#pragma unroll
              for (int ks = 0; ks < 2; ++ks) { PIN(tw[ks]); zw = MFMA16(tw[ks], wf[ks], zw); PIN(ad[ks]); za = MFMA16(ad[ks], wf[2 + ks], za); }
              if (l == 1) { PIN(vl); zv = MFMA16(vl, wf[4], zv); }
#pragma unroll
              for (int jj = 0; jj < 4; ++jj) { const int s = m0 + 4 * fq + jj, o = (s * LDF + 16 * lnt + fr) * 4;
                  *(LAS float*)(L + O_AF + o) = sigmoidf_(za[jj] + lc_a0);
                  *(LAS float*)(L + O_LW + o) = -0.6065306597126334f * sigmoidf_(zw[jj] + lc_w0); }
              if (l == 1) {
#pragma unroll
                  for (int jj = 0; jj < 4; ++jj) { const int s = m0 + 4 * fq + jj, o = (s * LDF + 16 * lnt + fr) * 4; *(LAS float*)(L + O_ZV + o) = sigmoidf_(zv[jj] + lc_v0); } } }
          if (d == 0) {
#pragma unroll
              for (int mi = 0; mi < 2; ++mi) { const int m0 = 16 * (lmt0 + mi);
                  bf16x8 sg[4];
#pragma unroll
                  for (int ks = 0; ks < 4; ++ks) sg[ks] = ldfrag(L + O_SG, LDSG, m0, 32 * ks, fr, fq);
                  CFENCE();
                  f32x4 zg = (f32x4){0.f, 0.f, 0.f, 0.f};
#pragma unroll
                  for (int ks = 0; ks < 4; ++ks) { PIN(sg[ks]); zg = MFMA16(gf[ks], sg[ks], zg); }
                  { v2u o; o.x = pk2(zg[0], zg[1]); o.y = pk2(zg[2], zg[3]); *(v2u*)(GOUT + ((size_t)b * T + c0 + m0 + fr) * CH + hc + 16 * lnt + 4 * fq) = o; } } } }
        __syncthreads();
        { const int j = tid & 63, sg = tid >> 6; float c[8]; float run = 0.f;
#pragma unroll
          for (int i = 0; i < 8; ++i) { run += *(LAS float*)(L + O_LW + ((8 * sg + i) * LDF + j) * 4); c[i] = run; }
          *(LAS float*)(L + O_PART + (sg * 64 + j) * 4) = run;
          __syncthreads();
          float pre = 0.f;
#pragma unroll
          for (int q = 0; q < 8; ++q) { const float pv = *(LAS float*)(L + O_PART + (q * 64 + j) * 4); pre += (q < sg) ? pv : 0.f; }
#pragma unroll
          for (int i = 0; i < 8; ++i) *(LAS float*)(L + O_LW + ((8 * sg + i) * LDF + j) * 4) = c[i] + pre; }
        __syncthreads();
        { float kkr[8], av[8], cl[8], clm[8], zv[8], kd[8], ss = 0.f, bon = 0.f;
          const unsigned vfw[4] = {vf4.x, vf4.y, vf4.z, vf4.w};
          const LAS float* CKT = (const LAS float*)(L + O_CK) + ec;
          const f32x4 kka = *(const LAS f32x4*)CKT, kkb = *(const LAS f32x4*)(CKT + 4), kaa = *(const LAS f32x4*)(CKT + 64), kab = *(const LAS f32x4*)(CKT + 68), rka = *(const LAS f32x4*)(CKT + 128), rkb = *(const LAS f32x4*)(CKT + 132);
          const int o0 = (et * LDF + ec) * 4, om = (et > 0) ? o0 - LDF * 4 : o0;
#pragma unroll
          for (int e = 0; e < 8; ++e) { av[e] = *(LAS float*)(L + O_AF + o0 + 4 * e); cl[e] = *(LAS float*)(L + O_LW + o0 + 4 * e); clm[e] = *(LAS float*)(L + O_LW + om + 4 * e); zv[e] = 0.f; }
          if (l == 1) {
#pragma unroll
              for (int e = 0; e < 8; ++e) zv[e] = *(LAS float*)(L + O_ZV + o0 + 4 * e); }
          CFENCE();
          const float ckk[8] = {kka[0], kka[1], kka[2], kka[3], kkb[0], kkb[1], kkb[2], kkb[3]}, cka[8] = {kaa[0], kaa[1], kaa[2], kaa[3], kab[0], kab[1], kab[2], kab[3]},
                      crk[8] = {rka[0], rka[1], rka[2], rka[3], rkb[0], rkb[1], rkb[2], rkb[3]};
#pragma unroll
          for (int e = 0; e < 8; ++e) {
              const float vf = (e & 1) ? bfhi(vfw[e >> 1]) : bflo(vfw[e >> 1]); vr[e] = vr[e] + (vf - vr[e]) * zv[e];
              kkr[e] = kr[e] * ckk[e]; ss += kkr[e] * kkr[e];
              kd[e] = kr[e] * (1.0f + (av[e] - 1.0f) * cka[e]); bon += rr[e] * kd[e] * crk[e]; }
          ss = sum8(ss); bon = sum8(bon);
          const float inv = __builtin_amdgcn_rsqf(fmaxf(ss, 1e-24f));
          if ((tid & 7) == 0) BS[m * NH + h] = bon;
          if (d == 0) *(v4u*)(VOUT + m * CH + hc + ec) = pack8(vr);
          float ah[8], bh[8], kh[8], rh[8], Pv[8];
#pragma unroll
          for (int e = 0; e < 8; ++e) {
              const float P = __expf(cl[e]), Pi = __builtin_amdgcn_rcpf(P), Pm = (et > 0) ? __expf(clm[e]) : 1.0f, kk = kkr[e] * inv;
              ah[e] = -kk * Pm; bh[e] = kk * av[e] * Pi; kh[e] = kd[e] * Pi; rh[e] = rr[e] * P; Pv[e] = P; }
          if (et == 63) { *(LAS f32x4*)(L + O_PL + ec * 4) = (f32x4){Pv[0], Pv[1], Pv[2], Pv[3]}; *(LAS f32x4*)(L + O_PL + ec * 4 + 16) = (f32x4){Pv[4], Pv[5], Pv[6], Pv[7]}; }
          *(LAS v4u*)(L + O_AH + (et * LDB + ec) * 2) = pack8(ah); *(LAS v4u*)(L + O_BH + (et * LDB + ec) * 2) = pack8(bh);
          *(LAS v4u*)(L + O_KH + (et * LDB + ec) * 2) = pack8(kh); *(LAS v4u*)(L + O_RH + (et * LDB + ec) * 2) = pack8(rh);
          { unsigned pab[8], pkv[8]; const int c = tid & 7;
#pragma unroll
            for (int e = 0; e < 8; ++e) { pab[e] = pk2(ah[e], bh[e]); pkv[e] = pk2(kh[e], vr[e]); }
#pragma unroll
            for (int sh = 1; sh < 8; sh <<= 1) { const bool on = (c & sh) != 0; unsigned ta[8], tk[8];
#pragma unroll
                for (int e = 0; e < 8; ++e) { ta[e] = on ? pab[(e + sh) & 7] : pab[e]; tk[e] = on ? pkv[(e + sh) & 7] : pkv[e]; }
#pragma unroll
                for (int e = 0; e < 8; ++e) { pab[e] = ta[e]; pkv[e] = tk[e]; } }
#pragma unroll
            for (int e = 0; e < 8; ++e) { const int o = ((ec + ((e + c) & 7)) * LDB + et) * 2;
                *(LAS bf16*)(L + O_AHT + o) = (bf16)(pab[e] & 0xffffu); *(LAS bf16*)(L + O_BHT + o) = (bf16)(pab[e] >> 16);
                *(LAS bf16*)(L + O_KHT + o) = (bf16)(pkv[e] & 0xffffu); *(LAS bf16*)(L + O_VT + o) = (bf16)(pkv[e] >> 16); } } }
        __syncthreads();
        { if (wave & 1) m2_half<1>(L, wave >> 1, fr, fq); else m2_half<0>(L, wave >> 1, fr, fq); }
        __syncthreads();
        if (ci + 1 < T / CL_ / 2) { const int c0n = (d == 0) ? c0 + CL_ : c0 - CL_; load_raw(raw, PRW, VFIRST, b, (d == 0) ? c0n + et : c0n + 63 - et, hc, ec, d, l, (tid & 7) < 4); }
        if (wave < 2) inv_block_regs(L, wave, fr, fq);
        __syncthreads();
        { if (wave < 4) { const int bmt = (wave >> 1) & 1, bnt = wave & 1;
            bf16x8 a0 = ldfrag(L + O_XA, LDB, 32, 0, fr, fq), a1 = ldfrag(L + O_XA, LDB, 48, 0, fr, fq), t1b = ldfrag(L + O_T0T, LDB, 16 * bnt, 0, fr, fq), t22 = ldfrag(L + O_TB, LDB, 32 + 16 * bmt, 32, fr, fq);
            const f32x4 z4 = (f32x4){0.f, 0.f, 0.f, 0.f};
            const f32x4 w0 = MFMA16(a0, t1b, z4), w1 = MFMA16(a1, t1b, z4);
            st_tile_bf16_T(L + O_WT, LDB, 0, 16 * bnt, fr, fq, w0); st_tile_bf16_T(L + O_WT, LDB, 16, 16 * bnt, fr, fq, w1);
            LDS_WAIT();
            const bf16x8 wb = ldfrag(L + O_WT, LDB, 16 * bnt, 0, fr, fq);
            const f32x4 t21 = MFMA16(t22, wb, z4);
            st_tile_bf16(L + O_TB, LDB, 32 + 16 * bmt, 16 * bnt, fr, fq, t21);
        } else { const int bmt = (wave >> 1) & 1, bnt = wave & 1;
            unsigned zz_ = 0u; asm volatile("" : "+v"(zz_)); *(LAS v2u*)(L + O_TB + ((16 * bmt + fr) * LDB + 32 + 16 * bnt + 4 * fq) * 2) = (v2u){zz_, zz_}; } }
        f32x4 y0[2] = {(f32x4){0.f, 0.f, 0.f, 0.f}, (f32x4){0.f, 0.f, 0.f, 0.f}}, g0[2] = {y0[0], y0[0]};
        { f32x4 m1[2] = {(f32x4){0.f, 0.f, 0.f, 0.f}, (f32x4){0.f, 0.f, 0.f, 0.f}};
          bf16x8 aak[2], ark[2], vta[2], vtb[2][2], khb[2][2];
          ldA(aak, L + O_AAK, mt, fr, fq); ldB(vtb, L + O_VT, nt0, fr, fq); ldA(ark, L + O_ARK, mt, fr, fq); ldA(vta, L + O_VT, mt, fr, fq); ldB(khb, L + O_KHT, nt0, fr, fq);
          CFENCE();
          mmac(aak, vtb, m1); mmacT(ark, vtb, y0); mmac(vta, khb, g0);
#pragma unroll
          for (int j = 0; j < 2; ++j) st_tile_bf16_T(L + O_M1T, LDB, 16 * mt, 16 * (nt0 + j), fr, fq, m1[j]); }
        __syncthreads();
        f32x4 u0[2] = {(f32x4){0.f, 0.f, 0.f, 0.f}, (f32x4){0.f, 0.f, 0.f, 0.f}};
        { f32x4 ap[2] = {u0[0], u0[0]};
          bf16x8 tba[2], ahb[2][2], m1b[2][2];
          ldA(tba, L + O_TB, mt, fr, fq); ldB(ahb, L + O_AHT, nt0, fr, fq); ldB(m1b, L + O_M1T, nt0, fr, fq);
          CFENCE();
          mmac(tba, ahb, ap); mmac(tba, m1b, u0);
#pragma unroll
          for (int j = 0; j < 2; ++j) st_tile_bf16(L + O_APB, LDB, 16 * mt, 16 * (nt0 + j), fr, fq, ap[j]);
          if (seg) {
#pragma unroll
              for (int j = 0; j < 2; ++j) st_tile_bf16(L + O_VT, LDB, 16 * mt, 16 * (nt0 + j), fr, fq, Ph[j]); } }
        __syncthreads();
        { bf16x8 apa[2], s0b[2][2], phb[2][2];
          ldA(apa, L + O_APB, mt, fr, fq); ldB(s0b, L + O_S0B, nt0, fr, fq); phb[0][0] = ZFRAG; phb[0][1] = ZFRAG; phb[1][0] = ZFRAG; phb[1][1] = ZFRAG; if (seg) ldB(phb, L + O_VT, nt0, fr, fq);
          CFENCE();
          mmac(apa, s0b, u0);
#pragma unroll
          for (int j = 0; j < 2; ++j) st_tile_bf16_T(L + O_UT, LDB, 16 * mt, 16 * (nt0 + j), fr, fq, u0[j]);
          if (seg) { f32x4 up[2] = {(f32x4){0.f, 0.f, 0.f, 0.f}, (f32x4){0.f, 0.f, 0.f, 0.f}};
              mmac(apa, phb, up);
#pragma unroll
              for (int j = 0; j < 2; ++j) st_tile_bf16_T(L + O_KHT, LDB, 16 * mt, 16 * (nt0 + j), fr, fq, up[j]); } }
        __syncthreads();
        { bf16x8 rha[2], arba[2], uta[2], s0b[2][2], utb[2][2], bhb[2][2]; float plv[2];
          ldA(rha, L + O_RH, mt, fr, fq); ldB(s0b, L + O_S0B, nt0, fr, fq); ldA(arba, L + O_ARB, mt, fr, fq); ldB(utb, L + O_UT, nt0, fr, fq);
#pragma unroll
          for (int j = 0; j < 2; ++j) plv[j] = *(LAS float*)(L + O_PL + (16 * (nt0 + j) + fr) * 4);
          CFENCE();
          mmacT(rha, s0b, y0);
          ldA(uta, L + O_UT, mt, fr, fq); ldB(bhb, L + O_BHT, nt0, fr, fq);
          CFENCE();
          mmacT(arba, utb, y0);
          { const int s = 16 * mt + fr; const int tk = (d == 0) ? c0 + s : c0 + 63 - s;
#pragma unroll
            for (int j = 0; j < 2; ++j) { v2u o; o.x = pk2(y0[j][0], y0[j][1]); o.y = pk2(y0[j][2], y0[j][3]); *(v2u*)(YS + ((size_t)b * T + tk) * CH + hc + 16 * (nt0 + j) + 4 * fq) = o; } }
          f32x4 sn[2] = {g0[0], g0[1]};
          mmac(uta, bhb, sn);
#pragma unroll
          for (int j = 0; j < 2; ++j) S[j] = (S[j] + sn[j]) * plv[j];
          if (seg) { f32x4 yp[2] = {(f32x4){0.f, 0.f, 0.f, 0.f}, (f32x4){0.f, 0.f, 0.f, 0.f}}, pn[2] = {yp[0], yp[0]};
              bf16x8 rh2[2], arb2[2], kha[2], phb[2][2], khb[2][2], bh2[2][2];
              ldA(rh2, L + O_RH, mt, fr, fq); ldB(phb, L + O_VT, nt0, fr, fq); ldA(arb2, L + O_ARB, mt, fr, fq); ldB(khb, L + O_KHT, nt0, fr, fq); ldA(kha, L + O_KHT, mt, fr, fq); ldB(bh2, L + O_BHT, nt0, fr, fq);
              CFENCE();
              mmacT(rh2, phb, yp);
              mmacT(arb2, khb, yp);
              { const int s = 16 * mt + fr; const int tk = (d == 0) ? c0 + s : c0 + 63 - s;
#pragma unroll
                for (int j = 0; j < 2; ++j) { v2u o; o.x = pk2(yp[j][0], yp[j][1]); o.y = pk2(yp[j][2], yp[j][3]); *(v2u*)(YPHI + (size_t)(tk & (T / 2 - 1)) * 64 + 16 * (nt0 + j) + 4 * fq) = o; } }
              mmac(kha, bh2, pn);
#pragma unroll
              for (int j = 0; j < 2; ++j) Ph[j] = (Ph[j] + pn[j]) * plv[j]; } }
        __syncthreads();
#pragma unroll
        for (int j = 0; j < 2; ++j) st_tile_bf16(L + O_S0B, LDB, 16 * mt, 16 * (nt0 + j), fr, fq, S[j]);
    }
    if (seg == 0) { float* SF = (float*)(F.ws + WS_SFIN) + (size_t)chain * 4096;
        int t2 = (int)__builtin_amdgcn_mbcnt_hi(~0u, __builtin_amdgcn_mbcnt_lo(~0u, 0u)); asm volatile("" : "+v"(t2)); const int fr2 = t2 & 15, fq2 = (t2 >> 4) & 3;
#pragma unroll
        for (int j = 0; j < 2; ++j)
#pragma unroll
            for (int jj = 0; jj < 4; ++jj) SF[(16 * mt + 4 * fq2 + jj) * 64 + 16 * (nt0 + j) + fr2] = S[j][jj]; }
    __syncthreads();
}


__device__ __forceinline__ void tr_item(const float* W, int ld, int col0, int nblk, int K, bf16* WT, int row_off, LAS float* scr, int item, int lane, const float* gain = nullptr) {
    const int kb = item / nblk, nb = item % nblk, k0 = 64 * kb, n0 = 32 * nb;
    float wv[32];
#pragma unroll
    for (int i = 0; i < 32; ++i) wv[i] = W[(size_t)(k0 + 2 * i + (lane >> 5)) * ld + col0 + n0 + (lane & 31)];
    if (gain) {
#pragma unroll
        for (int i = 0; i < 32; ++i) wv[i] *= gain[k0 + 2 * i + (lane >> 5)]; }
#pragma unroll
    for (int i = 0; i < 32; ++i) scr[(2 * i + (lane >> 5)) * 33 + (lane & 31)] = wv[i];
    LDS_WAIT(); asm volatile("" ::: "memory");
    const int c = lane & 7;
#pragma unroll
    for (int j = 0; j < 4; ++j) { const int n = (lane >> 3) + 8 * j; const LAS float* s = scr + (8 * c) * 33 + n;
        v4u o; o.x = pk2(s[0 * 33], s[1 * 33]); o.y = pk2(s[2 * 33], s[3 * 33]); o.z = pk2(s[4 * 33], s[5 * 33]); o.w = pk2(s[6 * 33], s[7 * 33]);
        *(v4u*)(WT + (size_t)(row_off + n0 + n) * K + k0 + 8 * c) = o; }
    LDS_WAIT(); asm volatile("" ::: "memory");
}
__device__ __forceinline__ void wq_max_item(const float* W, int ld, int col0, int nblk, unsigned* cmax, int item, int lane) {
    const int kb = item / nblk, nb = item % nblk, k0 = 64 * kb, n0 = 32 * nb; float am = 0.f;
#pragma unroll
    for (int i = 0; i < 32; ++i) am = fmaxf(am, fabsf(W[(size_t)(k0 + 2 * i + (lane >> 5)) * ld + col0 + n0 + (lane & 31)]));
    am = fmaxf(am, __shfl_xor(am, 32));
    if (lane < 32) atomicMax(cmax + n0 + lane, __float_as_uint(am));
}
__device__ __forceinline__ void wq_item(const float* W, int ld, int col0, int nblk, const unsigned* cmax, float* csc, unsigned char* WQ, int row_off, LAS float* scr, int item, int lane) {
    const int kb = item / nblk, nb = item % nblk, k0 = 64 * kb, n0 = 32 * nb;
    float wv[32];
#pragma unroll
    for (int i = 0; i < 32; ++i) wv[i] = W[(size_t)(k0 + 2 * i + (lane >> 5)) * ld + col0 + n0 + (lane & 31)];
#pragma unroll
    for (int i = 0; i < 32; ++i) scr[(2 * i + (lane >> 5)) * 33 + (lane & 31)] = wv[i];
    LDS_WAIT(); asm volatile("" ::: "memory");
    const int c = lane & 7;
#pragma unroll
    for (int j = 0; j < 4; ++j) { const int n = (lane >> 3) + 8 * j; const LAS float* sp = scr + (8 * c) * 33 + n;
        const float cm = __uint_as_float(cmax[n0 + n]), inv = cm > 0.f ? 127.0f / cm : 0.f;
        v2u o; o.x = q4(sp[0 * 33] * inv, sp[1 * 33] * inv, sp[2 * 33] * inv, sp[3 * 33] * inv); o.y = q4(sp[4 * 33] * inv, sp[5 * 33] * inv, sp[6 * 33] * inv, sp[7 * 33] * inv);
        *(v2u*)(WQ + (size_t)(row_off + n0 + n) * D + k0 + 8 * c) = o;
        if (kb == 0 && c == 0) csc[n0 + n] = cm * (1.0f / 127.0f); }
    LDS_WAIT(); asm volatile("" ::: "memory");
}
__device__ __forceinline__ void p_convert(Frame& F) {
    PHASE_TID();
    LAS float* scr = (LAS float*)(F.lds + wave * 16384);
    const int gw = bid * NWAVES + wave, NGW = F.G * NWAVES;
    constexpr int C_HY = 16 * 48, C_RW = 16 * 60, C_V1 = 16, C_O = 16 * 32, C_1 = 16 * 128, C_2 = 64 * 32, C_L = C_HY + C_RW + C_V1 + C_O + C_1 + C_2;
    for (int it = gw; it < NL * C_L; it += NGW) {
        const int l = it / C_L; int r = it % C_L;
        unsigned char* wb = F.ws + WS_W + (size_t)l * W_LAYER;
        const float* win = F.in[I_WIN] + (size_t)l * D * PIN;
        unsigned* cmax = F.ctl + CW_CMAX + l * (HYP + NRW);
        if (r < C_HY) { wq_max_item(win, PIN, 0, 48, cmax, r, lane); continue; } r -= C_HY;
        if (r < C_RW) { wq_max_item(win, PIN, HYP, 60, cmax + HYP, r, lane); continue; } r -= C_RW;
        if (r < C_V1) { if (l == 1) wq_max_item(F.in[I_V1], 32, 0, 1, cmax + HYP + RWP, r, lane); continue; } r -= C_V1;
        if (r < C_O) { tr_item(F.in[I_WOUT] + (size_t)l * D * D, D, 0, 32, D, (bf16*)(wb + W_O), 0, scr, r, lane); continue; } r -= C_O;
        if (r < C_1) { tr_item(F.in[I_MW1] + (size_t)l * D * FF, FF, 0, 128, D, (bf16*)(wb + W_1), 0, scr, r, lane, F.in[I_N2G] + (size_t)l * D); continue; } r -= C_1;
        tr_item(F.in[I_MW2] + (size_t)l * FF * D, D, 0, 32, FF, (bf16*)(wb + W_2), 0, scr, r, lane);
    }
}
__device__ __forceinline__ void p_wquant(Frame& F) {
    PHASE_TID();
    LAS float* scr = (LAS float*)(F.lds + wave * 16384);
    const int gw = bid * NWAVES + wave, NGW = F.G * NWAVES;
    constexpr int C_HY = 16 * 48, C_RW = 16 * 60, C_V1 = 16, C_L = C_HY + C_RW + C_V1;
    for (int it = gw; it < NL * C_L; it += NGW) {
        const int l = it / C_L; int r = it % C_L;
        unsigned char* wb = F.ws + WS_W + (size_t)l * W_LAYER;
        const float* win = F.in[I_WIN] + (size_t)l * D * PIN;
        const unsigned* cmax = F.ctl + CW_CMAX + l * (HYP + NRW); float* csc = (float*)(F.ws + WS_CSC) + l * (HYP + NRW);
        if (r < C_HY) { wq_item(win, PIN, 0, 48, cmax, csc, wb + W_HY, 0, scr, r, lane); continue; } r -= C_HY;
        if (r < C_RW) { wq_item(win, PIN, HYP, 60, cmax + HYP, csc + HYP, wb + W_RW, 0, scr, r, lane); continue; } r -= C_RW;
        if (l == 1) wq_item(F.in[I_V1], 32, 0, 1, cmax + HYP + RWP, csc + HYP + RWP, wb + W_RW, RWP, scr, r, lane);
    }
    for (int l = 0; l < NL; ++l) {
        const int r0 = (l == 0) ? RWP : RWP + 32; const int n16 = (NRW - r0) * D / 16;
        v4u* p = (v4u*)(F.ws + WS_W + (size_t)l * W_LAYER + W_RW + (size_t)r0 * D);
        for (int i = bid * NTHR + tid; i < n16; i += F.G * NTHR) p[i] = (v4u){0u, 0u, 0u, 0u};
        float* csc = (float*)(F.ws + WS_CSC) + l * (HYP + NRW) + HYP;
        if (bid == 0 && tid < NRW - r0) csc[r0 + tid] = 0.f;
    }
}

__device__ __forceinline__ void p_filter_item(Frame& F, int l, int item) {
    LAS float* Z = (LAS float*)F.lds;
    LAS float* H1 = Z + 32 * 36;
    LAS float* H2 = H1 + 32 * 64;
    LAS float* H3 = H2 + 32 * 64;
    PHASE_TID(); const int pos0 = item * 32;
    const float* w1 = F.in[I_FW1] + l * 33 * 64; const float* b1 = F.in[I_FB1] + l * 64;
    const float* w2 = F.in[I_FW2] + l * 64 * 64; const float* b2 = F.in[I_FB2] + l * 64;
    const float* w3 = F.in[I_FW3] + l * 64 * 64; const float* b3 = F.in[I_FB3] + l * 64;
    const float* fq = F.in[I_FFREQ] + l * 3 * 64;
    __syncthreads();
    for (int e = tid; e < 32 * 33; e += NTHR) {
        const int p = e / 33, f = e % 33, pos = pos0 + p; float v;
        if (f == 0) v = (float)pos / (float)(T - 1);
        else { const int band = (f - 1) & 15; const float fr = 1e-4f + (float)band * ((15.0f - 1e-4f) / 15.0f);
            float x = (float)pos * fr * (1.0f / (float)T); x -= floorf(x);
            v = (f <= 16) ? __builtin_amdgcn_cosf(x) : -__builtin_amdgcn_sinf(x); }
        Z[p * 36 + f] = v;
    }
    __syncthreads();
    const int j = tid & 63, pb = tid >> 6;
    { float wc[33];
#pragma unroll
      for (int f = 0; f < 33; ++f) wc[f] = w1[f * 64 + j];
      const float bj = b1[j], fj = fq[j];
#pragma unroll
      for (int i = 0; i < 4; ++i) { const int p = pb + 8 * i; float s = bj;
#pragma unroll
          for (int f = 0; f < 33; ++f) s += Z[p * 36 + f] * wc[f];
          H1[p * 64 + j] = sin_hw(fj * s); } }
    __syncthreads();
#pragma unroll 1
    for (int ly = 0; ly < 2; ++ly) { const float* w = ly ? w3 : w2; const float* bb = ly ? b3 : b2; const LAS float* Hi = ly ? H2 : H1; LAS float* Ho = ly ? H3 : H2;
        float wc[64];
#pragma unroll
        for (int f = 0; f < 64; ++f) wc[f] = w[f * 64 + j];
        const float bj = bb[j], fj = fq[64 + 64 * ly + j];
#pragma unroll
        for (int i = 0; i < 4; ++i) { const int p = pb + 8 * i; float s = bj;
#pragma unroll
            for (int q = 0; q < 16; ++q) { const f32x4 h = *(const LAS f32x4*)(Hi + p * 64 + 4 * q); s += (h[0] * wc[4 * q] + h[1] * wc[4 * q + 1]) + (h[2] * wc[4 * q + 2] + h[3] * wc[4 * q + 3]); }
            Ho[p * 64 + j] = sin_hw(fj * s); }
        __syncthreads(); }
    const int fr = lane & 15, fqd = lane >> 4;
    bf16x8 af[2][2];
#pragma unroll
    for (int mt = 0; mt < 2; ++mt)
#pragma unroll
        for (int ks = 0; ks < 2; ++ks) { const LAS float* hp = H3 + (16 * mt + fr) * 64 + 32 * ks + 8 * fqd; const f32x4 h0 = *(const LAS f32x4*)hp, h1 = *(const LAS f32x4*)(hp + 4);
            const float hv[8] = {h0[0], h0[1], h0[2], h0[3], h1[0], h1[1], h1[2], h1[3]}; af[mt][ks] = __builtin_bit_cast(bf16x8, pack8(hv)); }
    const float* wo = F.in[I_FWOUT] + (size_t)l * 64 * 2048;
    float* HF = (float*)(F.ws + WS_HF);
#pragma unroll 1
    for (int tb = 0; tb < 16; tb += 4) {
        bf16x8 bfr[4][2];
#pragma unroll
        for (int u = 0; u < 4; ++u)
#pragma unroll
            for (int ks = 0; ks < 2; ++ks) { float v[8]; const float* wp = wo + (size_t)(32 * ks + 8 * fqd) * 2048 + 256 * wave + 16 * (tb + u) + fr;
#pragma unroll
                for (int e = 0; e < 8; ++e) v[e] = wp[(size_t)e * 2048];
                bfr[u][ks] = __builtin_bit_cast(bf16x8, pack8(v)); }
#pragma unroll
        for (int u = 0; u < 4; ++u) { const int col = 256 * wave + 16 * (tb + u) + fr, c = col & 511;
            const float delta = 3.0701134573f + (float)c * ((15.350567286f - 3.0701134573f) / 511.0f);
#pragma unroll
            for (int mt = 0; mt < 2; ++mt) { f32x4 acc = (f32x4){0.f, 0.f, 0.f, 0.f};
                acc = MFMA16(af[mt][0], bfr[u][0], acc); acc = MFMA16(af[mt][1], bfr[u][1], acc);
                f32x4 o;
#pragma unroll
                for (int jj = 0; jj < 4; ++jj) { const float t = (float)(pos0 + 16 * mt + 4 * fqd + jj) / (float)(T - 1); o[jj] = acc[jj] * __expf(-t * delta); }
                *(f32x4*)(HF + (size_t)col * T + pos0 + 16 * mt + 4 * fqd) = o; } } }
}
__device__ __forceinline__ void p_filter(Frame& F, int l) { PHASE_TID(); (void)tid; for (int it = bid; it < T / 32; it += F.G) p_filter_item(F, l, it); __syncthreads(); }

template <bool F32IN> __device__ __forceinline__ void p_rmsnorm_q(Frame& F, const void* xin, const float* g, unsigned char* HQ, float* RSC, int m0, int m1) {
    PHASE_TID();
    const int gw = bid * NWAVES + wave, NGW = F.G * NWAVES;
    constexpr int R = F32IN ? 2 : 4;
    f32x4 gv[4];
#pragma unroll
    for (int j = 0; j < 4; ++j) gv[j] = F32IN ? *(const f32x4*)(g + 4 * lane + 256 * j) : *(const f32x4*)(g + 16 * lane + 4 * j);
    for (int mb = m0 + gw; mb < m1; mb += R * NGW) {
        f32x4 xf[F32IN ? R : 1][4]; v4u xw[F32IN ? 1 : R][2];
#pragma unroll
        for (int r = 0; r < R; ++r) { const int m = mb + r * NGW;
            if (F32IN) { const f32x4* xr = (const f32x4*)((const float*)xin + (size_t)m * D) + lane;
#pragma unroll
                for (int j = 0; j < 4; ++j) xf[r][j] = xr[64 * j]; }
            else { const v4u* xr = (const v4u*)((const bf16*)xin + (size_t)m * D + 16 * lane); xw[r][0] = xr[0]; xw[r][1] = xr[1]; } }
        asm volatile("" ::: "memory");
#pragma unroll
        for (int r = 0; r < R; ++r) { const int m = mb + r * NGW;
            f32x4 v[4]; float s = 0.f;
            if (F32IN) {
#pragma unroll
                for (int j = 0; j < 4; ++j) v[j] = xf[r][j]; }
            else { const unsigned ww[8] = {xw[r][0].x, xw[r][0].y, xw[r][0].z, xw[r][0].w, xw[r][1].x, xw[r][1].y, xw[r][1].z, xw[r][1].w};
#pragma unroll
                for (int j = 0; j < 4; ++j) v[j] = (f32x4){bflo(ww[2 * j]), bfhi(ww[2 * j]), bflo(ww[2 * j + 1]), bfhi(ww[2 * j + 1])}; }
#pragma unroll
            for (int j = 0; j < 4; ++j) s += (v[j].x * v[j].x + v[j].y * v[j].y) + (v[j].z * v[j].z + v[j].w * v[j].w);
            const float rstd = 1.0f / sqrtf(wave_sum(s) * (1.0f / D) + RMS_EPS);
            float am = 0.f;
#pragma unroll
            for (int j = 0; j < 4; ++j) { v[j] = v[j] * rstd * gv[j]; am = fmaxf(fmaxf(am, fmaxf(fabsf(v[j].x), fabsf(v[j].y))), fmaxf(fabsf(v[j].z), fabsf(v[j].w))); }
            am = wave_max(am);
            const float inv = am > 0.f ? 127.0f / am : 0.f;
            unsigned qd[4];
#pragma unroll
            for (int j = 0; j < 4; ++j) qd[j] = q4(v[j].x * inv, v[j].y * inv, v[j].z * inv, v[j].w * inv);
            if (F32IN) {
#pragma unroll
                for (int j = 0; j < 4; ++j) *(unsigned*)(HQ + (size_t)m * D + 256 * j + 4 * lane) = qd[j]; }
            else *(v4u*)(HQ + (size_t)m * D + 16 * lane) = (v4u){qd[0], qd[1], qd[2], qd[3]};
            if (lane == 0) RSC[m] = am * (1.0f / 127.0f); }
    }
}
__device__ __forceinline__ void p_rmsnorm_b16(Frame& F, const bf16* x, const float* g, bf16* out, int m0, int m1) {
    PHASE_TID();
    const int gw = bid * NWAVES + wave, NGW = F.G * NWAVES;
    f32x4 gv[4];
#pragma unroll
    for (int j = 0; j < 4; ++j) gv[j] = *(const f32x4*)(g + 16 * lane + 4 * j);
    for (int m = m0 + gw; m < m1; m += NGW) {
        const v4u* xr = (const v4u*)(x + (size_t)m * D + 16 * lane); const v4u w0 = xr[0], w1 = xr[1];
        const unsigned ww[8] = {w0.x, w0.y, w0.z, w0.w, w1.x, w1.y, w1.z, w1.w}; f32x4 v[4]; float s = 0.f;
#pragma unroll
        for (int j = 0; j < 4; ++j) { v[j] = (f32x4){bflo(ww[2 * j]), bfhi(ww[2 * j]), bflo(ww[2 * j + 1]), bfhi(ww[2 * j + 1])}; s += (v[j].x * v[j].x + v[j].y * v[j].y) + (v[j].z * v[j].z + v[j].w * v[j].w); }
        const float rstd = 1.0f / sqrtf(wave_sum(s) * (1.0f / D) + RMS_EPS);
        v4u o[2];
#pragma unroll
        for (int j = 0; j < 2; ++j) { const f32x4 ya = v[2 * j] * rstd * gv[2 * j], yb = v[2 * j + 1] * rstd * gv[2 * j + 1]; o[j].x = pk2(ya.x, ya.y); o[j].y = pk2(ya.z, ya.w); o[j].z = pk2(yb.x, yb.y); o[j].w = pk2(yb.z, yb.w); }
        v4u* op = (v4u*)(out + (size_t)m * D + 16 * lane); op[0] = o[0]; op[1] = o[1];
    }
}
__device__ __forceinline__ void p_finalnorm(Frame& F, const bf16* x, const float* g, float* out) {
    PHASE_TID();
    const int gw = bid * NWAVES + wave, NGW = F.G * NWAVES;
    constexpr int R = 4;
    f32x4 gv[4];
#pragma unroll
    for (int j = 0; j < 4; ++j) gv[j] = *(const f32x4*)(g + 4 * lane + 256 * j);
    for (int mb = gw; mb < M; mb += R * NGW) {
        v2u xw[R][4];
#pragma unroll
        for (int r = 0; r < R; ++r) { const v2u* xr = (const v2u*)(x + (size_t)(mb + r * NGW) * D) + lane;
#pragma unroll
            for (int j = 0; j < 4; ++j) xw[r][j] = xr[64 * j]; }
        asm volatile("" ::: "memory");
#pragma unroll
        for (int r = 0; r < R; ++r) { f32x4 v[4]; float s = 0.f;
#pragma unroll
            for (int j = 0; j < 4; ++j) { v[j] = (f32x4){bflo(xw[r][j].x), bfhi(xw[r][j].x), bflo(xw[r][j].y), bfhi(xw[r][j].y)}; s += (v[j].x * v[j].x + v[j].y * v[j].y) + (v[j].z * v[j].z + v[j].w * v[j].w); }
            const float rstd = 1.0f / sqrtf(wave_sum(s) * (1.0f / D) + RMS_EPS);
            f32x4* o = (f32x4*)(out + (size_t)(mb + r * NGW) * D) + lane;
#pragma unroll
            for (int j = 0; j < 4; ++j) o[64 * j] = v[j] * rstd * gv[j]; }
    }
}
template <bool F32OUT> __device__ __forceinline__ void p_rmsnorm(Frame& F, const float* x, const float* g, void* outp, int m0, int m1) {
    PHASE_TID();
    const int gw = bid * NWAVES + wave, NGW = F.G * NWAVES;
    f32x4 gv[4];
#pragma unroll
    for (int j = 0; j < 4; ++j) gv[j] = *(const f32x4*)(g + 4 * lane + 256 * j);
    for (int m = m0 + gw; m < m1; m += NGW) {
        const f32x4* xr = (const f32x4*)(x + (size_t)m * D) + lane; f32x4 v[4]; float s = 0.f;
#pragma unroll
        for (int j = 0; j < 4; ++j) { v[j] = xr[64 * j]; s += (v[j].x * v[j].x + v[j].y * v[j].y) + (v[j].z * v[j].z + v[j].w * v[j].w); }
        const float rstd = 1.0f / sqrtf(wave_sum(s) * (1.0f / D) + RMS_EPS);
        if (F32OUT) { f32x4* o = (f32x4*)((float*)outp + (size_t)m * D) + lane;
#pragma unroll
            for (int j = 0; j < 4; ++j) o[64 * j] = v[j] * rstd * gv[j]; }
        else { v2u* o = (v2u*)((bf16*)outp + (size_t)m * D) + lane;
#pragma unroll
            for (int j = 0; j < 4; ++j) { const f32x4 y = v[j] * rstd * gv[j]; v2u w; w.x = pk2(y.x, y.y); w.y = pk2(y.z, y.w); o[64 * j] = w; } }
    }
}

constexpr int KPAD = 2 * T + 2 * T / 16;

constexpr int LC = 32;

__device__ __forceinline__ void p_mix(Frame& F, int l) {
    PHASE_TID();
#ifndef NO_SCAN
#ifdef SEQ_SCAN
    if (bid < 128) scan_chain(F, l, bid);
#else
    cscan_chain(F, l, bid);
#endif
#endif
    unsigned* head = F.ctl + CW_QUEUE + 64 * l;
    for (;;) {
        __syncthreads();
        if (tid == 0) F.MISC[16] = __hip_atomic_fetch_add(head, 1u, RLX_AGENT);
        __syncthreads();
        const unsigned it = F.MISC[16];
        if (it >= (unsigned)(4 * CH)) break;
        hy_fft_item(F, l, (int)it);
    }
    __syncthreads();
}

__device__ __forceinline__ void p_post(Frame& F, int l) {
    PHASE_TID();
    const int gw = bid * NWAVES + wave, NGW = F.G * NWAVES;
    bf16* YM = (bf16*)(F.ws + WS_YMIX);
    { LAS float* scr = (LAS float*)(F.lds + wave * 16640);
      const bf16* PHT = (const bf16*)(F.ws + WS_PHT); const float* ng = F.in[I_HNG] + (size_t)l * CH;
      for (int it = gw; it < NB * 8 * (T / 64); it += NGW) { const int tb = it & 127, g = (it >> 7) & 7, b = it >> 10, t0 = tb * 64;
          const bf16* src = PHT + ((size_t)b * HYP + CH + g * 64 + lane) * T + t0;
#pragma unroll
          for (int q = 0; q < 8; ++q) { const v4u w = *(const v4u*)(src + 8 * q); LAS float* d = scr + lane * 65 + 8 * q;
              d[0] = bflo(w.x); d[1] = bfhi(w.x); d[2] = bflo(w.y); d[3] = bfhi(w.y); d[4] = bflo(w.z); d[5] = bfhi(w.z); d[6] = bflo(w.w); d[7] = bfhi(w.w); }
          LDS_WAIT(); asm volatile("" ::: "memory");
          float z[64], ss = 0.f;
#pragma unroll
          for (int cc = 0; cc < 64; ++cc) { z[cc] = scr[cc * 65 + lane]; ss += z[cc] * z[cc]; }
          const float rs = 1.0f / sqrtf(ss * (1.0f / 64.0f) + RMS_EPS);
          bf16* dst = YM + ((size_t)b * T + t0 + lane) * D + g * 64;
#pragma unroll
          for (int q = 0; q < 8; ++q) { v4u o; const float* gq = ng + g * 64 + 8 * q;
              o.x = pk2(z[8 * q] * rs * gq[0], z[8 * q + 1] * rs * gq[1]); o.y = pk2(z[8 * q + 2] * rs * gq[2], z[8 * q + 3] * rs * gq[3]);
              o.z = pk2(z[8 * q + 4] * rs * gq[4], z[8 * q + 5] * rs * gq[5]); o.w = pk2(z[8 * q + 6] * rs * gq[6], z[8 * q + 7] * rs * gq[7]);
              *(v4u*)(dst + 8 * q) = o; }
          LDS_WAIT(); asm volatile("" ::: "memory"); } }
}

struct PostRows { v4u a, c, v, g; float bs; };
__device__ __forceinline__ void post_rows_load(PostRows& R, const bf16* YS0, const bf16* YS1, const bf16* VV, const bf16* GG, const float* BS0, const float* BS1, size_t m, int h, int ec) {
    const size_t o = m * CH + h * HD + ec;
    R.a = *(const v4u*)(YS0 + o); R.c = *(const v4u*)(YS1 + o); R.v = *(const v4u*)(VV + o); R.g = *(const v4u*)(GG + o); R.bs = BS0[m * NH + h] + BS1[m * NH + h];
}
__device__ __forceinline__ void p_postfix(Frame& F, int l) {
    PHASE_TID(); const int fr = lane & 15, fq = lane >> 4, mtw = wave >> 1, ntw = 2 * (wave & 1), et = tid >> 3, ec = (tid & 7) * 8;
    const int bh = bid >> 2, b = bh >> 3, h = bh & 7, tq = bid & 3, dfix = (tq >= 2) ? 0 : 1, chain = (b * NH + h) * 2 + dfix;
    const float* SF = (const float*)(F.ws + WS_SFIN) + (size_t)chain * 4096;
    bf16x8 sfb[2][2];
#pragma unroll
    for (int ks = 0; ks < 2; ++ks)
#pragma unroll
        for (int j = 0; j < 2; ++j) { const float* sp = SF + (16 * (ntw + j) + fr) * 64 + 32 * ks + 8 * fq; const f32x4 s0 = *(const f32x4*)sp, s1 = *(const f32x4*)(sp + 4);
            const float sv[8] = {s0[0], s0[1], s0[2], s0[3], s1[0], s1[1], s1[2], s1[3]}; sfb[ks][j] = __builtin_bit_cast(bf16x8, pack8(sv)); }
    const bf16* YP = (const bf16*)(F.ws + WS_YPHI) + ((size_t)chain * (T / 2) + 16 * mtw + fr) * 64 + 8 * fq;
    const bf16* YS0 = (const bf16*)(F.ws + WS_YS); const bf16* YS1 = YS0 + (size_t)M * CH;
    const bf16* VV = (l == 0) ? (const bf16*)(F.ws + WS_VFIRST) : (const bf16*)(F.ws + WS_V2);
    const bf16* GG = (const bf16*)(F.ws + WS_G); const float* BS0 = (const float*)(F.ws + WS_BS); const float* BS1 = BS0 + (size_t)M * NH;
    bf16* YM = (bf16*)(F.ws + WS_YMIX);
    float lg[8], lb[8];
#pragma unroll
    for (int j = 0; j < 8; ++j) { lg[j] = F.in[I_LNG][l * CH + h * HD + ec + j]; lb[j] = F.in[I_LNB][l * CH + h * HD + ec + j]; }
    LAS float* FX = (LAS float*)F.lds;
    const size_t mb = (size_t)b * T + 64 * (32 * tq) + et;
    __syncthreads();
    PostRows cur; bf16x8 acur[2];
    post_rows_load(cur, YS0, YS1, VV, GG, BS0, BS1, mb, h, ec);
#pragma unroll
    for (int ks = 0; ks < 2; ++ks) acur[ks] = *(const bf16x8*)(YP + (size_t)((32 * tq) & 63) * 64 * 64 + 32 * ks);
#pragma unroll 1
    for (int t = 0; t < 32; ++t) {
        PostRows nxt; bf16x8 anxt[2]; const int tn = (t + 1 < 32) ? t + 1 : t;
        post_rows_load(nxt, YS0, YS1, VV, GG, BS0, BS1, mb + 64 * tn, h, ec);
#pragma unroll
        for (int ks = 0; ks < 2; ++ks) anxt[ks] = *(const bf16x8*)(YP + (size_t)((32 * tq + tn) & 63) * 64 * 64 + 32 * ks);
        { f32x4 acc[2] = {(f32x4){0.f, 0.f, 0.f, 0.f}, (f32x4){0.f, 0.f, 0.f, 0.f}};
#pragma unroll
          for (int ks = 0; ks < 2; ++ks)
#pragma unroll
              for (int j = 0; j < 2; ++j) acc[j] = MFMA16(sfb[ks][j], acur[ks], acc[j]);
          LAS float* fx = FX + (t & 1) * 64 * 68 + (16 * mtw + fr) * 68 + 16 * ntw + 4 * fq;
          *(LAS f32x4*)fx = acc[0]; *(LAS f32x4*)(fx + 16) = acc[1]; }
        __syncthreads();
        { const LAS float* fx = FX + (t & 1) * 64 * 68 + et * 68 + ec; const f32x4 f0 = *(const LAS f32x4*)fx, f1 = *(const LAS f32x4*)(fx + 4);
          const float fv[8] = {f0[0], f0[1], f0[2], f0[3], f1[0], f1[1], f1[2], f1[3]};
          const unsigned aw[4] = {cur.a.x, cur.a.y, cur.a.z, cur.a.w}, cw[4] = {cur.c.x, cur.c.y, cur.c.z, cur.c.w}, vx[4] = {cur.v.x, cur.v.y, cur.v.z, cur.v.w}, gx[4] = {cur.g.x, cur.g.y, cur.g.z, cur.g.w};
          float sv[8], sum = 0.f;
#pragma unroll
          for (int j = 0; j < 4; ++j) { sv[2 * j] = bflo(aw[j]) + bflo(cw[j]) + fv[2 * j]; sv[2 * j + 1] = bfhi(aw[j]) + bfhi(cw[j]) + fv[2 * j + 1]; sum += sv[2 * j] + sv[2 * j + 1]; }
          const float mean = sum8(sum) * (1.0f / 64.0f); float q = 0.f;
#pragma unroll
          for (int j = 0; j < 8; ++j) { sv[j] -= mean; q += sv[j] * sv[j]; }
          const float rs = 1.0f / sqrtf(sum8(q) * (1.0f / 64.0f) + GN_EPS);
          float y[8];
#pragma unroll
          for (int j = 0; j < 4; ++j) { y[2 * j] = (sv[2 * j] * rs * lg[2 * j] + lb[2 * j] + cur.bs * bflo(vx[j])) * bflo(gx[j]);
                                        y[2 * j + 1] = (sv[2 * j + 1] * rs * lg[2 * j + 1] + lb[2 * j + 1] + cur.bs * bfhi(vx[j])) * bfhi(gx[j]); }
          v4u ov; ov.x = pk2(y[0], y[1]); ov.y = pk2(y[2], y[3]); ov.z = pk2(y[4], y[5]); ov.w = pk2(y[6], y[7]);
          *(v4u*)(YM + (mb + 64 * t) * D + CH + h * HD + ec) = ov; }
        cur = nxt; acur[0] = anxt[0]; acur[1] = anxt[1];
    }
    __syncthreads();
}
__device__ __forceinline__ int obid() { int b = blockIdx.x; asm volatile("" : "+s"(b)); return b; }
struct Args { const float* in[34]; float* out; unsigned char* ws; int ph_lo, ph_hi; };
__global__ void __launch_bounds__(NTHR, 2) enc_fwd(Args args) {
    extern __shared__ __attribute__((aligned(16))) unsigned char lds[];
    Frame F;
    F.lds = (LAS unsigned char*)lds;
    F.MISC = (volatile LAS unsigned*)(F.lds + LDSCTL_OFF);
    F.G = gridDim.x;
    F.ws = args.ws; F.out = args.out; F.ctl = (unsigned*)(args.ws + WS_CTL);
    F.in = args.in;
    for (int u = threadIdx.x; u < (LDS_BYTES - LDSCTL_OFF) / 4; u += NTHR) F.MISC[u] = 0u;
    __syncthreads();
    const XcdBarrier bar = xcd_barrier_post(F.ctl + CW_BAR, F.MISC + 8);
#define SEAM() xcd_barrier(bar)

    bf16* HN = (bf16*)(F.ws + WS_HN);
    float* RSS = (float*)(F.ws + WS_RSS);
    unsigned char* HQ = F.ws + WS_HN; float* RSC = (float*)(F.ws + WS_RSC);
    p_convert(F); __syncthreads(); p_filter(F, 0); p_rmsnorm_q<true>(F, F.in[I_X], F.in[I_N1G], HQ, RSC, 0, M / 2);
    SEAM();
    p_wquant(F);
    SEAM();
#pragma unroll 1
    for (int l = 0; l < NL; ++l) {
        unsigned char* wb = F.ws + WS_W + (size_t)l * W_LAYER;
        bf16* X2B = (bf16*)F.out;
        {
#pragma unroll 1
            for (int hf = 0; hf < 2; ++hf) { constexpr int MH = M / 2; const size_t r0 = (size_t)hf * MH;
                if (hf == 0) p_spectra(F);
                const float* CSC = (const float*)(F.ws + WS_CSC) + l * (HYP + NRW);
                { pg8::Gemm g{(const bf16*)(wb + W_HY), (const bf16*)(HQ + r0 * D), HYP, MH, D / 2}; pg8::StaticOrder S; S.init(HYP, MH, F.G, obid());
                  pg8::EpiBf16Q E{(bf16*)(F.ws + WS_PHT) + (size_t)(4 * hf) * HYP * T, (size_t)T, (size_t)HYP * T, 13, CSC, RSC + r0};
                  pg8::gemm_phase<pg8::EpiBf16Q, pg8::StaticOrder, true, true>(F.lds, g, S, E); }
                { pg8::Gemm g{(const bf16*)(HQ + r0 * D), (const bf16*)(wb + W_RW), MH, NRW, D / 2}; pg8::StaticOrder S; S.init(MH, NRW, F.G, obid());
                  pg8::EpiBf16Q E{(bf16*)(F.ws + WS_PRW) + r0 * NRW, (size_t)NRW, 0, 31, RSC + r0, CSC + HYP};
                  pg8::gemm_phase<pg8::EpiBf16Q, pg8::StaticOrder, true, true>(F.lds, g, S, E); }
                if (hf == 0) { if (l == 0) p_rmsnorm_q<true>(F, F.in[I_X], F.in[I_N1G], HQ, RSC, MH, M); else p_rmsnorm_q<false>(F, X2B, F.in[I_N1G] + (size_t)l * D, HQ, RSC, MH, M);
                    SEAM(); } }
        }
        SEAM();
        p_mix(F, l);
        SEAM();
        { p_post(F, l); p_postfix(F, l); }
        SEAM();
        {
            if (l + 1 < NL) p_filter(F, l + 1);
            pg8::Gemm g{(const bf16*)(F.ws + WS_YMIX), (const bf16*)(wb + W_O), M, D, D}; pg8::StaticOrder S; S.init(M, D, F.G, obid());
            if (l == 0) { pg8::EpiRes<1, false> E{F.in[I_X], nullptr, HN, D, RSS}; pg8::gemm_phase<pg8::EpiRes<1, false>, pg8::StaticOrder, true, true>(F.lds, g, S, E); }
            else { pg8::EpiRes<1, true> E{nullptr, X2B, HN, D, RSS}; pg8::gemm_phase<pg8::EpiRes<1, true>, pg8::StaticOrder, true, true>(F.lds, g, S, E); }
        }
        SEAM();
#pragma unroll 1
        for (int ck = 0; ck < MLP_CHUNKS; ++ck) { constexpr int MC = M / MLP_CHUNKS; const size_t r0 = (size_t)ck * MC;
            bf16* HIDc = (bf16*)(F.ws + WS_HID + (size_t)(ck & 1) * MC * FF * 2);
            {
                pg8::Gemm g{HN + r0 * D, (const bf16*)(wb + W_1), MC, FF, D}; pg8::StaticOrder S; S.init(MC, FF, F.G, obid());
                pg8::EpiBf16<1> E{HIDc, (size_t)FF};
                pg8::gemm_phase<pg8::EpiBf16<1>, pg8::StaticOrder, true, true>(F.lds, g, S, E);
            }
            SEAM();
            {
                pg8::Gemm g{HIDc, (const bf16*)(wb + W_2), MC, D, FF}; pg8::StaticOrder S; S.init(MC, D, F.G, obid());
                pg8::EpiRes<2, true> E{nullptr, HN + r0 * D, ((l + 1 < NL) ? X2B : HN) + r0 * D, D, RSS + r0 * 16};
                pg8::gemm_phase<pg8::EpiRes<2, true>, pg8::StaticOrder, true, true>(F.lds, g, S, E);
            }
            if (ck == MLP_CHUNKS - 1 && l + 1 < NL) p_rmsnorm_q<false>(F, X2B, F.in[I_N1G] + (size_t)(l + 1) * D, HQ, RSC, 0, M / 2);
        }
        SEAM();
        if (l + 1 == NL) p_finalnorm(F, HN, F.in[I_FING], F.out);
    }
#undef SEAM
}

extern "C" void kernel_launch(void* const* d_in, const int* in_sizes, int n_in, void* d_out, int out_size, void* d_ws, size_t ws_size, hipStream_t stream) {
    static int grid = 0;
    if (grid == 0) {
        if (n_in != 34 || in_sizes[0] != M * D || out_size != M * D || ws_size < WS_END) {
            fprintf(stderr, "kernel_launch: unexpected problem: n_in %d in0 %d out %d ws %zu (need %zu); nothing launched\n", n_in, n_in > 0 ? in_sizes[0] : -1, out_size, ws_size, (size_t)WS_END); grid = -1; return; }
        int dev = 0, cus = 0, per_cu = 0;
        if (hipGetDevice(&dev) != hipSuccess || hipDeviceGetAttribute(&cus, hipDeviceAttributeMultiprocessorCount, dev) != hipSuccess) { grid = -1; return; }
        if (hipFuncSetAttribute((const void*)enc_fwd, hipFuncAttributeMaxDynamicSharedMemorySize, LDS_BYTES) != hipSuccess) { fprintf(stderr, "kernel_launch: hipFuncSetAttribute failed\n"); grid = -1; return; }
        if (hipOccupancyMaxActiveBlocksPerMultiprocessor(&per_cu, (const void*)enc_fwd, NTHR, LDS_BYTES) != hipSuccess || per_cu < 1)
            fprintf(stderr, "kernel_launch: note: occupancy query reports %d workgroups per CU\n", per_cu);
        (void)hipGetLastError();
        grid = cus;
        if (grid != 256) { fprintf(stderr, "kernel_launch: built for a 256-CU device (got %d); nothing launched\n", cus); grid = -1; return; }
    }
    if (grid < 0) return;
    if (hipMemsetAsync((char*)d_ws + WS_CTL, 0, CTL_ZERO_BYTES, stream) != hipSuccess) return;
    Args a{};
    for (int i = 0; i < 34; ++i) a.in[i] = (const float*)d_in[i];
    a.out = (float*)d_out; a.ws = (unsigned char*)d_ws;
    a.ph_lo = 0; a.ph_hi = 0;
    hipLaunchKernelGGL(enc_fwd, dim3(grid), dim3(NTHR), LDS_BYTES, stream, a);
}
```

```cpp
#include <hip/hip_runtime.h>
#include <cstdio>
#include <cstdint>
namespace pg8 {
#define PG8_LAS __attribute__((address_space(3)))
typedef unsigned short bf16_t;
typedef short bf16x8 __attribute__((ext_vector_type(8)));
typedef float f32x4 __attribute__((ext_vector_type(4)));
typedef int i32x4 __attribute__((ext_vector_type(4)));
template <bool I8> struct AccT { typedef f32x4 t; };
template <> struct AccT<true> { typedef i32x4 t; };
typedef unsigned u32x4 __attribute__((ext_vector_type(4)));
constexpr int BM = 256, BK = 64, HALF = 128, HTB = HALF * BK * 2  , STAGE_BYTES = 8 * HTB, NXCD = 8, WGM = 8;

__host__ __device__ __forceinline__ int lds_byte(int r, int c) { const int st = (r >> 4) * 2 + (c >> 5), rr = r & 15, cc = c & 31, ob = rr * 64 + cc * 2; return st * 1024 + (ob ^ (((ob >> 9) & 1) << 5)); }
__host__ __device__ __forceinline__ void stage_rc(int b, int& R, int& C) { const int st = b / 1024, sb = b % 1024, swz = sb ^ (((sb >> 9) & 1) << 5); R = (st >> 1) * 16 + swz / 64; C = (st & 1) * 32 + (swz % 64) / 2; }
__host__ __device__ __forceinline__ int perm32(int rho) { const int n = rho >> 4, i = rho & 15; return 8 * (i >> 2) + 4 * n + (i & 3); }

struct Unit { int pm, pn; };
struct Gemm { const bf16_t* A; const bf16_t* Bt; int M, N, K; };

struct StaticOrder {
    int nM, nN, nwg, G, c;
    __host__ __device__ void init(int M, int N, int G_, int c_) { nM = M / BM; nN = N / BM; nwg = nM * nN; G = G_; c = c_; }
    __host__ __device__ bool next(int i, Unit& u) const {
        const long L = (long)i * G + c; if (L >= nwg) return false;
        int wgid = (int)L; { const int q = nwg / NXCD, r = nwg % NXCD, xcd = wgid % NXCD, off = wgid / NXCD; wgid = (xcd < r ? xcd * (q + 1) : r * (q + 1) + (xcd - r) * q) + off; }
        const int nig = WGM * nN, gid = wgid / nig, fm = gid * WGM, gsz = (nM - fm) < WGM ? (nM - fm) : WGM;
        u.pm = fm + ((wgid % nig) % gsz); u.pn = (wgid % nig) / gsz; return true;
    }
    __device__ __forceinline__ void a_ready(const Unit&) const {}
    __device__ __forceinline__ void done(const Unit&) const {}
};
typedef float f32x2e __attribute__((ext_vector_type(2))); typedef __bf16 bf16x2e __attribute__((ext_vector_type(2)));
__device__ __forceinline__ unsigned cvt_pk_bf16(float lo, float hi) { return __builtin_bit_cast(unsigned, __builtin_convertvector((f32x2e){lo, hi}, bf16x2e)); }
template <int ACT> struct EpiBf16 {
    static constexpr bool PERM = true, AFTER_DRAIN = false, I8 = false;
    bf16_t* O; size_t ldc; size_t bstride = 0; int tshift = 31;
    __device__ __forceinline__ void operator()(const f32x4 (&acc)[2][2][4][2], const Unit& u, int wr, int wc, int fr, int fq) const {
        const int row0 = u.pm * BM + wr * 64 + fr; const int cb = u.pn * BM; const size_t col0 = (size_t)(cb >> tshift) * bstride + (size_t)(cb & ((1 << tshift) - 1)) + wc * 32 + 8 * fq;
#pragma unroll
        for (int ai = 0; ai < 2; ++ai)
#pragma unroll
            for (int m = 0; m < 4; ++m) { bf16_t* rowp = O + (size_t)(row0 + ai * HALF + m * 16) * ldc + col0;
#pragma unroll
                for (int bj = 0; bj < 2; ++bj) { f32x4 v0 = acc[ai][bj][m][0], v1 = acc[ai][bj][m][1];
                    if (ACT == 1) {
#pragma unroll
                        for (int j = 0; j < 4; ++j) { const float a = fmaxf(v0[j], 0.f), b = fmaxf(v1[j], 0.f); v0[j] = a * a; v1[j] = b * b; } }
                    u32x4 w; w.x = cvt_pk_bf16(v0[0], v0[1]); w.y = cvt_pk_bf16(v0[2], v0[3]); w.z = cvt_pk_bf16(v1[0], v1[1]); w.w = cvt_pk_bf16(v1[2], v1[3]);
                    *(u32x4*)(rowp + bj * HALF) = w;
                    } }
    }
};
struct EpiBf16Q {
    static constexpr bool PERM = true, AFTER_DRAIN = false, I8 = true;
    bf16_t* O; size_t ldc; size_t bstride; int tshift; const float* rs; const float* cs;
    __device__ __forceinline__ void operator()(const i32x4 (&acc)[2][2][4][2], const Unit& u, int wr, int wc, int fr, int fq) const {
        const int row0 = u.pm * BM + wr * 64 + fr; const int cb = u.pn * BM, ci0 = cb + wc * 32 + 8 * fq;
        const size_t col0 = (size_t)(cb >> tshift) * bstride + (size_t)(cb & ((1 << tshift) - 1)) + wc * 32 + 8 * fq;
        f32x4 cv[2][2];
#pragma unroll
        for (int bj = 0; bj < 2; ++bj) { cv[bj][0] = *(const f32x4*)(cs + ci0 + bj * HALF); cv[bj][1] = *(const f32x4*)(cs + ci0 + bj * HALF + 4); }
#pragma unroll
        for (int ai = 0; ai < 2; ++ai)
#pragma unroll
            for (int m = 0; m < 4; ++m) { const int row = row0 + ai * HALF + m * 16; bf16_t* rowp = O + (size_t)row * ldc + col0; const float r = rs[row];
#pragma unroll
                for (int bj = 0; bj < 2; ++bj) { const i32x4 a0 = acc[ai][bj][m][0], a1 = acc[ai][bj][m][1];
                    const f32x4 v0 = (f32x4){(float)a0[0], (float)a0[1], (float)a0[2], (float)a0[3]} * r * cv[bj][0], v1 = (f32x4){(float)a1[0], (float)a1[1], (float)a1[2], (float)a1[3]} * r * cv[bj][1];
                    u32x4 w; w.x = cvt_pk_bf16(v0[0], v0[1]); w.y = cvt_pk_bf16(v0[2], v0[3]); w.z = cvt_pk_bf16(v1[0], v1[1]); w.w = cvt_pk_bf16(v1[2], v1[3]);
                    *(u32x4*)(rowp + bj * HALF) = w; } }
    }
};
__device__ __forceinline__ float rss16(const float* p) { const f32x4 a = *(const f32x4*)p, b = *(const f32x4*)(p + 4), c = *(const f32x4*)(p + 8), d = *(const f32x4*)(p + 12);
    return (((a[0] + a[1]) + (a[2] + a[3])) + ((b[0] + b[1]) + (b[2] + b[3]))) + (((c[0] + c[1]) + (c[2] + c[3])) + ((d[0] + d[1]) + (d[2] + d[3]))); }
template <int MODE, bool RB16> struct EpiRes {
    static constexpr bool PERM = true, AFTER_DRAIN = false, I8 = false;
    const float* R; const bf16_t* RB; bf16_t* O; int ldc; float* rss;
    __device__ __forceinline__ void operator()(const f32x4 (&acc)[2][2][4][2], const Unit& u, int wr, int wc, int fr, int fq) const {
        const int row0 = u.pm * BM + wr * 64 + fr, col0 = u.pn * BM + wc * 32 + 8 * fq;
#pragma unroll
        for (int ai = 0; ai < 2; ++ai)
#pragma unroll
            for (int m = 0; m < 4; ++m) { const int row = row0 + ai * HALF + m * 16; const size_t off = (size_t)row * ldc + col0;
                f32x4 rv[2][2]; float ss = 0.f, sc = 1.0f;
                if (MODE == 2) sc = __builtin_amdgcn_rcpf(rss16(rss + (size_t)row * 16) * (1.0f / 1024.0f) + 1e-5f);
#pragma unroll
                for (int bj = 0; bj < 2; ++bj) {
                    if (RB16) { const u32x4 w = *(const u32x4*)(RB + off + bj * HALF);
                        rv[bj][0] = (f32x4){__builtin_bit_cast(float, w.x << 16), __builtin_bit_cast(float, w.x & 0xffff0000u), __builtin_bit_cast(float, w.y << 16), __builtin_bit_cast(float, w.y & 0xffff0000u)};
                        rv[bj][1] = (f32x4){__builtin_bit_cast(float, w.z << 16), __builtin_bit_cast(float, w.z & 0xffff0000u), __builtin_bit_cast(float, w.w << 16), __builtin_bit_cast(float, w.w & 0xffff0000u)}; }
                    else { rv[bj][0] = *(const f32x4*)(R + off + bj * HALF); rv[bj][1] = *(const f32x4*)(R + off + bj * HALF + 4); } }
#pragma unroll
                for (int bj = 0; bj < 2; ++bj) { f32x4 o0 = acc[ai][bj][m][0], o1 = acc[ai][bj][m][1];
                    if (MODE == 2) { o0 = o0 * sc; o1 = o1 * sc; }
                    o0 = o0 + rv[bj][0]; o1 = o1 + rv[bj][1];
                    if (MODE == 1) ss += ((o0[0] * o0[0] + o0[1] * o0[1]) + (o0[2] * o0[2] + o0[3] * o0[3])) + ((o1[0] * o1[0] + o1[1] * o1[1]) + (o1[2] * o1[2] + o1[3] * o1[3]));
                    u32x4 w; w.x = cvt_pk_bf16(o0[0], o0[1]); w.y = cvt_pk_bf16(o0[2], o0[3]); w.z = cvt_pk_bf16(o1[0], o1[1]); w.w = cvt_pk_bf16(o1[2], o1[3]);
                    *(u32x4*)(O + off + bj * HALF) = w; }
                if (MODE == 1) { ss += __shfl_xor(ss, 16); ss += __shfl_xor(ss, 32); if (fq == 0) rss[(size_t)row * 16 + u.pn * 4 + wc] = ss; }
                asm volatile("" ::: "memory"); }
    }
};

template <bool I8> __device__ __forceinline__ typename AccT<I8>::t pg8_mma16(const bf16x8& a, const bf16x8& b, const typename AccT<I8>::t& c) {
    if constexpr (I8) return __builtin_amdgcn_mfma_i32_16x16x64_i8(__builtin_bit_cast(i32x4, a), __builtin_bit_cast(i32x4, b), c, 0, 0, 0);
    else return __builtin_amdgcn_mfma_f32_16x16x32_bf16(a, b, c, 0, 0, 0);
}
template <class Epi, class Sched, bool ALIGN_EPI = false, bool SP2 = false>
__device__ __forceinline__ void gemm_phase(PG8_LAS unsigned char* lds, const Gemm g, const Sched& S, const Epi& E) {
    int tid = threadIdx.x; asm volatile("" : "+v"(tid));
    const int wid = __builtin_amdgcn_readfirstlane(tid >> 6), lane = tid & 63, wr = wid >> 2, wc = wid & 3, fr = lane & 15, fq = lane >> 4;
    const int K = g.K, nt = K / BK;
    unsigned voffA[2], voffB[2];
#pragma unroll
    for (int i = 0; i < 2; ++i) { int R, C; stage_rc(tid * 16 + i * 8192, R, C); const int Rb = Epi::PERM ? ((R & ~31) + perm32(R & 31)) : R;
        voffA[i] = (unsigned)(R * K + C) * 2u; voffB[i] = (unsigned)(Rb * K + C) * 2u; }
    const size_t kstep = (size_t)(BK * 2);
    const size_t hstep = (size_t)HALF * K * 2;
    const size_t tstep = 2 * hstep;
    const unsigned ldsw = (unsigned)wid * 1024u;
    const int aoff = lds_byte(wr * 64 + fr, fq * 8), boff = lds_byte(wc * 32 + fr, fq * 8);
#define PG8_SA(b, h) (((b) * 2 + (h)) * HTB)
#define PG8_SB(b, h) ((4 + (b) * 2 + (h)) * HTB)
#define PG8_STAGE(bufoff, gbase, voff) do { _Pragma("unroll") for (int _i = 0; _i < 2; ++_i) \
        __builtin_amdgcn_global_load_lds((const unsigned*)((const char*)(gbase) + (voff)[_i]), (PG8_LAS unsigned*)(lds + (bufoff) + ldsw + _i * 8192), 16, 0, 0); } while (0)
#define PG8_LDA(dst, b, h) do { _Pragma("unroll") for (int m = 0; m < 4; ++m) _Pragma("unroll") for (int k = 0; k < 2; ++k) dst[m][k] = *(const PG8_LAS bf16x8*)(lds + PG8_SA(b, h) + aoff + m * 2048 + k * 1024); } while (0)
#define PG8_LDB(dst, b, h) do { _Pragma("unroll") for (int n = 0; n < 2; ++n) _Pragma("unroll") for (int k = 0; k < 2; ++k) dst[n][k] = *(const PG8_LAS bf16x8*)(lds + PG8_SB(b, h) + boff + n * 2048 + k * 1024); } while (0)
#define PG8_MMA(ai, bj, At, Bt) do { __builtin_amdgcn_s_setprio(1); _Pragma("unroll") for (int m = 0; m < 4; ++m) _Pragma("unroll") for (int n = 0; n < 2; ++n) _Pragma("unroll") for (int k = 0; k < 2; ++k) \
        acc[ai][bj][m][n] = pg8_mma16<Epi::I8>(Bt[n][k], At[m][k], acc[ai][bj][m][n]); __builtin_amdgcn_s_setprio(0); } while (0)
#define PG8_WAIT_V(n) asm volatile("s_waitcnt vmcnt(" #n ")" ::: "memory")
#define PG8_WAIT_L(n) asm volatile("s_waitcnt lgkmcnt(" #n ")" ::: "memory")
#define PG8_BAR __builtin_amdgcn_s_barrier()
#define PG8_SCHED __builtin_amdgcn_sched_barrier(0)
    Unit cur, nxt; int ui = 0;
    if (!S.next(0, cur)) return;
    typedef typename AccT<Epi::I8>::t acc_t;
    acc_t acc[2][2][4][2];
#pragma unroll
    for (int a = 0; a < 2; ++a)
#pragma unroll
        for (int b = 0; b < 2; ++b)
#pragma unroll
            for (int m = 0; m < 4; ++m)
#pragma unroll
                for (int n = 0; n < 2; ++n) acc[a][b][m][n] = (acc_t){0, 0, 0, 0};
    bf16x8 At[4][2], B0[2][2], B1[2][2];
    const char* cA = (const char*)g.A + (size_t)cur.pm * tstep; const char* cB = (const char*)g.Bt + (size_t)cur.pn * tstep;
    S.a_ready(cur);
    if constexpr (SP2) {
        PG8_STAGE(PG8_SB(0, 0), cB, voffB); PG8_STAGE(PG8_SB(0, 1), cB + hstep, voffB); PG8_STAGE(PG8_SA(0, 0), cA, voffA); PG8_STAGE(PG8_SA(0, 1), cA + hstep, voffA);
        if (wr == 1) PG8_BAR;
        PG8_WAIT_V(2); PG8_BAR;
        PG8_STAGE(PG8_SB(1, 0), cB + kstep, voffB); PG8_STAGE(PG8_SA(1, 0), cA + kstep, voffA); PG8_STAGE(PG8_SB(1, 1), cB + hstep + kstep, voffB);
        PG8_WAIT_V(6); PG8_BAR;
    } else {
        PG8_STAGE(PG8_SB(0, 0), cB, voffB); PG8_STAGE(PG8_SA(0, 0), cA, voffA); PG8_STAGE(PG8_SB(0, 1), cB + hstep, voffB); PG8_STAGE(PG8_SA(0, 1), cA + hstep, voffA);
        if (wr == 1) PG8_BAR;
        PG8_WAIT_V(4); PG8_BAR;
        PG8_STAGE(PG8_SB(1, 0), cB + kstep, voffB); PG8_STAGE(PG8_SA(1, 0), cA + kstep, voffA); PG8_STAGE(PG8_SB(1, 1), cB + hstep + kstep, voffB);
        PG8_WAIT_V(6); PG8_BAR;
    }
    for (;;) {
        const bool has_next = S.next(ui + 1, nxt);
        const char* nA = has_next ? (const char*)g.A + (size_t)nxt.pm * tstep : cA; const char* nB = has_next ? (const char*)g.Bt + (size_t)nxt.pn * tstep : cB;
        for (int t = 0; t < nt; t += 2) {
            const bool last = (t == nt - 2);
            const char* a1 = cA + (size_t)(t + 1) * kstep;
            const char* a2 = last ? nA : cA + (size_t)(t + 2) * kstep; const char* b2 = last ? nB : cB + (size_t)(t + 2) * kstep;
            const char* a3 = a2 + kstep; const char* b3 = b2 + kstep;
            if (last && has_next) S.a_ready(nxt);
            if constexpr (SP2) {
            PG8_LDB(B0, 0, 0); PG8_LDB(B1, 0, 1); PG8_SCHED; PG8_LDA(At, 0, 0); PG8_STAGE(PG8_SA(1, 1), a1 + hstep, voffA);
            PG8_WAIT_V(8); PG8_WAIT_L(0); PG8_BAR; PG8_MMA(0, 0, At, B0); PG8_MMA(0, 1, At, B1); PG8_BAR; PG8_SCHED;
            PG8_LDA(At, 0, 1); PG8_STAGE(PG8_SB(0, 0), b2, voffB); PG8_STAGE(PG8_SB(0, 1), b2 + hstep, voffB); PG8_STAGE(PG8_SA(0, 0), a2, voffA);
            PG8_WAIT_V(8); PG8_WAIT_L(0); PG8_BAR; PG8_MMA(1, 0, At, B0); PG8_MMA(1, 1, At, B1); PG8_BAR; PG8_SCHED;
            PG8_LDB(B0, 1, 0); PG8_LDB(B1, 1, 1); PG8_SCHED; PG8_LDA(At, 1, 0); PG8_STAGE(PG8_SA(0, 1), a2 + hstep, voffA);
            PG8_WAIT_V(8); PG8_WAIT_L(0); PG8_BAR; PG8_MMA(0, 0, At, B0); PG8_MMA(0, 1, At, B1); PG8_BAR; PG8_SCHED;
            PG8_LDA(At, 1, 1); PG8_STAGE(PG8_SB(1, 0), b3, voffB); PG8_STAGE(PG8_SB(1, 1), b3 + hstep, voffB); PG8_STAGE(PG8_SA(1, 0), a3, voffA);
            PG8_WAIT_V(8); PG8_WAIT_L(0); PG8_BAR; PG8_MMA(1, 0, At, B0); PG8_MMA(1, 1, At, B1); PG8_BAR; PG8_SCHED;
            } else {
            PG8_LDB(B0, 0, 0); PG8_SCHED; PG8_LDA(At, 0, 0); PG8_STAGE(PG8_SA(1, 1), a1 + hstep, voffA);
            PG8_WAIT_L(8); PG8_BAR; PG8_WAIT_L(0); PG8_MMA(0, 0, At, B0); PG8_BAR; PG8_SCHED;
            PG8_LDB(B1, 0, 1); PG8_STAGE(PG8_SB(0, 0), b2, voffB);
            PG8_BAR; PG8_WAIT_L(0); PG8_MMA(0, 1, At, B1); PG8_BAR;
            PG8_LDA(At, 0, 1); PG8_STAGE(PG8_SA(0, 0), a2, voffA);
            PG8_BAR; PG8_WAIT_L(0); PG8_MMA(1, 0, At, B0); PG8_BAR; PG8_SCHED;
            PG8_STAGE(PG8_SB(0, 1), b2 + hstep, voffB);
            PG8_WAIT_V(6); PG8_BAR; PG8_MMA(1, 1, At, B1); PG8_BAR;
            PG8_LDB(B0, 1, 0); PG8_SCHED; PG8_LDA(At, 1, 0); PG8_STAGE(PG8_SA(0, 1), a2 + hstep, voffA);
            PG8_WAIT_L(8); PG8_BAR; PG8_WAIT_L(0); PG8_MMA(0, 0, At, B0); PG8_BAR; PG8_SCHED;
            PG8_LDB(B1, 1, 1); PG8_STAGE(PG8_SB(1, 0), b3, voffB);
            PG8_BAR; PG8_WAIT_L(0); PG8_MMA(0, 1, At, B1); PG8_BAR;
            PG8_LDA(At, 1, 1); PG8_STAGE(PG8_SA(1, 0), a3, voffA);
            PG8_BAR; PG8_WAIT_L(0); PG8_MMA(1, 0, At, B0); PG8_BAR; PG8_SCHED;
            PG8_STAGE(PG8_SB(1, 1), b3 + hstep, voffB);
            PG8_WAIT_V(6); PG8_BAR; PG8_MMA(1, 1, At, B1); PG8_BAR;
            }
        }
        if constexpr (ALIGN_EPI) { if (wr == 0) PG8_BAR; }
        if constexpr (!Epi::AFTER_DRAIN) { E(acc, cur, wr, wc, fr, fq); S.done(cur); }
        if (!has_next) break;
#pragma unroll
        for (int a = 0; a < 2; ++a)
#pragma unroll
            for (int b = 0; b < 2; ++b)
#pragma unroll
                for (int m = 0; m < 4; ++m)
#pragma unroll
                    for (int n = 0; n < 2; ++n) acc[a][b][m][n] = (acc_t){0, 0, 0, 0};
        cur = nxt; cA = nA; cB = nB; ++ui;
        if constexpr (ALIGN_EPI) { if (wr == 1) PG8_BAR; }
    }
    PG8_WAIT_V(0);
    if constexpr (!ALIGN_EPI) { if (wr == 0) PG8_BAR; }
    PG8_BAR;
    if constexpr (Epi::AFTER_DRAIN) { E.fused(acc, cur, wr, wc, fr, fq, lds, wid, lane); S.done(cur); }
#undef PG8_SA
#undef PG8_SB
#undef PG8_STAGE
#undef PG8_LDA
#undef PG8_LDB
#undef PG8_MMA
#undef PG8_WAIT_V
#undef PG8_WAIT_L
#undef PG8_BAR
#undef PG8_SCHED
}
}
constexpr int NWAVES = 8, NTHR = 512;
constexpr int NB = 8, T = 8192, M = NB * T, D = 1024, CH = 512, NH = 8, HD = 64, FF = 4096, NL = 2;
constexpr int PIN = 3456, HYP = 1536, RWP = 1920, NRW = 2048;
constexpr float RMS_EPS = 1e-5f, GN_EPS = 64.0f * 1e-5f;
constexpr int MLP_CHUNKS = 4;
static_assert(MLP_CHUNKS >= 2 && M % (MLP_CHUNKS * 256) == 0, "the next layer's first-half RMSNorm is folded into the last MLP chunk: it needs a barrier between the first half's down GEMMs and that chunk");

constexpr size_t MiB = 1u << 20;
constexpr size_t WS_CTL = 0, CTL_ZERO_BYTES = 1 * MiB;
constexpr size_t WS_W = 2 * MiB;
constexpr size_t W_LAYER = 25 * MiB, W_HY = 0, W_RW = 3 * MiB, W_O = 7 * MiB, W_1 = 9 * MiB, W_2 = 17 * MiB;
constexpr size_t WS_RSC = 52 * MiB;
constexpr size_t WS_CSC = 52 * MiB + 512 * 1024;
constexpr size_t WS_FSC = 52 * MiB;
constexpr size_t WS_RSS = 53 * MiB;
constexpr size_t WS_BS = 53 * MiB;
constexpr size_t WS_FRAG = 57 * MiB;
constexpr size_t WS_SFIN = 62 * MiB;
constexpr size_t WS_YPHI = 64 * MiB;
constexpr size_t WS_HF = 64 * MiB;
constexpr size_t WS_HN = 128 * MiB;
constexpr size_t WS_G = 128 * MiB, WS_V2 = 192 * MiB;
constexpr size_t WS_VFIRST = 256 * MiB;
constexpr size_t WS_PHT = 320 * MiB;
constexpr size_t WS_PRW = 512 * MiB;
constexpr size_t WS_YS = 768 * MiB;
constexpr size_t WS_HID = 320 * MiB;
constexpr size_t WS_YMIX = 896 * MiB;
constexpr size_t WS_END = 1024 * MiB;
constexpr int CW_BAR = 4096;
constexpr int CW_CMAX = 32768;
constexpr int CW_QUEUE = 16384;

constexpr int LDS_BYTES = 163840;
constexpr int LDSCTL_OFF = LDS_BYTES - 512;

#define GAS __attribute__((address_space(1)))
#define LAS __attribute__((address_space(3)))
typedef unsigned short bf16;
typedef unsigned v4u __attribute__((ext_vector_type(4)));
typedef unsigned v2u __attribute__((ext_vector_type(2)));
typedef float f32x4 __attribute__((ext_vector_type(4)));
#define PHASE_TID() int bid = blockIdx.x; asm volatile("" : "+s"(bid)); (void)bid; int tid = threadIdx.x; asm volatile("" : "+v"(tid)); const int lane = tid & 63; const int wave = __builtin_amdgcn_readfirstlane(tid >> 6); (void)lane; (void)wave
#define RLX_AGENT __ATOMIC_RELAXED, __HIP_MEMORY_SCOPE_AGENT
#define LDS_WAIT() asm volatile("s_waitcnt lgkmcnt(0)" ::: "memory")
#define VM_WAIT() asm volatile("s_waitcnt vmcnt(0)" ::: "memory")
typedef float f32x2_ __attribute__((ext_vector_type(2)));
typedef __bf16 bf16x2_ __attribute__((ext_vector_type(2)));
__device__ __forceinline__ unsigned pk2(float lo, float hi) { return __builtin_bit_cast(unsigned, __builtin_convertvector((f32x2_){lo, hi}, bf16x2_)); }
__device__ __forceinline__ unsigned f2bf(float f) { return pk2(f, f) & 0xffffu; }
__device__ __forceinline__ float bf2f(unsigned h) { return __uint_as_float(h << 16); }
__device__ __forceinline__ float bflo(unsigned w) { return __uint_as_float(w << 16); }
__device__ __forceinline__ float bfhi(unsigned w) { return __uint_as_float(w & 0xffff0000u); }
__device__ __forceinline__ float sigmoidf_(float x) { return __builtin_amdgcn_rcpf(1.0f + __expf(-x)); }
__device__ __forceinline__ float tanhf_(float x) { return 1.0f - 2.0f * __builtin_amdgcn_rcpf(1.0f + __expf(2.0f * x)); }
template <int CTRL> __device__ __forceinline__ float dpp(float x) { return __builtin_bit_cast(float, __builtin_amdgcn_mov_dpp(__builtin_bit_cast(int, x), CTRL, 0xf, 0xf, true)); }
constexpr int XOR1 = 0xB1, XOR2 = 0x4E, XOR7 = 0x141, XOR8 = 0x128;
__device__ __forceinline__ float sin_hw(float x) { const float r = x * 0.15915494309189535f; return __builtin_amdgcn_sinf(r - floorf(r)); }
__device__ __forceinline__ float sum8(float v) { v += dpp<XOR1>(v); v += dpp<XOR2>(v); v += dpp<XOR7>(v); return v; }
__device__ __forceinline__ float sum16(float v) { v = sum8(v); v += dpp<XOR8>(v); return v; }

#define XB_TMO      128
#define XB_XCNT(j)  (256  + 64 * (j))
#define XB_XSUB(j)  (1280 + 64 * (j))
#define XB_XGEN(j)  (2304 + 64 * (j))
#define XB_TOP      3328
#define XB_TOPGEN   3392
#define XCD_BAR_WORDS 3456
#define XB_SPIN_CAP (1u << 18)

__device__ __forceinline__ unsigned xb_ld(unsigned* p)              { return __hip_atomic_load(p, __ATOMIC_RELAXED, __HIP_MEMORY_SCOPE_AGENT); }
__device__ __forceinline__ unsigned xb_add(unsigned* p, unsigned v) { return __hip_atomic_fetch_add(p, v, __ATOMIC_RELAXED, __HIP_MEMORY_SCOPE_AGENT); }
__device__ __forceinline__ unsigned xb_xcc_id() { return (unsigned)__builtin_amdgcn_s_getreg((3 << 11) | 20) & 0xFu; }
#define XB_SPIN(cond, bar) do { unsigned _sp = 0; while (cond) { __builtin_amdgcn_s_sleep(1); \
    if ((++_sp & 255u) == 0u) { if (xb_ld(&(bar)[XB_TMO])) break; if (_sp > XB_SPIN_CAP) { atomicAdd(&(bar)[XB_TMO], 1u); break; } } } } while (0)

struct XcdBarrier {
    unsigned* bar; unsigned x;
    volatile LAS unsigned* st;
};
__device__ __forceinline__ XcdBarrier xcd_barrier_post(unsigned* bar, volatile LAS unsigned* st) {
    XcdBarrier b; b.bar = bar; b.x = xb_xcc_id(); b.st = st;
    if (threadIdx.x == 0) (void)xb_add(&bar[XB_XCNT(b.x)], 1u);
    return b;
}
__device__ __forceinline__ void xcd_barrier_complete(unsigned* bar, unsigned x, unsigned& nloc, unsigned& nx) {
    const unsigned G = gridDim.x * gridDim.y * gridDim.z;
    unsigned sum, cnt, mine, sp = 0u;
    for (;;) {
        sum = 0u; cnt = 0u; mine = 0u;
#pragma unroll
        for (unsigned j = 0; j < 16; ++j) { const unsigned c = xb_ld(&bar[XB_XCNT(j)]); sum += c; cnt += (c > 0u) ? 1u : 0u; mine = (j == x) ? c : mine; }
        if (sum == G) break;
        __builtin_amdgcn_s_sleep(1);
        if ((++sp & 255u) == 0u) { if (xb_ld(&bar[XB_TMO])) break; if (sp > XB_SPIN_CAP) { atomicAdd(&bar[XB_TMO], 1u); break; } }
    }
    nloc = mine > 0u ? mine : 1u; nx = cnt > 0u ? cnt : 1u;
}
__device__ __forceinline__ void xcd_barrier(const XcdBarrier& b) {
    asm volatile("s_waitcnt vmcnt(0)" ::: "memory");
    __syncthreads();
    if (threadIdx.x == 0) {
        unsigned* bar = b.bar;
        unsigned bx = b.x; asm volatile("" : "+s"(bx));
        __builtin_amdgcn_s_waitcnt(0);
        unsigned nloc = b.st[0], nx = b.st[1];
        if (nloc == 0u) { xcd_barrier_complete(bar, bx, nloc, nx); b.st[0] = nloc; b.st[1] = nx; }
        const unsigned old = xb_add(&bar[XB_XSUB(bx)], 1u);
        const unsigned gen = old / nloc;
        if (old + 1u == (gen + 1u) * nloc) {
            __builtin_amdgcn_fence(__ATOMIC_RELEASE, "agent");
            asm volatile("s_waitcnt vmcnt(0)" ::: "memory");
            const unsigned og = xb_add(&bar[XB_TOP], 1u);
            const unsigned tg = og / nx;
            if (og + 1u == (tg + 1u) * nx) xb_add(&bar[XB_TOPGEN], 1u);
            else XB_SPIN(xb_ld(&bar[XB_TOPGEN]) == tg, bar);
            __builtin_amdgcn_fence(__ATOMIC_ACQUIRE, "agent");
            xb_add(&bar[XB_XGEN(bx)], 1u);
            asm volatile("s_waitcnt vmcnt(0)" ::: "memory");
        } else {
            XB_SPIN(xb_ld(&bar[XB_XGEN(bx)]) == gen, bar);
            __builtin_amdgcn_fence(__ATOMIC_ACQUIRE, "agent");
            asm volatile("s_waitcnt vmcnt(0)" ::: "memory");
        }
    }
    __syncthreads();
}

struct Frame {
    LAS unsigned char* lds;
    volatile LAS unsigned* MISC;
    unsigned* ctl;
    int G;
    const float* const* in;
    float* out; unsigned char* ws;
};
enum { I_X = 0, I_N1G, I_WIN, I_HCW, I_HCB, I_FW1, I_FB1, I_FW2, I_FB2, I_FW3, I_FB3, I_FFREQ, I_FWOUT, I_HSKIP, I_HNG, I_SHIFT, I_W0, I_W2, I_A0, I_A2, I_G2, I_KK, I_KA, I_RK, I_LNG, I_LNB, I_V0, I_V1, I_V2, I_WOUT, I_N2G, I_MW1, I_MW2, I_FING };

__device__ __forceinline__ float wave_max(float v) {
#pragma unroll
    for (int o = 1; o < 64; o <<= 1) v = fmaxf(v, __shfl_xor(v, o));
    return v;
}
__device__ __forceinline__ unsigned q4(float a, float b, float c, float d) {
    const int ia = (int)__builtin_rintf(a), ib = (int)__builtin_rintf(b), ic = (int)__builtin_rintf(c), id = (int)__builtin_rintf(d);
    return (unsigned)(ia & 255) | ((unsigned)(ib & 255) << 8) | ((unsigned)(ic & 255) << 16) | ((unsigned)id << 24);
}
__device__ __forceinline__ float wave_sum(float v) {
#pragma unroll
    for (int o = 1; o < 64; o <<= 1) v += __shfl_xor(v, o);
    return v;
}
typedef float f32x2 __attribute__((ext_vector_type(2)));
constexpr int FN = 2 * T;
constexpr int XPAD = FN + FN / 16 + 16 * (FN / 512);
__device__ __forceinline__ f32x2 cmul(f32x2 a, f32x2 b) { return (f32x2){a.x * b.x - a.y * b.y, a.x * b.y + a.y * b.x}; }
__device__ __forceinline__ f32x2 pk_fma_rot(f32x2 a, f32x2 b, f32x2 t) { f32x2 r;
    asm("v_pk_fma_f32 %0, %1, %2, %3 op_sel:[1,1,0] op_sel_hi:[1,0,1] neg_lo:[0,1,0]" : "=v"(r) : "v"(a), "v"(b), "v"(t)); return r; }
__device__ __forceinline__ f32x2 pk_add_mib(f32x2 a, f32x2 b) { f32x2 r; asm("v_pk_add_f32 %0, %1, %2 op_sel:[0,1] op_sel_hi:[1,0] neg_hi:[0,1]" : "=v"(r) : "v"(a), "v"(b)); return r; }
__device__ __forceinline__ f32x2 pk_add_pib(f32x2 a, f32x2 b) { f32x2 r; asm("v_pk_add_f32 %0, %1, %2 op_sel:[0,1] op_sel_hi:[1,0] neg_lo:[0,1]" : "=v"(r) : "v"(a), "v"(b)); return r; }
__device__ __forceinline__ f32x2 cmulc(f32x2 a, f32x2 b) { return (f32x2){a.x * b.x + a.y * b.y, a.y * b.x - a.x * b.y}; }
__device__ constexpr float C32[16] = {1.0f, 0.98078528040323043f, 0.92387953251128674f, 0.83146961230254524f, 0.70710678118654752f, 0.55557023301960218f, 0.38268343236508977f, 0.19509032201612825f,
                                      0.0f, -0.19509032201612825f, -0.38268343236508977f, -0.55557023301960218f, -0.70710678118654752f, -0.83146961230254524f, -0.92387953251128674f, -0.98078528040323043f};
__device__ constexpr float S32[16] = {0.0f, 0.19509032201612825f, 0.38268343236508977f, 0.55557023301960218f, 0.70710678118654752f, 0.83146961230254524f, 0.92387953251128674f, 0.98078528040323043f,
                                      1.0f, 0.98078528040323043f, 0.92387953251128674f, 0.83146961230254524f, 0.70710678118654752f, 0.55557023301960218f, 0.38268343236508977f, 0.19509032201612825f};
constexpr int bitrev_c(int v, int bits) { int r = 0; for (int i = 0; i < bits; ++i) r |= ((v >> i) & 1) << (bits - 1 - i); return r; }
#define SH0(v) __builtin_shufflevector(v, v, 0, 0)
#define SH1(v) __builtin_shufflevector(v, v, 1, 1)
template <int R, bool INV, bool STORE = false, int NOUT = R> __device__ __forceinline__ void dft_regs(f32x2 (&x)[R], LAS f32x2* P = nullptr, int stride = 0) {
    constexpr int LOG = (R == 32) ? 5 : 4;
    f32x2 y[R];
#pragma unroll
    for (int k = 0; k < R; ++k) y[k] = x[bitrev_c(k, LOG)];
#pragma unroll
    for (int s = 1; s < R; s <<= 1) {
#pragma unroll
        for (int blk = 0; blk < R; blk += 2 * s) {
            const bool st = STORE && (2 * s == R);
            { const f32x2 a = y[blk], b = y[blk + s]; y[blk] = a + b; y[blk + s] = a - b;
              if (st) { P[0] = y[blk]; if (s < NOUT) P[s * stride] = y[blk + s]; } }
            if (s >= 2) { const f32x2 a = y[blk + s / 2], b = y[blk + s / 2 + s];
                y[blk + s / 2] = INV ? pk_add_pib(a, b) : pk_add_mib(a, b); y[blk + s / 2 + s] = INV ? pk_add_mib(a, b) : pk_add_pib(a, b);
                if (st) { P[(s / 2) * stride] = y[blk + s / 2]; if (s / 2 + s < NOUT) P[(s / 2 + s) * stride] = y[blk + s / 2 + s]; } }
#pragma unroll
            for (int j = 1; j < s / 2; ++j) { const int j2 = s - j, m1 = j * (16 / s), m2 = j2 * (16 / s);
                const float c1 = C32[m1], s1 = INV ? S32[m1] : -S32[m1], c2 = C32[m2], s2 = INV ? S32[m2] : -S32[m2];
                const f32x2 a1 = y[blk + j], b1 = y[blk + j + s], a2 = y[blk + j2], b2 = y[blk + j2 + s];
                const f32x2 p1 = __builtin_elementwise_fma(SH0(b1), (f32x2){c1, s1}, a1), p2 = __builtin_elementwise_fma(SH0(b2), (f32x2){c2, s2}, a2);
                if (st) asm volatile("" :: "v"(p1), "v"(p2) : "memory"); else asm volatile("" :: "v"(p1), "v"(p2));
                const f32x2 q1 = __builtin_elementwise_fma(SH1(b1), (f32x2){-s1, c1}, p1), q2 = __builtin_elementwise_fma(SH1(b2), (f32x2){-s2, c2}, p2);
                asm volatile("" :: "v"(q1), "v"(q2));
                y[blk + j] = q1; y[blk + j2] = q2;
                y[blk + j + s] = __builtin_elementwise_fma(a1, (f32x2){2.0f, 2.0f}, -q1); y[blk + j2 + s] = __builtin_elementwise_fma(a2, (f32x2){2.0f, 2.0f}, -q2);
                if (st) { P[j * stride] = q1; P[j2 * stride] = q2; if (j + s < NOUT) P[(j + s) * stride] = y[blk + j + s]; if (j2 + s < NOUT) P[(j2 + s) * stride] = y[blk + j2 + s]; } }
        }
    }
#pragma unroll
    for (int k = 0; k < R; ++k) x[k] = y[k];
}
template <int R, bool INV, bool STORE = false> __device__ __forceinline__ void twiddle_regs(f32x2 (&x)[R], float frac, LAS f32x2* P = nullptr, int stride = 0) {
    asm volatile("" : "+v"(frac));
    const float sn0 = __builtin_amdgcn_sinf(0.5f * frac), cs = __builtin_amdgcn_cosf(0.5f * frac);
    const float sn = INV ? sn0 : -sn0;
    const f32x2 w = (f32x2){cs, sn}, iw = (f32x2){-sn, cs};
    f32x2 w2; { f32x2 t = __builtin_shufflevector(w, w, 0, 0) * w; w2 = pk_fma_rot(w, w, t); }
    f32x2 wa = w, wb = w2;
    if (STORE) P[0] = x[0];
#pragma unroll
    for (int k = 1; k < R; k += 2) {
        const bool hb = (k + 1 < R), na = (k + 2 < R), nb = (k + 3 < R);
        const f32x2 xa = x[k], xb = hb ? x[k + 1] : x[k];
        const f32x2 tda = __builtin_shufflevector(xa, xa, 0, 0) * wa, tdb = __builtin_shufflevector(xb, xb, 0, 0) * wb;
        const f32x2 tpa = __builtin_shufflevector(wa, wa, 0, 0) * w2, tpb = __builtin_shufflevector(wb, wb, 0, 0) * w2;
        if (hb && na && nb) { if (STORE) asm volatile("" :: "v"(tda), "v"(tdb), "v"(tpa), "v"(tpb) : "memory"); else asm volatile("" :: "v"(tda), "v"(tdb), "v"(tpa), "v"(tpb)); }
        else asm volatile("" :: "v"(tda));
        x[k] = pk_fma_rot(xa, wa, tda);
        if (hb) x[k + 1] = pk_fma_rot(xb, wb, tdb);
        if (STORE) { P[k * stride] = x[k]; if (hb) P[(k + 1) * stride] = x[k + 1]; }
        if (na) wa = pk_fma_rot(wa, w2, tpa);
        if (nb) wb = pk_fma_rot(wb, w2, tpb);
    }
}
#define XP(i) ((i) + ((i) >> 4) + 16 * ((i) >> 9))
constexpr int XBP = 560;
template <bool ZUP> __device__ __forceinline__ void fft_f1(LAS f32x2* X, int t) {
    f32x2 x[32]; const int base = t + (t >> 4);
#pragma unroll
    for (int j = 0; j < 32; ++j) x[j] = (ZUP && j >= 16) ? (f32x2){0.f, 0.f} : X[base + j * XBP];
    dft_regs<32, false>(x);
    twiddle_regs<32, false, true>(x, (float)t * (1.0f / 8192.0f), X + base, XBP);
}
__device__ __forceinline__ void fft_f2(LAS f32x2* X, int t) {
    f32x2 x[32]; const int base = (t >> 4) * XBP + (t & 15);
#pragma unroll
    for (int j = 0; j < 32; ++j) x[j] = X[base + j * 17];
    dft_regs<32, false>(x);
    twiddle_regs<32, false, true>(x, (float)(t & 15) * (1.0f / 256.0f), X + base, 17);
}
__device__ __forceinline__ void fft_mid(LAS f32x2* X, const f32x2* H, int t) {
#pragma unroll 1
    for (int r = 0; r < 2; ++r) { const int b = (t >> 6) * 128 + (t & 63) + 64 * r; f32x2 x[16];
        const f32x4* hp = (const f32x4*)(H + 16 * b); f32x4 h[8];
#pragma unroll
        for (int k = 0; k < 8; ++k) h[k] = hp[k];
#pragma unroll
        for (int j = 0; j < 16; ++j) x[j] = X[17 * b + 16 * (b >> 5) + j];
        dft_regs<16, false>(x);
#pragma unroll
        for (int k = 0; k < 8; ++k) { const f32x2 h0 = (f32x2){h[k][0], h[k][1]}, h1 = (f32x2){h[k][2], h[k][3]}, a0 = x[2 * k], a1 = x[2 * k + 1];
            f32x2 t0 = __builtin_shufflevector(a0, a0, 0, 0) * h0, t1 = __builtin_shufflevector(a1, a1, 0, 0) * h1;
            asm volatile("" :: "v"(t0), "v"(t1));
            x[2 * k] = pk_fma_rot(a0, h0, t0); x[2 * k + 1] = pk_fma_rot(a1, h1, t1); }
        dft_regs<16, true>(x);
#pragma unroll
        for (int j = 0; j < 16; ++j) X[17 * b + 16 * (b >> 5) + j] = x[j]; }
}
__device__ __forceinline__ void fft_i2(LAS f32x2* X, int t) {
    f32x2 x[32]; const int base = (t >> 4) * XBP + (t & 15);
#pragma unroll
    for (int k = 0; k < 32; ++k) x[k] = X[base + k * 17];
    twiddle_regs<32, true>(x, (float)(t & 15) * (1.0f / 256.0f));
    dft_regs<32, true, true, 32>(x, X + base, 17);
}
__device__ __forceinline__ void fft_i1(LAS f32x2* X, int t) {
    f32x2 x[32]; const int base = t + (t >> 4);
#pragma unroll
    for (int k = 0; k < 32; ++k) x[k] = X[base + k * XBP];
    twiddle_regs<32, true>(x, (float)t * (1.0f / 8192.0f));
    dft_regs<32, true, true, 16>(x, X + base, XBP);
}
__device__ __forceinline__ void fft_conv(LAS f32x2* X, const f32x2* H, int tid) {
    __syncthreads(); fft_f1<true>(X, tid);
    __syncthreads(); fft_f2(X, tid);
    LDS_WAIT(); asm volatile("" ::: "memory"); fft_mid(X, H, tid);
    LDS_WAIT(); asm volatile("" ::: "memory"); fft_i2(X, tid);
    __syncthreads(); fft_i1(X, tid);
    __syncthreads();
}
__device__ __forceinline__ void hy_spectrum_item(Frame& F, int item) {
    PHASE_TID();
    LAS f32x2* X = (LAS f32x2*)F.lds; LAS float* RED = (LAS float*)(F.lds + XPAD * 8);
    const int o = item >> 9, c = item & 511;
    const float* HF = (const float*)(F.ws + WS_HF);
    const float* f = HF + ((size_t)(o * 2 + 0) * CH + c) * T; const float* bw = HF + ((size_t)(o * 2 + 1) * CH + c) * T;
    f32x2* HS = (f32x2*)(F.ws + WS_YMIX) + (size_t)item * FN;
    __syncthreads();
    f32x2 x[32]; float ss = 0.f; const int base = tid + (tid >> 4);
#pragma unroll
    for (int j = 0; j < 32; ++j) { const int idx = j * 512 + tid; float v;
        if (j < 16) v = f[idx]; else v = (idx == T) ? 0.f : bw[FN - idx];
        ss += v * v; x[j] = (f32x2){v, 0.f}; }
    ss = wave_sum(ss);
    if (lane == 0) RED[wave] = ss;
    dft_regs<32, false>(x);
    twiddle_regs<32, false>(x, (float)tid * (1.0f / 8192.0f));
#pragma unroll
    for (int k = 0; k < 32; ++k) X[base + k * XBP] = x[k];
    __syncthreads();
    float tot = 0.f;
#pragma unroll
    for (int w = 0; w < 8; ++w) tot += RED[w];
    const float sc = (1.0f / sqrtf(tot + 1e-6f)) * (1.0f / (float)FN);
    fft_f2(X, tid);
    __syncthreads();
#pragma unroll 1
    for (int r = 0; r < 2; ++r) { const int b = tid + 512 * r; f32x2 y[16];
#pragma unroll
        for (int j = 0; j < 16; ++j) y[j] = X[17 * b + 16 * (b >> 5) + j];
        dft_regs<16, false>(y);
        f32x4* dst = (f32x4*)(HS + 16 * b);
#pragma unroll
        for (int k = 0; k < 8; ++k) dst[k] = (f32x4){y[2 * k].x * sc, y[2 * k].y * sc, y[2 * k + 1].x * sc, y[2 * k + 1].y * sc}; }
}
__device__ __forceinline__ void p_spectra(Frame& F) { PHASE_TID(); (void)tid; for (int it = bid; it < 2 * CH; it += F.G) hy_spectrum_item(F, it); __syncthreads(); }

struct RowRaw { v4u a, b; unsigned lo, hi; };
__device__ __forceinline__ void hy_row_load(RowRaw& R, const bf16* row, int t0) {
    R.a = *(const v4u*)(row + t0); R.b = *(const v4u*)(row + t0 + 8);
    R.lo = t0 > 0 ? (unsigned)row[t0 - 1] : 0u; R.hi = t0 + 16 < T ? (unsigned)row[t0 + 16] : 0u;
}
__device__ __forceinline__ void hy_u16r(const RowRaw& R, float w0, float w1, float w2, float bias, float (&u)[16]) {
    float p[18];
    p[0] = __builtin_bit_cast(float, R.lo << 16); p[17] = __builtin_bit_cast(float, R.hi << 16);
    const unsigned w[8] = {R.a.x, R.a.y, R.a.z, R.a.w, R.b.x, R.b.y, R.b.z, R.b.w};
#pragma unroll
    for (int i = 0; i < 8; ++i) { p[1 + 2 * i] = bflo(w[i]); p[2 + 2 * i] = bfhi(w[i]); }
#pragma unroll
    for (int i = 0; i < 16; ++i) u[i] = w0 * p[i] + w1 * p[i + 1] + w2 * p[i + 2] + bias;
}
__device__ __forceinline__ void hy_pack_store(bf16* dst, const float (&y)[16]) {
    v4u o0, o1;
    o0.x = pk2(y[0], y[1]); o0.y = pk2(y[2], y[3]); o0.z = pk2(y[4], y[5]); o0.w = pk2(y[6], y[7]);
    o1.x = pk2(y[8], y[9]); o1.y = pk2(y[10], y[11]); o1.z = pk2(y[12], y[13]); o1.w = pk2(y[14], y[15]);
    *(v4u*)dst = o0; *(v4u*)(dst + 8) = o1;
}
__device__ __forceinline__ void hy_fft_item(Frame& F, int l, int item) {
    PHASE_TID(); const int c = item >> 2, bp = item & 3, t0 = 16 * tid, xb = 17 * tid + 16 * (tid >> 5);
    LAS f32x2* X = (LAS f32x2*)F.lds;
    bf16* PHT = (bf16*)(F.ws + WS_PHT);
    bf16* rx1a = PHT + ((size_t)(2 * bp) * HYP + c) * T; bf16* rx1b = rx1a + (size_t)HYP * T;
    bf16* rx2a = PHT + ((size_t)(2 * bp) * HYP + CH + c) * T; bf16* rx2b = rx2a + (size_t)HYP * T;
    const bf16* rva = PHT + ((size_t)(2 * bp) * HYP + 2 * CH + c) * T; const bf16* rvb = rva + (size_t)HYP * T;
    const float* cw = F.in[I_HCW] + (size_t)l * 3 * HYP; const float* cb = F.in[I_HCB] + (size_t)l * HYP;
    const float* skip = F.in[I_HSKIP] + (size_t)l * 2 * CH;
    const f32x2* H0 = (const f32x2*)(F.ws + WS_YMIX) + (size_t)c * FN; const f32x2* H1 = H0 + (size_t)CH * FN;
    __syncthreads();
    RowRaw va, vb, xa, xb2;
    hy_row_load(va, rva, t0); hy_row_load(vb, rvb, t0);
    const float vw0 = cw[2 * CH + c], vw1 = cw[HYP + 2 * CH + c], vw2 = cw[2 * HYP + 2 * CH + c], vbs = cb[2 * CH + c];
    const float x1w0 = cw[c], x1w1 = cw[HYP + c], x1w2 = cw[2 * HYP + c], x1bs = cb[c], x2w0 = cw[CH + c], x2w1 = cw[HYP + CH + c], x2w2 = cw[2 * HYP + CH + c], x2bs = cb[CH + c], s0 = skip[c], s1 = skip[CH + c];
    { float ua[16], ub[16];
      hy_u16r(va, vw0, vw1, vw2, vbs, ua); hy_u16r(vb, vw0, vw1, vw2, vbs, ub);
#pragma unroll
      for (int i = 0; i < 16; ++i) X[xb + i] = (f32x2){ua[i], ub[i]}; }
    hy_row_load(xa, rx1a, t0); hy_row_load(xb2, rx1b, t0);
    fft_conv(X, H0, tid);
    v4u z2a[2], z2b[2];
    { float ua[16], ub[16], za[16], zb[16];
      {
        hy_u16r(va, vw0, vw1, vw2, vbs, ua); hy_u16r(vb, vw0, vw1, vw2, vbs, ub);
#pragma unroll
        for (int i = 0; i < 16; ++i) { const f32x2 y = X[xb + i]; za[i] = y.x + s0 * ua[i]; zb[i] = y.y + s0 * ub[i]; } }
      hy_u16r(xa, x1w0, x1w1, x1w2, x1bs, ua); hy_u16r(xb2, x1w0, x1w1, x1w2, x1bs, ub);
#pragma unroll
      for (int i = 0; i < 16; ++i) { za[i] *= ua[i]; zb[i] *= ub[i]; }
#pragma unroll
      for (int q = 0; q < 2; ++q) { z2a[q].x = pk2(za[8 * q], za[8 * q + 1]); z2a[q].y = pk2(za[8 * q + 2], za[8 * q + 3]); z2a[q].z = pk2(za[8 * q + 4], za[8 * q + 5]); z2a[q].w = pk2(za[8 * q + 6], za[8 * q + 7]);
                                    z2b[q].x = pk2(zb[8 * q], zb[8 * q + 1]); z2b[q].y = pk2(zb[8 * q + 2], zb[8 * q + 3]); z2b[q].z = pk2(zb[8 * q + 4], zb[8 * q + 5]); z2b[q].w = pk2(zb[8 * q + 6], zb[8 * q + 7]); }
#pragma unroll
      for (int i = 0; i < 16; ++i) X[xb + i] = (f32x2){za[i], zb[i]}; }
    hy_row_load(xa, rx2a, t0); hy_row_load(xb2, rx2b, t0);
    fft_conv(X, H1, tid);
    { float ua[16], ub[16];
      hy_u16r(xa, x2w0, x2w1, x2w2, x2bs, ua); hy_u16r(xb2, x2w0, x2w1, x2w2, x2bs, ub);
      float za[16], zb[16];
      const unsigned wa[8] = {z2a[0].x, z2a[0].y, z2a[0].z, z2a[0].w, z2a[1].x, z2a[1].y, z2a[1].z, z2a[1].w}, wb[8] = {z2b[0].x, z2b[0].y, z2b[0].z, z2b[0].w, z2b[1].x, z2b[1].y, z2b[1].z, z2b[1].w};
#pragma unroll
      for (int i = 0; i < 8; ++i) { za[2 * i] = bflo(wa[i]); za[2 * i + 1] = bfhi(wa[i]); zb[2 * i] = bflo(wb[i]); zb[2 * i + 1] = bfhi(wb[i]); }
#pragma unroll
      for (int i = 0; i < 16; ++i) { const f32x2 y = X[xb + i]; za[i] = ua[i] * (y.x + s1 * za[i]); zb[i] = ub[i] * (y.y + s1 * zb[i]); }
      hy_pack_store(rx2a + t0, za); hy_pack_store(rx2b + t0, zb); }
}
typedef short bf16x8 __attribute__((ext_vector_type(8)));
constexpr int CL_ = 64;
constexpr int LDB = 80;
constexpr int LDSG = 144, LDVL = 48;
constexpr int LDF = 65;
constexpr int MB = 64 * LDB * 2;
constexpr int MF = 64 * LDF * 4;
constexpr int O_AH = 0, O_AHT = MB, O_RH = 2 * MB, O_BH = 3 * MB, O_BHT = 4 * MB, O_KH = 5 * MB, O_KHT = 6 * MB, O_VT = 7 * MB;
constexpr int O_TW = 0, O_AD = MB, O_SG = 2 * MB  , O_VL = 2 * MB + 64 * LDSG * 2  ;
constexpr int O_APB = O_KH;
constexpr int O_F = 8 * MB;
constexpr int O_AF = O_F, O_LW = O_F + MF, O_ZV = O_F + 2 * MF;
constexpr int O_XA = O_F, O_XAT = O_F + MB, O_AAK = O_F + 2 * MB, O_ARB = O_F + 3 * MB, O_ARK = O_F + 4 * MB;
constexpr int O_S0B = O_F + ((3 * MF > 5 * MB) ? 3 * MF : 5 * MB);
constexpr int O_UT = O_S0B + MB;
constexpr int O_TB = O_UT, O_M1T = O_BH, O_T0T = O_AH, O_WT = O_KH;
constexpr int O_PL = O_UT + MB;
constexpr int O_PART = O_PL + 256;
constexpr int O_MU = O_PART + 2048;
constexpr int O_CK = O_MU + 1792;
constexpr int O_MC = O_CK + 768;
static_assert(O_ARK + MB <= O_S0B && O_ZV + MF <= O_S0B && O_VL + 64 * LDVL * 2 <= O_F && O_MC + 1792 <= LDSCTL_OFF, "cscan LDS map");

__device__ __forceinline__ unsigned pk2s(float v) { return pk2(v, v); }
#define MFMA16(a, b, c) __builtin_amdgcn_mfma_f32_16x16x32_bf16((a), (b), (c), 0, 0, 0)
__device__ __forceinline__ bf16x8 ldfrag(const LAS unsigned char* base, int ld, int row0, int k0, int fr, int fq) {
    return *(const LAS bf16x8*)(base + ((row0 + fr) * ld + k0 + 8 * fq) * 2);
}
__device__ __forceinline__ void st_tile_bf16(LAS unsigned char* base, int ld, int m0, int n0, int fr, int fq, const f32x4& v) {
#pragma unroll
    for (int jj = 0; jj < 4; ++jj) *(LAS bf16*)(base + ((m0 + 4 * fq + jj) * ld + n0 + fr) * 2) = (bf16)pk2s(v[jj]);
}
__device__ __forceinline__ void st_tile_bf16_T(LAS unsigned char* base, int ld, int m0, int n0, int fr, int fq, const f32x4& v) {
    v2u o; o.x = pk2(v[0], v[1]); o.y = pk2(v[2], v[3]);
    *(LAS v2u*)(base + ((n0 + fr) * ld + m0 + 4 * fq) * 2) = o;
}
#define CFENCE() asm volatile("" ::: "memory")
#define ZFRAG ((bf16x8){0, 0, 0, 0, 0, 0, 0, 0})
__device__ __forceinline__ void ldA(bf16x8 (&a)[2], const LAS unsigned char* A, int mt, int fr, int fq) {
#pragma unroll
    for (int ks = 0; ks < 2; ++ks) a[ks] = ldfrag(A, LDB, 16 * mt, 32 * ks, fr, fq);
}
__device__ __forceinline__ void ldB(bf16x8 (&b)[2][2], const LAS unsigned char* B, int nt0, int fr, int fq) {
#pragma unroll
    for (int ks = 0; ks < 2; ++ks)
#pragma unroll
        for (int j = 0; j < 2; ++j) b[ks][j] = ldfrag(B, LDB, 16 * (nt0 + j), 32 * ks, fr, fq);
}
#define PIN(x) asm volatile("" : "+v"(x))
__device__ __forceinline__ void mmac(bf16x8 (&a)[2], bf16x8 (&b)[2][2], f32x4 (&acc)[2]) {
#pragma unroll
    for (int ks = 0; ks < 2; ++ks) { PIN(a[ks]);
#pragma unroll
        for (int j = 0; j < 2; ++j) { PIN(b[ks][j]); acc[j] = MFMA16(a[ks], b[ks][j], acc[j]); } }
}
__device__ __forceinline__ void mmacT(bf16x8 (&a)[2], bf16x8 (&b)[2][2], f32x4 (&acc)[2]) {
#pragma unroll
    for (int ks = 0; ks < 2; ++ks) { PIN(a[ks]);
#pragma unroll
        for (int j = 0; j < 2; ++j) { PIN(b[ks][j]); acc[j] = MFMA16(b[ks][j], a[ks], acc[j]); } }
}
__device__ __forceinline__ v4u pack8(const float (&v)[8]) { v4u o; o.x = pk2(v[0], v[1]); o.y = pk2(v[2], v[3]); o.z = pk2(v[4], v[5]); o.w = pk2(v[6], v[7]); return o; }
__device__ __forceinline__ bf16x8 wfrag(const float* W, int k0, int col, int fq) {
    float v[8];
#pragma unroll
    for (int e = 0; e < 8; ++e) v[e] = W[(size_t)(k0 + 8 * fq + e) * CH + col];
    return __builtin_bit_cast(bf16x8, pack8(v));
}

struct RawTok { v4u g[7][3]; };
__device__ __forceinline__ void load_raw(RawTok& R, const bf16* PRW, const bf16* VFIRST, int b, int tok, int hc, int ec, int d, int l, bool has_vl) {
    const size_t m = (size_t)b * T + tok; const v4u z = (v4u){0u, 0u, 0u, 0u};
    const int cols[7] = {hc + ec, CH + hc + ec, 2 * CH + hc + ec, 1536 + d * 64 + ec, 1664 + d * 64 + ec, 1792 + ec, 1856 + ec};
#pragma unroll
    for (int g = 0; g < 7; ++g) { if (g >= 5 && d != 0) { R.g[g][0] = z; R.g[g][1] = z; R.g[g][2] = z; continue; }
        const bf16* p = PRW + m * NRW + cols[g];
        R.g[g][1] = *(const v4u*)p; R.g[g][0] = *(const v4u*)(p - NRW); R.g[g][2] = *(const v4u*)(p + NRW); }
    if (__builtin_amdgcn_readfirstlane((int)__builtin_amdgcn_ballot_w64(tok == 0 || tok == T - 1) != 0 || (int)(__builtin_amdgcn_ballot_w64(tok == 0 || tok == T - 1) >> 32) != 0)) {
#pragma unroll
        for (int g = 0; g < 7; ++g) { R.g[g][0] = (tok == 0) ? z : R.g[g][0]; R.g[g][2] = (tok == T - 1) ? z : R.g[g][2]; } }
}
typedef __bf16 bf16x2v __attribute__((ext_vector_type(2)));
__device__ __forceinline__ void mix8r(const v4u (&r)[3], const LAS unsigned* mub, const LAS float* mcb, float (&out)[8]) {
    const v4u ma = *(const LAS v4u*)mub, mb = *(const LAS v4u*)(mub + 4); const f32x4 ca = *(const LAS f32x4*)mcb, cb = *(const LAS f32x4*)(mcb + 4);
    const unsigned mw[8] = {ma.x, ma.y, ma.z, ma.w, mb.x, mb.y, mb.z, mb.w}; const float mc[8] = {ca[0], ca[1], ca[2], ca[3], cb[0], cb[1], cb[2], cb[3]};
    const unsigned pw[4] = {r[0].x, r[0].y, r[0].z, r[0].w}, cw[4] = {r[1].x, r[1].y, r[1].z, r[1].w}, nw[4] = {r[2].x, r[2].y, r[2].z, r[2].w};
#pragma unroll
    for (int i = 0; i < 4; ++i) {
        const unsigned pn0 = __builtin_amdgcn_perm(nw[i], pw[i], 0x05040100u), pn1 = __builtin_amdgcn_perm(nw[i], pw[i], 0x07060302u);
        out[2 * i] = __builtin_amdgcn_fdot2_f32_bf16(__builtin_bit_cast(bf16x2v, pn0), __builtin_bit_cast(bf16x2v, mw[2 * i]), bflo(cw[i]) * mc[2 * i], false);
        out[2 * i + 1] = __builtin_amdgcn_fdot2_f32_bf16(__builtin_bit_cast(bf16x2v, pn1), __builtin_bit_cast(bf16x2v, mw[2 * i + 1]), bfhi(cw[i]) * mc[2 * i + 1], false); }
}
template <bool DO_T, bool DO_X, bool LAST> __device__ __forceinline__ void blk_stage(const LAS unsigned char* X, const LAS unsigned char* XT, const LAS unsigned char* TT, LAS unsigned char* To, LAS unsigned char* T0T,
                                                                                    LAS unsigned char* Xo, LAS unsigned char* XoT, int wave, int fr, int fq) {
    const int bk = wave >> 2, k0 = 32 * bk, m0 = k0 + 16 * ((wave >> 1) & 1), n0 = k0 + 16 * (wave & 1);
    bf16x8 a = ldfrag(X, LDB, m0, k0, fr, fq), tb = a, xb = a; v2u tw = (v2u){0u, 0u};
    if (DO_T) { tb = ldfrag(TT, LDB, n0, k0, fr, fq); tw = *(const LAS v2u*)(TT + ((n0 + fr) * LDB + m0 + 4 * fq) * 2); }
    if (DO_X) xb = ldfrag(XT, LDB, n0, k0, fr, fq);
    CFENCE();
    PIN(a);
    if (DO_T) { f32x4 ta = (f32x4){bflo(tw.x), bfhi(tw.x), bflo(tw.y), bfhi(tw.y)}; PIN(tb); ta = MFMA16(a, tb, ta);
        if (LAST) { st_tile_bf16(To, LDB, m0, n0, fr, fq, ta); if (bk == 0) st_tile_bf16_T(T0T, LDB, m0, n0, fr, fq, ta); }
        else st_tile_bf16_T(To, LDB, m0, n0, fr, fq, ta); }
    if (DO_X) { f32x4 xa = (f32x4){0.f, 0.f, 0.f, 0.f}; PIN(xb); xa = MFMA16(a, xb, xa);
        st_tile_bf16(Xo, LDB, m0, n0, fr, fq, xa); st_tile_bf16_T(XoT, LDB, m0, n0, fr, fq, xa); }
}

__device__ __forceinline__ bf16x8 pack2(const f32x4& lo, const f32x4& hi) { v4u p; p.x = pk2(lo[0], lo[1]); p.y = pk2(lo[2], lo[3]); p.z = pk2(hi[0], hi[1]); p.w = pk2(hi[2], hi[3]); return __builtin_bit_cast(bf16x8, p); }
__device__ __forceinline__ void inv_block_regs(LAS unsigned char* L, int bk, int fr, int fq) {
    const int k0 = 32 * bk; const f32x4 z4 = (f32x4){0.f, 0.f, 0.f, 0.f};
    const bf16x8 fa0 = ldfrag(L + O_XA, LDB, k0, k0, fr, fq), fa1 = ldfrag(L + O_XA, LDB, k0 + 16, k0, fr, fq), fb0 = ldfrag(L + O_XAT, LDB, k0, k0, fr, fq), fb1 = ldfrag(L + O_XAT, LDB, k0 + 16, k0, fr, fq);
    f32x4 t00, t10, t11;
    { const v2u w00 = *(const LAS v2u*)(L + O_UT + ((k0 + fr) * LDB + k0 + 4 * fq) * 2), w10 = *(const LAS v2u*)(L + O_UT + ((k0 + fr) * LDB + k0 + 16 + 4 * fq) * 2), w11 = *(const LAS v2u*)(L + O_UT + ((k0 + 16 + fr) * LDB + k0 + 16 + 4 * fq) * 2);
      t00 = (f32x4){bflo(w00.x), bfhi(w00.x), bflo(w00.y), bfhi(w00.y)}; t10 = (f32x4){bflo(w10.x), bfhi(w10.x), bflo(w10.y), bfhi(w10.y)}; t11 = (f32x4){bflo(w11.x), bfhi(w11.x), bflo(w11.y), bfhi(w11.y)}; }
    CFENCE();
    f32x4 x00 = MFMA16(fa0, fb0, z4), x10 = MFMA16(fa1, fb0, z4), x11 = MFMA16(fa1, fb1, z4);
    f32x4 y00 = MFMA16(fb0, fa0, z4), y01 = MFMA16(fb0, fa1, z4), y11 = MFMA16(fb1, fa1, z4);
#pragma unroll
    for (int st = 0; st < 4; ++st) {
        const bf16x8 px0 = pack2(x00, x10), px1 = pack2(z4, x11), py0 = pack2(y00, z4), py1 = pack2(y01, y11), pt0 = pack2(t00, t10), pt1 = pack2(z4, t11);
        t00 = MFMA16(py0, pt0, t00); t10 = MFMA16(py1, pt0, t10); t11 = MFMA16(py1, pt1, t11);
        if (st < 3) {
            const f32x4 n00 = MFMA16(py0, px0, z4), n10 = MFMA16(py1, px0, z4), n11 = MFMA16(py1, px1, z4);
            const f32x4 m00 = MFMA16(px0, py0, z4), m01 = MFMA16(px0, py1, z4), m11 = MFMA16(px1, py1, z4);
            x00 = n00; x10 = n10; x11 = n11; y00 = m00; y01 = m01; y11 = m11; }
    }
    st_tile_bf16(L + O_TB, LDB, k0, k0, fr, fq, t00); st_tile_bf16(L + O_TB, LDB, k0 + 16, k0, fr, fq, t10); st_tile_bf16(L + O_TB, LDB, k0 + 16, k0 + 16, fr, fq, t11); st_tile_bf16(L + O_TB, LDB, k0, k0 + 16, fr, fq, z4);
    if (bk == 0) { st_tile_bf16_T(L + O_T0T, LDB, 0, 0, fr, fq, t00); st_tile_bf16_T(L + O_T0T, LDB, 16, 0, fr, fq, t10); st_tile_bf16_T(L + O_T0T, LDB, 16, 16, fr, fq, t11); st_tile_bf16_T(L + O_T0T, LDB, 0, 16, fr, fq, z4); }
}

template <int HH> __device__ __forceinline__ void m2_half(LAS unsigned char* L, int q, int fr, int fq) {
    const LAS unsigned char* Am = L + ((q < 2) ? O_AH : O_RH); const LAS unsigned char* Bm = L + ((q & 1) ? O_KH : O_BH);
    LAS unsigned char* Om = L + (q == 0 ? O_XA : (q == 1 ? O_AAK : (q == 2 ? O_ARB : O_ARK)));
    constexpr int MT0 = HH ? 1 : 0, MT1 = HH ? 2 : 3, NB = MT1 + 1;
    unsigned zz_ = 0u; asm volatile("" : "+v"(zz_)); const v2u z2 = (v2u){zz_, zz_};
    bf16x8 a[2][2], b[NB][2];
#pragma unroll
    for (int ks = 0; ks < 2; ++ks) { a[0][ks] = ldfrag(Am, LDB, 16 * MT0, 32 * ks, fr, fq); a[1][ks] = ldfrag(Am, LDB, 16 * MT1, 32 * ks, fr, fq); }
#pragma unroll
    for (int nt = 0; nt < NB; ++nt)
#pragma unroll
        for (int ks = 0; ks < 2; ++ks) b[nt][ks] = ldfrag(Bm, LDB, 16 * nt, 32 * ks, fr, fq);
    CFENCE();
#pragma unroll
    for (int mi = 0; mi < 2; ++mi) { const int mtile = mi ? MT1 : MT0;
        PIN(a[mi][0]); PIN(a[mi][1]);
#pragma unroll
        for (int nt = 0; nt < 4; ++nt) {
            if (nt > mtile) {
                *(LAS v2u*)(Om + ((16 * mtile + fr) * LDB + 16 * nt + 4 * fq) * 2) = z2;
                if (q == 0) { *(LAS v2u*)(L + O_XAT + ((16 * nt + fr) * LDB + 16 * mtile + 4 * fq) * 2) = z2; *(LAS v2u*)(L + O_UT + ((16 * nt + fr) * LDB + 16 * mtile + 4 * fq) * 2) = z2; }
                continue; }
            if (mi == 0) { PIN(b[nt][0]); PIN(b[nt][1]); }
            f32x4 at = (f32x4){0.f, 0.f, 0.f, 0.f};
            at = MFMA16(b[nt][0], a[mi][0], at); at = MFMA16(b[nt][1], a[mi][1], at);
            if (nt == mtile) {
#pragma unroll
                for (int jj = 0; jj < 4; ++jj) { const bool keep = (q < 2) ? (4 * fq + jj < fr) : (4 * fq + jj <= fr); if (!keep) at[jj] = 0.f; } }
            { v2u o; o.x = pk2(at[0], at[1]); o.y = pk2(at[2], at[3]); *(LAS v2u*)(Om + ((16 * mtile + fr) * LDB + 16 * nt + 4 * fq) * 2) = o; }
            if ((mtile >> 1) == (nt >> 1)) {
                if (q == 0) { f32x4 an = (f32x4){0.f, 0.f, 0.f, 0.f};
                    an = MFMA16(a[mi][0], b[nt][0], an); an = MFMA16(a[mi][1], b[nt][1], an);
                    f32x4 t1 = an;
                    if (nt == mtile) {
#pragma unroll
                        for (int jj = 0; jj < 4; ++jj) { if (!(fr < 4 * fq + jj)) an[jj] = 0.f; t1[jj] = (fr == 4 * fq + jj) ? 1.0f : an[jj]; } }
                    st_tile_bf16_T(L + O_XAT, LDB, 16 * mtile, 16 * nt, fr, fq, an);
                    st_tile_bf16_T(L + O_UT, LDB, 16 * mtile, 16 * nt, fr, fq, t1); } }
        } }
}

__device__ __forceinline__ void cscan_chain(Frame& F, int l, int unit) {
    PHASE_TID(); const int chain = unit >> 1, seg = unit & 1; const int b = chain >> 4, h = (chain >> 1) & 7, d = chain & 1, hc = h * HD;
    const int fr_o = lane & 15, fq_o = lane >> 4;
    LAS unsigned char* L = F.lds;
    const bf16* PRW = (const bf16*)(F.ws + WS_PRW);
    const float* mu = F.in[I_SHIFT] + (size_t)l * 2 * RWP;
    const bf16* VFIRST = (const bf16*)(F.ws + WS_VFIRST);
    bf16* VOUT = (l == 0) ? (bf16*)(F.ws + WS_VFIRST) : (bf16*)(F.ws + WS_V2);
    bf16* GOUT = (bf16*)(F.ws + WS_G);
    bf16* YS = (bf16*)(F.ws + WS_YS) + (size_t)d * M * CH;
    float* BS = (float*)(F.ws + WS_BS) + (size_t)d * M * NH;
    bf16* YPHI = (bf16*)(F.ws + WS_YPHI) + (size_t)chain * (T / 2) * 64;
    const int lnt = wave & 3, lmt0 = 2 * (wave >> 2);
    if (wave < 4) { const int lcol = hc + 16 * lnt + fr_o; bf16x8* FRAGS = (bf16x8*)(F.ws + WS_FRAG) + ((size_t)chain * 4 + lnt) * 9 * 64 + lane; const float* w2 = F.in[I_W2] + (size_t)(l * 2 + d) * 64 * CH; const float* a2 = F.in[I_A2] + (size_t)(l * 2 + d) * 64 * CH; const float* g2 = F.in[I_G2] + (size_t)l * 128 * CH;
#pragma unroll
      for (int ks = 0; ks < 2; ++ks) { FRAGS[ks * 64] = wfrag(w2, 32 * ks, lcol, fq_o); FRAGS[(2 + ks) * 64] = wfrag(a2, 32 * ks, lcol, fq_o); }
      if (l == 1) FRAGS[4 * 64] = wfrag(F.in[I_V2], 0, lcol, fq_o);
#pragma unroll
      for (int ks = 0; ks < 4; ++ks) if (d == 0) FRAGS[(5 + ks) * 64] = wfrag(g2, 32 * ks, lcol, fq_o); }
    const int lcol_o = hc + 16 * lnt + fr_o;
    const float lc_w0 = F.in[I_W0][(l * 2 + d) * CH + lcol_o], lc_a0 = F.in[I_A0][(l * 2 + d) * CH + lcol_o], lc_v0 = (l == 1) ? F.in[I_V0][lcol_o] : 0.f;
    const int mt = wave >> 1, nt0 = 2 * (wave & 1);
    f32x4 S[2] = {(f32x4){0.f, 0.f, 0.f, 0.f}, (f32x4){0.f, 0.f, 0.f, 0.f}};
    f32x4 Ph[2];
#pragma unroll
    for (int j = 0; j < 2; ++j)
#pragma unroll
        for (int jj = 0; jj < 4; ++jj) Ph[j][jj] = (16 * mt + 4 * fq_o + jj == 16 * (nt0 + j) + fr_o) ? 1.0f : 0.f;
    __syncthreads();
    for (int e = tid; e < MB / 4; e += NTHR) ((LAS unsigned*)(L + O_S0B))[e] = 0u;
    if (tid < 448) { const int g = tid >> 6, j = tid & 63; const int col = (g < 3) ? g * CH + hc + j : (g == 3 ? 1536 + d * 64 + j : (g == 4 ? 1664 + d * 64 + j : 1792 + (tid - 320)));
        const unsigned pm = pk2(mu[col], mu[RWP + col]); ((LAS unsigned*)(L + O_MU))[tid] = pm; ((LAS float*)(L + O_MC))[tid] = 1.0f - bflo(pm) - bfhi(pm); }
    if (tid < 192) { const int g = tid >> 6, j = tid & 63; ((LAS float*)(L + O_CK))[tid] = F.in[g == 0 ? I_KK : (g == 1 ? I_KA : I_RK)][l * CH + hc + j]; }
    RawTok raw;
    { const int et0 = tid >> 3, ec0 = (tid & 7) * 8; const int cf = (d == 0) ? seg * 64 * CL_ : (127 - seg * 64) * CL_; load_raw(raw, PRW, VFIRST, b, (d == 0) ? cf + et0 : cf + 63 - et0, hc, ec0, d, l, (tid & 7) < 4); }
#pragma unroll 1
    for (int ci = 0; ci < T / CL_ / 2; ++ci) {
        int tid = (wave << 6) | (int)__builtin_amdgcn_mbcnt_hi(~0u, __builtin_amdgcn_mbcnt_lo(~0u, 0u)); asm volatile("" : "+v"(tid));
        const int lane = tid & 63, fr = lane & 15, fq = lane >> 4, et = tid >> 3, ec = (tid & 7) * 8;
        const int lcol = hc + 16 * lnt + fr;
        const unsigned char* FRB = F.ws + WS_FRAG + (((size_t)chain * 4 + lnt) * 9 * 64) * 16; unsigned fo = (unsigned)lane * 16u;
#define FRAGS_(k) (*(const bf16x8*)(FRB + fo + (k) * 1024))
        int c0 = (d == 0 ? seg * 64 + ci : 127 - seg * 64 - ci) * CL_; asm volatile("" : "+s"(c0));
        const int tok = (d == 0) ? c0 + et : c0 + 63 - et;
        const size_t m = (size_t)b * T + tok;
        __syncthreads();
        float rr[8], kr[8], vr[8];
        const LAS unsigned* MUB = (const LAS unsigned*)(L + O_MU) + ec; const LAS float* MCB = (const LAS float*)(L + O_MC) + ec;
        v4u vl4 = (v4u){0u, 0u, 0u, 0u}, vf4 = vl4;
        if (l == 1 && (tid & 7) < 4) vl4 = *(const v4u*)(PRW + m * NRW + RWP + ec);
        bf16x8 wf[5];
        {
          if (d == 0) { float g0[8], g1[8];
              mix8r(raw.g[5], MUB + 320, MCB + 320, g0); CFENCE(); mix8r(raw.g[6], MUB + 384, MCB + 384, g1); CFENCE();
#pragma unroll
              for (int e = 0; e < 8; ++e) { g0[e] = sigmoidf_(g0[e]); g1[e] = sigmoidf_(g1[e]); }
              *(LAS v4u*)(L + O_SG + (et * LDSG + ec) * 2) = pack8(g0); *(LAS v4u*)(L + O_SG + (et * LDSG + 64 + ec) * 2) = pack8(g1); }
          float xw[8], xa[8];
          mix8r(raw.g[3], MUB + 192, MCB + 192, xw); CFENCE(); mix8r(raw.g[4], MUB + 256, MCB + 256, xa);
          asm volatile("" : "+v"(fo) : "v"(xw[7]), "v"(xa[7]));
          wf[0] = FRAGS_(0); wf[1] = FRAGS_(1); wf[2] = FRAGS_(2); wf[3] = FRAGS_(3); wf[4] = ZFRAG; if (l == 1) wf[4] = FRAGS_(4);
          CFENCE();
#pragma unroll
          for (int e = 0; e < 8; ++e) xw[e] = tanhf_(xw[e]);
          *(LAS v4u*)(L + O_TW + (et * LDB + ec) * 2) = pack8(xw);
          *(LAS v4u*)(L + O_AD + (et * LDB + ec) * 2) = pack8(xa);
          mix8r(raw.g[0], MUB, MCB, rr); CFENCE(); mix8r(raw.g[1], MUB + 64, MCB + 64, kr); CFENCE(); mix8r(raw.g[2], MUB + 128, MCB + 128, vr);
          if (l == 1 && (tid & 7) < 4) *(LAS v4u*)(L + O_VL + (et * LDVL + ec) * 2) = vl4;
          if (l == 1) vf4 = *(const v4u*)(VFIRST + m * CH + hc + ec); }
        __syncthreads();
        { bf16x8 gf[4];
          gf[0] = ZFRAG; gf[1] = ZFRAG; gf[2] = ZFRAG; gf[3] = ZFRAG;
          if (d == 0) { gf[0] = FRAGS_(5); gf[1] = FRAGS_(6); gf[2] = FRAGS_(7); gf[3] = FRAGS_(8); }
          float lw_carry = 0.f;
#pragma unroll
          for (int mi = 0; mi < 2; ++mi) { const int m0 = 16 * (lmt0 + mi);
              bf16x8 tw[2], ad[2], vl;
#pragma unroll
              for (int ks = 0; ks < 2; ++ks) { tw[ks] = ldfrag(L + O_TW, LDB, m0, 32 * ks, fr, fq); ad[ks] = ldfrag(L + O_AD, LDB, m0, 32 * ks, fr, fq); }
              vl = ZFRAG; if (l == 1) vl = ldfrag(L + O_VL, LDVL, m0, 0, fr, fq);
              CFENCE();
              f32x4 zw = (f32x4){0.f, 0.f, 0.f, 0.f}, za = zw, zv = zw;
#pragma unroll
              for (int ks = 0; ks < 2; ++ks) { PIN(tw[ks]); zw = MFMA16(tw[ks], wf[ks], zw); PIN(ad[ks]); za = MFMA16(ad[ks], wf[2 + ks], za); }
              if (l == 1) { PIN(vl); zv = MFMA16(vl, wf[4], zv); }
#pragma unroll
              for (int jj = 0; jj < 4; ++jj) { const int s = m0 + 4 * fq + jj, o = (s * LDF + 16 * lnt + fr) * 4; *(LAS float*)(L + O_AF + o) = sigmoidf_(za[jj] + lc_a0); }
#pragma unroll
              for (int jj = 0; jj < 4; ++jj) zw[jj] = -0.6065306597126334f * sigmoidf_(zw[jj] + lc_w0);
              zw[1] += zw[0]; zw[2] += zw[1]; zw[3] += zw[2];
              { float inc = zw[3]; const float u1 = __shfl_up(inc, 16); inc += (fq >= 1 ? u1 : 0.f); const float u2 = __shfl_up(inc, 32); inc += (fq >= 2 ? u2 : 0.f);
                const float excl = (inc - zw[3]) + lw_carry;
                lw_carry += __shfl(inc, 48 + fr);
#pragma unroll
                for (int jj = 0; jj < 4; ++jj) { const int s = m0 + 4 * fq + jj, o = (s * LDF + 16 * lnt + fr) * 4; *(LAS float*)(L + O_LW + o) = zw[jj] + excl; } }
              if (l == 1) {
#pragma unroll
                  for (int jj = 0; jj < 4; ++jj) { const int s = m0 + 4 * fq + jj, o = (s * LDF + 16 * lnt + fr) * 4; *(LAS float*)(L + O_ZV + o) = sigmoidf_(zv[jj] + lc_v0); } } }
          if (lmt0 == 0 && fq == 0) *(LAS float*)(L + O_PART + (16 * lnt + fr) * 4) = lw_carry;
          if (d == 0) {
#pragma unroll
              for (int mi = 0; mi < 2; ++mi) { const int m0 = 16 * (lmt0 + mi);
                  bf16x8 sg[4];
#pragma unroll
                  for (int ks = 0; ks < 4; ++ks) sg[ks] = ldfrag(L + O_SG, LDSG, m0, 32 * ks, fr, fq);
                  CFENCE();
                  f32x4 zg = (f32x4){0.f, 0.f, 0.f, 0.f};
#pragma unroll
                  for (int ks = 0; ks < 4; ++ks) { PIN(sg[ks]); zg = MFMA16(gf[ks], sg[ks], zg); }
                  { v2u o; o.x = pk2(zg[0], zg[1]); o.y = pk2(zg[2], zg[3]); *(v2u*)(GOUT + ((size_t)b * T + c0 + m0 + fr) * CH + hc + 16 * lnt + 4 * fq) = o; } } } }
        __syncthreads();
        { float kkr[8], av[8], cl[8], clm[8], zv[8], kd[8], ss = 0.f, bon = 0.f;
          const unsigned vfw[4] = {vf4.x, vf4.y, vf4.z, vf4.w};
          const LAS float* CKT = (const LAS float*)(L + O_CK) + ec;
          const f32x4 kka = *(const LAS f32x4*)CKT, kkb = *(const LAS f32x4*)(CKT + 4), kaa = *(const LAS f32x4*)(CKT + 64), kab = *(const LAS f32x4*)(CKT + 68), rka = *(const LAS f32x4*)(CKT + 128), rkb = *(const LAS f32x4*)(CKT + 132);
          const int o0 = (et * LDF + ec) * 4, om = (et > 0) ? o0 - LDF * 4 : o0;
#pragma unroll
          for (int e = 0; e < 8; ++e) { av[e] = *(LAS float*)(L + O_AF + o0 + 4 * e); cl[e] = *(LAS float*)(L + O_LW + o0 + 4 * e); clm[e] = *(LAS float*)(L + O_LW + om + 4 * e); zv[e] = 0.f; }
          if (l == 1) {
#pragma unroll
              for (int e = 0; e < 8; ++e) zv[e] = *(LAS float*)(L + O_ZV + o0 + 4 * e); }
          CFENCE();
#pragma unroll
          for (int hq = 0; hq < 2; ++hq) { const f32x4 hp = *(const LAS f32x4*)(L + O_PART + (ec + 4 * hq) * 4);
#pragma unroll
              for (int e = 0; e < 4; ++e) { cl[4 * hq + e] += (et >= 32) ? hp[e] : 0.f; clm[4 * hq + e] += (et >= 33) ? hp[e] : 0.f; } }
          const float ckk[8] = {kka[0], kka[1], kka[2], kka[3], kkb[0], kkb[1], kkb[2], kkb[3]}, cka[8] = {kaa[0], kaa[1], kaa[2], kaa[3], kab[0], kab[1], kab[2], kab[3]},
                      crk[8] = {rka[0], rka[1], rka[2], rka[3], rkb[0], rkb[1], rkb[2], rkb[3]};
#pragma unroll
          for (int e = 0; e < 8; ++e) {
              const float vf = (e & 1) ? bfhi(vfw[e >> 1]) : bflo(vfw[e >> 1]); vr[e] = vr[e] + (vf - vr[e]) * zv[e];
              kkr[e] = kr[e] * ckk[e]; ss += kkr[e] * kkr[e];
              kd[e] = kr[e] * (1.0f + (av[e] - 1.0f) * cka[e]); bon += rr[e] * kd[e] * crk[e]; }
          ss = sum8(ss); bon = sum8(bon);
          const float inv = __builtin_amdgcn_rsqf(fmaxf(ss, 1e-24f));
          if ((tid & 7) == 0) BS[m * NH + h] = bon;
          if (d == 0) *(v4u*)(VOUT + m * CH + hc + ec) = pack8(vr);
          float ah[8], bh[8], kh[8], rh[8], Pv[8];
#pragma unroll
          for (int e = 0; e < 8; ++e) {
              const float P = __expf(cl[e]), Pi = __builtin_amdgcn_rcpf(P), Pm = (et > 0) ? __expf(clm[e]) : 1.0f, kk = kkr[e] * inv;
              ah[e] = -kk * Pm; bh[e] = kk * av[e] * Pi; kh[e] = kd[e] * Pi; rh[e] = rr[e] * P; Pv[e] = P; }
          if (et == 63) { *(LAS f32x4*)(L + O_PL + ec * 4) = (f32x4){Pv[0], Pv[1], Pv[2], Pv[3]}; *(LAS f32x4*)(L + O_PL + ec * 4 + 16) = (f32x4){Pv[4], Pv[5], Pv[6], Pv[7]}; }
          *(LAS v4u*)(L + O_AH + (et * LDB + ec) * 2) = pack8(ah); *(LAS v4u*)(L + O_BH + (et * LDB + ec) * 2) = pack8(bh);
          *(LAS v4u*)(L + O_KH + (et * LDB + ec) * 2) = pack8(kh); *(LAS v4u*)(L + O_RH + (et * LDB + ec) * 2) = pack8(rh);
          { unsigned pab[8], pkv[8]; const int c = tid & 7;
#pragma unroll
            for (int e = 0; e < 8; ++e) { pab[e] = pk2(ah[e], bh[e]); pkv[e] = pk2(kh[e], vr[e]); }
#pragma unroll
            for (int sh = 1; sh < 8; sh <<= 1) { const bool on = (c & sh) != 0; unsigned ta[8], tk[8];
#pragma unroll
                for (int e = 0; e < 8; ++e) { ta[e] = on ? pab[(e + sh) & 7] : pab[e]; tk[e] = on ? pkv[(e + sh) & 7] : pkv[e]; }
#pragma unroll
                for (int e = 0; e < 8; ++e) { pab[e] = ta[e]; pkv[e] = tk[e]; } }
#pragma unroll
            for (int e = 0; e < 8; ++e) { const int o = ((ec + ((e + c) & 7)) * LDB + et) * 2;
                *(LAS bf16*)(L + O_AHT + o) = (bf16)(pab[e] & 0xffffu); *(LAS bf16*)(L + O_BHT + o) = (bf16)(pab[e] >> 16);
                *(LAS bf16*)(L + O_KHT + o) = (bf16)(pkv[e] & 0xffffu); *(LAS bf16*)(L + O_VT + o) = (bf16)(pkv[e] >> 16); } } }
        __syncthreads();
        { if (wave & 1) m2_half<1>(L, wave >> 1, fr, fq); else m2_half<0>(L, wave >> 1, fr, fq); }
        __syncthreads();
        if (ci + 1 < T / CL_ / 2) { const int c0n = (d == 0) ? c0 + CL_ : c0 - CL_; load_raw(raw, PRW, VFIRST, b, (d == 0) ? c0n + et : c0n + 63 - et, hc, ec, d, l, (tid & 7) < 4); }
        if (wave < 2) inv_block_regs(L, wave, fr, fq);
        __syncthreads();
        { if (wave < 4) { const int bmt = (wave >> 1) & 1, bnt = wave & 1;
            bf16x8 a0 = ldfrag(L + O_XA, LDB, 32, 0, fr, fq), a1 = ldfrag(L + O_XA, LDB, 48, 0, fr, fq), t1b = ldfrag(L + O_T0T, LDB, 16 * bnt, 0, fr, fq), t22 = ldfrag(L + O_TB, LDB, 32 + 16 * bmt, 32, fr, fq);
            const f32x4 z4 = (f32x4){0.f, 0.f, 0.f, 0.f};
            const f32x4 w0 = MFMA16(a0, t1b, z4), w1 = MFMA16(a1, t1b, z4);
            st_tile_bf16_T(L + O_WT, LDB, 0, 16 * bnt, fr, fq, w0); st_tile_bf16_T(L + O_WT, LDB, 16, 16 * bnt, fr, fq, w1);
            LDS_WAIT();
            const bf16x8 wb = ldfrag(L + O_WT, LDB, 16 * bnt, 0, fr, fq);
            const f32x4 t21 = MFMA16(t22, wb, z4);
            st_tile_bf16(L + O_TB, LDB, 32 + 16 * bmt, 16 * bnt, fr, fq, t21);
        } else { const int bmt = (wave >> 1) & 1, bnt = wave & 1;
            unsigned zz_ = 0u; asm volatile("" : "+v"(zz_)); *(LAS v2u*)(L + O_TB + ((16 * bmt + fr) * LDB + 32 + 16 * bnt + 4 * fq) * 2) = (v2u){zz_, zz_}; } }
        f32x4 y0[2] = {(f32x4){0.f, 0.f, 0.f, 0.f}, (f32x4){0.f, 0.f, 0.f, 0.f}}, g0[2] = {y0[0], y0[0]};
        { f32x4 m1[2] = {(f32x4){0.f, 0.f, 0.f, 0.f}, (f32x4){0.f, 0.f, 0.f, 0.f}};
          bf16x8 aak[2], ark[2], vta[2], vtb[2][2], khb[2][2];
          ldA(aak, L + O_AAK, mt, fr, fq); ldB(vtb, L + O_VT, nt0, fr, fq); ldA(ark, L + O_ARK, mt, fr, fq); ldA(vta, L + O_VT, mt, fr, fq); ldB(khb, L + O_KHT, nt0, fr, fq);
          CFENCE();
          mmac(aak, vtb, m1); mmacT(ark, vtb, y0); mmac(vta, khb, g0);
#pragma unroll
          for (int j = 0; j < 2; ++j) st_tile_bf16_T(L + O_M1T, LDB, 16 * mt, 16 * (nt0 + j), fr, fq, m1[j]); }
        __syncthreads();
        f32x4 u0[2] = {(f32x4){0.f, 0.f, 0.f, 0.f}, (f32x4){0.f, 0.f, 0.f, 0.f}};
        { f32x4 ap[2] = {u0[0], u0[0]};
          bf16x8 tba[2], ahb[2][2], m1b[2][2];
          ldA(tba, L + O_TB, mt, fr, fq); ldB(ahb, L + O_AHT, nt0, fr, fq); ldB(m1b, L + O_M1T, nt0, fr, fq);
          CFENCE();
          mmac(tba, ahb, ap); mmac(tba, m1b, u0);
#pragma unroll
          for (int j = 0; j < 2; ++j) st_tile_bf16(L + O_APB, LDB, 16 * mt, 16 * (nt0 + j), fr, fq, ap[j]);
          if (seg) {
#pragma unroll
              for (int j = 0; j < 2; ++j) st_tile_bf16(L + O_VT, LDB, 16 * mt, 16 * (nt0 + j), fr, fq, Ph[j]); } }
        __syncthreads();
        { bf16x8 apa[2], s0b[2][2], phb[2][2];
          ldA(apa, L + O_APB, mt, fr, fq); ldB(s0b, L + O_S0B, nt0, fr, fq); phb[0][0] = ZFRAG; phb[0][1] = ZFRAG; phb[1][0] = ZFRAG; phb[1][1] = ZFRAG; if (seg) ldB(phb, L + O_VT, nt0, fr, fq);
          CFENCE();
          mmac(apa, s0b, u0);
#pragma unroll
          for (int j = 0; j < 2; ++j) st_tile_bf16_T(L + O_UT, LDB, 16 * mt, 16 * (nt0 + j), fr, fq, u0[j]);
          if (seg) { f32x4 up[2] = {(f32x4){0.f, 0.f, 0.f, 0.f}, (f32x4){0.f, 0.f, 0.f, 0.f}};
              mmac(apa, phb, up);
#pragma unroll
              for (int j = 0; j < 2; ++j) st_tile_bf16_T(L + O_KHT, LDB, 16 * mt, 16 * (nt0 + j), fr, fq, up[j]); } }
        __syncthreads();
        { bf16x8 rha[2], arba[2], uta[2], s0b[2][2], utb[2][2], bhb[2][2]; float plv[2];
          ldA(rha, L + O_RH, mt, fr, fq); ldB(s0b, L + O_S0B, nt0, fr, fq); ldA(arba, L + O_ARB, mt, fr, fq); ldB(utb, L + O_UT, nt0, fr, fq);
#pragma unroll
          for (int j = 0; j < 2; ++j) plv[j] = *(LAS float*)(L + O_PL + (16 * (nt0 + j) + fr) * 4);
          CFENCE();
          mmacT(rha, s0b, y0);
          ldA(uta, L + O_UT, mt, fr, fq); ldB(bhb, L + O_BHT, nt0, fr, fq);
          CFENCE();
          mmacT(arba, utb, y0);
          { const int s = 16 * mt + fr; const int tk = (d == 0) ? c0 + s : c0 + 63 - s;
#pragma unroll
            for (int j = 0; j < 2; ++j) { v2u o; o.x = pk2(y0[j][0], y0[j][1]); o.y = pk2(y0[j][2], y0[j][3]); *(v2u*)(YS + ((size_t)b * T + tk) * CH + hc + 16 * (nt0 + j) + 4 * fq) = o; } }
          f32x4 sn[2] = {g0[0], g0[1]};
          mmac(uta, bhb, sn);
#pragma unroll
          for (int j = 0; j < 2; ++j) S[j] = (S[j] + sn[j]) * plv[j];
          if (seg) { f32x4 yp[2] = {(f32x4){0.f, 0.f, 0.f, 0.f}, (f32x4){0.f, 0.f, 0.f, 0.f}}, pn[2] = {yp[0], yp[0]};
              bf16x8 rh2[2], arb2[2], kha[2], phb[2][2], khb[2][2], bh2[2][2];
              ldA(rh2, L + O_RH, mt, fr, fq); ldB(phb, L + O_VT, nt0, fr, fq); ldA(arb2, L + O_ARB, mt, fr, fq); ldB(khb, L + O_KHT, nt0, fr, fq); ldA(kha, L + O_KHT, mt, fr, fq); ldB(bh2, L + O_BHT, nt0, fr, fq);
              CFENCE();
              mmacT(rh2, phb, yp);
              mmacT(arb2, khb, yp);
              { const int s = 16 * mt + fr; const int tk = (d == 0) ? c0 + s : c0 + 63 - s;
#pragma unroll
                for (int j = 0; j < 2; ++j) { v2u o; o.x = pk2(yp[j][0], yp[j][1]); o.y = pk2(yp[j][2], yp[j][3]); *(v2u*)(YPHI + (size_t)(tk & (T / 2 - 1)) * 64 + 16 * (nt0 + j) + 4 * fq) = o; } }
              mmac(kha, bh2, pn);
#pragma unroll
              for (int j = 0; j < 2; ++j) Ph[j] = (Ph[j] + pn[j]) * plv[j]; } }
        __syncthreads();
#pragma unroll
        for (int j = 0; j < 2; ++j) st_tile_bf16(L + O_S0B, LDB, 16 * mt, 16 * (nt0 + j), fr, fq, S[j]);
    }
    if (seg == 0) { float* SF = (float*)(F.ws + WS_SFIN) + (size_t)chain * 4096;
        int t2 = (int)__builtin_amdgcn_mbcnt_hi(~0u, __builtin_amdgcn_mbcnt_lo(~0u, 0u)); asm volatile("" : "+v"(t2)); const int fr2 = t2 & 15, fq2 = (t2 >> 4) & 3;
#pragma unroll
        for (int j = 0; j < 2; ++j)
#pragma unroll
            for (int jj = 0; jj < 4; ++jj) SF[(16 * mt + 4 * fq2 + jj) * 64 + 16 * (nt0 + j) + fr2] = S[j][jj]; }
    __syncthreads();
}


__device__ __forceinline__ void tr_item(const float* W, int ld, int col0, int nblk, int K, bf16* WT, int row_off, LAS float* scr, int item, int lane, const float* gain = nullptr) {
    const int kb = item / nblk, nb = item % nblk, k0 = 64 * kb, n0 = 32 * nb;
    float wv[32];
#pragma unroll
    for (int i = 0; i < 32; ++i) wv[i] = W[(size_t)(k0 + 2 * i + (lane >> 5)) * ld + col0 + n0 + (lane & 31)];
    if (gain) {
#pragma unroll
        for (int i = 0; i < 32; ++i) wv[i] *= gain[k0 + 2 * i + (lane >> 5)]; }
#pragma unroll
    for (int i = 0; i < 32; ++i) scr[(2 * i + (lane >> 5)) * 33 + (lane & 31)] = wv[i];
    LDS_WAIT(); asm volatile("" ::: "memory");
    const int c = lane & 7;
#pragma unroll
    for (int j = 0; j < 4; ++j) { const int n = (lane >> 3) + 8 * j; const LAS float* s = scr + (8 * c) * 33 + n;
        v4u o; o.x = pk2(s[0 * 33], s[1 * 33]); o.y = pk2(s[2 * 33], s[3 * 33]); o.z = pk2(s[4 * 33], s[5 * 33]); o.w = pk2(s[6 * 33], s[7 * 33]);
        *(v4u*)(WT + (size_t)(row_off + n0 + n) * K + k0 + 8 * c) = o; }
    LDS_WAIT(); asm volatile("" ::: "memory");
}
__device__ __forceinline__ void wq_max_item(const float* W, int ld, int col0, int nblk, unsigned* cmax, int item, int lane) {
    const int kb = item / nblk, nb = item % nblk, k0 = 64 * kb, n0 = 32 * nb; float am = 0.f;
#pragma unroll
    for (int i = 0; i < 32; ++i) am = fmaxf(am, fabsf(W[(size_t)(k0 + 2 * i + (lane >> 5)) * ld + col0 + n0 + (lane & 31)]));
    am = fmaxf(am, __shfl_xor(am, 32));
    if (lane < 32) atomicMax(cmax + n0 + lane, __float_as_uint(am));
}
__device__ __forceinline__ void wq_item(const float* W, int ld, int col0, int nblk, const unsigned* cmax, float* csc, unsigned char* WQ, int row_off, LAS float* scr, int item, int lane) {
    const int kb = item / nblk, nb = item % nblk, k0 = 64 * kb, n0 = 32 * nb;
    float wv[32];
#pragma unroll
    for (int i = 0; i < 32; ++i) wv[i] = W[(size_t)(k0 + 2 * i + (lane >> 5)) * ld + col0 + n0 + (lane & 31)];
#pragma unroll
    for (int i = 0; i < 32; ++i) scr[(2 * i + (lane >> 5)) * 33 + (lane & 31)] = wv[i];
    LDS_WAIT(); asm volatile("" ::: "memory");
    const int c = lane & 7;
#pragma unroll
    for (int j = 0; j < 4; ++j) { const int n = (lane >> 3) + 8 * j; const LAS float* sp = scr + (8 * c) * 33 + n;
        const float cm = __uint_as_float(cmax[n0 + n]), inv = cm > 0.f ? 127.0f / cm : 0.f;
        v2u o; o.x = q4(sp[0 * 33] * inv, sp[1 * 33] * inv, sp[2 * 33] * inv, sp[3 * 33] * inv); o.y = q4(sp[4 * 33] * inv, sp[5 * 33] * inv, sp[6 * 33] * inv, sp[7 * 33] * inv);
        *(v2u*)(WQ + (size_t)(row_off + n0 + n) * D + k0 + 8 * c) = o;
        if (kb == 0 && c == 0) csc[n0 + n] = cm * (1.0f / 127.0f); }
    LDS_WAIT(); asm volatile("" ::: "memory");
}
__device__ __forceinline__ void p_convert(Frame& F) {
    PHASE_TID();
    LAS float* scr = (LAS float*)(F.lds + wave * 16384);
    const int gw = bid * NWAVES + wave, NGW = F.G * NWAVES;
    constexpr int C_HY = 16 * 48, C_RW = 16 * 60, C_V1 = 16, C_O = 16 * 32, C_1 = 16 * 128, C_2 = 64 * 32, C_L = C_HY + C_RW + C_V1 + C_O + C_1 + C_2;
    for (int it = gw; it < NL * C_L; it += NGW) {
        const int l = it / C_L; int r = it % C_L;
        unsigned char* wb = F.ws + WS_W + (size_t)l * W_LAYER;
        const float* win = F.in[I_WIN] + (size_t)l * D * PIN;
        unsigned* cmax = F.ctl + CW_CMAX + l * (HYP + NRW);
        if (r < C_HY) { wq_max_item(win, PIN, 0, 48, cmax, r, lane); continue; } r -= C_HY;
        if (r < C_RW) { wq_max_item(win, PIN, HYP, 60, cmax + HYP, r, lane); continue; } r -= C_RW;
        if (r < C_V1) { if (l == 1) wq_max_item(F.in[I_V1], 32, 0, 1, cmax + HYP + RWP, r, lane); continue; } r -= C_V1;
        if (r < C_O) { tr_item(F.in[I_WOUT] + (size_t)l * D * D, D, 0, 32, D, (bf16*)(wb + W_O), 0, scr, r, lane); continue; } r -= C_O;
        if (r < C_1) { tr_item(F.in[I_MW1] + (size_t)l * D * FF, FF, 0, 128, D, (bf16*)(wb + W_1), 0, scr, r, lane, F.in[I_N2G] + (size_t)l * D); continue; } r -= C_1;
        tr_item(F.in[I_MW2] + (size_t)l * FF * D, D, 0, 32, FF, (bf16*)(wb + W_2), 0, scr, r, lane);
    }
}
__device__ __forceinline__ void p_wquant(Frame& F) {
    PHASE_TID();
    LAS float* scr = (LAS float*)(F.lds + wave * 16384);
    const int gw = bid * NWAVES + wave, NGW = F.G * NWAVES;
    constexpr int C_HY = 16 * 48, C_RW = 16 * 60, C_V1 = 16, C_L = C_HY + C_RW + C_V1;
    for (int it = gw; it < NL * C_L; it += NGW) {
        const int l = it / C_L; int r = it % C_L;
        unsigned char* wb = F.ws + WS_W + (size_t)l * W_LAYER;
        const float* win = F.in[I_WIN] + (size_t)l * D * PIN;
        const unsigned* cmax = F.ctl + CW_CMAX + l * (HYP + NRW); float* csc = (float*)(F.ws + WS_CSC) + l * (HYP + NRW);
        if (r < C_HY) { wq_item(win, PIN, 0, 48, cmax, csc, wb + W_HY, 0, scr, r, lane); continue; } r -= C_HY;
        if (r < C_RW) { wq_item(win, PIN, HYP, 60, cmax + HYP, csc + HYP, wb + W_RW, 0, scr, r, lane); continue; } r -= C_RW;
        if (l == 1) wq_item(F.in[I_V1], 32, 0, 1, cmax + HYP + RWP, csc + HYP + RWP, wb + W_RW, RWP, scr, r, lane);
    }
    for (int l = 0; l < NL; ++l) {
        const int r0 = (l == 0) ? RWP : RWP + 32; const int n16 = (NRW - r0) * D / 16;
        v4u* p = (v4u*)(F.ws + WS_W + (size_t)l * W_LAYER + W_RW + (size_t)r0 * D);
        for (int i = bid * NTHR + tid; i < n16; i += F.G * NTHR) p[i] = (v4u){0u, 0u, 0u, 0u};
        float* csc = (float*)(F.ws + WS_CSC) + l * (HYP + NRW) + HYP;
        if (bid == 0 && tid < NRW - r0) csc[r0 + tid] = 0.f;
    }
}

__device__ __forceinline__ void p_filter_item(Frame& F, int l, int item) {
    LAS float* Z = (LAS float*)F.lds;
    LAS float* H1 = Z + 32 * 36;
    LAS float* H2 = H1 + 32 * 64;
    LAS float* H3 = H2 + 32 * 64;
    PHASE_TID(); const int pos0 = item * 32;
    const float* w1 = F.in[I_FW1] + l * 33 * 64; const float* b1 = F.in[I_FB1] + l * 64;
    const float* w2 = F.in[I_FW2] + l * 64 * 64; const float* b2 = F.in[I_FB2] + l * 64;
    const float* w3 = F.in[I_FW3] + l * 64 * 64; const float* b3 = F.in[I_FB3] + l * 64;
    const float* fq = F.in[I_FFREQ] + l * 3 * 64;
    __syncthreads();
    for (int e = tid; e < 32 * 33; e += NTHR) {
        const int p = e / 33, f = e % 33, pos = pos0 + p; float v;
        if (f == 0) v = (float)pos / (float)(T - 1);
        else { const int band = (f - 1) & 15; const float fr = 1e-4f + (float)band * ((15.0f - 1e-4f) / 15.0f);
            float x = (float)pos * fr * (1.0f / (float)T); x -= floorf(x);
            v = (f <= 16) ? __builtin_amdgcn_cosf(x) : -__builtin_amdgcn_sinf(x); }
        Z[p * 36 + f] = v;
    }
    __syncthreads();
    const int j = tid & 63, pb = tid >> 6;
    { float wc[33];
#pragma unroll
      for (int f = 0; f < 33; ++f) wc[f] = w1[f * 64 + j];
      const float bj = b1[j], fj = fq[j];
#pragma unroll
      for (int i = 0; i < 4; ++i) { const int p = pb + 8 * i; float s = bj;
#pragma unroll
          for (int f = 0; f < 33; ++f) s += Z[p * 36 + f] * wc[f];
          H1[p * 64 + j] = sin_hw(fj * s); } }
    __syncthreads();
#pragma unroll 1
    for (int ly = 0; ly < 2; ++ly) { const float* w = ly ? w3 : w2; const float* bb = ly ? b3 : b2; const LAS float* Hi = ly ? H2 : H1; LAS float* Ho = ly ? H3 : H2;
        float wc[64];
#pragma unroll
        for (int f = 0; f < 64; ++f) wc[f] = w[f * 64 + j];
        const float bj = bb[j], fj = fq[64 + 64 * ly + j];
#pragma unroll
        for (int i = 0; i < 4; ++i) { const int p = pb + 8 * i; float s = bj;
#pragma unroll
            for (int q = 0; q < 16; ++q) { const f32x4 h = *(const LAS f32x4*)(Hi + p * 64 + 4 * q); s += (h[0] * wc[4 * q] + h[1] * wc[4 * q + 1]) + (h[2] * wc[4 * q + 2] + h[3] * wc[4 * q + 3]); }
            Ho[p * 64 + j] = sin_hw(fj * s); }
        __syncthreads(); }
    const int fr = lane & 15, fqd = lane >> 4;
    bf16x8 af[2][2];
#pragma unroll
    for (int mt = 0; mt < 2; ++mt)
#pragma unroll
        for (int ks = 0; ks < 2; ++ks) { const LAS float* hp = H3 + (16 * mt + fr) * 64 + 32 * ks + 8 * fqd; const f32x4 h0 = *(const LAS f32x4*)hp, h1 = *(const LAS f32x4*)(hp + 4);
            const float hv[8] = {h0[0], h0[1], h0[2], h0[3], h1[0], h1[1], h1[2], h1[3]}; af[mt][ks] = __builtin_bit_cast(bf16x8, pack8(hv)); }
    const float* wo = F.in[I_FWOUT] + (size_t)l * 64 * 2048;
    float* HF = (float*)(F.ws + WS_HF);
#pragma unroll 1
    for (int tb = 0; tb < 16; tb += 4) {
        bf16x8 bfr[4][2];
#pragma unroll
        for (int u = 0; u < 4; ++u)
#pragma unroll
            for (int ks = 0; ks < 2; ++ks) { float v[8]; const float* wp = wo + (size_t)(32 * ks + 8 * fqd) * 2048 + 256 * wave + 16 * (tb + u) + fr;
#pragma unroll
                for (int e = 0; e < 8; ++e) v[e] = wp[(size_t)e * 2048];
                bfr[u][ks] = __builtin_bit_cast(bf16x8, pack8(v)); }
#pragma unroll
        for (int u = 0; u < 4; ++u) { const int col = 256 * wave + 16 * (tb + u) + fr, c = col & 511;
            const float delta = 3.0701134573f + (float)c * ((15.350567286f - 3.0701134573f) / 511.0f);
#pragma unroll
            for (int mt = 0; mt < 2; ++mt) { f32x4 acc = (f32x4){0.f, 0.f, 0.f, 0.f};
                acc = MFMA16(af[mt][0], bfr[u][0], acc); acc = MFMA16(af[mt][1], bfr[u][1], acc);
                f32x4 o;
#pragma unroll
                for (int jj = 0; jj < 4; ++jj) { const float t = (float)(pos0 + 16 * mt + 4 * fqd + jj) / (float)(T - 1); o[jj] = acc[jj] * __expf(-t * delta); }
                *(f32x4*)(HF + (size_t)col * T + pos0 + 16 * mt + 4 * fqd) = o; } } }
}
__device__ __forceinline__ void p_filter(Frame& F, int l) { PHASE_TID(); (void)tid; for (int it = bid; it < T / 32; it += F.G) p_filter_item(F, l, it); __syncthreads(); }

template <bool F32IN> __device__ __forceinline__ void p_rmsnorm_q(Frame& F, const void* xin, const float* g, unsigned char* HQ, float* RSC, int m0, int m1) {
    PHASE_TID();
    const int gw = bid * NWAVES + wave, NGW = F.G * NWAVES;
    constexpr int R = F32IN ? 2 : 4;
    f32x4 gv[4];
#pragma unroll
    for (int j = 0; j < 4; ++j) gv[j] = F32IN ? *(const f32x4*)(g + 4 * lane + 256 * j) : *(const f32x4*)(g + 16 * lane + 4 * j);
    for (int mb = m0 + gw; mb < m1; mb += R * NGW) {
        f32x4 xf[F32IN ? R : 1][4]; v4u xw[F32IN ? 1 : R][2];
#pragma unroll
        for (int r = 0; r < R; ++r) { const int m = mb + r * NGW;
            if (F32IN) { const f32x4* xr = (const f32x4*)((const float*)xin + (size_t)m * D) + lane;
#pragma unroll
                for (int j = 0; j < 4; ++j) xf[r][j] = xr[64 * j]; }
            else { const v4u* xr = (const v4u*)((const bf16*)xin + (size_t)m * D + 16 * lane); xw[r][0] = xr[0]; xw[r][1] = xr[1]; } }
        asm volatile("" ::: "memory");
#pragma unroll
        for (int r = 0; r < R; ++r) { const int m = mb + r * NGW;
            f32x4 v[4]; float s = 0.f;
            if (F32IN) {
#pragma unroll
                for (int j = 0; j < 4; ++j) v[j] = xf[r][j]; }
            else { const unsigned ww[8] = {xw[r][0].x, xw[r][0].y, xw[r][0].z, xw[r][0].w, xw[r][1].x, xw[r][1].y, xw[r][1].z, xw[r][1].w};
#pragma unroll
                for (int j = 0; j < 4; ++j) v[j] = (f32x4){bflo(ww[2 * j]), bfhi(ww[2 * j]), bflo(ww[2 * j + 1]), bfhi(ww[2 * j + 1])}; }
#pragma unroll
            for (int j = 0; j < 4; ++j) s += (v[j].x * v[j].x + v[j].y * v[j].y) + (v[j].z * v[j].z + v[j].w * v[j].w);
            const float rstd = 1.0f / sqrtf(wave_sum(s) * (1.0f / D) + RMS_EPS);
            float am = 0.f;
#pragma unroll
            for (int j = 0; j < 4; ++j) { v[j] = v[j] * rstd * gv[j]; am = fmaxf(fmaxf(am, fmaxf(fabsf(v[j].x), fabsf(v[j].y))), fmaxf(fabsf(v[j].z), fabsf(v[j].w))); }
            am = wave_max(am);
            const float inv = am > 0.f ? 127.0f / am : 0.f;
            unsigned qd[4];
#pragma unroll
            for (int j = 0; j < 4; ++j) qd[j] = q4(v[j].x * inv, v[j].y * inv, v[j].z * inv, v[j].w * inv);
            if (F32IN) {
#pragma unroll
                for (int j = 0; j < 4; ++j) *(unsigned*)(HQ + (size_t)m * D + 256 * j + 4 * lane) = qd[j]; }
            else *(v4u*)(HQ + (size_t)m * D + 16 * lane) = (v4u){qd[0], qd[1], qd[2], qd[3]};
            if (lane == 0) RSC[m] = am * (1.0f / 127.0f); }
    }
}
__device__ __forceinline__ void p_rmsnorm_b16(Frame& F, const bf16* x, const float* g, bf16* out, int m0, int m1) {
    PHASE_TID();
    const int gw = bid * NWAVES + wave, NGW = F.G * NWAVES;
    f32x4 gv[4];
#pragma unroll
    for (int j = 0; j < 4; ++j) gv[j] = *(const f32x4*)(g + 16 * lane + 4 * j);
    for (int m = m0 + gw; m < m1; m += NGW) {
        const v4u* xr = (const v4u*)(x + (size_t)m * D + 16 * lane); const v4u w0 = xr[0], w1 = xr[1];
        const unsigned ww[8] = {w0.x, w0.y, w0.z, w0.w, w1.x, w1.y, w1.z, w1.w}; f32x4 v[4]; float s = 0.f;
#pragma unroll
        for (int j = 0; j < 4; ++j) { v[j] = (f32x4){bflo(ww[2 * j]), bfhi(ww[2 * j]), bflo(ww[2 * j + 1]), bfhi(ww[2 * j + 1])}; s += (v[j].x * v[j].x + v[j].y * v[j].y) + (v[j].z * v[j].z + v[j].w * v[j].w); }
        const float rstd = 1.0f / sqrtf(wave_sum(s) * (1.0f / D) + RMS_EPS);
        v4u o[2];
#pragma unroll
        for (int j = 0; j < 2; ++j) { const f32x4 ya = v[2 * j] * rstd * gv[2 * j], yb = v[2 * j + 1] * rstd * gv[2 * j + 1]; o[j].x = pk2(ya.x, ya.y); o[j].y = pk2(ya.z, ya.w); o[j].z = pk2(yb.x, yb.y); o[j].w = pk2(yb.z, yb.w); }
        v4u* op = (v4u*)(out + (size_t)m * D + 16 * lane); op[0] = o[0]; op[1] = o[1];
    }
}
__device__ __forceinline__ void p_finalnorm(Frame& F, const bf16* x, const float* g, float* out) {
    PHASE_TID();
    const int gw = bid * NWAVES + wave, NGW = F.G * NWAVES;
    constexpr int R = 4;
    f32x4 gv[4];
#pragma unroll
    for (int j = 0; j < 4; ++j) gv[j] = *(const f32x4*)(g + 4 * lane + 256 * j);
    for (int mb = gw; mb < M; mb += R * NGW) {
        v2u xw[R][4];
#pragma unroll
        for (int r = 0; r < R; ++r) { const v2u* xr = (const v2u*)(x + (size_t)(mb + r * NGW) * D) + lane;
#pragma unroll
            for (int j = 0; j < 4; ++j) xw[r][j] = xr[64 * j]; }
        asm volatile("" ::: "memory");
#pragma unroll
        for (int r = 0; r < R; ++r) { f32x4 v[4]; float s = 0.f;
#pragma unroll
            for (int j = 0; j < 4; ++j) { v[j] = (f32x4){bflo(xw[r][j].x), bfhi(xw[r][j].x), bflo(xw[r][j].y), bfhi(xw[r][j].y)}; s += (v[j].x * v[j].x + v[j].y * v[j].y) + (v[j].z * v[j].z + v[j].w * v[j].w); }
            const float rstd = 1.0f / sqrtf(wave_sum(s) * (1.0f / D) + RMS_EPS);
            f32x4* o = (f32x4*)(out + (size_t)(mb + r * NGW) * D) + lane;
#pragma unroll
            for (int j = 0; j < 4; ++j) o[64 * j] = v[j] * rstd * gv[j]; }
    }
}
template <bool F32OUT> __device__ __forceinline__ void p_rmsnorm(Frame& F, const float* x, const float* g, void* outp, int m0, int m1) {
    PHASE_TID();
    const int gw = bid * NWAVES + wave, NGW = F.G * NWAVES;
    f32x4 gv[4];
#pragma unroll
    for (int j = 0; j < 4; ++j) gv[j] = *(const f32x4*)(g + 4 * lane + 256 * j);
    for (int m = m0 + gw; m < m1; m += NGW) {
        const f32x4* xr = (const f32x4*)(x + (size_t)m * D) + lane; f32x4 v[4]; float s = 0.f;
#pragma unroll
        for (int j = 0; j < 4; ++j) { v[j] = xr[64 * j]; s += (v[j].x * v[j].x + v[j].y * v[j].y) + (v[j].z * v[j].z + v[j].w * v[j].w); }
        const float rstd = 1.0f / sqrtf(wave_sum(s) * (1.0f / D) + RMS_EPS);
        if (F32OUT) { f32x4* o = (f32x4*)((float*)outp + (size_t)m * D) + lane;
#pragma unroll
            for (int j = 0; j < 4; ++j) o[64 * j] = v[j] * rstd * gv[j]; }
        else { v2u* o = (v2u*)((bf16*)outp + (size_t)m * D) + lane;
#pragma unroll
            for (int j = 0; j < 4; ++j) { const f32x4 y = v[j] * rstd * gv[j]; v2u w; w.x = pk2(y.x, y.y); w.y = pk2(y.z, y.w); o[64 * j] = w; } }
    }
}

constexpr int KPAD = 2 * T + 2 * T / 16;

constexpr int LC = 32;

__device__ __forceinline__ void p_mix(Frame& F, int l) {
    { PHASE_TID(); (void)tid;
      cscan_chain(F, l, bid); }
    PHASE_TID();
    unsigned* head = F.ctl + CW_QUEUE + 64 * l;
    for (;;) {
        __syncthreads();
        if (tid == 0) F.MISC[16] = __hip_atomic_fetch_add(head, 1u, RLX_AGENT);
        __syncthreads();
        const unsigned it = F.MISC[16];
        if (it >= (unsigned)(4 * CH)) break;
        hy_fft_item(F, l, (int)it);
    }
    __syncthreads();
}

__device__ __forceinline__ void p_post(Frame& F, int l) {
    PHASE_TID();
    const int gw = bid * NWAVES + wave, NGW = F.G * NWAVES;
    bf16* YM = (bf16*)(F.ws + WS_YMIX);
    { LAS float* scr = (LAS float*)(F.lds + wave * 16640);
      const bf16* PHT = (const bf16*)(F.ws + WS_PHT); const float* ng = F.in[I_HNG] + (size_t)l * CH;
      for (int it = gw; it < NB * 8 * (T / 64); it += NGW) { const int tb = it & 127, g = (it >> 7) & 7, b = it >> 10, t0 = tb * 64;
          const bf16* src = PHT + ((size_t)b * HYP + CH + g * 64 + lane) * T + t0;
#pragma unroll
          for (int q = 0; q < 8; ++q) { const v4u w = *(const v4u*)(src + 8 * q); LAS float* d = scr + lane * 65 + 8 * q;
              d[0] = bflo(w.x); d[1] = bfhi(w.x); d[2] = bflo(w.y); d[3] = bfhi(w.y); d[4] = bflo(w.z); d[5] = bfhi(w.z); d[6] = bflo(w.w); d[7] = bfhi(w.w); }
          LDS_WAIT(); asm volatile("" ::: "memory");
          float z[64], ss = 0.f;
#pragma unroll
          for (int cc = 0; cc < 64; ++cc) { z[cc] = scr[cc * 65 + lane]; ss += z[cc] * z[cc]; }
          const float rs = 1.0f / sqrtf(ss * (1.0f / 64.0f) + RMS_EPS);
          bf16* dst = YM + ((size_t)b * T + t0 + lane) * D + g * 64;
#pragma unroll
          for (int q = 0; q < 8; ++q) { v4u o; const float* gq = ng + g * 64 + 8 * q;
              o.x = pk2(z[8 * q] * rs * gq[0], z[8 * q + 1] * rs * gq[1]); o.y = pk2(z[8 * q + 2] * rs * gq[2], z[8 * q + 3] * rs * gq[3]);
              o.z = pk2(z[8 * q + 4] * rs * gq[4], z[8 * q + 5] * rs * gq[5]); o.w = pk2(z[8 * q + 6] * rs * gq[6], z[8 * q + 7] * rs * gq[7]);
              *(v4u*)(dst + 8 * q) = o; }
          LDS_WAIT(); asm volatile("" ::: "memory"); } }
}

struct PostRows { v4u a, c, v, g; float bs; };
__device__ __forceinline__ void post_rows_load(PostRows& R, const bf16* YS0, const bf16* YS1, const bf16* VV, const bf16* GG, const float* BS0, const float* BS1, size_t m, int h, int ec) {
    const size_t o = m * CH + h * HD + ec;
    R.a = *(const v4u*)(YS0 + o); R.c = *(const v4u*)(YS1 + o); R.v = *(const v4u*)(VV + o); R.g = *(const v4u*)(GG + o); R.bs = BS0[m * NH + h] + BS1[m * NH + h];
}
__device__ __forceinline__ void p_postfix(Frame& F, int l) {
    PHASE_TID(); const int fr = lane & 15, fq = lane >> 4, mtw = wave >> 1, ntw = 2 * (wave & 1), et = tid >> 3, ec = (tid & 7) * 8;
    const int bh = bid >> 2, b = bh >> 3, h = bh & 7, tq = bid & 3, dfix = (tq >= 2) ? 0 : 1, chain = (b * NH + h) * 2 + dfix;
    const float* SF = (const float*)(F.ws + WS_SFIN) + (size_t)chain * 4096;
    bf16x8 sfb[2][2];
#pragma unroll
    for (int ks = 0; ks < 2; ++ks)
#pragma unroll
        for (int j = 0; j < 2; ++j) { const float* sp = SF + (16 * (ntw + j) + fr) * 64 + 32 * ks + 8 * fq; const f32x4 s0 = *(const f32x4*)sp, s1 = *(const f32x4*)(sp + 4);
            const float sv[8] = {s0[0], s0[1], s0[2], s0[3], s1[0], s1[1], s1[2], s1[3]}; sfb[ks][j] = __builtin_bit_cast(bf16x8, pack8(sv)); }
    const bf16* YP = (const bf16*)(F.ws + WS_YPHI) + ((size_t)chain * (T / 2) + 16 * mtw + fr) * 64 + 8 * fq;
    const bf16* YS0 = (const bf16*)(F.ws + WS_YS); const bf16* YS1 = YS0 + (size_t)M * CH;
    const bf16* VV = (l == 0) ? (const bf16*)(F.ws + WS_VFIRST) : (const bf16*)(F.ws + WS_V2);
    const bf16* GG = (const bf16*)(F.ws + WS_G); const float* BS0 = (const float*)(F.ws + WS_BS); const float* BS1 = BS0 + (size_t)M * NH;
    bf16* YM = (bf16*)(F.ws + WS_YMIX);
    float lg[8], lb[8];
#pragma unroll
    for (int j = 0; j < 8; ++j) { lg[j] = F.in[I_LNG][l * CH + h * HD + ec + j]; lb[j] = F.in[I_LNB][l * CH + h * HD + ec + j]; }
    LAS float* FX = (LAS float*)F.lds;
    const size_t mb = (size_t)b * T + 64 * (32 * tq) + et;
    __syncthreads();
    PostRows cur; bf16x8 acur[2];
    post_rows_load(cur, YS0, YS1, VV, GG, BS0, BS1, mb, h, ec);
#pragma unroll
    for (int ks = 0; ks < 2; ++ks) acur[ks] = *(const bf16x8*)(YP + (size_t)((32 * tq) & 63) * 64 * 64 + 32 * ks);
#pragma unroll 1
    for (int t = 0; t < 32; ++t) {
        PostRows nxt; bf16x8 anxt[2]; const int tn = (t + 1 < 32) ? t + 1 : t;
        post_rows_load(nxt, YS0, YS1, VV, GG, BS0, BS1, mb + 64 * tn, h, ec);
#pragma unroll
        for (int ks = 0; ks < 2; ++ks) anxt[ks] = *(const bf16x8*)(YP + (size_t)((32 * tq + tn) & 63) * 64 * 64 + 32 * ks);
        { f32x4 acc[2] = {(f32x4){0.f, 0.f, 0.f, 0.f}, (f32x4){0.f, 0.f, 0.f, 0.f}};
#pragma unroll
          for (int ks = 0; ks < 2; ++ks)
#pragma unroll
              for (int j = 0; j < 2; ++j) acc[j] = MFMA16(sfb[ks][j], acur[ks], acc[j]);
          LAS float* fx = FX + (t & 1) * 64 * 68 + (16 * mtw + fr) * 68 + 16 * ntw + 4 * fq;
          *(LAS f32x4*)fx = acc[0]; *(LAS f32x4*)(fx + 16) = acc[1]; }
        __syncthreads();
        { const LAS float* fx = FX + (t & 1) * 64 * 68 + et * 68 + ec; const f32x4 f0 = *(const LAS f32x4*)fx, f1 = *(const LAS f32x4*)(fx + 4);
          const float fv[8] = {f0[0], f0[1], f0[2], f0[3], f1[0], f1[1], f1[2], f1[3]};
          const unsigned aw[4] = {cur.a.x, cur.a.y, cur.a.z, cur.a.w}, cw[4] = {cur.c.x, cur.c.y, cur.c.z, cur.c.w}, vx[4] = {cur.v.x, cur.v.y, cur.v.z, cur.v.w}, gx[4] = {cur.g.x, cur.g.y, cur.g.z, cur.g.w};
          float sv[8], sum = 0.f;
#pragma unroll
          for (int j = 0; j < 4; ++j) { sv[2 * j] = bflo(aw[j]) + bflo(cw[j]) + fv[2 * j]; sv[2 * j + 1] = bfhi(aw[j]) + bfhi(cw[j]) + fv[2 * j + 1]; sum += sv[2 * j] + sv[2 * j + 1]; }
          const float mean = sum8(sum) * (1.0f / 64.0f); float q = 0.f;
#pragma unroll
          for (int j = 0; j < 8; ++j) { sv[j] -= mean; q += sv[j] * sv[j]; }
          const float rs = 1.0f / sqrtf(sum8(q) * (1.0f / 64.0f) + GN_EPS);
          float y[8];
#pragma unroll
          for (int j = 0; j < 4; ++j) { y[2 * j] = (sv[2 * j] * rs * lg[2 * j] + lb[2 * j] + cur.bs * bflo(vx[j])) * bflo(gx[j]);
                                        y[2 * j + 1] = (sv[2 * j + 1] * rs * lg[2 * j + 1] + lb[2 * j + 1] + cur.bs * bfhi(vx[j])) * bfhi(gx[j]); }
          v4u ov; ov.x = pk2(y[0], y[1]); ov.y = pk2(y[2], y[3]); ov.z = pk2(y[4], y[5]); ov.w = pk2(y[6], y[7]);
          *(v4u*)(YM + (mb + 64 * t) * D + CH + h * HD + ec) = ov; }
        cur = nxt; acur[0] = anxt[0]; acur[1] = anxt[1];
    }
    __syncthreads();
}
__device__ __forceinline__ int obid() { int b = blockIdx.x; asm volatile("" : "+s"(b)); return b; }
struct Args { const float* in[34]; float* out; unsigned char* ws; int ph_lo, ph_hi; };
__global__ void __launch_bounds__(NTHR, 2) enc_fwd(Args args) {
    extern __shared__ __attribute__((aligned(16))) unsigned char lds[];
    Frame F;
    F.lds = (LAS unsigned char*)lds;
    F.MISC = (volatile LAS unsigned*)(F.lds + LDSCTL_OFF);
    F.G = gridDim.x;
    F.ws = args.ws; F.out = args.out; F.ctl = (unsigned*)(args.ws + WS_CTL);
    F.in = args.in;
    for (int u = threadIdx.x; u < (LDS_BYTES - LDSCTL_OFF) / 4; u += NTHR) F.MISC[u] = 0u;
    __syncthreads();
    const XcdBarrier bar = xcd_barrier_post(F.ctl + CW_BAR, F.MISC + 8);
#define SEAM() xcd_barrier(bar)

    bf16* HN = (bf16*)(F.ws + WS_HN);
    float* RSS = (float*)(F.ws + WS_RSS);
    unsigned char* HQ = F.ws + WS_HN; float* RSC = (float*)(F.ws + WS_RSC);
    p_convert(F); __syncthreads(); p_filter(F, 0); p_rmsnorm_q<true>(F, F.in[I_X], F.in[I_N1G], HQ, RSC, 0, M / 2);
    SEAM();
    p_wquant(F);
    SEAM();
#pragma unroll 1
    for (int l = 0; l < NL; ++l) {
        unsigned char* wb = F.ws + WS_W + (size_t)l * W_LAYER;
        bf16* X2B = (bf16*)F.out;
        {
#pragma unroll 1
            for (int hf = 0; hf < 2; ++hf) { constexpr int MH = M / 2; const size_t r0 = (size_t)hf * MH;
                if (hf == 0) p_spectra(F);
                const float* CSC = (const float*)(F.ws + WS_CSC) + l * (HYP + NRW);
                { pg8::Gemm g{(const bf16*)(wb + W_HY), (const bf16*)(HQ + r0 * D), HYP, MH, D / 2}; pg8::StaticOrder S; S.init(HYP, MH, F.G, obid());
                  pg8::EpiBf16Q E{(bf16*)(F.ws + WS_PHT) + (size_t)(4 * hf) * HYP * T, (size_t)T, (size_t)HYP * T, 13, CSC, RSC + r0};
                  pg8::gemm_phase<pg8::EpiBf16Q, pg8::StaticOrder, true, true>(F.lds, g, S, E); }
                { pg8::Gemm g{(const bf16*)(HQ + r0 * D), (const bf16*)(wb + W_RW), MH, NRW, D / 2}; pg8::StaticOrder S; S.init(MH, NRW, F.G, obid());
                  pg8::EpiBf16Q E{(bf16*)(F.ws + WS_PRW) + r0 * NRW, (size_t)NRW, 0, 31, RSC + r0, CSC + HYP};
                  pg8::gemm_phase<pg8::EpiBf16Q, pg8::StaticOrder, true, true>(F.lds, g, S, E); }
                if (hf == 0) { if (l == 0) p_rmsnorm_q<true>(F, F.in[I_X], F.in[I_N1G], HQ, RSC, MH, M); else p_rmsnorm_q<false>(F, X2B, F.in[I_N1G] + (size_t)l * D, HQ, RSC, MH, M);
                    SEAM(); } }
        }
        SEAM();
        p_mix(F, l);
        SEAM();
        { p_post(F, l); p_postfix(F, l); }
        SEAM();
        {
            if (l + 1 < NL) p_filter(F, l + 1);
            pg8::Gemm g{(const bf16*)(F.ws + WS_YMIX), (const bf16*)(wb + W_O), M, D, D}; pg8::StaticOrder S; S.init(M, D, F.G, obid());
            if (l == 0) { pg8::EpiRes<1, false> E{F.in[I_X], nullptr, HN, D, RSS}; pg8::gemm_phase<pg8::EpiRes<1, false>, pg8::StaticOrder, true, true>(F.lds, g, S, E); }
            else { pg8::EpiRes<1, true> E{nullptr, X2B, HN, D, RSS}; pg8::gemm_phase<pg8::EpiRes<1, true>, pg8::StaticOrder, true, true>(F.lds, g, S, E); }
        }
        SEAM();
#pragma unroll 1
        for (int ck = 0; ck < MLP_CHUNKS; ++ck) { constexpr int MC = M / MLP_CHUNKS; const size_t r0 = (size_t)ck * MC;
            bf16* HIDc = (bf16*)(F.ws + WS_HID + (size_t)(ck & 1) * MC * FF * 2);
            {
                pg8::Gemm g{HN + r0 * D, (const bf16*)(wb + W_1), MC, FF, D}; pg8::StaticOrder S; S.init(MC, FF, F.G, obid());
                pg8::EpiBf16<1> E{HIDc, (size_t)FF};
                pg8::gemm_phase<pg8::EpiBf16<1>, pg8::StaticOrder, true, true>(F.lds, g, S, E);
            }
            SEAM();
            {
                pg8::Gemm g{HIDc, (const bf16*)(wb + W_2), MC, D, FF}; pg8::StaticOrder S; S.init(MC, D, F.G, obid());
                pg8::EpiRes<2, true> E{nullptr, HN + r0 * D, ((l + 1 < NL) ? X2B : HN) + r0 * D, D, RSS + r0 * 16};
                pg8::gemm_phase<pg8::EpiRes<2, true>, pg8::StaticOrder, true, true>(F.lds, g, S, E);
            }
            if (ck == MLP_CHUNKS - 1 && l + 1 < NL) p_rmsnorm_q<false>(F, X2B, F.in[I_N1G] + (size_t)(l + 1) * D, HQ, RSC, 0, M / 2);
        }
        SEAM();
        if (l + 1 == NL) p_finalnorm(F, HN, F.in[I_FING], F.out);
    }
#undef SEAM
}

extern "C" void kernel_launch(void* const* d_in, const int* in_sizes, int n_in, void* d_out, int out_size, void* d_ws, size_t ws_size, hipStream_t stream) {
    static int grid = 0;
    if (grid == 0) {
        if (n_in != 34 || in_sizes[0] != M * D || out_size != M * D || ws_size < WS_END) {
            fprintf(stderr, "kernel_launch: unexpected problem: n_in %d in0 %d out %d ws %zu (need %zu); nothing launched\n", n_in, n_in > 0 ? in_sizes[0] : -1, out_size, ws_size, (size_t)WS_END); grid = -1; return; }
        int dev = 0, cus = 0, per_cu = 0;
        if (hipGetDevice(&dev) != hipSuccess || hipDeviceGetAttribute(&cus, hipDeviceAttributeMultiprocessorCount, dev) != hipSuccess) { grid = -1; return; }
        if (hipFuncSetAttribute((const void*)enc_fwd, hipFuncAttributeMaxDynamicSharedMemorySize, LDS_BYTES) != hipSuccess) { fprintf(stderr, "kernel_launch: hipFuncSetAttribute failed\n"); grid = -1; return; }
        if (hipOccupancyMaxActiveBlocksPerMultiprocessor(&per_cu, (const void*)enc_fwd, NTHR, LDS_BYTES) != hipSuccess || per_cu < 1)
            fprintf(stderr, "kernel_launch: note: occupancy query reports %d workgroups per CU\n", per_cu);
        (void)hipGetLastError();
        grid = cus;
        if (grid != 256) { fprintf(stderr, "kernel_launch: built for a 256-CU device (got %d); nothing launched\n", cus); grid = -1; return; }
    }
    if (grid < 0) return;
    if (hipMemsetAsync((char*)d_ws + WS_CTL, 0, CTL_ZERO_BYTES, stream) != hipSuccess) return;
    Args a{};
    for (int i = 0; i < 34; ++i) a.in[i] = (const float*)d_in[i];
    a.out = (float*)d_out; a.ws = (unsigned char*)d_ws;
    a.ph_lo = 0; a.ph_hi = 0;
    hipLaunchKernelGGL(enc_fwd, dim3(grid), dim3(NTHR), LDS_BYTES, stream, a);
}
```
